# Optimizing an MI355X kernel written in HIP

```python
import math
import jax, jax.numpy as jnp
from jax import lax
import numpy as np

D_MODEL = 1024
BATCH = 2
SEQ = 8192
DEPTH = 2

CHUNK = 64
D_MIX = D_MODEL
A_HEADS = 6
A_HEAD_DIM = 64
A_WIDTH = A_HEADS * A_HEAD_DIM
A_W_LORA = 32
A_A_LORA = 32
A_G_LORA = 64
A_V_LORA = 16
RWKV_GN_EPS = 64e-5
B_HEADS = 6
B_NOPE = 64
B_ROPE = 32
B_QK = B_NOPE + B_ROPE
B_V = 64
B_WIDTH = B_HEADS * B_V
B_Q_LORA = 256
B_KV_LORA = 128
ROPE_THETA = 10000.0
Q_BLOCK = 128
C_GROUPS = 4
C_GROUP_DIM = 64
C_WIDTH = C_GROUPS * C_GROUP_DIM
C_BLOCK = 128
A_SPLITS = (A_WIDTH, 2 * A_WIDTH, 3 * A_WIDTH, 3 * A_WIDTH + A_W_LORA, 3 * A_WIDTH + A_W_LORA + A_A_LORA)
A_COLS = 3 * A_WIDTH + A_W_LORA + A_A_LORA + A_G_LORA
B_COLS = B_Q_LORA + B_KV_LORA + B_ROPE
C_COLS = 2 * C_WIDTH
IN_COLS = A_COLS + B_COLS + C_COLS
D_FF_DENSE = 2816
N_EXPERTS = 8
TOP_K = 2
D_FF_EXPERT = 3584
N_DENSE = (DEPTH + 1) // 2
N_MOE = DEPTH // 2
N_VRES = DEPTH - 1
EPS = 1e-6

kernel_name = 'hybrid_rwkv7_mla_gmlp_moe_trunk'


def rms_norm(x, g, eps=EPS):
    xf = x.astype(jnp.float32)
    y = xf * lax.rsqrt(jnp.mean(xf * xf, axis=-1, keepdims=True) + eps)
    return (y * g.astype(jnp.float32)).astype(x.dtype)


def layer_norm(x, g, b, eps=EPS):
    xf = x.astype(jnp.float32)
    mu = jnp.mean(xf, axis=-1, keepdims=True)
    var = jnp.mean(jnp.square(xf - mu), axis=-1, keepdims=True)
    y = (xf - mu) * lax.rsqrt(var + eps) * g.astype(jnp.float32) + b.astype(jnp.float32)
    return y.astype(x.dtype)


def token_shift(y, mu):
    prev = jnp.pad(y, ((0, 0), (1, 0), (0, 0)))[:, :-1]
    return y + (prev - y) * mu


def rwkv7_time_mix(za, shift_mu, w0, w_up, a0, a_up, g_up, k_k, k_a, r_k, ln_g, ln_b,
                   v_first, v0, v_down, v_up):
    B_, S_, _ = za.shape
    za = token_shift(za, shift_mu)
    r, k, v, wd, ad, gd = jnp.split(za, A_SPLITS, axis=-1)
    w_log = -jax.nn.softplus(-(w0 + jnp.tanh(wd) @ w_up)) - 0.5
    decay = jnp.exp(-jnp.exp(w_log.astype(jnp.float32)))
    a = jax.nn.sigmoid(a0 + ad @ a_up)
    g = jax.nn.sigmoid(gd) @ g_up
    if v_first is not None:
        v = v + (v_first - v) * jax.nn.sigmoid(v0 + (v @ v_down) @ v_up)
    heads = lambda t: t.reshape(B_, S_, A_HEADS, A_HEAD_DIM).astype(jnp.float32)
    kk = heads(k * k_k)
    kk = kk / jnp.maximum(jnp.sqrt(jnp.sum(kk * kk, axis=-1, keepdims=True)), 1e-12)
    k = k * (1 + (a - 1) * k_a)
    rh, kh, vh, ah, wh = heads(r), heads(k), heads(v), heads(a), heads(decay)

    def step(state, inp):
        r_t, w_t, k_t, v_t, kk_t, a_t = inp
        sa = jnp.einsum('bhvk,bhk->bhv', state, -kk_t)
        state = (state * w_t[:, :, None, :]
                 + sa[..., None] * (kk_t * a_t)[:, :, None, :]
                 + v_t[..., None] * k_t[:, :, None, :])
        return state, jnp.einsum('bhvk,bhk->bhv', state, r_t)

    xs = tuple(jnp.swapaxes(t, 0, 1) for t in (rh, wh, kh, vh, kk, ah))
    state0 = jnp.zeros((B_, A_HEADS, A_HEAD_DIM, A_HEAD_DIM), jnp.float32)
    _, y = lax.scan(step, state0, xs)
    y = jnp.swapaxes(y, 0, 1)
    mu = jnp.mean(y, axis=-1, keepdims=True)
    var = jnp.mean(jnp.square(y - mu), axis=-1, keepdims=True)
    y = (y - mu) * lax.rsqrt(var + RWKV_GN_EPS)
    y = (y * ln_g.reshape(A_HEADS, A_HEAD_DIM).astype(jnp.float32)
         + ln_b.reshape(A_HEADS, A_HEAD_DIM).astype(jnp.float32))
    y = y + jnp.sum(rh * kh * r_k.astype(jnp.float32), axis=-1, keepdims=True) * vh
    y = y.reshape(B_, S_, A_WIDTH).astype(za.dtype) * g
    return y, v


def apply_rope(t, cos, sin):
    half = B_ROPE // 2
    t1, t2 = t[..., :half], t[..., half:]
    return jnp.concatenate([t1 * cos - t2 * sin, t1 * sin + t2 * cos], axis=-1)


def mla_attention(zb, positions, q_norm_g, w_uq, kv_norm_g, w_ukv, q_head_g, k_head_g, out_g):
    B_, S_, _ = zb.shape
    cq, ckv, kr = jnp.split(zb, (B_Q_LORA, B_Q_LORA + B_KV_LORA), axis=-1)
    q = (rms_norm(cq, q_norm_g) @ w_uq).reshape(B_, S_, B_HEADS, B_QK)
    kv = (rms_norm(ckv, kv_norm_g) @ w_ukv).reshape(B_, S_, B_HEADS, B_NOPE + B_V)
    k_nope, v = kv[..., :B_NOPE], kv[..., B_NOPE:]
    k = jnp.concatenate([k_nope, jnp.broadcast_to(kr[:, :, None, :], (B_, S_, B_HEADS, B_ROPE))], axis=-1)
    q = rms_norm(q, q_head_g)
    k = rms_norm(k, k_head_g)
    inv_freq = ROPE_THETA ** (-jnp.arange(0, B_ROPE, 2, dtype=jnp.float32) / B_ROPE)
    ang = positions.astype(jnp.float32)[..., None] * inv_freq
    cos = jnp.cos(ang)[:, :, None, :].astype(q.dtype)
    sin = jnp.sin(ang)[:, :, None, :].astype(q.dtype)
    q = jnp.concatenate([q[..., :B_NOPE], apply_rope(q[..., B_NOPE:], cos, sin)], axis=-1)
    k = jnp.concatenate([k[..., :B_NOPE], apply_rope(k[..., B_NOPE:], cos, sin)], axis=-1)
    q = jnp.transpose(q, (0, 2, 1, 3))
    k = jnp.transpose(k, (0, 2, 1, 3))
    v = jnp.transpose(v, (0, 2, 1, 3))
    n_blocks = S_ // Q_BLOCK
    qb = jnp.transpose(q.reshape(B_, B_HEADS, n_blocks, Q_BLOCK, B_QK), (2, 0, 1, 3, 4))
    key_chunk = jnp.arange(S_) // CHUNK
    scale = 1.0 / math.sqrt(B_QK)

    def block(args):
        q_blk, i = args
        s = jnp.einsum('bhqd,bhkd->bhqk', q_blk, k).astype(jnp.float32) * scale
        q_chunk = (i * Q_BLOCK + jnp.arange(Q_BLOCK)) // CHUNK
        s = jnp.where(key_chunk[None, :] <= q_chunk[:, None], s, -jnp.inf)
        p = jax.nn.softmax(s, axis=-1).astype(v.dtype)
        return jnp.einsum('bhqk,bhkd->bhqd', p, v)

    o = lax.map(block, (qb, jnp.arange(n_blocks)))
    o = jnp.transpose(o, (1, 0, 3, 2, 4)).reshape(B_, S_, B_WIDTH)
    return rms_norm(o, out_g)


def gmlp_spatial_gate(zc, ln_g, ln_b, w_s, b_s, out_g):
    B_, S_, _ = zc.shape
    z = jax.nn.gelu(zc, approximate=False)
    u, v = jnp.split(z, 2, axis=-1)
    v = layer_norm(v, ln_g, ln_b)
    vb = v.reshape(B_, S_ // C_BLOCK, C_BLOCK, C_GROUPS, C_GROUP_DIM)
    tri = jnp.tril(jnp.ones((C_BLOCK, C_BLOCK), dtype=bool))
    w = jnp.where(tri[None], w_s, 0)
    sv = jnp.einsum('gts,bnsgc->bntgc', w, vb) + jnp.transpose(b_s)[None, None, :, :, None]
    y = u * sv.reshape(B_, S_, C_WIDTH)
    return rms_norm(y, out_g)


def swiglu(h, wg, wu, wd):
    return (jax.nn.silu(h @ wg) * (h @ wu)) @ wd


def moe_swiglu(h, router, wg, wu, wd):
    B_, S_, D_ = h.shape
    t = h.reshape(B_ * S_, D_)
    logits = (t @ router).astype(jnp.float32)
    top_v, top_i = lax.top_k(logits, TOP_K)
    gates = jax.nn.softmax(top_v, axis=-1)
    gate_full = jnp.sum(jax.nn.one_hot(top_i, N_EXPERTS, dtype=jnp.float32) * gates[..., None], axis=1)
    out = jnp.zeros_like(t)
    for e in range(N_EXPERTS):
        out = out + gate_full[:, e:e + 1].astype(t.dtype) * swiglu(t, wg[e], wu[e], wd[e])
    return out.reshape(B_, S_, D_)


def setup_inputs(seed: int = 0) -> dict:
    key = jax.random.key(seed)
    ks = iter(jax.random.split(key, 64))
    nrm = lambda shape, scale: jax.random.normal(next(ks), shape, jnp.float32) * scale
    gain = lambda shape: 1.0 + nrm(shape, 0.05)
    offs = jax.random.randint(next(ks), (BATCH, 1), 0, 64) * CHUNK
    positions = (offs + jnp.arange(SEQ, dtype=jnp.int32)[None, :]).astype(jnp.int32)
    return {
        'x': nrm((BATCH, SEQ, D_MODEL), 1.0),
        'positions': positions,
        'mix_norm_g': gain((DEPTH, D_MODEL)),
        'w_in': nrm((DEPTH, D_MODEL, IN_COLS), D_MODEL ** -0.5),
        'shift_mu': jax.random.uniform(next(ks), (DEPTH, A_COLS), jnp.float32, 0.1, 0.9),
        'a_w0': jax.random.uniform(next(ks), (DEPTH, A_WIDTH), jnp.float32, -6.0, 1.0),
        'a_w_up': nrm((DEPTH, A_W_LORA, A_WIDTH), 0.1 * A_W_LORA ** -0.5),
        'a_a0': nrm((DEPTH, A_WIDTH), 0.5),
        'a_a_up': nrm((DEPTH, A_A_LORA, A_WIDTH), 0.1 * A_A_LORA ** -0.5),
        'a_g_up': nrm((DEPTH, A_G_LORA, A_WIDTH), A_G_LORA ** -0.5),
        'a_k_k': 0.85 + nrm((DEPTH, A_WIDTH), 0.1),
        'a_k_a': 1.0 + nrm((DEPTH, A_WIDTH), 0.1),
        'a_r_k': nrm((DEPTH, A_HEADS, A_HEAD_DIM), 0.1),
        'a_ln_g': gain((DEPTH, A_WIDTH)),
        'a_ln_b': nrm((DEPTH, A_WIDTH), 0.02),
        'a_v0': nrm((N_VRES, A_WIDTH), 0.5),
        'a_v_down': nrm((N_VRES, A_WIDTH, A_V_LORA), A_WIDTH ** -0.5),
        'a_v_up': nrm((N_VRES, A_V_LORA, A_WIDTH), 0.1 * A_V_LORA ** -0.5),
        'b_q_norm_g': gain((DEPTH, B_Q_LORA)),
        'b_w_uq': nrm((DEPTH, B_Q_LORA, B_HEADS * B_QK), B_Q_LORA ** -0.5),
        'b_kv_norm_g': gain((DEPTH, B_KV_LORA)),
        'b_w_ukv': nrm((DEPTH, B_KV_LORA, B_HEADS * (B_NOPE + B_V)), B_KV_LORA ** -0.5),
        'b_q_head_g': gain((DEPTH, B_QK)),
        'b_k_head_g': gain((DEPTH, B_QK)),
        'b_out_g': gain((DEPTH, B_WIDTH)),
        'c_ln_g': gain((DEPTH, C_WIDTH)),
        'c_ln_b': nrm((DEPTH, C_WIDTH), 0.02),
        'c_w_s': nrm((DEPTH, C_GROUPS, C_BLOCK, C_BLOCK), 0.5 * C_BLOCK ** -0.5),
        'c_b_s': 1.0 + nrm((DEPTH, C_GROUPS, C_BLOCK), 0.1),
        'c_out_g': gain((DEPTH, C_WIDTH)),
        'w_out': nrm((DEPTH, D_MIX, D_MODEL), D_MIX ** -0.5),
        'ffn_norm_g': gain((DEPTH, D_MODEL)),
        'dense_w_gate': nrm((N_DENSE, D_MODEL, D_FF_DENSE), D_MODEL ** -0.5),
        'dense_w_up': nrm((N_DENSE, D_MODEL, D_FF_DENSE), D_MODEL ** -0.5),
        'dense_w_down': nrm((N_DENSE, D_FF_DENSE, D_MODEL), D_FF_DENSE ** -0.5),
        'moe_router': nrm((N_MOE, D_MODEL, N_EXPERTS), D_MODEL ** -0.5),
        'moe_w_gate': nrm((N_MOE, N_EXPERTS, D_MODEL, D_FF_EXPERT), D_MODEL ** -0.5),
        'moe_w_up': nrm((N_MOE, N_EXPERTS, D_MODEL, D_FF_EXPERT), D_MODEL ** -0.5),
        'moe_w_down': nrm((N_MOE, N_EXPERTS, D_FF_EXPERT, D_MODEL), D_FF_EXPERT ** -0.5),
    }


def reference(x, positions, mix_norm_g, w_in, shift_mu, a_w0, a_w_up, a_a0, a_a_up, a_g_up,
              a_k_k, a_k_a, a_r_k, a_ln_g, a_ln_b, a_v0, a_v_down, a_v_up,
              b_q_norm_g, b_w_uq, b_kv_norm_g, b_w_ukv, b_q_head_g, b_k_head_g, b_out_g,
              c_ln_g, c_ln_b, c_w_s, c_b_s, c_out_g, w_out, ffn_norm_g,
              dense_w_gate, dense_w_up, dense_w_down, moe_router, moe_w_gate, moe_w_up, moe_w_down):
    v_first = None
    for l in range(DEPTH):
        h = rms_norm(x, mix_norm_g[l])
        z = h @ w_in[l]
        za, zb, zc = jnp.split(z, (A_COLS, A_COLS + B_COLS), axis=-1)
        if l > 0:
            vres = (a_v0[l - 1], a_v_down[l - 1], a_v_up[l - 1])
        else:
            vres = (None, None, None)
        ya, v_l = rwkv7_time_mix(za, shift_mu[l], a_w0[l], a_w_up[l], a_a0[l], a_a_up[l], a_g_up[l],
                                 a_k_k[l], a_k_a[l], a_r_k[l], a_ln_g[l], a_ln_b[l], v_first, *vres)
        if l == 0:
            v_first = v_l
        yb = mla_attention(zb, positions, b_q_norm_g[l], b_w_uq[l], b_kv_norm_g[l], b_w_ukv[l],
                           b_q_head_g[l], b_k_head_g[l], b_out_g[l])
        yc = gmlp_spatial_gate(zc, c_ln_g[l], c_ln_b[l], c_w_s[l], c_b_s[l], c_out_g[l])
        x = x + jnp.concatenate([ya, yb, yc], axis=-1) @ w_out[l]
        h = rms_norm(x, ffn_norm_g[l])
        if l % 2 == 0:
            i = l // 2
            x = x + swiglu(h, dense_w_gate[i], dense_w_up[i], dense_w_down[i])
        else:
            i = l // 2
            x = x + moe_swiglu(h, moe_router[i], moe_w_gate[i], moe_w_up[i], moe_w_down[i])
    return x
```

```cpp
#include <hip/hip_runtime.h>
#include <cstdio>
#include <cstdint>
#include <cmath>
namespace pg8 {
#define PG8_LAS __attribute__((address_space(3)))
typedef unsigned short bf16_t;
typedef short bf16x8 __attribute__((ext_vector_type(8)));
typedef float f32x4 __attribute__((ext_vector_type(4)));
typedef unsigned u32x4 __attribute__((ext_vector_type(4)));
constexpr int BM = 256, BK = 64, HALF = 128, HTB = HALF * BK * 2  , STAGE_BYTES = 8 * HTB, NXCD = 8, WGM = 8;

__host__ __device__ __forceinline__ int lds_byte(int r, int c) { const int st = (r >> 4) * 2 + (c >> 5), rr = r & 15, cc = c & 31, ob = rr * 64 + cc * 2; return st * 1024 + (ob ^ (((ob >> 9) & 1) << 5)); }
__host__ __device__ __forceinline__ void stage_rc(int b, int& R, int& C) { const int st = b / 1024, sb = b % 1024, swz = sb ^ (((sb >> 9) & 1) << 5); R = (st >> 1) * 16 + swz / 64; C = (st & 1) * 32 + (swz % 64) / 2; }
__host__ __device__ __forceinline__ int perm32(int rho) { const int n = rho >> 4, i = rho & 15; return 8 * (i >> 2) + 4 * n + (i & 3); }

struct Unit { int pm, pn; };
struct Gemm { const bf16_t* A; const bf16_t* Bt; int M, N, K; };

struct StaticOrder {
    int nM, nN, nwg, G, c;
    __host__ __device__ void init(int M, int N, int G_, int c_) { nM = M / BM; nN = N / BM; nwg = nM * nN; G = G_; c = c_; }
    __host__ __device__ bool next(int i, Unit& u) const {
        const long L = (long)i * G + c; if (L >= nwg) return false;
        int wgid = (int)L; { const int q = nwg / NXCD, r = nwg % NXCD, xcd = wgid % NXCD, off = wgid / NXCD; wgid = (xcd < r ? xcd * (q + 1) : r * (q + 1) + (xcd - r) * q) + off; }
        const int nig = WGM * nN, gid = wgid / nig, fm = gid * WGM, gsz = (nM - fm) < WGM ? (nM - fm) : WGM;
        u.pm = fm + ((wgid % nig) % gsz); u.pn = (wgid % nig) / gsz; return true;
    }
    __device__ __forceinline__ void a_ready(const Unit&) const {}
    __device__ __forceinline__ void done(const Unit&) const {}
};

__device__ __forceinline__ unsigned cvt_pk_bf16(float lo, float hi) { unsigned r; asm volatile("v_cvt_pk_bf16_f32 %0, %1, %2" : "=v"(r) : "v"(lo), "v"(hi)); return r; }
typedef float f32x2 __attribute__((ext_vector_type(2)));
__device__ __forceinline__ f32x2 gelu_pk(f32x2 v) {
    const f32x2 av = __builtin_elementwise_abs(v), d = av * 0.2316418882f + 1.0f;
    f32x2 t; t.x = __builtin_amdgcn_rcpf(d.x); t.y = __builtin_amdgcn_rcpf(d.y);
    f32x2 q = t * 0.5307027145f + (-0.7265760135f); q = q * t + 0.7107068705f; q = q * t + (-0.142248368f); q = q * t + 0.127414796f; q = q * t;
    const f32x2 s = (v * v) * (-0.72134752044f);
    f32x2 e; e.x = __builtin_amdgcn_exp2f(s.x); e.y = __builtin_amdgcn_exp2f(s.y);
    const f32x2 m = v * (q * e), r = v - m;
    f32x2 o; o.x = v.x < 0.f ? m.x : r.x; o.y = v.y < 0.f ? m.y : r.y; return o;
}

template <int ACT  > struct EpiBf16 {
    static constexpr bool PERM = true, AFTER_DRAIN = false; static_assert(ACT == 0 || ACT == 1, "EpiBf16: ACT is 0 (none) or 1 (gelu_pk)");
    bf16_t* O; int ldc; const float* bias; int split_cols; size_t split_stride; float scale0;
    __device__ __forceinline__ void operator()(const f32x4 (&acc)[2][2][4][2], const Unit& u, int wr, int wc, int fr, int fq) const {
        const int row0 = u.pm * BM + wr * 64 + fr; int colt = u.pn * BM; bf16_t* base = O;
        float sc = 1.f; if (split_cols) { const int t = colt / split_cols; base += (size_t)t * split_stride; colt -= t * split_cols; if (t == 0) sc = scale0; }
        const int col0 = colt + wc * 32 + 8 * fq, bcol0 = u.pn * BM + wc * 32 + 8 * fq;
        f32x4 bv[2][2];
#pragma unroll
        for (int bj = 0; bj < 2; ++bj)
#pragma unroll
            for (int n = 0; n < 2; ++n) bv[bj][n] = bias ? *(const f32x4*)(bias + bcol0 + bj * HALF + 4 * n) : (f32x4){0.f, 0.f, 0.f, 0.f};
#pragma unroll
        for (int ai = 0; ai < 2; ++ai)
#pragma unroll
            for (int m = 0; m < 4; ++m) { bf16_t* rowp = base + (size_t)(row0 + ai * HALF + m * 16) * ldc + col0;
#pragma unroll
                for (int bj = 0; bj < 2; ++bj) { f32x4 v0 = acc[ai][bj][m][0] + bv[bj][0], v1 = acc[ai][bj][m][1] + bv[bj][1];
                    if (ACT == 1) { f32x2 a = gelu_pk((f32x2){v0[0], v0[1]}), b = gelu_pk((f32x2){v0[2], v0[3]}), c = gelu_pk((f32x2){v1[0], v1[1]}), d = gelu_pk((f32x2){v1[2], v1[3]});
                        v0 = (f32x4){a.x, a.y, b.x, b.y}; v1 = (f32x4){c.x, c.y, d.x, d.y}; }
                    v0 = v0 * sc; v1 = v1 * sc; u32x4 w; w.x = cvt_pk_bf16(v0[0], v0[1]); w.y = cvt_pk_bf16(v0[2], v0[3]); w.z = cvt_pk_bf16(v1[0], v1[1]); w.w = cvt_pk_bf16(v1[2], v1[3]);
                    *(u32x4*)(rowp + bj * HALF) = w; } }
    }
};

struct EpiResF32 {
    static constexpr bool PERM = false, AFTER_DRAIN = false;
    const float* base; float* out; int ldc;
    __device__ __forceinline__ void operator()(const f32x4 (&acc)[2][2][4][2], const Unit& u, int wr, int wc, int fr, int fq) const {
        const int row0 = u.pm * BM + wr * 64 + fr, col0 = u.pn * BM + wc * 32 + 4 * fq;
#pragma unroll
        for (int ai = 0; ai < 2; ++ai)
#pragma unroll
            for (int m = 0; m < 4; ++m) { const size_t off = (size_t)(row0 + ai * HALF + m * 16) * ldc + col0;
#pragma unroll
                for (int bj = 0; bj < 2; ++bj)
#pragma unroll
                    for (int n = 0; n < 2; ++n) { const f32x4 b = *(const f32x4*)(base + off + bj * HALF + n * 16); *(f32x4*)(out + off + bj * HALF + n * 16) = b + acc[ai][bj][m][n]; } }
    }
};
struct EpiBf16P {
    static constexpr bool PERM = true, AFTER_DRAIN = false;
    bf16_t* O; int ldc; int ntn;
    __device__ __forceinline__ void operator()(const f32x4 (&acc)[2][2][4][2], const Unit& u, int wr, int wc, int fr, int fq) const {
        const int row0 = u.pm * BM + wr * 64 + fr, col0 = (u.pn % ntn) * BM + wc * 32 + 8 * fq;
#pragma unroll
        for (int ai = 0; ai < 2; ++ai)
#pragma unroll
            for (int m = 0; m < 4; ++m) { bf16_t* rowp = O + (size_t)(row0 + ai * HALF + m * 16) * ldc + col0;
#pragma unroll
                for (int bj = 0; bj < 2; ++bj) { const f32x4 v0 = acc[ai][bj][m][0], v1 = acc[ai][bj][m][1];
                    u32x4 w; w.x = cvt_pk_bf16(v0[0], v0[1]); w.y = cvt_pk_bf16(v0[2], v0[3]); w.z = cvt_pk_bf16(v1[0], v1[1]); w.w = cvt_pk_bf16(v1[2], v1[3]);
                    *(u32x4*)(rowp + bj * HALF) = w; } }
    }
};
__device__ __forceinline__ float silu_f(float x) { return x / (1.0f + __expf(-x)); }
struct EpiSwiGLU {
    static constexpr bool PERM = true, AFTER_DRAIN = false;
    bf16_t* H; int ldh; int ntn;
    __device__ __forceinline__ void operator()(const f32x4 (&acc)[2][2][4][2], const Unit& u, int wr, int wc, int fr, int fq) const {
        const int row0 = u.pm * BM + wr * 64 + fr, col0 = (u.pn % ntn) * HALF + wc * 32 + 8 * fq;
#pragma unroll
        for (int ai = 0; ai < 2; ++ai)
#pragma unroll
            for (int m = 0; m < 4; ++m) { bf16_t* rowp = H + (size_t)(row0 + ai * HALF + m * 16) * ldh + col0;
                const f32x4 g0 = acc[ai][0][m][0], g1 = acc[ai][0][m][1], u0 = acc[ai][1][m][0], u1 = acc[ai][1][m][1];
                u32x4 w;
                w.x = cvt_pk_bf16(silu_f(g0[0]) * u0[0], silu_f(g0[1]) * u0[1]); w.y = cvt_pk_bf16(silu_f(g0[2]) * u0[2], silu_f(g0[3]) * u0[3]);
                w.z = cvt_pk_bf16(silu_f(g1[0]) * u1[0], silu_f(g1[1]) * u1[1]); w.w = cvt_pk_bf16(silu_f(g1[2]) * u1[2], silu_f(g1[3]) * u1[3]);
                *(u32x4*)rowp = w; }
    }
};
struct RangeOrder {
    int pm0, nM, pn0, nN, G, c;
    __device__ __forceinline__ bool next(int i, Unit& u) const { const long L = (long)i * G + c; if (L >= (long)nM * nN) return false; u.pn = pn0 + (int)(L / nM); u.pm = pm0 + (int)(L % nM); return true; }
    __device__ __forceinline__ void a_ready(const Unit&) const {}
    __device__ __forceinline__ void done(const Unit&) const {}
};

template <class Epi, class Sched, bool ALIGN_EPI = false, bool SP2 = false>
__device__ __forceinline__ void gemm_phase(PG8_LAS unsigned char* lds, const Gemm g, const Sched& S, const Epi& E) {
    const int tid = threadIdx.x, wid = __builtin_amdgcn_readfirstlane(tid >> 6), lane = tid & 63, wr = wid >> 2, wc = wid & 3, fr = lane & 15, fq = lane >> 4;
    const int K = g.K, nt = K / BK;
    unsigned voffA[2], voffB[2];
#pragma unroll
    for (int i = 0; i < 2; ++i) { int R, C; stage_rc(tid * 16 + i * 8192, R, C); const int Rb = Epi::PERM ? ((R & ~31) + perm32(R & 31)) : R;
        voffA[i] = (unsigned)(R * K + C) * 2u; voffB[i] = (unsigned)(Rb * K + C) * 2u; }
    const size_t kstep = (size_t)(BK * 2);
    const size_t hstep = (size_t)HALF * K * 2;
    const size_t tstep = 2 * hstep;
    const unsigned ldsw = (unsigned)wid * 1024u;
    const int aoff = lds_byte(wr * 64 + fr, fq * 8), boff = lds_byte(wc * 32 + fr, fq * 8);
#define PG8_SA(b, h) (((b) * 2 + (h)) * HTB)
#define PG8_SB(b, h) ((4 + (b) * 2 + (h)) * HTB)
#define PG8_STAGE(bufoff, gbase, voff) do { _Pragma("unroll") for (int _i = 0; _i < 2; ++_i) \
        __builtin_amdgcn_global_load_lds((const unsigned*)((const char*)(gbase) + (voff)[_i]), (PG8_LAS unsigned*)(lds + (bufoff) + ldsw + _i * 8192), 16, 0, 0); } while (0)
#define PG8_LDA(dst, b, h) do { _Pragma("unroll") for (int m = 0; m < 4; ++m) _Pragma("unroll") for (int k = 0; k < 2; ++k) dst[m][k] = *(const PG8_LAS bf16x8*)(lds + PG8_SA(b, h) + aoff + m * 2048 + k * 1024); } while (0)
#define PG8_LDB(dst, b, h) do { _Pragma("unroll") for (int n = 0; n < 2; ++n) _Pragma("unroll") for (int k = 0; k < 2; ++k) dst[n][k] = *(const PG8_LAS bf16x8*)(lds + PG8_SB(b, h) + boff + n * 2048 + k * 1024); } while (0)
#define PG8_MMA(ai, bj, At, Bt) do { __builtin_amdgcn_s_setprio(1); _Pragma("unroll") for (int m = 0; m < 4; ++m) _Pragma("unroll") for (int n = 0; n < 2; ++n) _Pragma("unroll") for (int k = 0; k < 2; ++k) \
        acc[ai][bj][m][n] = __builtin_amdgcn_mfma_f32_16x16x32_bf16(Bt[n][k], At[m][k], acc[ai][bj][m][n], 0, 0, 0); __builtin_amdgcn_s_setprio(0); } while (0)
#define PG8_WAIT_V(n) asm volatile("s_waitcnt vmcnt(" #n ")" ::: "memory")
#define PG8_WAIT_L(n) asm volatile("s_waitcnt lgkmcnt(" #n ")" ::: "memory")
#define PG8_BAR __builtin_amdgcn_s_barrier()
#define PG8_SCHED __builtin_amdgcn_sched_barrier(0)
    Unit cur, nxt; int ui = 0;
    if (!S.next(0, cur)) return;
    f32x4 acc[2][2][4][2];
#pragma unroll
    for (int a = 0; a < 2; ++a)
#pragma unroll
        for (int b = 0; b < 2; ++b)
#pragma unroll
            for (int m = 0; m < 4; ++m)
#pragma unroll
                for (int n = 0; n < 2; ++n) acc[a][b][m][n] = (f32x4){0.f, 0.f, 0.f, 0.f};
    bf16x8 At[4][2], B0[2][2], B1[2][2];
    const char* cA = (const char*)g.A + (size_t)cur.pm * tstep; const char* cB = (const char*)g.Bt + (size_t)cur.pn * tstep;
    S.a_ready(cur);
    if constexpr (SP2) {
        PG8_STAGE(PG8_SB(0, 0), cB, voffB); PG8_STAGE(PG8_SB(0, 1), cB + hstep, voffB); PG8_STAGE(PG8_SA(0, 0), cA, voffA); PG8_STAGE(PG8_SA(0, 1), cA + hstep, voffA);
        if (wr == 1) PG8_BAR;
        PG8_WAIT_V(2); PG8_BAR;
        PG8_STAGE(PG8_SB(1, 0), cB + kstep, voffB); PG8_STAGE(PG8_SA(1, 0), cA + kstep, voffA); PG8_STAGE(PG8_SB(1, 1), cB + hstep + kstep, voffB);
        PG8_WAIT_V(6); PG8_BAR;
    } else {
        PG8_STAGE(PG8_SB(0, 0), cB, voffB); PG8_STAGE(PG8_SA(0, 0), cA, voffA); PG8_STAGE(PG8_SB(0, 1), cB + hstep, voffB); PG8_STAGE(PG8_SA(0, 1), cA + hstep, voffA);
        if (wr == 1) PG8_BAR;
        PG8_WAIT_V(4); PG8_BAR;
        PG8_STAGE(PG8_SB(1, 0), cB + kstep, voffB); PG8_STAGE(PG8_SA(1, 0), cA + kstep, voffA); PG8_STAGE(PG8_SB(1, 1), cB + hstep + kstep, voffB);
        PG8_WAIT_V(6); PG8_BAR;
    }
    for (;;) {
        const bool has_next = S.next(ui + 1, nxt);
        const char* nA = has_next ? (const char*)g.A + (size_t)nxt.pm * tstep : cA; const char* nB = has_next ? (const char*)g.Bt + (size_t)nxt.pn * tstep : cB;
        for (int t = 0; t < nt; t += 2) {
            const bool last = (t == nt - 2);
            const char* a1 = cA + (size_t)(t + 1) * kstep;
            const char* a2 = last ? nA : cA + (size_t)(t + 2) * kstep; const char* b2 = last ? nB : cB + (size_t)(t + 2) * kstep;
            const char* a3 = a2 + kstep; const char* b3 = b2 + kstep;
            if (last && has_next) S.a_ready(nxt);
            if constexpr (SP2) {
            PG8_LDB(B0, 0, 0); PG8_LDB(B1, 0, 1); PG8_SCHED; PG8_LDA(At, 0, 0); PG8_STAGE(PG8_SA(1, 1), a1 + hstep, voffA);
            PG8_WAIT_V(8); PG8_WAIT_L(0); PG8_BAR; PG8_MMA(0, 0, At, B0); PG8_MMA(0, 1, At, B1); PG8_BAR; PG8_SCHED;
            PG8_LDA(At, 0, 1); PG8_STAGE(PG8_SB(0, 0), b2, voffB); PG8_STAGE(PG8_SB(0, 1), b2 + hstep, voffB); PG8_STAGE(PG8_SA(0, 0), a2, voffA);
            PG8_WAIT_V(8); PG8_WAIT_L(0); PG8_BAR; PG8_MMA(1, 0, At, B0); PG8_MMA(1, 1, At, B1); PG8_BAR; PG8_SCHED;
            PG8_LDB(B0, 1, 0); PG8_LDB(B1, 1, 1); PG8_SCHED; PG8_LDA(At, 1, 0); PG8_STAGE(PG8_SA(0, 1), a2 + hstep, voffA);
            PG8_WAIT_V(8); PG8_WAIT_L(0); PG8_BAR; PG8_MMA(0, 0, At, B0); PG8_MMA(0, 1, At, B1); PG8_BAR; PG8_SCHED;
            PG8_LDA(At, 1, 1); PG8_STAGE(PG8_SB(1, 0), b3, voffB); PG8_STAGE(PG8_SB(1, 1), b3 + hstep, voffB); PG8_STAGE(PG8_SA(1, 0), a3, voffA);
            PG8_WAIT_V(8); PG8_WAIT_L(0); PG8_BAR; PG8_MMA(1, 0, At, B0); PG8_MMA(1, 1, At, B1); PG8_BAR; PG8_SCHED;
            } else {
            PG8_LDB(B0, 0, 0); PG8_SCHED; PG8_LDA(At, 0, 0); PG8_STAGE(PG8_SA(1, 1), a1 + hstep, voffA);
            PG8_WAIT_L(8); PG8_BAR; PG8_WAIT_L(0); PG8_MMA(0, 0, At, B0); PG8_BAR; PG8_SCHED;
            PG8_LDB(B1, 0, 1); PG8_STAGE(PG8_SB(0, 0), b2, voffB);
            PG8_BAR; PG8_WAIT_L(0); PG8_MMA(0, 1, At, B1); PG8_BAR;
            PG8_LDA(At, 0, 1); PG8_STAGE(PG8_SA(0, 0), a2, voffA);
            PG8_BAR; PG8_WAIT_L(0); PG8_MMA(1, 0, At, B0); PG8_BAR; PG8_SCHED;
            PG8_STAGE(PG8_SB(0, 1), b2 + hstep, voffB);
            PG8_WAIT_V(6); PG8_BAR; PG8_MMA(1, 1, At, B1); PG8_BAR;
            PG8_LDB(B0, 1, 0); PG8_SCHED; PG8_LDA(At, 1, 0); PG8_STAGE(PG8_SA(0, 1), a2 + hstep, voffA);
            PG8_WAIT_L(8); PG8_BAR; PG8_WAIT_L(0); PG8_MMA(0, 0, At, B0); PG8_BAR; PG8_SCHED;
            PG8_LDB(B1, 1, 1); PG8_STAGE(PG8_SB(1, 0), b3, voffB);
            PG8_BAR; PG8_WAIT_L(0); PG8_MMA(0, 1, At, B1); PG8_BAR;
            PG8_LDA(At, 1, 1); PG8_STAGE(PG8_SA(1, 0), a3, voffA);
            PG8_BAR; PG8_WAIT_L(0); PG8_MMA(1, 0, At, B0); PG8_BAR; PG8_SCHED;
            PG8_STAGE(PG8_SB(1, 1), b3 + hstep, voffB);
            PG8_WAIT_V(6); PG8_BAR; PG8_MMA(1, 1, At, B1); PG8_BAR;
            }
        }
        if constexpr (ALIGN_EPI) { if (wr == 0) PG8_BAR; }
        if constexpr (!Epi::AFTER_DRAIN) { E(acc, cur, wr, wc, fr, fq); S.done(cur); }
        if (!has_next) break;
#pragma unroll
        for (int a = 0; a < 2; ++a)
#pragma unroll
            for (int b = 0; b < 2; ++b)
#pragma unroll
                for (int m = 0; m < 4; ++m)
#pragma unroll
                    for (int n = 0; n < 2; ++n) acc[a][b][m][n] = (f32x4){0.f, 0.f, 0.f, 0.f};
        cur = nxt; cA = nA; cB = nB; ++ui;
        if constexpr (ALIGN_EPI) { if (wr == 1) PG8_BAR; }
    }
    PG8_WAIT_V(0);
    if constexpr (!ALIGN_EPI) { if (wr == 0) PG8_BAR; }
    PG8_BAR;
    if constexpr (Epi::AFTER_DRAIN) { E.fused(acc, cur, wr, wc, fr, fq, lds, wid, lane); S.done(cur); }
#undef PG8_SA
#undef PG8_SB
#undef PG8_STAGE
#undef PG8_LDA
#undef PG8_LDB
#undef PG8_MMA
#undef PG8_WAIT_V
#undef PG8_WAIT_L
#undef PG8_BAR
#undef PG8_SCHED
}
}

constexpr int NWAVES = 8, NTHR = 512;
constexpr int BATCH = 2, SEQ = 8192, M = BATCH * SEQ, D = 1024;
constexpr int AH = 6, AW = 384;
constexpr int ZP = 2304;
constexpr int ZR = 0, ZK = 384, ZV = 768, ZWD = 1152, ZAD = 1184, ZGD = 1216, ZU = 1280, ZCV = 1536, ZCQ = 1792, ZCKV = 2048, ZKR = 2176;
constexpr int DFF = 2816, DFE = 3584, NE = 8;
constexpr int QKD = 96, QP = 576;
constexpr float EPS = 1e-6f;
constexpr int M2MAX = 2 * M + NE * 256;

constexpr size_t MiB = 1u << 20;
constexpr size_t WS_CTL = 0, CTL_ZERO_BYTES = 1 * MiB;
constexpr size_t WS_WIN = 1 * MiB, WS_WOUT = 10 * MiB, WS_WDGU = 14 * MiB, WS_WDD = 25 * MiB, WS_WMEGU = 31 * MiB, WS_WMED = 45 * MiB;
constexpr size_t WS_XN = 52 * MiB, WS_VF = 84 * MiB, WS_TOK = 96 * MiB, WS_R = 98 * MiB;
constexpr size_t R_Z = 0, R_RW = 72 * MiB, R_LW = 144 * MiB, R_Q = 168 * MiB, R_K = 186 * MiB, R_V = 204 * MiB, R_YCAT = 216 * MiB;
constexpr size_t R_YRAW = 0, R_OATT = 24 * MiB;
constexpr size_t R_H = 0;
constexpr size_t R_XNP = 0, R_HME = 68 * MiB, R_YP = 180 * MiB;
constexpr size_t WS_END = WS_R + 248 * MiB;
constexpr size_t RWSZ = (size_t)M * AW;
constexpr size_t TOK_E = 0, TOK_G = (size_t)M * 2 * 4, TOK_POS = (size_t)M * 4 * 4, TOK_SEG = (size_t)M * 6 * 4, TOK_TILE = TOK_SEG + 256 * 8 * 4;
constexpr int NSEG = 256, SEGT = M / NSEG;

constexpr int CW_BAR = 4096;
constexpr int LDS_BYTES = 147456, RING_BYTES = 131072, MISC_OFF = RING_BYTES + 320;

#define GAS __attribute__((address_space(1)))
#define LAS __attribute__((address_space(3)))
typedef unsigned short bf16;
typedef unsigned v4u __attribute__((ext_vector_type(4)));
typedef unsigned v2u __attribute__((ext_vector_type(2)));
typedef float f32x4 __attribute__((ext_vector_type(4)));
typedef float f32x2 __attribute__((ext_vector_type(2)));
#define LDS_WAIT() asm volatile("s_waitcnt lgkmcnt(0)" ::: "memory")
#define VM_WAIT() asm volatile("s_waitcnt vmcnt(0)" ::: "memory")
__device__ __forceinline__ unsigned f2bf(float f) { unsigned u = __builtin_bit_cast(unsigned, f); return (u + 0x7fffu + ((u >> 16) & 1u)) >> 16; }
__device__ __forceinline__ unsigned pk2(float lo, float hi) { return f2bf(lo) | (f2bf(hi) << 16); }
__device__ __forceinline__ float bf2f(bf16 b) { return __builtin_bit_cast(float, (unsigned)b << 16); }
__device__ __forceinline__ float bflo(unsigned w) { return __builtin_bit_cast(float, w << 16); }
__device__ __forceinline__ float bfhi(unsigned w) { return __builtin_bit_cast(float, w & 0xffff0000u); }
__device__ __forceinline__ float wave_sum(float v) {
#pragma unroll
    for (int o = 1; o < 64; o <<= 1) v += __shfl_xor(v, o);
    return v;
}
__device__ __forceinline__ float sigmoid_f(float x) { return 1.0f / (1.0f + __expf(-x)); }
__device__ __forceinline__ float gelu_erf(float x) { return 0.5f * x * (1.0f + erff(x * 0.70710678118654752f)); }

#define XB_TMO      128
#define XB_XCNT(j)  (256  + 64 * (j))
#define XB_XSUB(j)  (1280 + 64 * (j))
#define XB_XGEN(j)  (2304 + 64 * (j))
#define XB_TOP      3328
#define XB_TOPGEN   3392
#define XCD_BAR_WORDS 3456
#define XB_SPIN_CAP (1u << 18)

__device__ __forceinline__ unsigned xb_ld(unsigned* p)              { return __hip_atomic_load(p, __ATOMIC_RELAXED, __HIP_MEMORY_SCOPE_AGENT); }
__device__ __forceinline__ unsigned xb_add(unsigned* p, unsigned v) { return __hip_atomic_fetch_add(p, v, __ATOMIC_RELAXED, __HIP_MEMORY_SCOPE_AGENT); }
__device__ __forceinline__ unsigned xb_xcc_id() { return (unsigned)__builtin_amdgcn_s_getreg((3 << 11) | 20) & 0xFu; }
#define XB_SPIN(cond, bar) do { unsigned _sp = 0; while (cond) { __builtin_amdgcn_s_sleep(1); \
    if ((++_sp & 255u) == 0u) { if (xb_ld(&(bar)[XB_TMO])) break; if (_sp > XB_SPIN_CAP) { atomicAdd(&(bar)[XB_TMO], 1u); break; } } } } while (0)

struct XcdBarrier {
    unsigned* bar; unsigned x;
    volatile LAS unsigned* st;
};

__device__ __forceinline__ XcdBarrier xcd_barrier_post(unsigned* bar, volatile LAS unsigned* st) {
    XcdBarrier b; b.bar = bar; b.x = xb_xcc_id(); b.st = st;
    if (threadIdx.x == 0) (void)xb_add(&bar[XB_XCNT(b.x)], 1u);
    return b;
}
__device__ __forceinline__ void xcd_barrier_complete(unsigned* bar, unsigned x, unsigned& nloc, unsigned& nx) {
    const unsigned G = gridDim.x * gridDim.y * gridDim.z;
    unsigned sum, cnt, mine, sp = 0u;
    for (;;) {
        sum = 0u; cnt = 0u; mine = 0u;
#pragma unroll
        for (unsigned j = 0; j < 16; ++j) { const unsigned c = xb_ld(&bar[XB_XCNT(j)]); sum += c; cnt += (c > 0u) ? 1u : 0u; mine = (j == x) ? c : mine; }
        if (sum == G) break;
        __builtin_amdgcn_s_sleep(1);
        if ((++sp & 255u) == 0u) { if (xb_ld(&bar[XB_TMO])) break; if (sp > XB_SPIN_CAP) { atomicAdd(&bar[XB_TMO], 1u); break; } }
    }
    nloc = mine > 0u ? mine : 1u; nx = cnt > 0u ? cnt : 1u;
}

__device__ __forceinline__ void xcd_barrier(const XcdBarrier& b) {
    asm volatile("s_waitcnt vmcnt(0)" ::: "memory");
    __syncthreads();
    if (threadIdx.x == 0) {
        unsigned* bar = b.bar;
        __builtin_amdgcn_s_waitcnt(0);
        unsigned nloc = b.st[0], nx = b.st[1];
        if (nloc == 0u) { xcd_barrier_complete(bar, b.x, nloc, nx); b.st[0] = nloc; b.st[1] = nx; }
        const unsigned old = xb_add(&bar[XB_XSUB(b.x)], 1u);
        const unsigned gen = old / nloc;
        if (old + 1u == (gen + 1u) * nloc) {
            __builtin_amdgcn_fence(__ATOMIC_RELEASE, "agent");
            asm volatile("s_waitcnt vmcnt(0)" ::: "memory");
            const unsigned og = xb_add(&bar[XB_TOP], 1u);
            const unsigned tg = og / nx;
            if (og + 1u == (tg + 1u) * nx) xb_add(&bar[XB_TOPGEN], 1u);
            else XB_SPIN(xb_ld(&bar[XB_TOPGEN]) == tg, bar);
            __builtin_amdgcn_fence(__ATOMIC_ACQUIRE, "agent");
            xb_add(&bar[XB_XGEN(b.x)], 1u);
            asm volatile("s_waitcnt vmcnt(0)" ::: "memory");
        } else {
            XB_SPIN(xb_ld(&bar[XB_XGEN(b.x)]) == gen, bar);
            __builtin_amdgcn_fence(__ATOMIC_ACQUIRE, "agent");
            asm volatile("s_waitcnt vmcnt(0)" ::: "memory");
        }
    }
    __syncthreads();
}


struct Args { const float* in[39]; float* out; unsigned char* ws; int ph_lo, ph_hi; };
enum { I_X = 0, I_POS, I_MIXG, I_WIN, I_MU, I_W0, I_WUP, I_A0, I_AUP, I_GUP, I_KK, I_KA, I_RK, I_LNG, I_LNB, I_V0, I_VDN, I_VUP,
       I_QNG, I_WUQ, I_KVNG, I_WUKV, I_QHG, I_KHG, I_BOG, I_CLNG, I_CLNB, I_CWS, I_CBS, I_COG, I_WOUT, I_FFNG, I_DWG, I_DWU, I_DWD, I_ROUTER, I_MWG, I_MWU, I_MWD };

struct Ctx {
    LAS unsigned char* lds; int tid, lane, wave, bid, nb, gw, ngw;
    const Args* a; unsigned char* ws; unsigned char* R;
};

__device__ __forceinline__ void conv_item(const float* W, int K, int N, bf16* WT, int n0, int drow0, int k0, LAS float* scr, int lane) {
#pragma unroll 8
    for (int i = 0; i < 32; ++i) { const int kk = 2 * i + (lane >> 5); scr[kk * 33 + (lane & 31)] = W[(size_t)(k0 + kk) * N + n0 + (lane & 31)]; }
    LDS_WAIT(); asm volatile("" ::: "memory");
    const int c = lane & 7;
#pragma unroll
    for (int j = 0; j < 4; ++j) { const int n = (lane >> 3) + 8 * j; const LAS float* s = scr + (8 * c) * 33 + n;
        v4u o; o.x = pk2(s[0 * 33], s[1 * 33]); o.y = pk2(s[2 * 33], s[3 * 33]); o.z = pk2(s[4 * 33], s[5 * 33]); o.w = pk2(s[6 * 33], s[7 * 33]);
        *(GAS v4u*)(WT + (size_t)(drow0 + n) * K + k0 + 8 * c) = o; }
    LDS_WAIT(); asm volatile("" ::: "memory");
}
template <int MAP> __device__ __forceinline__ int conv_row(int n0) {
    if (MAP == 1) return n0 < 1280 ? n0 : (n0 < 1696 ? n0 - 1280 + ZCQ : n0 - 1696 + ZU);
    if (MAP == 2) return (n0 >> 7) * 256 + (n0 & 127);
    if (MAP == 3) return (n0 >> 7) * 256 + 128 + (n0 & 127);
    return n0;
}
template <int MAP> __device__ __forceinline__ void conv_matrix(const Ctx& c, const float* W, int K, int N, bf16* WT) {
    LAS float* scr = (LAS float*)(c.lds + c.wave * 8704);
    const int nblk = N / 32, items = (K / 64) * nblk;
    for (int it = c.gw; it < items; it += c.ngw) { const int kb = it / nblk, nbk = it % nblk; conv_item(W, K, N, WT, 32 * nbk, conv_row<MAP>(32 * nbk), 64 * kb, scr, c.lane); }
}

__device__ __forceinline__ void phase_conv_static(const Ctx& c) {
    const Args& a = *c.a;
    for (int l = 0; l < 2; ++l) {
        bf16* win = (bf16*)(c.ws + WS_WIN) + (size_t)l * ZP * D;
        conv_matrix<1>(c, a.in[I_WIN] + (size_t)l * D * 2208, D, 2208, win);
        for (int i = c.bid * NTHR + c.tid; i < 96 * D / 8; i += c.nb * NTHR) ((GAS v4u*)(win + (size_t)2208 * D))[i] = (v4u){0u, 0u, 0u, 0u};
        conv_matrix<0>(c, a.in[I_WOUT] + (size_t)l * D * D, D, D, (bf16*)(c.ws + WS_WOUT) + (size_t)l * D * D);
    }
    conv_matrix<2>(c, a.in[I_DWG], D, DFF, (bf16*)(c.ws + WS_WDGU));
    conv_matrix<3>(c, a.in[I_DWU], D, DFF, (bf16*)(c.ws + WS_WDGU));
    conv_matrix<0>(c, a.in[I_DWD], DFF, D, (bf16*)(c.ws + WS_WDD));
}
__device__ __forceinline__ void phase_conv_expert(const Ctx& c, int e) {
    const Args& a = *c.a;
    conv_matrix<2>(c, a.in[I_MWG] + (size_t)e * D * DFE, D, DFE, (bf16*)(c.ws + WS_WMEGU));
    conv_matrix<3>(c, a.in[I_MWU] + (size_t)e * D * DFE, D, DFE, (bf16*)(c.ws + WS_WMEGU));
    conv_matrix<0>(c, a.in[I_MWD] + (size_t)e * DFE * D, DFE, D, (bf16*)(c.ws + WS_WMED));
}

template <bool ROUTER> __device__ __forceinline__ void phase_rmsnorm(const Ctx& c, const float* x, const float* g, bf16* xn, const float* router) {
    const f32x4* gp = (const f32x4*)g + c.lane;
    f32x4 gv[4];
#pragma unroll
    for (int j = 0; j < 4; ++j) gv[j] = gp[64 * j];
    for (int m = c.gw; m < M; m += c.ngw) {
        const f32x4* xr = (const f32x4*)(x + (size_t)m * D) + c.lane;
        f32x4 v[4]; float ss = 0.f;
#pragma unroll
        for (int j = 0; j < 4; ++j) { v[j] = xr[64 * j]; ss += (v[j].x * v[j].x + v[j].y * v[j].y) + (v[j].z * v[j].z + v[j].w * v[j].w); }
        const float rstd = 1.0f / sqrtf(wave_sum(ss) * (1.0f / D) + EPS);
#pragma unroll
        for (int j = 0; j < 4; ++j) v[j] = v[j] * rstd * gv[j];
        v2u* o8 = (v2u*)(xn + (size_t)m * D) + c.lane;
#pragma unroll
        for (int j = 0; j < 4; ++j) o8[64 * j] = (v2u){pk2(v[j].x, v[j].y), pk2(v[j].z, v[j].w)};
        if (ROUTER) {
            float lg[8];
#pragma unroll
            for (int e = 0; e < 8; ++e) lg[e] = 0.f;
#pragma unroll
            for (int j = 0; j < 4; ++j)
#pragma unroll
                for (int i = 0; i < 4; ++i) { const float* rr = router + (size_t)(4 * c.lane + 256 * j + i) * 8; const f32x4 r0 = *(const f32x4*)rr, r1 = *(const f32x4*)(rr + 4); const float h = v[j][i];
                    lg[0] += h * r0.x; lg[1] += h * r0.y; lg[2] += h * r0.z; lg[3] += h * r0.w; lg[4] += h * r1.x; lg[5] += h * r1.y; lg[6] += h * r1.z; lg[7] += h * r1.w; }
#pragma unroll
            for (int e = 0; e < 8; ++e) lg[e] = wave_sum(lg[e]);
            if (c.lane == 0) {
                int e0 = 0; float v0 = lg[0];
#pragma unroll
                for (int e = 1; e < 8; ++e) if (lg[e] > v0) { v0 = lg[e]; e0 = e; }
                int e1 = -1; float v1 = -INFINITY;
#pragma unroll
                for (int e = 0; e < 8; ++e) if (e != e0 && lg[e] > v1) { v1 = lg[e]; e1 = e; }
                const float p1 = 1.0f / (1.0f + __expf(v0 - v1)), p0 = 1.0f - p1;
                int* te = (int*)(c.ws + WS_TOK + TOK_E); float* tg = (float*)(c.ws + WS_TOK + TOK_G);
                te[2 * m] = e0; te[2 * m + 1] = e1; tg[2 * m] = p0; tg[2 * m + 1] = p1;
            }
        }
    }
}

__device__ __forceinline__ float zsh(const bf16* Z, int m, int s, int col, float mu) {
    const float cur = bf2f(Z[(size_t)m * ZP + col]); const float prev = s > 0 ? bf2f(Z[(size_t)(m - 1) * ZP + col]) : 0.f; return cur + (prev - cur) * mu;
}
__device__ __forceinline__ void phase_rwkv_prep(const Ctx& c, int l) {
    const Args& a = *c.a;
    const bf16* Z = (const bf16*)(c.R + R_Z);
    bf16* RW = (bf16*)(c.R + R_RW); float* LW = (float*)(c.R + R_LW); bf16* VF = (bf16*)(c.ws + WS_VF);
    const float* mu = a.in[I_MU] + l * 1280; const float* w0 = a.in[I_W0] + l * AW; const float* wup = a.in[I_WUP] + (size_t)l * 32 * AW;
    const float* a0 = a.in[I_A0] + l * AW; const float* aup = a.in[I_AUP] + (size_t)l * 32 * AW; const float* gup = a.in[I_GUP] + (size_t)l * 64 * AW;
    const float* kkw = a.in[I_KK] + l * AW; const float* kaw = a.in[I_KA] + l * AW;
    const float* v0 = a.in[I_V0]; const float* vdn = a.in[I_VDN]; const float* vup = a.in[I_VUP];
    LAS float* sm = (LAS float*)c.lds;
    LAS float* vs = sm + 8 * 128;
    LAS float* vd = vs + 8 * 384;
    const int t = c.tid;
    for (int grp = c.bid; grp < M / 8; grp += c.nb) {
        const int m0 = grp * 8;
        float r[8], k[8], v[8];
        if (t < AW) {
            const float mr = mu[ZR + t], mk = mu[ZK + t], mv = mu[ZV + t];
#pragma unroll
            for (int q = 0; q < 8; ++q) { const int m = m0 + q, s = m % SEQ; r[q] = zsh(Z, m, s, ZR + t, mr); k[q] = zsh(Z, m, s, ZK + t, mk); v[q] = zsh(Z, m, s, ZV + t, mv); }
        } else {
            const int j = t - AW; const float mj = mu[ZWD + j];
#pragma unroll
            for (int q = 0; q < 8; ++q) { const int m = m0 + q, s = m % SEQ; float x = zsh(Z, m, s, ZWD + j, mj);
                if (j < 32) x = tanhf(x); else if (j >= 64) x = sigmoid_f(x);
                sm[q * 128 + j] = x; }
        }
        __syncthreads();
        float wa[8], aa[8], ga[8];
        if (t < AW) {
#pragma unroll
            for (int q = 0; q < 8; ++q) { wa[q] = 0.f; aa[q] = 0.f; ga[q] = 0.f; }
            for (int j = 0; j < 32; ++j) { const float ww = wup[j * AW + t], au = aup[j * AW + t];
#pragma unroll
                for (int q = 0; q < 8; ++q) { wa[q] += sm[q * 128 + j] * ww; aa[q] += sm[q * 128 + 32 + j] * au; } }
            for (int j = 0; j < 64; ++j) { const float gu = gup[j * AW + t];
#pragma unroll
                for (int q = 0; q < 8; ++q) ga[q] += sm[q * 128 + 64 + j] * gu; }
            if (l > 0) {
#pragma unroll
                for (int q = 0; q < 8; ++q) vs[q * AW + t] = v[q];
            }
        }
        __syncthreads();
        if (l > 0) {
            if (t < 128) { const int q = t >> 4, j = t & 15; float s = 0.f; for (int cc = 0; cc < AW; ++cc) s += vs[q * AW + cc] * vdn[cc * 16 + j]; vd[q * 16 + j] = s; }
            __syncthreads();
        }
        if (t < AW) {
            const float w0t = w0[t], a0t = a0[t], kkt = kkw[t], kat = kaw[t];
#pragma unroll
            for (int q = 0; q < 8; ++q) { const int m = m0 + q; const size_t o = (size_t)m * AW + t;
                const float xw = -(w0t + wa[q]);
                const float sp = xw > 20.f ? xw : log1pf(__expf(xw));
                const float lw = -__expf(-sp - 0.5f);
                const float av = sigmoid_f(a0t + aa[q]);
                float vv = v[q];
                if (l > 0) { float x = v0[t];
#pragma unroll
                    for (int j = 0; j < 16; ++j) x += vd[q * 16 + j] * vup[j * AW + t];
                    const float vf = bf2f(VF[o]); vv = vv + (vf - vv) * sigmoid_f(x); }
                else VF[o] = (bf16)f2bf(vv);
                float kk = k[q] * kkt; const float ss = wave_sum(kk * kk); kk = kk / fmaxf(sqrtf(ss), 1e-12f);
                const float k2 = k[q] * (1.0f + (av - 1.0f) * kat);
                RW[0 * RWSZ + o] = (bf16)f2bf(r[q]); RW[1 * RWSZ + o] = (bf16)f2bf(k2); RW[2 * RWSZ + o] = (bf16)f2bf(vv); RW[3 * RWSZ + o] = (bf16)f2bf(kk);
                RW[4 * RWSZ + o] = (bf16)f2bf(av); RW[5 * RWSZ + o] = (bf16)f2bf(ga[q]); LW[o] = lw; }
        }
        __syncthreads();
    }
}

__device__ __forceinline__ void phase_rwkv_scan_naive(const Ctx& c) {
    const bf16* RW = (const bf16*)(c.R + R_RW); const float* LW = (const float*)(c.R + R_LW); float* YRAW = (float*)(c.R + R_YRAW);
    constexpr int CH = 32;
    LAS float* sr = (LAS float*)c.lds;
    LAS float* sw = sr + CH * 64; LAS float* skk = sw + CH * 64; LAS float* sb = skk + CH * 64; LAS float* sk2 = sb + CH * 64; LAS float* sv = sk2 + CH * 64; LAS float* sy = sv + CH * 64;
    const int t = c.tid, vrow = t >> 3, kq = t & 7;
    for (int item = c.bid; item < BATCH * AH; item += c.nb) {
        const int b = item / AH, h = item % AH;
        float st[8];
#pragma unroll
        for (int i = 0; i < 8; ++i) st[i] = 0.f;
        for (int s0 = 0; s0 < SEQ; s0 += CH) {
            __syncthreads();
#pragma unroll
            for (int q = 0; q < 4; ++q) { const int e = t + q * NTHR, ts = e >> 6, ch = e & 63; const size_t o = (size_t)(b * SEQ + s0 + ts) * AW + h * 64 + ch;
                const float kk = bf2f(RW[3 * RWSZ + o]), av = bf2f(RW[4 * RWSZ + o]);
                sr[e] = bf2f(RW[0 * RWSZ + o]); sw[e] = __expf(LW[o]); skk[e] = kk; sb[e] = kk * av; sk2[e] = bf2f(RW[1 * RWSZ + o]); sv[e] = bf2f(RW[2 * RWSZ + o]); }
            __syncthreads();
            for (int ts = 0; ts < CH; ++ts) {
                const int o = ts * 64 + kq * 8; float p = 0.f;
#pragma unroll
                for (int i = 0; i < 8; ++i) p += st[i] * skk[o + i];
                p += __shfl_xor(p, 1); p += __shfl_xor(p, 2); p += __shfl_xor(p, 4);
                const float sa = -p, vv = sv[ts * 64 + vrow]; float y = 0.f;
#pragma unroll
                for (int i = 0; i < 8; ++i) { st[i] = st[i] * sw[o + i] + sa * sb[o + i] + vv * sk2[o + i]; y += st[i] * sr[o + i]; }
                y += __shfl_xor(y, 1); y += __shfl_xor(y, 2); y += __shfl_xor(y, 4);
                if (kq == 0) sy[ts * 64 + vrow] = y;
            }
            __syncthreads();
#pragma unroll
            for (int q = 0; q < 4; ++q) { const int e = t + q * NTHR, ts = e >> 6, ch = e & 63; YRAW[(size_t)(b * SEQ + s0 + ts) * AW + h * 64 + ch] = sy[e]; }
        }
        __syncthreads();
    }
}

__device__ __forceinline__ void phase_rwkv_post(const Ctx& c, int l) {
    const Args& a = *c.a;
    const bf16* RW = (const bf16*)(c.R + R_RW); const float* YRAW = (const float*)(c.R + R_YRAW); bf16* YC = (bf16*)(c.R + R_YCAT);
    const float* lng = a.in[I_LNG] + l * AW; const float* lnb = a.in[I_LNB] + l * AW; const float* rk = a.in[I_RK] + l * AW;
    for (int it = c.gw; it < M * AH; it += c.ngw) {
        const int m = it / AH, h = it % AH, ch = h * 64 + c.lane; const size_t o = (size_t)m * AW + ch;
        const float y = YRAW[o]; const float mean = wave_sum(y) * (1.0f / 64.0f); const float d = y - mean; const float var = wave_sum(d * d) * (1.0f / 64.0f);
        const float yn = d * (1.0f / sqrtf(var + 64e-5f)) * lng[ch] + lnb[ch];
        const float r = bf2f(RW[0 * RWSZ + o]), k2 = bf2f(RW[1 * RWSZ + o]), v = bf2f(RW[2 * RWSZ + o]), g = bf2f(RW[5 * RWSZ + o]);
        const float bonus = wave_sum(r * k2 * rk[ch]);
        YC[(size_t)m * D + ch] = (bf16)f2bf((yn + bonus * v) * g);
    }
}

__device__ __forceinline__ void phase_mla_prep(const Ctx& c, int l) {
    const Args& a = *c.a;
    const bf16* Z = (const bf16*)(c.R + R_Z);
    bf16* Q = (bf16*)(c.R + R_Q); bf16* K = (bf16*)(c.R + R_K); bf16* V = (bf16*)(c.R + R_V);
    const float* qng = a.in[I_QNG] + l * 256; const float* wuq = a.in[I_WUQ] + (size_t)l * 256 * QP; const float* kvng = a.in[I_KVNG] + l * 128; const float* wukv = a.in[I_WUKV] + (size_t)l * 128 * 768;
    const float* qhg = a.in[I_QHG] + l * QKD; const float* khg = a.in[I_KHG] + l * QKD; const int* pos = (const int*)a.in[I_POS];
    LAS float* cqn = (LAS float*)c.lds;
    LAS float* ckn = cqn + 16 * 256;
    LAS float* krs = ckn + 16 * 128;
    LAS float* qb = krs + 16 * 32;
    LAS float* kvb = qb + 16 * QP;
    const float qscale = 1.4426950408889634f / sqrtf((float)QKD);
    for (int grp = c.bid; grp < M / 16; grp += c.nb) {
        const int m0 = grp * 16;
        __syncthreads();
#pragma unroll
        for (int q = 0; q < 2; ++q) { const int tk = 2 * c.wave + q; const bf16* zr = Z + (size_t)(m0 + tk) * ZP;
            float x[4]; float ss = 0.f;
#pragma unroll
            for (int i = 0; i < 4; ++i) { x[i] = bf2f(zr[ZCQ + c.lane + 64 * i]); ss += x[i] * x[i]; }
            float rstd = 1.0f / sqrtf(wave_sum(ss) * (1.0f / 256.0f) + EPS);
#pragma unroll
            for (int i = 0; i < 4; ++i) cqn[tk * 256 + c.lane + 64 * i] = x[i] * rstd * qng[c.lane + 64 * i];
            float y[2]; ss = 0.f;
#pragma unroll
            for (int i = 0; i < 2; ++i) { y[i] = bf2f(zr[ZCKV + c.lane + 64 * i]); ss += y[i] * y[i]; }
            rstd = 1.0f / sqrtf(wave_sum(ss) * (1.0f / 128.0f) + EPS);
#pragma unroll
            for (int i = 0; i < 2; ++i) ckn[tk * 128 + c.lane + 64 * i] = y[i] * rstd * kvng[c.lane + 64 * i];
            if (c.lane < 32) krs[tk * 32 + c.lane] = bf2f(zr[ZKR + c.lane]);
        }
        __syncthreads();
        for (int col = c.tid; col < QP; col += NTHR) {
            float acc[16];
#pragma unroll
            for (int q = 0; q < 16; ++q) acc[q] = 0.f;
            for (int kx = 0; kx < 256; ++kx) { const float w = wuq[(size_t)kx * QP + col];
#pragma unroll
                for (int q = 0; q < 16; ++q) acc[q] += cqn[q * 256 + kx] * w; }
#pragma unroll
            for (int q = 0; q < 16; ++q) qb[q * QP + col] = acc[q];
        }
        for (int col = c.tid; col < 768; col += NTHR) {
            float acc[16];
#pragma unroll
            for (int q = 0; q < 16; ++q) acc[q] = 0.f;
            for (int kx = 0; kx < 128; ++kx) { const float w = wukv[(size_t)kx * 768 + col];
#pragma unroll
                for (int q = 0; q < 16; ++q) acc[q] += ckn[q * 128 + kx] * w; }
#pragma unroll
            for (int q = 0; q < 16; ++q) kvb[q * 768 + col] = acc[q];
        }
        __syncthreads();
        for (int pr = c.wave; pr < 16 * AH; pr += NWAVES) {
            const int tk = pr / AH, h = pr % AH, m = m0 + tk; const int ln = c.lane, l32 = ln & 31, fi = ln & 15;
            const float ang = (float)pos[m] * exp2f(-(float)(2 * fi) * (13.287712379549449f / 32.0f));
            const float cs = cosf(ang), sn = sinf(ang);
            { const float x0 = qb[tk * QP + h * QKD + ln], x1 = ln < 32 ? qb[tk * QP + h * QKD + 64 + l32] : 0.f;
              const float rstd = 1.0f / sqrtf(wave_sum(x0 * x0 + x1 * x1) * (1.0f / QKD) + EPS);
              const float n0 = x0 * rstd * qhg[ln], n1 = x1 * rstd * qhg[64 + l32];
              const float pn = __shfl_xor(n1, 16);
              const float ro = (ln & 16) ? (pn * sn + n1 * cs) : (n1 * cs - pn * sn);
              Q[(size_t)m * QP + h * QKD + ln] = (bf16)f2bf(n0 * qscale);
              if (ln < 32) Q[(size_t)m * QP + h * QKD + 64 + ln] = (bf16)f2bf(ro * qscale); }
            { const float x0 = kvb[tk * 768 + h * 128 + ln], x1 = ln < 32 ? krs[tk * 32 + l32] : 0.f;
              const float rstd = 1.0f / sqrtf(wave_sum(x0 * x0 + x1 * x1) * (1.0f / QKD) + EPS);
              const float n0 = x0 * rstd * khg[ln], n1 = x1 * rstd * khg[64 + l32];
              const float pn = __shfl_xor(n1, 16);
              const float ro = (ln & 16) ? (pn * sn + n1 * cs) : (n1 * cs - pn * sn);
              K[(size_t)m * QP + h * QKD + ln] = (bf16)f2bf(n0);
              if (ln < 32) K[(size_t)m * QP + h * QKD + 64 + ln] = (bf16)f2bf(ro); }
            V[(size_t)m * AW + h * 64 + ln] = (bf16)f2bf(kvb[tk * 768 + h * 128 + 64 + ln]);
        }
    }
    __syncthreads();
}

__device__ __forceinline__ void phase_attn_naive(const Ctx& c) {
    const bf16* Q = (const bf16*)(c.R + R_Q); const bf16* K = (const bf16*)(c.R + R_K); const bf16* V = (const bf16*)(c.R + R_V); float* O = (float*)(c.R + R_OATT);
    LAS float* ks = (LAS float*)c.lds;
    LAS float* vs = ks + 64 * QKD;
    for (int item = c.bid; item < BATCH * AH * 16 * 2; item += c.nb) {
        const int qg = 15 - item / (BATCH * AH * 2), rem = item % (BATCH * AH * 2), vh = rem & 1, bh = rem >> 1, b = bh / AH, h = bh % AH;
        const size_t qrow = (size_t)b * SEQ + qg * 512 + c.tid;
        float q[QKD];
#pragma unroll
        for (int i = 0; i < QKD / 2; ++i) { const unsigned w = *(const unsigned*)(Q + qrow * QP + h * QKD + 2 * i); q[2 * i] = bflo(w); q[2 * i + 1] = bfhi(w); }
        float acc[32];
#pragma unroll
        for (int i = 0; i < 32; ++i) acc[i] = 0.f;
        float mrun = -INFINITY, lrun = 0.f;
        const int myc = qg * 8 + c.wave, ntile = qg * 8 + 8;
        for (int j = 0; j < ntile; ++j) {
            __syncthreads();
            const size_t kr0 = (size_t)b * SEQ + j * 64;
            for (int e = c.tid; e < 64 * QKD / 2; e += NTHR) { const int kr = e / (QKD / 2), dd = e % (QKD / 2); const unsigned w = *(const unsigned*)(K + (kr0 + kr) * QP + h * QKD + 2 * dd); ks[kr * QKD + 2 * dd] = bflo(w); ks[kr * QKD + 2 * dd + 1] = bfhi(w); }
            for (int e = c.tid; e < 64 * 16; e += NTHR) { const int kr = e >> 4, dd = e & 15; const unsigned w = *(const unsigned*)(V + (kr0 + kr) * AW + h * 64 + vh * 32 + 2 * dd); vs[kr * 32 + 2 * dd] = bflo(w); vs[kr * 32 + 2 * dd + 1] = bfhi(w); }
            __syncthreads();
            if (j <= myc) {
#pragma unroll 1
                for (int k4 = 0; k4 < 64; k4 += 2) {
                    float s[2];
#pragma unroll
                    for (int u = 0; u < 2; ++u) { const LAS f32x4* kp = (const LAS f32x4*)(ks + (k4 + u) * QKD); float d0 = 0.f, d1 = 0.f;
#pragma unroll
                        for (int i = 0; i < QKD / 4; ++i) { const f32x4 kv = kp[i]; d0 += q[4 * i] * kv.x + q[4 * i + 2] * kv.z; d1 += q[4 * i + 1] * kv.y + q[4 * i + 3] * kv.w; }
                        s[u] = d0 + d1; }
                    const float mx = fmaxf(s[0], s[1]), mnew = fmaxf(mrun, mx), corr = exp2f(mrun - mnew);
                    mrun = mnew; lrun *= corr;
#pragma unroll
                    for (int i = 0; i < 32; ++i) acc[i] *= corr;
#pragma unroll
                    for (int u = 0; u < 2; ++u) { const float p = exp2f(s[u] - mnew); lrun += p; const LAS f32x4* vp = (const LAS f32x4*)(vs + (k4 + u) * 32);
#pragma unroll
                        for (int i = 0; i < 8; ++i) { const f32x4 vv = vp[i]; acc[4 * i] += p * vv.x; acc[4 * i + 1] += p * vv.y; acc[4 * i + 2] += p * vv.z; acc[4 * i + 3] += p * vv.w; } }
                }
            }
        }
        const float inv = 1.0f / lrun;
        float* op = O + qrow * AW + h * 64 + vh * 32;
#pragma unroll
        for (int i = 0; i < 8; ++i) *(f32x4*)(op + 4 * i) = (f32x4){acc[4 * i] * inv, acc[4 * i + 1] * inv, acc[4 * i + 2] * inv, acc[4 * i + 3] * inv};
    }
    __syncthreads();
}
__device__ __forceinline__ void phase_mla_post(const Ctx& c, int l) {
    const float* O = (const float*)(c.R + R_OATT); bf16* YC = (bf16*)(c.R + R_YCAT); const float* og = c.a->in[I_BOG] + l * AW;
    for (int m = c.gw; m < M; m += c.ngw) {
        float x[6]; float ss = 0.f;
#pragma unroll
        for (int i = 0; i < 6; ++i) { x[i] = O[(size_t)m * AW + c.lane + 64 * i]; ss += x[i] * x[i]; }
        const float rstd = 1.0f / sqrtf(wave_sum(ss) * (1.0f / AW) + EPS);
#pragma unroll
        for (int i = 0; i < 6; ++i) YC[(size_t)m * D + AW + c.lane + 64 * i] = (bf16)f2bf(x[i] * rstd * og[c.lane + 64 * i]);
    }
}

__device__ __forceinline__ void phase_gmlp(const Ctx& c, int l) {
    const Args& a = *c.a;
    const bf16* Z = (const bf16*)(c.R + R_Z); bf16* YC = (bf16*)(c.R + R_YCAT);
    const float* lng = a.in[I_CLNG] + l * 256; const float* lnb = a.in[I_CLNB] + l * 256; const float* ws = a.in[I_CWS] + (size_t)l * 4 * 128 * 128; const float* bs = a.in[I_CBS] + l * 4 * 128; const float* og = a.in[I_COG] + l * 256;
    LAS float* vln = (LAS float*)c.lds;
    LAS float* ssq2 = (LAS float*)(c.lds + MISC_OFF + 256);
    for (int item = c.bid; item < M / 128; item += c.nb) {
        const int m0 = item * 128;
        __syncthreads();
        for (int q = 0; q < 16; ++q) { const int t = c.wave * 16 + q; const bf16* zr = Z + (size_t)(m0 + t) * ZP + ZCV;
            float x[4]; float s = 0.f;
#pragma unroll
            for (int i = 0; i < 4; ++i) { x[i] = gelu_erf(bf2f(zr[c.lane + 64 * i])); s += x[i]; }
            const float mean = wave_sum(s) * (1.0f / 256.0f); float s2 = 0.f;
#pragma unroll
            for (int i = 0; i < 4; ++i) { x[i] -= mean; s2 += x[i] * x[i]; }
            const float rstd = 1.0f / sqrtf(wave_sum(s2) * (1.0f / 256.0f) + EPS);
#pragma unroll
            for (int i = 0; i < 4; ++i) vln[t * 256 + c.lane + 64 * i] = x[i] * rstd * lng[c.lane + 64 * i] + lnb[c.lane + 64 * i];
        }
        __syncthreads();
        const int g = c.wave & 3, half = c.wave >> 2, ch = g * 64 + c.lane;
        for (int tt = 0; tt < 64; ++tt) { const int t = half * 64 + tt; const float* wr = ws + ((size_t)g * 128 + t) * 128; float acc = 0.f;
            for (int s = 0; s <= t; ++s) acc += wr[s] * vln[s * 256 + ch];
            const float sv = acc + bs[g * 128 + t]; const float u = gelu_erf(bf2f(Z[(size_t)(m0 + t) * ZP + ZU + ch])); const float y = u * sv;
            const float p = wave_sum(y * y); if (c.lane == 0) ssq2[t * 4 + g] = p;
            YC[(size_t)(m0 + t) * D + 768 + ch] = (bf16)f2bf(y); }
        __syncthreads();
        for (int tt = 0; tt < 64; ++tt) { const int t = half * 64 + tt; const float tot = (ssq2[t * 4 + 0] + ssq2[t * 4 + 1]) + (ssq2[t * 4 + 2] + ssq2[t * 4 + 3]);
            const float rstd = 1.0f / sqrtf(tot * (1.0f / 256.0f) + EPS); bf16* p = YC + (size_t)(m0 + t) * D + 768 + ch; *p = (bf16)f2bf(bf2f(*p) * rstd * og[ch]); }
    }
    __syncthreads();
}

__device__ __forceinline__ void phase_moe_count(const Ctx& c) {
    const int* te = (const int*)(c.ws + WS_TOK + TOK_E); int* seg = (int*)(c.ws + WS_TOK + TOK_SEG);
    for (int sgi = c.gw; sgi < NSEG; sgi += c.ngw) {
        const int m = sgi * SEGT + c.lane; const int e0 = te[2 * m], e1 = te[2 * m + 1];
#pragma unroll
        for (int e = 0; e < NE; ++e) { const unsigned long long b0 = __ballot(e0 == e), b1 = __ballot(e1 == e); if (c.lane == 0) seg[sgi * NE + e] = __popcll(b0) + __popcll(b1); }
    }
}
__device__ __forceinline__ void phase_moe_scatter(const Ctx& c) {
    const int* te = (const int*)(c.ws + WS_TOK + TOK_E); const int* seg = (const int*)(c.ws + WS_TOK + TOK_SEG); int* tpos = (int*)(c.ws + WS_TOK + TOK_POS); int* tile = (int*)(c.ws + WS_TOK + TOK_TILE);
    const bf16* XN = (const bf16*)(c.ws + WS_XN); bf16* XNP = (bf16*)(c.R + R_XNP);
    LAS int* pre = (LAS int*)c.lds;
    LAS int* tot = pre + NSEG * NE;
    LAS int* base = tot + NE;
    __syncthreads();
    if (c.tid < NE) { int s = 0; for (int sgi = 0; sgi < NSEG; ++sgi) { pre[sgi * NE + c.tid] = s; s += seg[sgi * NE + c.tid]; } tot[c.tid] = s; }
    __syncthreads();
    if (c.tid == 0) { int s = 0; for (int e = 0; e < NE; ++e) { base[e] = s; s += (tot[e] + 255) & ~255; }
        if (c.bid == 0) { for (int e = 0; e < NE; ++e) { tile[e] = base[e] / 256; tile[8 + e] = ((tot[e] + 255) & ~255) / 256; } } }
    __syncthreads();
    for (int sgi = c.gw; sgi < NSEG; sgi += c.ngw) {
        const int m = sgi * SEGT + c.lane; const int e0 = te[2 * m], e1 = te[2 * m + 1]; int p0 = 0, p1 = 0;
        const unsigned long long below = (1ull << c.lane) - 1ull;
#pragma unroll
        for (int e = 0; e < NE; ++e) { const unsigned long long b0 = __ballot(e0 == e), b1 = __ballot(e1 == e);
            const int r = __popcll(b0 & below) + __popcll(b1 & below); const int st = base[e] + pre[sgi * NE + e];
            if (e0 == e) p0 = st + r; if (e1 == e) p1 = st + r + ((e0 == e) ? 1 : 0); }
        tpos[2 * m] = p0; tpos[2 * m + 1] = p1;
        for (int q = 0; q < 64; ++q) { const int mq = sgi * SEGT + q; const int d0 = __shfl(p0, q), d1 = __shfl(p1, q);
            const v4u* src = (const v4u*)(XN + (size_t)mq * D) + c.lane; v4u* o0 = (v4u*)(XNP + (size_t)d0 * D) + c.lane; v4u* o1 = (v4u*)(XNP + (size_t)d1 * D) + c.lane;
            const v4u x0 = src[0], x1 = src[64]; o0[0] = x0; o0[64] = x1; o1[0] = x0; o1[64] = x1; }
    }
    for (int e = 0; e < NE; ++e) { const int r0 = base[e] + tot[e], r1 = base[e] + ((tot[e] + 255) & ~255);
        for (int r = r0 + c.gw; r < r1; r += c.ngw) { v4u* o = (v4u*)(XNP + (size_t)r * D) + c.lane; o[0] = (v4u){0u, 0u, 0u, 0u}; o[64] = (v4u){0u, 0u, 0u, 0u}; } }
    __syncthreads();
}
__device__ __forceinline__ void phase_moe_combine(const Ctx& c) {
    const float* tg = (const float*)(c.ws + WS_TOK + TOK_G); const int* tpos = (const int*)(c.ws + WS_TOK + TOK_POS); const bf16* YP = (const bf16*)(c.R + R_YP); float* out = c.a->out;
    for (int m = c.gw; m < M; m += c.ngw) {
        const float g0 = tg[2 * m], g1 = tg[2 * m + 1]; const int p0 = tpos[2 * m], p1 = tpos[2 * m + 1];
        const v2u* y0 = (const v2u*)(YP + (size_t)p0 * D) + c.lane; const v2u* y1 = (const v2u*)(YP + (size_t)p1 * D) + c.lane; f32x4* o = (f32x4*)(out + (size_t)m * D) + c.lane;
#pragma unroll
        for (int j = 0; j < 4; ++j) { const v2u a0 = y0[64 * j], a1 = y1[64 * j]; f32x4 x = o[64 * j];
            x.x += g0 * bflo(a0.x) + g1 * bflo(a1.x); x.y += g0 * bfhi(a0.x) + g1 * bfhi(a1.x); x.z += g0 * bflo(a0.y) + g1 * bflo(a1.y); x.w += g0 * bfhi(a0.y) + g1 * bfhi(a1.y); o[64 * j] = x; }
    }
}

enum { PH_CONV = 0, PH_NORM1, PH_GEMM_IN, PH_RWKV_PREP, PH_MLA_PREP, PH_GMLP, PH_SCAN, PH_ATTN, PH_POST, PH_GEMM_OUT, PH_NORM2, PH_DGU, PH_DDOWN, PH_NORM2R, PH_COUNT, PH_SCATTER, PH_CONVE, PH_EGU, PH_EDOWN, PH_COMBINE };
template <int PH> __global__ void __launch_bounds__(NTHR, 2) k_ph(Args args, int l, int e) {
    extern __shared__ __attribute__((aligned(16))) unsigned char lds_raw[];
    Ctx c; c.lds = (LAS unsigned char*)lds_raw; c.tid = threadIdx.x; c.lane = c.tid & 63; c.wave = __builtin_amdgcn_readfirstlane(c.tid >> 6); c.bid = blockIdx.x; c.nb = gridDim.x;
    c.gw = c.bid * NWAVES + c.wave; c.ngw = c.nb * NWAVES; c.a = &args; c.ws = args.ws; c.R = args.ws + WS_R;
    const Args& a = args;
    bf16* XN = (bf16*)(c.ws + WS_XN); bf16* Zb = (bf16*)(c.R + R_Z); bf16* YC = (bf16*)(c.R + R_YCAT);
    if constexpr (PH == PH_CONV) phase_conv_static(c);
    if constexpr (PH == PH_NORM1) phase_rmsnorm<false>(c, l == 0 ? a.in[I_X] : a.out, a.in[I_MIXG] + l * D, XN, nullptr);
    if constexpr (PH == PH_GEMM_IN) { pg8::Gemm g{XN, (const bf16*)(c.ws + WS_WIN) + (size_t)l * ZP * D, M, ZP, D}; pg8::StaticOrder S; S.init(M, ZP, c.nb, c.bid); pg8::EpiBf16P E{Zb, ZP, ZP / 256};
        pg8::gemm_phase<pg8::EpiBf16P, pg8::StaticOrder, true, true>(c.lds, g, S, E); }
    if constexpr (PH == PH_RWKV_PREP) phase_rwkv_prep(c, l);
    if constexpr (PH == PH_MLA_PREP) phase_mla_prep(c, l);
    if constexpr (PH == PH_GMLP) phase_gmlp(c, l);
    if constexpr (PH == PH_SCAN) phase_rwkv_scan_naive(c);
    if constexpr (PH == PH_ATTN) phase_attn_naive(c);
    if constexpr (PH == PH_POST) { phase_rwkv_post(c, l); phase_mla_post(c, l); }
    if constexpr (PH == PH_GEMM_OUT) { pg8::Gemm g{YC, (const bf16*)(c.ws + WS_WOUT) + (size_t)l * D * D, M, D, D}; pg8::StaticOrder S; S.init(M, D, c.nb, c.bid); pg8::EpiResF32 E{l == 0 ? a.in[I_X] : a.out, a.out, D};
        pg8::gemm_phase<pg8::EpiResF32, pg8::StaticOrder, true, true>(c.lds, g, S, E); }
    if constexpr (PH == PH_NORM2) phase_rmsnorm<false>(c, a.out, a.in[I_FFNG], XN, nullptr);
    if constexpr (PH == PH_DGU) { pg8::Gemm g{XN, (const bf16*)(c.ws + WS_WDGU), M, 2 * DFF, D}; pg8::StaticOrder S; S.init(M, 2 * DFF, c.nb, c.bid); pg8::EpiSwiGLU E{(bf16*)(c.R + R_H), DFF, 2 * DFF / 256};
        pg8::gemm_phase<pg8::EpiSwiGLU, pg8::StaticOrder, true, true>(c.lds, g, S, E); }
    if constexpr (PH == PH_DDOWN) { pg8::Gemm g{(const bf16*)(c.R + R_H), (const bf16*)(c.ws + WS_WDD), M, D, DFF}; pg8::StaticOrder S; S.init(M, D, c.nb, c.bid); pg8::EpiResF32 E{a.out, a.out, D};
        pg8::gemm_phase<pg8::EpiResF32, pg8::StaticOrder, true, true>(c.lds, g, S, E); }
    if constexpr (PH == PH_NORM2R) phase_rmsnorm<true>(c, a.out, a.in[I_FFNG] + D, XN, a.in[I_ROUTER]);
    if constexpr (PH == PH_COUNT) phase_moe_count(c);
    if constexpr (PH == PH_SCATTER) phase_moe_scatter(c);
    if constexpr (PH == PH_CONVE) phase_conv_expert(c, e);
    if constexpr (PH == PH_EGU) { const int* tile = (const int*)(c.ws + WS_TOK + TOK_TILE); const int pm0 = tile[e], nM = tile[8 + e];
        pg8::Gemm g{(const bf16*)(c.R + R_XNP), (const bf16*)(c.ws + WS_WMEGU), M2MAX, 2 * DFE, D}; pg8::RangeOrder S{pm0, nM, 0, 2 * DFE / 256, c.nb, c.bid};
        pg8::EpiSwiGLU E{(bf16*)(c.R + R_HME) - (size_t)pm0 * 256 * DFE, DFE, 2 * DFE / 256};
        pg8::gemm_phase<pg8::EpiSwiGLU, pg8::RangeOrder, true, true>(c.lds, g, S, E); }
    if constexpr (PH == PH_EDOWN) { const int* tile = (const int*)(c.ws + WS_TOK + TOK_TILE); const int pm0 = tile[e], nM = tile[8 + e];
        pg8::Gemm g{(const bf16*)(c.R + R_HME) - (size_t)pm0 * 256 * DFE, (const bf16*)(c.ws + WS_WMED), M2MAX, D, DFE}; pg8::RangeOrder S{pm0, nM, 0, D / 256, c.nb, c.bid};
        pg8::EpiBf16P E{(bf16*)(c.R + R_YP), D, D / 256};
        pg8::gemm_phase<pg8::EpiBf16P, pg8::RangeOrder, true, true>(c.lds, g, S, E); }
    if constexpr (PH == PH_COMBINE) phase_moe_combine(c);
}

template <int PH> static void launch_ph(const Args& a, int l, int e, int grid, hipStream_t stream) {
    static bool attr = false;
    if (!attr) { (void)hipFuncSetAttribute((const void*)k_ph<PH>, hipFuncAttributeMaxDynamicSharedMemorySize, LDS_BYTES); attr = true; }
    hipLaunchKernelGGL(k_ph<PH>, dim3(grid), dim3(NTHR), LDS_BYTES, stream, a, l, e);
}
extern "C" void kernel_launch(void* const* d_in, const int* in_sizes, int n_in, void* d_out, int out_size, void* d_ws, size_t ws_size, hipStream_t stream) {
    static int grid = 0;
    if (grid == 0) {
        if (n_in != 39 || out_size != M * D || ws_size < WS_END) { fprintf(stderr, "kernel_launch: unexpected shapes (n_in %d, out %d, ws %zu < %zu)\n", n_in, out_size, ws_size, (size_t)WS_END); grid = -1; return; }
        int dev = 0, cus = 0;
        if (hipGetDevice(&dev) != hipSuccess || hipDeviceGetAttribute(&cus, hipDeviceAttributeMultiprocessorCount, dev) != hipSuccess) { grid = -1; return; }
        grid = cus;
    }
    if (grid < 0) return;
    Args a{};
    for (int i = 0; i < 39; ++i) a.in[i] = (const float*)d_in[i];
    a.out = (float*)d_out; a.ws = (unsigned char*)d_ws; a.ph_lo = 0; a.ph_hi = 0;
    launch_ph<PH_CONV>(a, 0, 0, grid, stream);
    for (int l = 0; l < 2; ++l) {
        launch_ph<PH_NORM1>(a, l, 0, grid, stream);
        launch_ph<PH_GEMM_IN>(a, l, 0, grid, stream);
        launch_ph<PH_RWKV_PREP>(a, l, 0, grid, stream);
        launch_ph<PH_MLA_PREP>(a, l, 0, grid, stream);
        launch_ph<PH_GMLP>(a, l, 0, grid, stream);
        launch_ph<PH_SCAN>(a, l, 0, grid, stream);
        launch_ph<PH_ATTN>(a, l, 0, grid, stream);
        launch_ph<PH_POST>(a, l, 0, grid, stream);
        launch_ph<PH_GEMM_OUT>(a, l, 0, grid, stream);
        if (l == 0) {
            launch_ph<PH_NORM2>(a, l, 0, grid, stream);
            launch_ph<PH_DGU>(a, l, 0, grid, stream);
            launch_ph<PH_DDOWN>(a, l, 0, grid, stream);
        } else {
            launch_ph<PH_NORM2R>(a, l, 0, grid, stream);
            launch_ph<PH_COUNT>(a, l, 0, grid, stream);
            launch_ph<PH_SCATTER>(a, l, 0, grid, stream);
            for (int e = 0; e < NE; ++e) {
                launch_ph<PH_CONVE>(a, l, e, grid, stream);
                launch_ph<PH_EGU>(a, l, e, grid, stream);
                launch_ph<PH_EDOWN>(a, l, e, grid, stream);
            }
            launch_ph<PH_COMBINE>(a, l, 0, grid, stream);
        }
    }
}
```

```cpp
#include <hip/hip_runtime.h>
#include <cstdio>
#include <cstdint>
#include <cmath>
namespace pg8 {
#define PG8_LAS __attribute__((address_space(3)))
typedef unsigned short bf16_t;
typedef short bf16x8 __attribute__((ext_vector_type(8)));
typedef float f32x4 __attribute__((ext_vector_type(4)));
typedef unsigned u32x4 __attribute__((ext_vector_type(4)));
constexpr int BM = 256, BK = 64, HALF = 128, HTB = HALF * BK * 2  , STAGE_BYTES = 8 * HTB, NXCD = 8, WGM = 8;

__host__ __device__ __forceinline__ int lds_byte(int r, int c) { const int st = (r >> 4) * 2 + (c >> 5), rr = r & 15, cc = c & 31, ob = rr * 64 + cc * 2; return st * 1024 + (ob ^ (((ob >> 9) & 1) << 5)); }
__host__ __device__ __forceinline__ void stage_rc(int b, int& R, int& C) { const int st = b / 1024, sb = b % 1024, swz = sb ^ (((sb >> 9) & 1) << 5); R = (st >> 1) * 16 + swz / 64; C = (st & 1) * 32 + (swz % 64) / 2; }
__host__ __device__ __forceinline__ int perm32(int rho) { const int n = rho >> 4, i = rho & 15; return 8 * (i >> 2) + 4 * n + (i & 3); }

struct Unit { int pm, pn, po; };
struct Gemm { const bf16_t* A; const bf16_t* Bt; int M, N, K, lda; };

struct StaticOrder {
    int nM, nN, nwg, G, c;
    __host__ __device__ void init(int M, int N, int G_, int c_) { nM = M / BM; nN = N / BM; nwg = nM * nN; G = G_; c = c_; }
    __host__ __device__ bool next(int i, Unit& u) const {
        const long L = (long)i * G + c; if (L >= nwg) return false;
        int wgid = (int)L; { const int q = nwg / NXCD, r = nwg % NXCD, xcd = wgid % NXCD, off = wgid / NXCD; wgid = (xcd < r ? xcd * (q + 1) : r * (q + 1) + (xcd - r) * q) + off; }
        const int nig = WGM * nN, gid = wgid / nig, fm = gid * WGM, gsz = (nM - fm) < WGM ? (nM - fm) : WGM;
        u.pm = fm + ((wgid % nig) % gsz); u.pn = (wgid % nig) / gsz; u.po = u.pm; return true;
    }
    __device__ __forceinline__ void a_ready(const Unit&) const {}
    __device__ __forceinline__ void done(const Unit&) const {}
};

__device__ __forceinline__ unsigned cvt_pk_bf16(float lo, float hi) { unsigned r; asm volatile("v_cvt_pk_bf16_f32 %0, %1, %2" : "=v"(r) : "v"(lo), "v"(hi)); return r; }
typedef float f32x2 __attribute__((ext_vector_type(2)));
__device__ __forceinline__ f32x2 gelu_pk(f32x2 v) {
    const f32x2 av = __builtin_elementwise_abs(v), d = av * 0.2316418882f + 1.0f;
    f32x2 t; t.x = __builtin_amdgcn_rcpf(d.x); t.y = __builtin_amdgcn_rcpf(d.y);
    f32x2 q = t * 0.5307027145f + (-0.7265760135f); q = q * t + 0.7107068705f; q = q * t + (-0.142248368f); q = q * t + 0.127414796f; q = q * t;
    const f32x2 s = (v * v) * (-0.72134752044f);
    f32x2 e; e.x = __builtin_amdgcn_exp2f(s.x); e.y = __builtin_amdgcn_exp2f(s.y);
    const f32x2 m = v * (q * e), r = v - m;
    f32x2 o; o.x = v.x < 0.f ? m.x : r.x; o.y = v.y < 0.f ? m.y : r.y; return o;
}

template <int ACT  > struct EpiBf16 {
    static constexpr bool PERM = true, AFTER_DRAIN = false; static_assert(ACT == 0 || ACT == 1, "EpiBf16: ACT is 0 (none) or 1 (gelu_pk)");
    bf16_t* O; int ldc; const float* bias; int split_cols; size_t split_stride; float scale0;
    __device__ __forceinline__ void operator()(const f32x4 (&acc)[2][2][4][2], const Unit& u, int wr, int wc, int fr, int fq) const {
        const int row0 = u.po * BM + wr * 64 + fr; int colt = u.pn * BM; bf16_t* base = O;
        float sc = 1.f; if (split_cols) { const int t = colt / split_cols; base += (size_t)t * split_stride; colt -= t * split_cols; if (t == 0) sc = scale0; }
        const int col0 = colt + wc * 32 + 8 * fq, bcol0 = u.pn * BM + wc * 32 + 8 * fq;
        f32x4 bv[2][2];
#pragma unroll
        for (int bj = 0; bj < 2; ++bj)
#pragma unroll
            for (int n = 0; n < 2; ++n) bv[bj][n] = bias ? *(const f32x4*)(bias + bcol0 + bj * HALF + 4 * n) : (f32x4){0.f, 0.f, 0.f, 0.f};
#pragma unroll
        for (int ai = 0; ai < 2; ++ai)
#pragma unroll
            for (int m = 0; m < 4; ++m) { bf16_t* rowp = base + (size_t)(row0 + ai * HALF + m * 16) * ldc + col0;
#pragma unroll
                for (int bj = 0; bj < 2; ++bj) { f32x4 v0 = acc[ai][bj][m][0] + bv[bj][0], v1 = acc[ai][bj][m][1] + bv[bj][1];
                    if (ACT == 1) { f32x2 a = gelu_pk((f32x2){v0[0], v0[1]}), b = gelu_pk((f32x2){v0[2], v0[3]}), c = gelu_pk((f32x2){v1[0], v1[1]}), d = gelu_pk((f32x2){v1[2], v1[3]});
                        v0 = (f32x4){a.x, a.y, b.x, b.y}; v1 = (f32x4){c.x, c.y, d.x, d.y}; }
                    v0 = v0 * sc; v1 = v1 * sc; u32x4 w; w.x = cvt_pk_bf16(v0[0], v0[1]); w.y = cvt_pk_bf16(v0[2], v0[3]); w.z = cvt_pk_bf16(v1[0], v1[1]); w.w = cvt_pk_bf16(v1[2], v1[3]);
                    *(u32x4*)(rowp + bj * HALF) = w; } }
    }
};

struct EpiResF32 {
    static constexpr bool PERM = false, AFTER_DRAIN = false;
    const float* base; float* out; int ldc;
    __device__ __forceinline__ void operator()(const f32x4 (&acc)[2][2][4][2], const Unit& u, int wr, int wc, int fr, int fq) const {
        const int row0 = u.po * BM + wr * 64 + fr, col0 = u.pn * BM + wc * 32 + 4 * fq;
#pragma unroll
        for (int ai = 0; ai < 2; ++ai)
#pragma unroll
            for (int m = 0; m < 4; ++m) { const size_t off = (size_t)(row0 + ai * HALF + m * 16) * ldc + col0;
#pragma unroll
                for (int bj = 0; bj < 2; ++bj)
#pragma unroll
                    for (int n = 0; n < 2; ++n) { const f32x4 b = *(const f32x4*)(base + off + bj * HALF + n * 16); *(f32x4*)(out + off + bj * HALF + n * 16) = b + acc[ai][bj][m][n]; } }
    }
};
struct EpiResF32N {
    static constexpr bool PERM = false, AFTER_DRAIN = false;
    const float* base; float* out; int ldc; bf16_t* xn; const float* gain; float* ss;
    __device__ __forceinline__ void operator()(const f32x4 (&acc)[2][2][4][2], const Unit& u, int wr, int wc, int fr, int fq) const {
        const int row0 = u.po * BM + wr * 64 + fr, col0 = u.pn * BM + wc * 32 + 4 * fq;
        f32x4 gv[2][2];
#pragma unroll
        for (int bj = 0; bj < 2; ++bj)
#pragma unroll
            for (int n = 0; n < 2; ++n) gv[bj][n] = *(const f32x4*)(gain + col0 + bj * HALF + n * 16);
#pragma unroll
        for (int ai = 0; ai < 2; ++ai)
#pragma unroll
            for (int m = 0; m < 4; ++m) { const int row = row0 + ai * HALF + m * 16; const size_t off = (size_t)row * ldc + col0; float s = 0.f;
#pragma unroll
                for (int bj = 0; bj < 2; ++bj)
#pragma unroll
                    for (int n = 0; n < 2; ++n) { const f32x4 b = *(const f32x4*)(base + off + bj * HALF + n * 16); const f32x4 v = b + acc[ai][bj][m][n]; *(f32x4*)(out + off + bj * HALF + n * 16) = v;
                        s += (v[0] * v[0] + v[1] * v[1]) + (v[2] * v[2] + v[3] * v[3]); const f32x4 w = v * gv[bj][n];
                        typedef unsigned u32x2v __attribute__((ext_vector_type(2))); *(u32x2v*)(xn + off + bj * HALF + n * 16) = (u32x2v){cvt_pk_bf16(w[0], w[1]), cvt_pk_bf16(w[2], w[3])}; }
                s += __shfl_xor(s, 16); s += __shfl_xor(s, 32);
                if (fq == 0) ss[(size_t)row * 16 + u.pn * 4 + wc] = s; }
    }
};
__device__ __forceinline__ float row_rstd(const float* ss, int row, float inv_n, float eps) { if (!ss) return 1.0f;
    const f32x4* p = (const f32x4*)(ss + (size_t)row * 16); const f32x4 a = p[0], b = p[1], c = p[2], d = p[3];
    const float t = ((a[0] + a[1]) + (a[2] + a[3])) + ((b[0] + b[1]) + (b[2] + b[3])) + (((c[0] + c[1]) + (c[2] + c[3])) + ((d[0] + d[1]) + (d[2] + d[3])));
    return __builtin_amdgcn_rsqf(t * inv_n + eps); }
struct EpiBf16P {
    static constexpr bool PERM = true, AFTER_DRAIN = false;
    bf16_t* O; int ldc; int ntn; const float* ss; float inv_n;
    __device__ __forceinline__ void operator()(const f32x4 (&acc)[2][2][4][2], const Unit& u, int wr, int wc, int fr, int fq) const {
        const int row0 = u.po * BM + wr * 64 + fr, col0 = (u.pn % ntn) * BM + wc * 32 + 8 * fq;
#pragma unroll
        for (int ai = 0; ai < 2; ++ai)
#pragma unroll
            for (int m = 0; m < 4; ++m) { bf16_t* rowp = O + (size_t)(row0 + ai * HALF + m * 16) * ldc + col0; const float rs = row_rstd(ss, row0 + ai * HALF + m * 16, inv_n, 1e-6f);
#pragma unroll
                for (int bj = 0; bj < 2; ++bj) { const f32x4 v0 = acc[ai][bj][m][0] * rs, v1 = acc[ai][bj][m][1] * rs;
                    u32x4 w; w.x = cvt_pk_bf16(v0[0], v0[1]); w.y = cvt_pk_bf16(v0[2], v0[3]); w.z = cvt_pk_bf16(v1[0], v1[1]); w.w = cvt_pk_bf16(v1[2], v1[3]);
                    *(u32x4*)(rowp + bj * HALF) = w; } }
    }
};
__device__ __forceinline__ float silu_f(float x) { return x / (1.0f + __expf(-x)); }
struct EpiSwiGLU {
    static constexpr bool PERM = true, AFTER_DRAIN = false;
    bf16_t* H; int ldh; int ntn; const float* ss; float inv_n;
    __device__ __forceinline__ void operator()(const f32x4 (&acc)[2][2][4][2], const Unit& u, int wr, int wc, int fr, int fq) const {
        const int row0 = u.po * BM + wr * 64 + fr, col0 = (u.pn % ntn) * HALF + wc * 32 + 8 * fq;
#pragma unroll
        for (int ai = 0; ai < 2; ++ai)
#pragma unroll
            for (int m = 0; m < 4; ++m) { bf16_t* rowp = H + (size_t)(row0 + ai * HALF + m * 16) * ldh + col0;
                const float rs = row_rstd(ss, row0 + ai * HALF + m * 16, inv_n, 1e-6f);
                const f32x4 g0 = acc[ai][0][m][0] * rs, g1 = acc[ai][0][m][1] * rs, u0 = acc[ai][1][m][0] * rs, u1 = acc[ai][1][m][1] * rs;
                u32x4 w;
                w.x = cvt_pk_bf16(silu_f(g0[0]) * u0[0], silu_f(g0[1]) * u0[1]); w.y = cvt_pk_bf16(silu_f(g0[2]) * u0[2], silu_f(g0[3]) * u0[3]);
                w.z = cvt_pk_bf16(silu_f(g1[0]) * u1[0], silu_f(g1[1]) * u1[1]); w.w = cvt_pk_bf16(silu_f(g1[2]) * u1[2], silu_f(g1[3]) * u1[3]);
                *(u32x4*)rowp = w; }
    }
};
struct RangeOrder {
    int pm0, nM, pn0, nN, G, c;
    __device__ __forceinline__ bool next(int i, Unit& u) const { const int L = i * G + c; if (L >= nM * nN) return false; const int q = L / nM; u.pn = pn0 + q; u.pm = pm0 + (L - q * nM); u.po = u.pm; return true; }
    __device__ __forceinline__ void a_ready(const Unit&) const {}
    __device__ __forceinline__ void done(const Unit&) const {}
};

template <bool AROW> struct MoeOrder {
    const PG8_LAS int* te; int t0, n0, s0, t1, n1, s1, nN, G, c, nq, q;
    __device__ __forceinline__ bool next(int i, Unit& u) const { const int U = (n0 + n1) * nN; int L;
        if (c < nq) { if (i >= q) return false; L = c * q + i; } else L = nq * q + (c - nq) + i * (G - nq);
        if (L >= U) return false; const int ti = L / nN, pn = L - ti * nN;
        const int tile = ti < n0 ? t0 + ti : t1 + (ti - n0), slot = ti < n0 ? s0 + ti : s1 + (ti - n0); const int e = te[tile];
        u.pn = e * nN + pn; u.pm = AROW ? tile : slot; u.po = AROW ? slot : tile; return true; }
    __device__ __forceinline__ void a_ready(const Unit&) const {}
    __device__ __forceinline__ void done(const Unit&) const {}
};
template <class Epi, class Sched, bool ALIGN_EPI = false, bool SP2 = false>
__device__ __forceinline__ void gemm_phase(PG8_LAS unsigned char* lds, const Gemm g, const Sched& S, const Epi& E) {
    int tid_ = threadIdx.x; asm volatile("" : "+v"(tid_));
    const int tid = tid_, wid = __builtin_amdgcn_readfirstlane(tid >> 6), lane = tid & 63, wr = wid >> 2, wc = wid & 3, fr = lane & 15, fq = lane >> 4;
    const int K = g.K, nt = K / BK, lda = g.lda ? g.lda : K;
    unsigned voffA[2], voffB[2];
#pragma unroll
    for (int i = 0; i < 2; ++i) { int R, C; stage_rc(tid * 16 + i * 8192, R, C); const int Rb = Epi::PERM ? ((R & ~31) + perm32(R & 31)) : R;
        voffA[i] = (unsigned)(R * lda + C) * 2u; voffB[i] = (unsigned)(Rb * K + C) * 2u; }
    const size_t kstep = (size_t)(BK * 2);
    const size_t hstep = (size_t)HALF * K * 2, hstepA = (size_t)HALF * lda * 2;
    const size_t tstep = 2 * hstep, tstepA = 2 * hstepA;
    const unsigned ldsw = (unsigned)wid * 1024u;
    const int aoff = lds_byte(wr * 64 + fr, fq * 8), boff = lds_byte(wc * 32 + fr, fq * 8);
#define PG8_SA(b, h) (((b) * 2 + (h)) * HTB)
#define PG8_SB(b, h) ((4 + (b) * 2 + (h)) * HTB)
#define PG8_STAGE(bufoff, gbase, voff) do { _Pragma("unroll") for (int _i = 0; _i < 2; ++_i) \
        __builtin_amdgcn_global_load_lds((const unsigned*)((const char*)(gbase) + (voff)[_i]), (PG8_LAS unsigned*)(lds + (bufoff) + ldsw + _i * 8192), 16, 0, 0); } while (0)
#define PG8_LDA(dst, b, h) do { _Pragma("unroll") for (int m = 0; m < 4; ++m) _Pragma("unroll") for (int k = 0; k < 2; ++k) dst[m][k] = *(const PG8_LAS bf16x8*)(lds + PG8_SA(b, h) + aoff + m * 2048 + k * 1024); } while (0)
#define PG8_LDB(dst, b, h) do { _Pragma("unroll") for (int n = 0; n < 2; ++n) _Pragma("unroll") for (int k = 0; k < 2; ++k) dst[n][k] = *(const PG8_LAS bf16x8*)(lds + PG8_SB(b, h) + boff + n * 2048 + k * 1024); } while (0)
#define PG8_MMA(ai, bj, At, Bt) do { __builtin_amdgcn_s_setprio(1); _Pragma("unroll") for (int m = 0; m < 4; ++m) _Pragma("unroll") for (int n = 0; n < 2; ++n) _Pragma("unroll") for (int k = 0; k < 2; ++k) \
        acc[ai][bj][m][n] = __builtin_amdgcn_mfma_f32_16x16x32_bf16(Bt[n][k], At[m][k], acc[ai][bj][m][n], 0, 0, 0); __builtin_amdgcn_s_setprio(0); } while (0)
#define PG8_WAIT_V(n) asm volatile("s_waitcnt vmcnt(" #n ")" ::: "memory")
#define PG8_WAIT_L(n) asm volatile("s_waitcnt lgkmcnt(" #n ")" ::: "memory")
#define PG8_BAR __builtin_amdgcn_s_barrier()
#define PG8_SCHED __builtin_amdgcn_sched_barrier(0)
    Unit cur, nxt; int ui = 0;
    if (!S.next(0, cur)) return;
    f32x4 acc[2][2][4][2];
#pragma unroll
    for (int a = 0; a < 2; ++a)
#pragma unroll
        for (int b = 0; b < 2; ++b)
#pragma unroll
            for (int m = 0; m < 4; ++m)
#pragma unroll
                for (int n = 0; n < 2; ++n) acc[a][b][m][n] = (f32x4){0.f, 0.f, 0.f, 0.f};
    bf16x8 At[4][2], B0[2][2], B1[2][2];
    const char* cA = (const char*)g.A + (size_t)cur.pm * tstepA; const char* cB = (const char*)g.Bt + (size_t)cur.pn * tstep;
    S.a_ready(cur);
    if constexpr (SP2) {
        PG8_STAGE(PG8_SB(0, 0), cB, voffB); PG8_STAGE(PG8_SB(0, 1), cB + hstep, voffB); PG8_STAGE(PG8_SA(0, 0), cA, voffA); PG8_STAGE(PG8_SA(0, 1), cA + hstepA, voffA);
        if (wr == 1) PG8_BAR;
        PG8_WAIT_V(2); PG8_BAR;
        PG8_STAGE(PG8_SB(1, 0), cB + kstep, voffB); PG8_STAGE(PG8_SA(1, 0), cA + kstep, voffA); PG8_STAGE(PG8_SB(1, 1), cB + hstep + kstep, voffB);
        PG8_WAIT_V(6); PG8_BAR;
    } else {
        PG8_STAGE(PG8_SB(0, 0), cB, voffB); PG8_STAGE(PG8_SA(0, 0), cA, voffA); PG8_STAGE(PG8_SB(0, 1), cB + hstep, voffB); PG8_STAGE(PG8_SA(0, 1), cA + hstepA, voffA);
        if (wr == 1) PG8_BAR;
        PG8_WAIT_V(4); PG8_BAR;
        PG8_STAGE(PG8_SB(1, 0), cB + kstep, voffB); PG8_STAGE(PG8_SA(1, 0), cA + kstep, voffA); PG8_STAGE(PG8_SB(1, 1), cB + hstep + kstep, voffB);
        PG8_WAIT_V(6); PG8_BAR;
    }
    for (;;) {
        const bool has_next = S.next(ui + 1, nxt);
        const char* nA = has_next ? (const char*)g.A + (size_t)nxt.pm * tstepA : cA; const char* nB = has_next ? (const char*)g.Bt + (size_t)nxt.pn * tstep : cB;
        for (int t = 0; t < nt; t += 2) {
            const bool last = (t == nt - 2);
            const char* a1 = cA + (size_t)(t + 1) * kstep;
            const char* a2 = last ? nA : cA + (size_t)(t + 2) * kstep; const char* b2 = last ? nB : cB + (size_t)(t + 2) * kstep;
            const char* a3 = a2 + kstep; const char* b3 = b2 + kstep;
            if (last && has_next) S.a_ready(nxt);
            if constexpr (SP2) {
            PG8_LDB(B0, 0, 0); PG8_LDB(B1, 0, 1); PG8_SCHED; PG8_LDA(At, 0, 0); PG8_STAGE(PG8_SA(1, 1), a1 + hstepA, voffA);
            PG8_WAIT_V(8); PG8_WAIT_L(0); PG8_BAR; PG8_MMA(0, 0, At, B0); PG8_MMA(0, 1, At, B1); PG8_BAR; PG8_SCHED;
            PG8_LDA(At, 0, 1); PG8_STAGE(PG8_SB(0, 0), b2, voffB); PG8_STAGE(PG8_SB(0, 1), b2 + hstep, voffB); PG8_STAGE(PG8_SA(0, 0), a2, voffA);
            PG8_WAIT_V(8); PG8_WAIT_L(0); PG8_BAR; PG8_MMA(1, 0, At, B0); PG8_MMA(1, 1, At, B1); PG8_BAR; PG8_SCHED;
            PG8_LDB(B0, 1, 0); PG8_LDB(B1, 1, 1); PG8_SCHED; PG8_LDA(At, 1, 0); PG8_STAGE(PG8_SA(0, 1), a2 + hstepA, voffA);
            PG8_WAIT_V(8); PG8_WAIT_L(0); PG8_BAR; PG8_MMA(0, 0, At, B0); PG8_MMA(0, 1, At, B1); PG8_BAR; PG8_SCHED;
            PG8_LDA(At, 1, 1); PG8_STAGE(PG8_SB(1, 0), b3, voffB); PG8_STAGE(PG8_SB(1, 1), b3 + hstep, voffB); PG8_STAGE(PG8_SA(1, 0), a3, voffA);
            PG8_WAIT_V(8); PG8_WAIT_L(0); PG8_BAR; PG8_MMA(1, 0, At, B0); PG8_MMA(1, 1, At, B1); PG8_BAR; PG8_SCHED;
            } else {
            PG8_LDB(B0, 0, 0); PG8_SCHED; PG8_LDA(At, 0, 0); PG8_STAGE(PG8_SA(1, 1), a1 + hstepA, voffA);
            PG8_WAIT_L(8); PG8_BAR; PG8_WAIT_L(0); PG8_MMA(0, 0, At, B0); PG8_BAR; PG8_SCHED;
            PG8_LDB(B1, 0, 1); PG8_STAGE(PG8_SB(0, 0), b2, voffB);
            PG8_BAR; PG8_WAIT_L(0); PG8_MMA(0, 1, At, B1); PG8_BAR;
            PG8_LDA(At, 0, 1); PG8_STAGE(PG8_SA(0, 0), a2, voffA);
            PG8_BAR; PG8_WAIT_L(0); PG8_MMA(1, 0, At, B0); PG8_BAR; PG8_SCHED;
            PG8_STAGE(PG8_SB(0, 1), b2 + hstep, voffB);
            PG8_WAIT_V(6); PG8_BAR; PG8_MMA(1, 1, At, B1); PG8_BAR;
            PG8_LDB(B0, 1, 0); PG8_SCHED; PG8_LDA(At, 1, 0); PG8_STAGE(PG8_SA(0, 1), a2 + hstepA, voffA);
            PG8_WAIT_L(8); PG8_BAR; PG8_WAIT_L(0); PG8_MMA(0, 0, At, B0); PG8_BAR; PG8_SCHED;
            PG8_LDB(B1, 1, 1); PG8_STAGE(PG8_SB(1, 0), b3, voffB);
            PG8_BAR; PG8_WAIT_L(0); PG8_MMA(0, 1, At, B1); PG8_BAR;
            PG8_LDA(At, 1, 1); PG8_STAGE(PG8_SA(1, 0), a3, voffA);
            PG8_BAR; PG8_WAIT_L(0); PG8_MMA(1, 0, At, B0); PG8_BAR; PG8_SCHED;
            PG8_STAGE(PG8_SB(1, 1), b3 + hstep, voffB);
            PG8_WAIT_V(6); PG8_BAR; PG8_MMA(1, 1, At, B1); PG8_BAR;
            }
        }
        if constexpr (ALIGN_EPI) { if (wr == 0) PG8_BAR; }
        if constexpr (!Epi::AFTER_DRAIN) { E(acc, cur, wr, wc, fr, fq); S.done(cur); }
        if (!has_next) break;
#pragma unroll
        for (int a = 0; a < 2; ++a)
#pragma unroll
            for (int b = 0; b < 2; ++b)
#pragma unroll
                for (int m = 0; m < 4; ++m)
#pragma unroll
                    for (int n = 0; n < 2; ++n) acc[a][b][m][n] = (f32x4){0.f, 0.f, 0.f, 0.f};
        cur = nxt; cA = nA; cB = nB; ++ui;
        if constexpr (ALIGN_EPI) { if (wr == 1) PG8_BAR; }
    }
    PG8_WAIT_V(0);
    if constexpr (!ALIGN_EPI) { if (wr == 0) PG8_BAR; }
    PG8_BAR;
    if constexpr (Epi::AFTER_DRAIN) { E.fused(acc, cur, wr, wc, fr, fq, lds, wid, lane); S.done(cur); }
#undef PG8_SA
#undef PG8_SB
#undef PG8_STAGE
#undef PG8_LDA
#undef PG8_LDB
#undef PG8_MMA
#undef PG8_WAIT_V
#undef PG8_WAIT_L
#undef PG8_BAR
#undef PG8_SCHED
}
}

#define PROBE_KS 4
#define PROBE_YL 1.f
#define PROBE_NO_VP 0
#ifndef PROBE_REP
#define PROBE_REP 1
#endif
#ifndef MK_ONE_LAUNCH
#define MK_ONE_LAUNCH 1
#endif
constexpr int NWAVES = 8, NTHR = 512;
constexpr int BATCH = 2, SEQ = 8192, M = BATCH * SEQ, D = 1024;
constexpr int AH = 6, AW = 384;
constexpr int ZP = 2304;
constexpr int ZR = 0, ZK = 384, ZV = 768, ZWD = 1152, ZAD = 1184, ZGD = 1216, ZU = 1280, ZCV = 1536, ZCQ = 1792, ZCKV = 2048, ZKR = 2176;
constexpr int DFF = 2816, DFE = 3584, NE = 8;
constexpr int QKD = 96, QP = 576;
constexpr float EPS = 1e-6f;
constexpr int M2MAX = 2 * M + NE * 256;

constexpr size_t MiB = 1u << 20;
constexpr size_t WS_CTL = 0, CTL_ZERO_BYTES = 1 * MiB;
constexpr size_t WS_WIN = 1 * MiB, WS_WOUT = 10 * MiB, WS_WDGU = 14 * MiB, WS_WDD = 25 * MiB;
constexpr size_t WS_WSM = 31 * MiB;
constexpr size_t WS_XN = 33 * MiB, WS_VF = 65 * MiB, WS_TOK = 77 * MiB, WS_R = 79 * MiB;
constexpr size_t WSM_UQ = 0, WSM_UKV = WSM_UQ + 2 * 768 * 256 * 2, WSM_GW = WSM_UKV + 2 * 768 * 128 * 2, WSM_LW = WSM_GW + 2 * 4 * 128 * 128 * 2, WSM_LA = WSM_LW + 2 * AW * 32 * 2, WSM_LG = WSM_LA + 2 * AW * 32 * 2, WSM_VD = WSM_LG + 2 * AW * 64 * 2, WSM_END = WSM_VD + 16 * AW * 2;
constexpr size_t R_Z = 0, R_NAT = 72 * MiB, R_TR = 120 * MiB, R_QR = 168 * MiB, R_KVR = 192 * MiB, R_VG = 216 * MiB, R_BON = 240 * MiB, R_WL = 240 * MiB + 512 * 1024, R_NT = 241 * MiB, R_YL = 265 * MiB;
constexpr size_t R_Q = 289 * MiB, R_K = 307 * MiB, R_V = 325 * MiB;
constexpr size_t R_CHM = 0, R_CHR = 12 * MiB, R_CHS = 24 * MiB, R_OATT = 36 * MiB;
constexpr size_t R_RW = R_NAT, R_LW = R_NT, R_YRAW = R_YL;
constexpr int NCHUNK = BATCH * AH * (SEQ / 64);
constexpr size_t BLK = 4096;
constexpr size_t R_H = 0;
constexpr size_t R_XN2 = 100 * MiB;
constexpr size_t R_WMD = 0, R_WMGU = 72 * MiB;
constexpr size_t R_XNP = 184 * MiB, R_YP = R_XNP, R_HME = 252 * MiB;
constexpr int HMAIN = 64, HCAP = 71;
constexpr size_t WS_END = WS_R + 377 * MiB;
constexpr size_t RWSZ = (size_t)M * AW;
constexpr size_t TOK_E = 0, TOK_G = (size_t)M * 2 * 4, TOK_POS = (size_t)M * 4 * 4, TOK_SEG = (size_t)M * 6 * 4, TOK_TILE = TOK_SEG + 256 * 8 * 4;
constexpr int NSEG = 256, SEGT = M / NSEG;

constexpr int CW_BAR = 4096;
constexpr int CW_CQ = 40000;
constexpr size_t R_SS0 = 140 * MiB, R_SS1 = 120 * MiB;
constexpr int LDS_BYTES = 147456, RING_BYTES = 131072, MISC_OFF = RING_BYTES + 320;

#define GAS __attribute__((address_space(1)))
#define LAS __attribute__((address_space(3)))
typedef unsigned short bf16;
typedef unsigned v4u __attribute__((ext_vector_type(4)));
typedef unsigned v2u __attribute__((ext_vector_type(2)));
typedef float f32x4 __attribute__((ext_vector_type(4)));
typedef float f32x2 __attribute__((ext_vector_type(2)));
#define LDS_WAIT() asm volatile("s_waitcnt lgkmcnt(0)" ::: "memory")
#define VM_WAIT() asm volatile("s_waitcnt vmcnt(0)" ::: "memory")
typedef __bf16 bf16x2_hw __attribute__((ext_vector_type(2)));
__device__ __forceinline__ unsigned pk2(float lo, float hi) { const f32x2 v = {lo, hi}; return __builtin_bit_cast(unsigned, __builtin_convertvector(v, bf16x2_hw)); }
__device__ __forceinline__ unsigned f2bf(float f) { return pk2(f, 0.f) & 0xffffu; }
__device__ __forceinline__ float bf2f(bf16 b) { return __builtin_bit_cast(float, (unsigned)b << 16); }
__device__ __forceinline__ float bflo(unsigned w) { return __builtin_bit_cast(float, w << 16); }
__device__ __forceinline__ float bfhi(unsigned w) { return __builtin_bit_cast(float, w & 0xffff0000u); }
template <int CTRL> __device__ __forceinline__ float dpp_mov(float v) { return __builtin_bit_cast(float, __builtin_amdgcn_update_dpp(0, __builtin_bit_cast(int, v), CTRL, 0xf, 0xf, false)); }
__device__ __forceinline__ float wave_sum(float v) {
    v += dpp_mov<0xB1>(v);
    v += dpp_mov<0x4E>(v);
    v += dpp_mov<0x124>(v);
    v += dpp_mov<0x128>(v);
    const int vi = __builtin_bit_cast(int, v);
    const float r0 = __builtin_bit_cast(float, __builtin_amdgcn_readlane(vi, 0)), r1 = __builtin_bit_cast(float, __builtin_amdgcn_readlane(vi, 16));
    const float r2 = __builtin_bit_cast(float, __builtin_amdgcn_readlane(vi, 32)), r3 = __builtin_bit_cast(float, __builtin_amdgcn_readlane(vi, 48));
    return (r0 + r1) + (r2 + r3);
}
__device__ __forceinline__ float row16_sum(float v) {
    v += dpp_mov<0xB1>(v); v += dpp_mov<0x4E>(v); v += dpp_mov<0x124>(v); v += dpp_mov<0x128>(v); return v; }
__device__ __forceinline__ float sigmoid_f(float x) { return 1.0f / (1.0f + __expf(-x)); }
__device__ __forceinline__ float sigmoid_fast(float x) { return __builtin_amdgcn_rcpf(1.0f + __expf(-x)); }
__device__ __forceinline__ unsigned short f2bf_hw(float x) { typedef __bf16 bfx2 __attribute__((ext_vector_type(2))); const f32x2 v = {x, 0.f}; return (unsigned short)(__builtin_bit_cast(unsigned, __builtin_convertvector(v, bfx2)) & 0xffffu); }
__device__ __forceinline__ float gelu_erf(float x) { return 0.5f * x * (1.0f + erff(x * 0.70710678118654752f)); }

#define XB_TMO      128
#define XB_XCNT(j)  (256  + 64 * (j))
#define XB_XSUB(j)  (1280 + 64 * (j))
#define XB_XGEN(j)  (2304 + 64 * (j))
#define XB_TOP      3328
#define XB_TOPGEN   3392
#define XCD_BAR_WORDS 3456
#define XB_SPIN_CAP (1u << 18)

__device__ __forceinline__ unsigned xb_ld(unsigned* p)              { return __hip_atomic_load(p, __ATOMIC_RELAXED, __HIP_MEMORY_SCOPE_AGENT); }
__device__ __forceinline__ unsigned xb_add(unsigned* p, unsigned v) { return __hip_atomic_fetch_add(p, v, __ATOMIC_RELAXED, __HIP_MEMORY_SCOPE_AGENT); }
__device__ __forceinline__ unsigned xb_xcc_id() { return (unsigned)__builtin_amdgcn_s_getreg((3 << 11) | 20) & 0xFu; }
#define XB_SPIN(cond, bar) do { unsigned _sp = 0; while (cond) { __builtin_amdgcn_s_sleep(1); \
    if ((++_sp & 255u) == 0u) { if (xb_ld(&(bar)[XB_TMO])) break; if (_sp > XB_SPIN_CAP) { atomicAdd(&(bar)[XB_TMO], 1u); break; } } } } while (0)

struct XcdBarrier {
    unsigned* bar; unsigned x;
    volatile LAS unsigned* st;
};

__device__ __forceinline__ XcdBarrier xcd_barrier_post(unsigned* bar, volatile LAS unsigned* st) {
    XcdBarrier b; b.bar = bar; b.x = xb_xcc_id(); b.st = st;
    if (threadIdx.x == 0) (void)xb_add(&bar[XB_XCNT(b.x)], 1u);
    return b;
}
__device__ __forceinline__ void xcd_barrier_complete(unsigned* bar, unsigned x, unsigned& nloc, unsigned& nx) {
    const unsigned G = gridDim.x * gridDim.y * gridDim.z;
    unsigned sum, cnt, mine, sp = 0u;
    for (;;) {
        sum = 0u; cnt = 0u; mine = 0u;
#pragma unroll
        for (unsigned j = 0; j < 16; ++j) { const unsigned c = xb_ld(&bar[XB_XCNT(j)]); sum += c; cnt += (c > 0u) ? 1u : 0u; mine = (j == x) ? c : mine; }
        if (sum == G) break;
        __builtin_amdgcn_s_sleep(1);
        if ((++sp & 255u) == 0u) { if (xb_ld(&bar[XB_TMO])) break; if (sp > XB_SPIN_CAP) { atomicAdd(&bar[XB_TMO], 1u); break; } }
    }
    nloc = mine > 0u ? mine : 1u; nx = cnt > 0u ? cnt : 1u;
}

__device__ __forceinline__ void xcd_barrier(const XcdBarrier& b) {
    asm volatile("s_waitcnt vmcnt(0)" ::: "memory");
    __syncthreads();
    if (threadIdx.x == 0) {
        unsigned* bar = b.bar;
        __builtin_amdgcn_s_waitcnt(0);
        unsigned nloc = b.st[0], nx = b.st[1];
        if (nloc == 0u) { xcd_barrier_complete(bar, b.x, nloc, nx); b.st[0] = nloc; b.st[1] = nx; }
        const unsigned old = xb_add(&bar[XB_XSUB(b.x)], 1u);
        const unsigned gen = old / nloc;
        if (old + 1u == (gen + 1u) * nloc) {
            __builtin_amdgcn_fence(__ATOMIC_RELEASE, "agent");
            asm volatile("s_waitcnt vmcnt(0)" ::: "memory");
            const unsigned og = xb_add(&bar[XB_TOP], 1u);
            const unsigned tg = og / nx;
            if (og + 1u == (tg + 1u) * nx) xb_add(&bar[XB_TOPGEN], 1u);
            else XB_SPIN(xb_ld(&bar[XB_TOPGEN]) == tg, bar);
            __builtin_amdgcn_fence(__ATOMIC_ACQUIRE, "agent");
            xb_add(&bar[XB_XGEN(b.x)], 1u);
            asm volatile("s_waitcnt vmcnt(0)" ::: "memory");
        } else {
            XB_SPIN(xb_ld(&bar[XB_XGEN(b.x)]) == gen, bar);
            __builtin_amdgcn_fence(__ATOMIC_ACQUIRE, "agent");
            asm volatile("s_waitcnt vmcnt(0)" ::: "memory");
        }
    }
    __syncthreads();
}


struct Args { const float* in[39]; float* out; unsigned char* ws; int ph_lo, ph_hi; };
enum { I_X = 0, I_POS, I_MIXG, I_WIN, I_MU, I_W0, I_WUP, I_A0, I_AUP, I_GUP, I_KK, I_KA, I_RK, I_LNG, I_LNB, I_V0, I_VDN, I_VUP,
       I_QNG, I_WUQ, I_KVNG, I_WUKV, I_QHG, I_KHG, I_BOG, I_CLNG, I_CLNB, I_CWS, I_CBS, I_COG, I_WOUT, I_FFNG, I_DWG, I_DWU, I_DWD, I_ROUTER, I_MWG, I_MWU, I_MWD };

constexpr int ARGS_OFF = RING_BYTES + 4096;
struct Ctx {
    LAS unsigned char* lds; int tid, lane, wave, bid, nb, gw, ngw;
    GAS unsigned char* ws; GAS unsigned char* R;
    __device__ __forceinline__ unsigned long long ptr_(int k) const { unsigned off = ARGS_OFF + 8 * k; asm volatile("" : "+v"(off));
        const volatile LAS unsigned* p = (const volatile LAS unsigned*)(lds + off);
        const unsigned lo = __builtin_amdgcn_readfirstlane(p[0]), hi = __builtin_amdgcn_readfirstlane(p[1]); return ((unsigned long long)hi << 32) | lo; }
    __device__ __forceinline__ const GAS float* in(int k) const { return (const GAS float*)ptr_(k); }
    __device__ __forceinline__ GAS float* out() const { return (GAS float*)ptr_(39); }
};

__device__ __forceinline__ void conv_item(const GAS float* W, int K, int N, GAS bf16* WT, int n0, int drow0, int k0, LAS float* scr, int lane, const GAS float* gk = nullptr) {
#pragma unroll 8
    for (int i = 0; i < 32; ++i) { const int kk = 2 * i + (lane >> 5); scr[kk * 33 + (lane & 31)] = W[(size_t)(k0 + kk) * N + n0 + (lane & 31)] * (gk ? gk[k0 + kk] : 1.0f); }
    LDS_WAIT(); asm volatile("" ::: "memory");
    const int c = lane & 7;
#pragma unroll
    for (int j = 0; j < 4; ++j) { const int n = (lane >> 3) + 8 * j; const LAS float* s = scr + (8 * c) * 33 + n;
        v4u o; o.x = pk2(s[0 * 33], s[1 * 33]); o.y = pk2(s[2 * 33], s[3 * 33]); o.z = pk2(s[4 * 33], s[5 * 33]); o.w = pk2(s[6 * 33], s[7 * 33]);
        *(GAS v4u*)(WT + (size_t)(drow0 + n) * K + k0 + 8 * c) = o; }
    LDS_WAIT(); asm volatile("" ::: "memory");
}
template <int MAP> __device__ __forceinline__ int conv_row(int n0) {
    if (MAP == 1) return n0 < 1280 ? n0 : (n0 < 1696 ? n0 - 1280 + ZCQ : n0 - 1696 + ZU);
    if (MAP == 2) return (n0 >> 7) * 256 + (n0 & 127);
    if (MAP == 3) return (n0 >> 7) * 256 + 128 + (n0 & 127);
    if (MAP == 4) return (n0 / QKD) * 128 + (n0 % QKD);
    return n0;
}
struct CJ { const GAS float* W; GAS bf16* WT; const GAS float* gk; int K, N, n0, drow0, k0; };
__device__ __forceinline__ void conv_load(const CJ& j, float (&r)[32], int lane) {
#pragma unroll
    for (int i = 0; i < 32; ++i) r[i] = __builtin_nontemporal_load(j.W + (size_t)(j.k0 + 2 * i + (lane >> 5)) * j.N + j.n0 + (lane & 31));
}
__device__ __forceinline__ void conv_finish(const CJ& j, const float (&r)[32], LAS float* scr, int lane) {
#pragma unroll
    for (int i = 0; i < 32; ++i) { const int kk = 2 * i + (lane >> 5); scr[kk * 33 + (lane & 31)] = r[i] * (j.gk ? j.gk[j.k0 + kk] : 1.0f); }
    LDS_WAIT(); asm volatile("" ::: "memory");
    const int cq = lane & 7;
#pragma unroll
    for (int q = 0; q < 4; ++q) { const int n = (lane >> 3) + 8 * q; const LAS float* p = scr + (8 * cq) * 33 + n;
        v4u o; o.x = pk2(p[0 * 33], p[1 * 33]); o.y = pk2(p[2 * 33], p[3 * 33]); o.z = pk2(p[4 * 33], p[5 * 33]); o.w = pk2(p[6 * 33], p[7 * 33]);
        *(GAS v4u*)(j.WT + (size_t)(j.drow0 + n) * j.K + j.k0 + 8 * cq) = o; }
    LDS_WAIT(); asm volatile("" ::: "memory");
}
template <class JobFn> __device__ __forceinline__ void conv_run(const Ctx& c, int total, const JobFn& job, int gw, int ngw) {
    LAS float* scr = (LAS float*)(c.lds + c.wave * 8704);
    float ra[32], rb[32];
    int it = gw;
    if (it < total) conv_load(job(it), ra, c.lane);
    for (; it < total; it += 2 * ngw) {
        const int it2 = it + ngw, it3 = it2 + ngw;
        if (it2 < total) conv_load(job(it2), rb, c.lane);
        conv_finish(job(it), ra, scr, c.lane);
        if (it3 < total) conv_load(job(it3), ra, c.lane);
        if (it2 < total) conv_finish(job(it2), rb, scr, c.lane);
    }
}
__device__ __forceinline__ CJ conv_mk(const GAS float* W, GAS bf16* WT, const GAS float* gk, int K, int N, int r, int map) {
    const int nblk = N / 32, kb = r / nblk, nbk = r - kb * nblk, n0 = 32 * nbk; CJ j; j.W = W; j.WT = WT; j.gk = gk; j.K = K; j.N = N; j.n0 = n0; j.k0 = 64 * kb;
    j.drow0 = map == 1 ? conv_row<1>(n0) : map == 2 ? conv_row<2>(n0) : map == 3 ? conv_row<3>(n0) : map == 4 ? conv_row<4>(n0) : n0; return j;
}
struct StaticJobsA { const Ctx* c;
    static constexpr int N_WIN = 16 * 69, N_UQ = 4 * 18, N_UKV = 2 * 24, PER_L = N_WIN + N_UQ + N_UKV, TOTAL = 2 * PER_L;
    __device__ __forceinline__ CJ operator()(int it) const { const Ctx& cx = *c; const int l = it / PER_L; int r = it - l * PER_L;
        if (r < N_WIN) return conv_mk(cx.in(I_WIN) + (size_t)l * D * 2208, (GAS bf16*)(cx.ws + WS_WIN) + (size_t)l * ZP * D, nullptr, D, 2208, r, 1); r -= N_WIN;
        if (r < N_UQ) return conv_mk(cx.in(I_WUQ) + (size_t)l * 256 * QP, (GAS bf16*)(cx.ws + WS_WSM + WSM_UQ) + (size_t)l * 768 * 256, cx.in(I_QNG) + l * 256, 256, QP, r, 4); r -= N_UQ;
        return conv_mk(cx.in(I_WUKV) + (size_t)l * 128 * 768, (GAS bf16*)(cx.ws + WS_WSM + WSM_UKV) + (size_t)l * 768 * 128, cx.in(I_KVNG) + l * 128, 128, 768, r, 0); }
};
struct StaticJobsB { const Ctx* c;
    static constexpr int N_WOUT = 16 * 32, N_DG = 16 * 88, N_DD = 44 * 32, TOTAL = 2 * N_WOUT + 2 * N_DG + N_DD;
    __device__ __forceinline__ CJ operator()(int it) const { const Ctx& cx = *c; int r = it;
        if (r < 2 * N_WOUT) { const int l = r / N_WOUT; return conv_mk(cx.in(I_WOUT) + (size_t)l * D * D, (GAS bf16*)(cx.ws + WS_WOUT) + (size_t)l * D * D, nullptr, D, D, r - l * N_WOUT, 0); } r -= 2 * N_WOUT;
        if (r < N_DG) return conv_mk(cx.in(I_DWG), (GAS bf16*)(cx.ws + WS_WDGU), nullptr, D, DFF, r, 2); r -= N_DG;
        if (r < N_DG) return conv_mk(cx.in(I_DWU), (GAS bf16*)(cx.ws + WS_WDGU), nullptr, D, DFF, r, 3); r -= N_DG;
        return conv_mk(cx.in(I_DWD), (GAS bf16*)(cx.ws + WS_WDD), nullptr, DFF, D, r, 0); }
};
__device__ __forceinline__ void phase_conv_b(const Ctx& c) {
    const int nfull = (M / 256) * (ZP / 256) - 2 * c.nb;
    if (nfull <= 0 || nfull >= c.nb) { StaticJobsB J{&c}; conv_run(c, StaticJobsB::TOTAL, J, c.gw, c.ngw); return; }
    if (c.bid < nfull) return;
    StaticJobsB J{&c}; conv_run(c, StaticJobsB::TOTAL, J, (c.bid - nfull) * NWAVES + c.wave, (c.nb - nfull) * NWAVES);
}
struct ExpertGUJobs { const Ctx* c;
    static constexpr int PER = 16 * 112, TOTAL = NE * 2 * PER;
    __device__ __forceinline__ CJ operator()(int it) const { const Ctx& cx = *c; const int j = it / PER, r = it - j * PER, e = j >> 1, kind = j & 1;
        return conv_mk((kind ? cx.in(I_MWU) : cx.in(I_MWG)) + (size_t)e * D * DFE, (GAS bf16*)(cx.R + R_WMGU) + (size_t)e * 2 * DFE * D, nullptr, D, DFE, r, 2 + kind); }
};
struct ExpertDJobs { const Ctx* c;
    static constexpr int PER = 56 * 32, TOTAL = NE * PER;
    __device__ __forceinline__ CJ operator()(int it) const { const Ctx& cx = *c; const int e = it / PER, r = it - e * PER;
        return conv_mk(cx.in(I_MWD) + (size_t)e * DFE * D, (GAS bf16*)(cx.R + R_WMD) + (size_t)e * D * DFE, nullptr, DFE, D, r, 0); }
};
template <class JobFn> __device__ __forceinline__ void conv_pop(const Ctx& c, GAS unsigned* head, int total, const JobFn& job, GAS unsigned* stop_ctr, unsigned stop_at) {
    LAS float* scr = (LAS float*)(c.lds + c.wave * 8704); LAS int* pb = (LAS int*)(c.lds + RING_BYTES + 12288);
    for (;;) {
        __syncthreads();
        if (c.tid == 0) { const bool stop = stop_ctr && __hip_atomic_load(stop_ctr, __ATOMIC_RELAXED, __HIP_MEMORY_SCOPE_AGENT) >= stop_at;
            pb[0] = stop ? total : (int)__hip_atomic_fetch_add(head, 16u, __ATOMIC_RELAXED, __HIP_MEMORY_SCOPE_AGENT); }
        __syncthreads();
        const int base = pb[0]; if (base >= total) break;
        const int i0 = base + c.wave, i1 = base + 8 + c.wave;
        float ra[32], rb[32];
        if (i0 < total) conv_load(job(i0), ra, c.lane);
        if (i1 < total) conv_load(job(i1), rb, c.lane);
        if (i0 < total) conv_finish(job(i0), ra, scr, c.lane);
        if (i1 < total) conv_finish(job(i1), rb, scr, c.lane);
    }
}

__device__ __forceinline__ void phase_conv_static(const Ctx& c) {
    StaticJobsA J{&c}; conv_run(c, StaticJobsA::TOTAL, J, c.gw, c.ngw);
    for (int l = 0; l < 2; ++l) {
        GAS bf16* win = (GAS bf16*)(c.ws + WS_WIN) + (size_t)l * ZP * D;
        for (int i = c.bid * NTHR + c.tid; i < 96 * D / 8; i += c.nb * NTHR) ((GAS v4u*)(win + (size_t)2208 * D))[i] = (v4u){0u, 0u, 0u, 0u};
        GAS bf16* uq = (GAS bf16*)(c.ws + WS_WSM + WSM_UQ) + (size_t)l * 768 * 256;
        { GAS bf16* lw_ = (GAS bf16*)(c.ws + WS_WSM + WSM_LW) + (size_t)l * AW * 32; GAS bf16* la_ = (GAS bf16*)(c.ws + WS_WSM + WSM_LA) + (size_t)l * AW * 32; GAS bf16* lg_ = (GAS bf16*)(c.ws + WS_WSM + WSM_LG) + (size_t)l * AW * 64;
          const GAS float* sw = c.in(I_WUP) + (size_t)l * 32 * AW; const GAS float* sa = c.in(I_AUP) + (size_t)l * 32 * AW; const GAS float* sg = c.in(I_GUP) + (size_t)l * 64 * AW;
          for (int i = c.bid * NTHR + c.tid; i < AW * 32; i += c.nb * NTHR) { const int ch = i >> 5, kq = i & 31; lw_[i] = (bf16)f2bf(sw[kq * AW + ch]); la_[i] = (bf16)f2bf(sa[kq * AW + ch]); }
          for (int i = c.bid * NTHR + c.tid; i < AW * 64; i += c.nb * NTHR) { const int ch = i >> 6, kq = i & 63; lg_[i] = (bf16)f2bf(sg[kq * AW + ch]); }
          if (l == 1) { GAS bf16* vdt = (GAS bf16*)(c.ws + WS_WSM + WSM_VD); const GAS float* sv = c.in(I_VDN); for (int i = c.bid * NTHR + c.tid; i < 16 * AW; i += c.nb * NTHR) { const int j = i / AW, cx = i % AW; vdt[i] = (bf16)f2bf(sv[cx * 16 + j]); } } }
        { const GAS float* wsrc = c.in(I_CWS) + (size_t)l * 4 * 128 * 128; GAS bf16* wdst = (GAS bf16*)(c.ws + WS_WSM + WSM_GW) + (size_t)l * 4 * 128 * 128;
          for (int i = c.bid * NTHR + c.tid; i < 4 * 128 * 128 / 2; i += c.nb * NTHR) { const int e0 = 2 * i, tq = (e0 >> 7) & 127, sq = e0 & 127; const f32x2 w = *(const GAS f32x2*)(wsrc + e0);
              ((GAS unsigned*)wdst)[i] = pk2(sq <= tq ? w.x : 0.f, sq + 1 <= tq ? w.y : 0.f); } }
        for (int i = c.bid * NTHR + c.tid; i < AH * 32 * 256 / 8; i += c.nb * NTHR) { const int r = i / 32, cc8 = i % 32; ((GAS v4u*)(uq + (size_t)((r / 32) * 128 + 96 + (r % 32)) * 256))[cc8] = (v4u){0u, 0u, 0u, 0u}; }
    }
}
__device__ __forceinline__ void phase_conv_experts(const Ctx& c) {
    ExpertGUJobs JG{&c}; conv_pop(c, (GAS unsigned*)(c.ws + WS_CTL) + CW_CQ, ExpertGUJobs::TOTAL, JG, nullptr, 0u);
    __syncthreads();
    ExpertDJobs JD{&c}; conv_run(c, ExpertDJobs::TOTAL, JD, c.gw, c.ngw); }

template <bool ROUTER> __device__ __forceinline__ void phase_rmsnorm(const Ctx& c, const GAS float* x, const GAS float* g, GAS bf16* xn, const GAS float* router) {
    LAS float* rl = (LAS float*)c.lds;
    if (ROUTER) { for (int i = c.tid; i < D * NE / 4; i += NTHR) { const f32x4 r = ((const GAS f32x4*)router)[i]; const int d = i >> 1, e4 = (i & 1) * 4; rl[(e4 + 0) * D + d] = r.x; rl[(e4 + 1) * D + d] = r.y; rl[(e4 + 2) * D + d] = r.z; rl[(e4 + 3) * D + d] = r.w; } __syncthreads(); }
    const int i16 = c.lane & 15, g16 = c.lane >> 4;
    f32x4 gv[16];
#pragma unroll
    for (int k = 0; k < 16; ++k) gv[k] = *(const GAS f32x4*)(g + 64 * k + 4 * i16);
    LAS int* sel = (LAS int*)(c.lds + 32768);
    GAS int* segc = (GAS int*)(c.ws + WS_TOK + TOK_SEG);
    for (int sg = ROUTER ? c.bid : 0; sg < (ROUTER ? NSEG : 1); sg += ROUTER ? c.nb : 1) {
    const int m0 = ROUTER ? sg * SEGT + c.wave * 8 : c.gw * 4, mstep = ROUTER ? 4 : c.ngw * 4, mend = ROUTER ? m0 + 8 : M;
    for (int mb = m0; mb < mend; mb += mstep) {
        const int m = mb + g16;
        f32x4 v[16]; float ss = 0.f;
#pragma unroll
        for (int k = 0; k < 16; ++k) v[k] = *(const GAS f32x4*)(x + (size_t)m * D + 64 * k + 4 * i16);
#pragma unroll
        for (int k = 0; k < 16; ++k) ss += (v[k].x * v[k].x + v[k].y * v[k].y) + (v[k].z * v[k].z + v[k].w * v[k].w);
        const float rstd = __builtin_amdgcn_rsqf(row16_sum(ss) * (1.0f / D) + EPS);
#pragma unroll
        for (int k = 0; k < 16; ++k) { v[k] = v[k] * rstd * gv[k]; *(GAS v2u*)(xn + (size_t)m * D + 64 * k + 4 * i16) = (v2u){pk2(v[k].x, v[k].y), pk2(v[k].z, v[k].w)}; }
        if (ROUTER) {
            float lg[8];
#pragma unroll
            for (int e = 0; e < 8; ++e) lg[e] = 0.f;
#pragma unroll
            for (int k = 0; k < 16; ++k)
#pragma unroll
                for (int e = 0; e < 8; ++e) { const f32x4 r = *(const LAS f32x4*)(rl + e * D + 64 * k + 4 * i16); lg[e] += (v[k].x * r.x + v[k].y * r.y) + (v[k].z * r.z + v[k].w * r.w); }
#pragma unroll
            for (int e = 0; e < 8; ++e) lg[e] = row16_sum(lg[e]);
            if (i16 == 0) {
                int e0 = 0; float v0 = lg[0];
#pragma unroll
                for (int e = 1; e < 8; ++e) if (lg[e] > v0) { v0 = lg[e]; e0 = e; }
                int e1 = -1; float v1 = -INFINITY;
#pragma unroll
                for (int e = 0; e < 8; ++e) if (e != e0 && lg[e] > v1) { v1 = lg[e]; e1 = e; }
                const float p1 = 1.0f / (1.0f + __expf(v0 - v1)), p0 = 1.0f - p1;
                GAS int* te = (GAS int*)(c.ws + WS_TOK + TOK_E); GAS float* tg = (GAS float*)(c.ws + WS_TOK + TOK_G);
                te[2 * m] = e0; te[2 * m + 1] = e1; tg[2 * m] = p0; tg[2 * m + 1] = p1;
                sel[2 * (m - sg * SEGT)] = e0; sel[2 * (m - sg * SEGT) + 1] = e1;
            }
        }
    }
    if (ROUTER) {
        __syncthreads();
        if (c.wave == 0) { const int e0 = sel[2 * c.lane], e1 = sel[2 * c.lane + 1];
#pragma unroll
            for (int e = 0; e < NE; ++e) { const unsigned long long b0 = __ballot(e0 == e), b1 = __ballot(e1 == e); if (c.lane == 0) segc[sg * NE + e] = __popcll(b0) + __popcll(b1); } }
        __syncthreads();
    }
    }
}

__device__ __forceinline__ float zsh(const GAS bf16* Z, int m, int s, int col, float mu) {
    const float cur = bf2f(Z[(size_t)m * ZP + col]); const float prev = s > 0 ? bf2f(Z[(size_t)(m - 1) * ZP + col]) : 0.f; return cur + (prev - cur) * mu;
}
__device__ __forceinline__ void phase_rwkv_prep(const Ctx& c, int l) {
    const GAS bf16* Z = (const GAS bf16*)(c.R + R_Z);
    GAS bf16* RW = (GAS bf16*)(c.R + R_RW); GAS float* LW = (GAS float*)(c.R + R_LW); GAS bf16* VF = (GAS bf16*)(c.ws + WS_VF);
    const GAS float* mu = c.in(I_MU) + l * 1280; const GAS float* w0 = c.in(I_W0) + l * AW; const GAS float* wup = c.in(I_WUP) + (size_t)l * 32 * AW;
    const GAS float* a0 = c.in(I_A0) + l * AW; const GAS float* aup = c.in(I_AUP) + (size_t)l * 32 * AW; const GAS float* gup = c.in(I_GUP) + (size_t)l * 64 * AW;
    const GAS float* kkw = c.in(I_KK) + l * AW; const GAS float* kaw = c.in(I_KA) + l * AW;
    const GAS float* v0 = c.in(I_V0); const GAS float* vdn = c.in(I_VDN); const GAS float* vup = c.in(I_VUP);
    LAS float* sm = (LAS float*)c.lds;
    LAS float* vs = sm + 8 * 128;
    LAS float* vd = vs + 8 * 384;
    const int t = c.tid;
    for (int grp = c.bid; grp < M / 8; grp += c.nb) {
        const int m0 = grp * 8;
        float r[8], k[8], v[8];
        if (t < AW) {
            const float mr = mu[ZR + t], mk = mu[ZK + t], mv = mu[ZV + t];
#pragma unroll
            for (int q = 0; q < 8; ++q) { const int m = m0 + q, s = m % SEQ; r[q] = zsh(Z, m, s, ZR + t, mr); k[q] = zsh(Z, m, s, ZK + t, mk); v[q] = zsh(Z, m, s, ZV + t, mv); }
        } else {
            const int j = t - AW; const float mj = mu[ZWD + j];
#pragma unroll
            for (int q = 0; q < 8; ++q) { const int m = m0 + q, s = m % SEQ; float x = zsh(Z, m, s, ZWD + j, mj);
                if (j < 32) x = tanhf(x); else if (j >= 64) x = sigmoid_f(x);
                sm[q * 128 + j] = x; }
        }
        __syncthreads();
        float wa[8], aa[8], ga[8];
        if (t < AW) {
#pragma unroll
            for (int q = 0; q < 8; ++q) { wa[q] = 0.f; aa[q] = 0.f; ga[q] = 0.f; }
            for (int j = 0; j < 32; ++j) { const float ww = wup[j * AW + t], au = aup[j * AW + t];
#pragma unroll
                for (int q = 0; q < 8; ++q) { wa[q] += sm[q * 128 + j] * ww; aa[q] += sm[q * 128 + 32 + j] * au; } }
            for (int j = 0; j < 64; ++j) { const float gu = gup[j * AW + t];
#pragma unroll
                for (int q = 0; q < 8; ++q) ga[q] += sm[q * 128 + 64 + j] * gu; }
            if (l > 0) {
#pragma unroll
                for (int q = 0; q < 8; ++q) vs[q * AW + t] = v[q];
            }
        }
        __syncthreads();
        if (l > 0) {
            if (t < 128) { const int q = t >> 4, j = t & 15; float s = 0.f; for (int cc = 0; cc < AW; ++cc) s += vs[q * AW + cc] * vdn[cc * 16 + j]; vd[q * 16 + j] = s; }
            __syncthreads();
        }
        if (t < AW) {
            const float w0t = w0[t], a0t = a0[t], kkt = kkw[t], kat = kaw[t];
#pragma unroll
            for (int q = 0; q < 8; ++q) { const int m = m0 + q; const size_t o = (size_t)m * AW + t;
                const float xw = -(w0t + wa[q]);
                const float sp = xw > 20.f ? xw : log1pf(__expf(xw));
                const float lw = -__expf(-sp - 0.5f);
                const float av = sigmoid_f(a0t + aa[q]);
                float vv = v[q];
                if (l > 0) { float x = v0[t];
#pragma unroll
                    for (int j = 0; j < 16; ++j) x += vd[q * 16 + j] * vup[j * AW + t];
                    const float vf = bf2f(VF[o]); vv = vv + (vf - vv) * sigmoid_f(x); }
                else VF[o] = (bf16)f2bf(vv);
                float kk = k[q] * kkt; const float ss = wave_sum(kk * kk); kk = kk / fmaxf(sqrtf(ss), 1e-12f);
                const float k2 = k[q] * (1.0f + (av - 1.0f) * kat);
                RW[0 * RWSZ + o] = (bf16)f2bf(r[q]); RW[1 * RWSZ + o] = (bf16)f2bf(k2); RW[2 * RWSZ + o] = (bf16)f2bf(vv); RW[3 * RWSZ + o] = (bf16)f2bf(kk);
                RW[4 * RWSZ + o] = (bf16)f2bf(av); RW[5 * RWSZ + o] = (bf16)f2bf(ga[q]); LW[o] = lw; }
        }
        __syncthreads();
    }
}

__device__ __forceinline__ void phase_rwkv_scan_naive(const Ctx& c) {
    const GAS bf16* RW = (const GAS bf16*)(c.R + R_RW); const GAS float* LW = (const GAS float*)(c.R + R_LW); GAS float* YRAW = (GAS float*)(c.R + R_YRAW);
    constexpr int CH = 32;
    LAS float* sr = (LAS float*)c.lds;
    LAS float* sw = sr + CH * 64; LAS float* skk = sw + CH * 64; LAS float* sb = skk + CH * 64; LAS float* sk2 = sb + CH * 64; LAS float* sv = sk2 + CH * 64; LAS float* sy = sv + CH * 64;
    const int t = c.tid, vrow = t >> 3, kq = t & 7;
    for (int item = c.bid; item < BATCH * AH; item += c.nb) {
        const int b = item / AH, h = item % AH;
        float st[8];
#pragma unroll
        for (int i = 0; i < 8; ++i) st[i] = 0.f;
        for (int s0 = 0; s0 < SEQ; s0 += CH) {
            __syncthreads();
#pragma unroll
            for (int q = 0; q < 4; ++q) { const int e = t + q * NTHR, ts = e >> 6, ch = e & 63; const size_t o = (size_t)(b * SEQ + s0 + ts) * AW + h * 64 + ch;
                const float kk = bf2f(RW[3 * RWSZ + o]), av = bf2f(RW[4 * RWSZ + o]);
                sr[e] = bf2f(RW[0 * RWSZ + o]); sw[e] = __expf(LW[o]); skk[e] = kk; sb[e] = kk * av; sk2[e] = bf2f(RW[1 * RWSZ + o]); sv[e] = bf2f(RW[2 * RWSZ + o]); }
            __syncthreads();
            for (int ts = 0; ts < CH; ++ts) {
                const int o = ts * 64 + kq * 8; float p = 0.f;
#pragma unroll
                for (int i = 0; i < 8; ++i) p += st[i] * skk[o + i];
                p += __shfl_xor(p, 1); p += __shfl_xor(p, 2); p += __shfl_xor(p, 4);
                const float sa = -p, vv = sv[ts * 64 + vrow]; float y = 0.f;
#pragma unroll
                for (int i = 0; i < 8; ++i) { st[i] = st[i] * sw[o + i] + sa * sb[o + i] + vv * sk2[o + i]; y += st[i] * sr[o + i]; }
                y += __shfl_xor(y, 1); y += __shfl_xor(y, 2); y += __shfl_xor(y, 4);
                if (kq == 0) sy[ts * 64 + vrow] = y;
            }
            __syncthreads();
#pragma unroll
            for (int q = 0; q < 4; ++q) { const int e = t + q * NTHR, ts = e >> 6, ch = e & 63; YRAW[(size_t)(b * SEQ + s0 + ts) * AW + h * 64 + ch] = sy[e]; }
        }
        __syncthreads();
    }
}

__device__ __forceinline__ void phase_rwkv_post(const Ctx& c, int l) {
    const GAS bf16* RW = (const GAS bf16*)(c.R + R_RW); const GAS float* YRAW = (const GAS float*)(c.R + R_YRAW); GAS bf16* YC = (GAS bf16*)(c.ws + WS_XN);
    const GAS float* lng = c.in(I_LNG) + l * AW; const GAS float* lnb = c.in(I_LNB) + l * AW; const GAS float* rk = c.in(I_RK) + l * AW;
    for (int it = c.gw; it < M * AH; it += c.ngw) {
        const int m = it / AH, h = it % AH, ch = h * 64 + c.lane; const size_t o = (size_t)m * AW + ch;
        const float y = YRAW[o]; const float mean = wave_sum(y) * (1.0f / 64.0f); const float d = y - mean; const float var = wave_sum(d * d) * (1.0f / 64.0f);
        const float yn = d * (__builtin_amdgcn_rsqf(var + 64e-5f)) * lng[ch] + lnb[ch];
        const float r = bf2f(RW[0 * RWSZ + o]), k2 = bf2f(RW[1 * RWSZ + o]), v = bf2f(RW[2 * RWSZ + o]), g = bf2f(RW[5 * RWSZ + o]);
        const float bonus = wave_sum(r * k2 * rk[ch]);
        YC[(size_t)m * D + ch] = (bf16)f2bf((yn + bonus * v) * g);
    }
}

__device__ __forceinline__ int vt_pos(int kap) { return 8 * ((kap >> 2) & 1) + 4 * (kap >> 3) + (kap & 3); }

typedef short bf16x8 __attribute__((ext_vector_type(8)));
typedef float f32x16 __attribute__((ext_vector_type(16)));
typedef __bf16 bf16x2_t __attribute__((ext_vector_type(2)));
__device__ __forceinline__ unsigned cvtpk(float lo, float hi) { const f32x2 v = {lo, hi}; const bf16x2_t b = __builtin_convertvector(v, bf16x2_t); return __builtin_bit_cast(unsigned, b); }
__device__ __forceinline__ bf16x8 pack8(const f32x16& a, int s8) {
    v4u t; t.x = cvtpk(a[s8], a[s8 + 1]); t.y = cvtpk(a[s8 + 2], a[s8 + 3]); t.z = cvtpk(a[s8 + 4], a[s8 + 5]); t.w = cvtpk(a[s8 + 6], a[s8 + 7]); return __builtin_bit_cast(bf16x8, t);
}
#define MFMA32(a, b, c) __builtin_amdgcn_mfma_f32_32x32x16_bf16(a, b, c, 0, 0, 0)
__device__ __forceinline__ float keep_neg(float x, int d) { return __builtin_bit_cast(float, __builtin_bit_cast(unsigned, x) & (unsigned)(d >> 31)); }
__device__ __forceinline__ float keep_zero(float x, int d) { return __builtin_bit_cast(float, __builtin_bit_cast(unsigned, x) & ~(unsigned)((d | -d) >> 31)); }
__device__ __forceinline__ f32x16 zero16() { f32x16 z;
#pragma unroll
    for (int r = 0; r < 16; ++r) z[r] = 0.f;
    return z; }

__device__ __forceinline__ void phase_rwkv_prep2(const Ctx& c, int l) {
    const GAS bf16* Z = (const GAS bf16*)(c.R + R_Z);
    GAS bf16* NAT = (GAS bf16*)(c.R + R_NAT); GAS bf16* TR = (GAS bf16*)(c.R + R_TR); GAS bf16* VN = (GAS bf16*)(c.R + R_VG); GAS bf16* GN = VN + (size_t)M * AW; GAS float* BON = (GAS float*)(c.R + R_BON); GAS float* WL = (GAS float*)(c.R + R_WL); GAS bf16* VF = (GAS bf16*)(c.ws + WS_VF);
    const GAS float* mu = c.in(I_MU) + l * 1280; const GAS float* w0 = c.in(I_W0) + l * AW; const GAS float* wup = c.in(I_WUP) + (size_t)l * 32 * AW;
    const GAS float* a0 = c.in(I_A0) + l * AW; const GAS float* aup = c.in(I_AUP) + (size_t)l * 32 * AW; const GAS float* gup = c.in(I_GUP) + (size_t)l * 64 * AW;
    const GAS float* kkw = c.in(I_KK) + l * AW; const GAS float* kaw = c.in(I_KA) + l * AW; const GAS float* rkw = c.in(I_RK) + l * AW;
    const GAS float* v0 = c.in(I_V0); const GAS float* vdn = c.in(I_VDN); const GAS float* vup = c.in(I_VUP);
    LAS float* sm = (LAS float*)c.lds;
    LAS float* vs = sm + 8 * 128;
    LAS float* vd = vs + 8 * 384;
    const int t = c.tid;
    constexpr size_t ASZ = (size_t)NCHUNK * BLK;
    for (int item = c.bid; item < M / 64; item += c.nb) {
        const int b = item / (SEQ / 64), cc = item % (SEQ / 64);
        const int hh = t >> 6, c64 = t & 63; const size_t cbo = ((size_t)((b * AH + hh) * (SEQ / 64) + cc)) * BLK;
        float cum = 0.f;
        for (int grp = 0; grp < 8; ++grp) {
            const int m0 = item * 64 + grp * 8;
            float r[8], k[8], v[8];
            if (t < AW) {
                const float mr = mu[ZR + t], mk = mu[ZK + t], mv = mu[ZV + t];
#pragma unroll
                for (int q = 0; q < 8; ++q) { const int m = m0 + q, s = m % SEQ; r[q] = zsh(Z, m, s, ZR + t, mr); k[q] = zsh(Z, m, s, ZK + t, mk); v[q] = zsh(Z, m, s, ZV + t, mv); }
            } else {
                const int j = t - AW; const float mj = mu[ZWD + j];
#pragma unroll
                for (int q = 0; q < 8; ++q) { const int m = m0 + q, s = m % SEQ; float x = zsh(Z, m, s, ZWD + j, mj);
                    if (j < 32) x = tanhf(x); else if (j >= 64) x = sigmoid_f(x);
                    sm[q * 128 + j] = x; }
            }
            __syncthreads();
            float wa[8], aa[8], ga[8];
            if (t < AW) {
#pragma unroll
                for (int q = 0; q < 8; ++q) { wa[q] = 0.f; aa[q] = 0.f; ga[q] = 0.f; }
                for (int j = 0; j < 32; ++j) { const float ww = wup[j * AW + t], au = aup[j * AW + t];
#pragma unroll
                    for (int q = 0; q < 8; ++q) { wa[q] += sm[q * 128 + j] * ww; aa[q] += sm[q * 128 + 32 + j] * au; } }
                for (int j = 0; j < 64; ++j) { const float gu = gup[j * AW + t];
#pragma unroll
                    for (int q = 0; q < 8; ++q) ga[q] += sm[q * 128 + 64 + j] * gu; }
                if (l > 0) {
#pragma unroll
                    for (int q = 0; q < 8; ++q) vs[q * AW + t] = v[q];
                }
            }
            __syncthreads();
            if (l > 0) {
                if (t < 128) { const int q = t >> 4, j = t & 15; float s = 0.f; for (int cx = 0; cx < AW; ++cx) s += vs[q * AW + cx] * vdn[cx * 16 + j]; vd[q * 16 + j] = s; }
                __syncthreads();
            }
            if (t < AW) {
                const float w0t = w0[t], a0t = a0[t], kkt = kkw[t], kat = kaw[t], rkt = rkw[t];
                unsigned short ta[8], tv[8], tb[8], tk[8];
#pragma unroll
                for (int q = 0; q < 8; ++q) { const int m = m0 + q; const size_t o = (size_t)m * AW + t;
                    const float xw = -(w0t + wa[q]);
                    const float sp = xw > 20.f ? xw : log1pf(__expf(xw));
                    const float lw = -__expf(-sp - 0.5f);
                    const float av = sigmoid_f(a0t + aa[q]);
                    float vv = v[q];
                    if (l > 0) { float x = v0[t];
#pragma unroll
                        for (int j = 0; j < 16; ++j) x += vd[q * 16 + j] * vup[j * AW + t];
                        const float vf = bf2f(VF[o]); vv = vv + (vf - vv) * sigmoid_f(x); }
                    else VF[o] = (bf16)f2bf(vv);
                    float kk = k[q] * kkt; const float ss = wave_sum(kk * kk); kk = kk / fmaxf(sqrtf(ss), 1e-12f);
                    const float k2 = k[q] * (1.0f + (av - 1.0f) * kat);
                    const float rq = bf2f((bf16)f2bf(r[q])), k2q = bf2f((bf16)f2bf(k2));
                    const float bon = wave_sum(rq * k2q * rkt);
                    if (c64 == 0) BON[(size_t)m * AH + hh] = bon;
                    VN[o] = (bf16)f2bf(vv); GN[o] = (bf16)f2bf(ga[q]);
                    const float cprev = cum; cum += lw;
                    const float ep = __expf(cum), en = __expf(-cum), epv = __expf(cprev);
                    const int tt = grp * 8 + q; const size_t no = cbo + (size_t)tt * 64 + c64;
                    const unsigned short xa = (unsigned short)f2bf(-kk * epv), xb = (unsigned short)f2bf(kk * av * en), xk = (unsigned short)f2bf(k2 * en);
                    NAT[0 * ASZ + no] = xa; NAT[1 * ASZ + no] = (bf16)f2bf(r[q] * ep); NAT[2 * ASZ + no] = xb; NAT[3 * ASZ + no] = xk;
                    ta[q] = xa; tv[q] = (unsigned short)f2bf(vv); tb[q] = xb; tk[q] = xk; }
                const int p1 = 16 * (grp >> 1) + 4 * (grp & 1); const size_t to = cbo + (size_t)c64 * 64 + p1;
                *(GAS v2u*)(TR + 0 * ASZ + to) = (v2u){(unsigned)ta[0] | ((unsigned)ta[1] << 16), (unsigned)ta[2] | ((unsigned)ta[3] << 16)}; *(GAS v2u*)(TR + 0 * ASZ + to + 8) = (v2u){(unsigned)ta[4] | ((unsigned)ta[5] << 16), (unsigned)ta[6] | ((unsigned)ta[7] << 16)};
                *(GAS v2u*)(TR + 1 * ASZ + to) = (v2u){(unsigned)tv[0] | ((unsigned)tv[1] << 16), (unsigned)tv[2] | ((unsigned)tv[3] << 16)}; *(GAS v2u*)(TR + 1 * ASZ + to + 8) = (v2u){(unsigned)tv[4] | ((unsigned)tv[5] << 16), (unsigned)tv[6] | ((unsigned)tv[7] << 16)};
                *(GAS v2u*)(TR + 2 * ASZ + to) = (v2u){(unsigned)tb[0] | ((unsigned)tb[1] << 16), (unsigned)tb[2] | ((unsigned)tb[3] << 16)}; *(GAS v2u*)(TR + 2 * ASZ + to + 8) = (v2u){(unsigned)tb[4] | ((unsigned)tb[5] << 16), (unsigned)tb[6] | ((unsigned)tb[7] << 16)};
                *(GAS v2u*)(TR + 3 * ASZ + to) = (v2u){(unsigned)tk[0] | ((unsigned)tk[1] << 16), (unsigned)tk[2] | ((unsigned)tk[3] << 16)}; *(GAS v2u*)(TR + 3 * ASZ + to + 8) = (v2u){(unsigned)tk[4] | ((unsigned)tk[5] << 16), (unsigned)tk[6] | ((unsigned)tk[7] << 16)};
            }
            __syncthreads();
        }
        if (t < AW) WL[(cbo >> 12) * 64 + c64] = __expf(cum);
    }
}


typedef float f32x4v __attribute__((ext_vector_type(4)));
__device__ __forceinline__ void phase_rwkv_prep3(const Ctx& c, int l) {
    const GAS bf16* Z = (const GAS bf16*)(c.R + R_Z);
    GAS bf16* NAT = (GAS bf16*)(c.R + R_NAT); GAS bf16* TR = (GAS bf16*)(c.R + R_TR); GAS bf16* VN = (GAS bf16*)(c.R + R_VG); GAS bf16* GN = VN + (size_t)M * AW; GAS float* BON = (GAS float*)(c.R + R_BON); GAS float* WL = (GAS float*)(c.R + R_WL); GAS bf16* VF = (GAS bf16*)(c.ws + WS_VF);
    const GAS float* mu = c.in(I_MU) + l * 1280; const GAS float* w0 = c.in(I_W0) + l * AW; const GAS float* a0 = c.in(I_A0) + l * AW;
    const GAS float* kkw = c.in(I_KK) + l * AW; const GAS float* kaw = c.in(I_KA) + l * AW; const GAS float* rkw = c.in(I_RK) + l * AW;
    const GAS float* v0 = c.in(I_V0); const GAS float* vdn = c.in(I_VDN); const GAS float* vup = c.in(I_VUP);
    const GAS bf16* LWt = (const GAS bf16*)(c.ws + WS_WSM + WSM_LW) + (size_t)l * AW * 32; const GAS bf16* LAt = (const GAS bf16*)(c.ws + WS_WSM + WSM_LA) + (size_t)l * AW * 32; const GAS bf16* LGt = (const GAS bf16*)(c.ws + WS_WSM + WSM_LG) + (size_t)l * AW * 64;
    constexpr int SP = 136;
    LAS unsigned short* sm = (LAS unsigned short*)c.lds;
    LAS float* lora = (LAS float*)(c.lds + 8192);
    LAS unsigned short* vs = (LAS unsigned short*)(lora + 3 * 16 * AW);
    LAS float* vd = (LAS float*)(vs + 16 * 392);
    const GAS bf16* VDt = (const GAS bf16*)(c.ws + WS_WSM + WSM_VD);
    const int t = c.tid, lane = c.lane;
    constexpr size_t ASZ = (size_t)NCHUNK * BLK;
    for (int item = c.bid; item < M / 64; item += c.nb) {
        const int b = item / (SEQ / 64), cc = item % (SEQ / 64);
        const int hh = c.wave < 6 ? c.wave : c.wave - 2, c64 = lane, tc = hh * 64 + lane, qlo = c.wave >= 6 ? 8 : 0, qhi = (c.wave == 4 || c.wave == 5) ? 8 : 16;
        const size_t cbo = ((size_t)((b * AH + hh) * (SEQ / 64) + cc)) * BLK;
        float cum = 0.f;
        for (int grp = 0; grp < 4; ++grp) {
            const int m0 = item * 64 + grp * 16;
            if (t < AW) {
                if (l > 0) { const float mv = mu[ZV + t];
#pragma unroll 4
                    for (int q = 0; q < 16; ++q) { const int m = m0 + q, s = m % SEQ; vs[q * 392 + t] = (unsigned short)f2bf(zsh(Z, m, s, ZV + t, mv)); } }
            } else {
                const int j = t - AW; const float mj = mu[ZWD + j];
                float zt[17]; const int s0_ = m0 % SEQ;
#pragma unroll
                for (int q = 0; q < 17; ++q) zt[q] = bf2f(Z[(size_t)(m0 + q - 1 + ((q == 0 && s0_ == 0) ? 1 : 0)) * ZP + ZWD + j]);
                if (s0_ == 0) zt[0] = 0.f;
#pragma unroll
                for (int q = 0; q < 16; ++q) { float x = zt[q + 1] + (zt[q] - zt[q + 1]) * mj;
                    const float ex = __expf(j < 32 ? 2.0f * x : -x), rc = 1.0f / (1.0f + ex);
                    x = j < 32 ? 1.0f - 2.0f * rc : (j >= 64 ? rc : x);
                    sm[q * SP + j] = (unsigned short)f2bf(x); }
            }
            __syncthreads();
            {
                const int row = lane & 15, kq = lane >> 4;
                const bf16x8 aw = *(const LAS bf16x8*)(sm + row * SP + 8 * kq), aa = *(const LAS bf16x8*)(sm + row * SP + 32 + 8 * kq), ag0 = *(const LAS bf16x8*)(sm + row * SP + 64 + 8 * kq), ag1 = *(const LAS bf16x8*)(sm + row * SP + 96 + 8 * kq);
#pragma unroll
                for (int i = 0; i < 3; ++i) { const int ch = 16 * (3 * c.wave + i) + row;
                    f32x4v dw = {0.f, 0.f, 0.f, 0.f}, da = dw, dg = dw;
                    dw = __builtin_amdgcn_mfma_f32_16x16x32_bf16(aw, *(const GAS bf16x8*)(LWt + ch * 32 + 8 * kq), dw, 0, 0, 0);
                    da = __builtin_amdgcn_mfma_f32_16x16x32_bf16(aa, *(const GAS bf16x8*)(LAt + ch * 32 + 8 * kq), da, 0, 0, 0);
                    dg = __builtin_amdgcn_mfma_f32_16x16x32_bf16(ag0, *(const GAS bf16x8*)(LGt + ch * 64 + 8 * kq), dg, 0, 0, 0);
                    dg = __builtin_amdgcn_mfma_f32_16x16x32_bf16(ag1, *(const GAS bf16x8*)(LGt + ch * 64 + 32 + 8 * kq), dg, 0, 0, 0);
#pragma unroll
                    for (int rr = 0; rr < 4; ++rr) { const int tq = 4 * kq + rr; lora[(0 * 16 + tq) * AW + ch] = dw[rr]; lora[(1 * 16 + tq) * AW + ch] = da[rr]; lora[(2 * 16 + tq) * AW + ch] = dg[rr]; } }
                if (l > 0 && c.wave == 7) {
                    f32x4v dv = {0.f, 0.f, 0.f, 0.f}; bf16x8 vbf[12];
#pragma unroll
                    for (int ks = 0; ks < 12; ++ks) vbf[ks] = *(const GAS bf16x8*)(VDt + row * AW + 32 * ks + 8 * kq);
#pragma unroll
                    for (int ks = 0; ks < 12; ++ks) dv = __builtin_amdgcn_mfma_f32_16x16x32_bf16(*(const LAS bf16x8*)(vs + row * 392 + 32 * ks + 8 * kq), vbf[ks], dv, 0, 0, 0);
#pragma unroll
                    for (int rr = 0; rr < 4; ++rr) vd[(4 * kq + rr) * 16 + row] = dv[rr]; }
            }
            __syncthreads();

            {
                const float w0t = w0[tc], a0t = a0[tc], kkt = kkw[tc], kat = kaw[tc], rkt = rkw[tc], mr = mu[ZR + tc], mk = mu[ZK + tc], mv = mu[ZV + tc];
                unsigned short ta[16], tv[16], tb[16], tk[16];
                float vupr[16], vfin[16]; float v0t = 0.f;
#pragma unroll
                for (int j = 0; j < 16; ++j) { vupr[j] = 0.f; vfin[j] = 0.f; }
                if (l > 0) { v0t = v0[tc];
                    unsigned short vfr[16];
#pragma unroll
                    for (int j = 0; j < 16; ++j) { vupr[j] = vup[j * AW + tc]; vfr[j] = VF[(size_t)(m0 + j) * AW + tc]; }
#pragma unroll
                    for (int j = 0; j < 16; ++j) vfin[j] = bf2f(vfr[j]); }
                float rin[16], kin[16], vin[16];
                { float zr_[17], zk_[17], zv_[17]; const int s0_ = m0 % SEQ;
#pragma unroll
                  for (int q = 0; q < 17; ++q) { const size_t zo = (size_t)(m0 + q - 1 + ((q == 0 && s0_ == 0) ? 1 : 0)) * ZP;
                      zr_[q] = bf2f(Z[zo + ZR + tc]); zk_[q] = bf2f(Z[zo + ZK + tc]); zv_[q] = bf2f(Z[zo + ZV + tc]); }
                  if (s0_ == 0) { zr_[0] = 0.f; zk_[0] = 0.f; zv_[0] = 0.f; }
#pragma unroll
                  for (int q = 0; q < 16; ++q) { rin[q] = zr_[q + 1] + (zr_[q] - zr_[q + 1]) * mr; kin[q] = zk_[q + 1] + (zk_[q] - zk_[q + 1]) * mk; vin[q] = zv_[q + 1] + (zv_[q] - zv_[q + 1]) * mv;
                  } }
#pragma unroll
                for (int q = 0; q < 16; ++q) { const int m = m0 + q; const size_t o = (size_t)m * AW + tc;
                    const float rv = rin[q], kv = kin[q], vv0 = vin[q];
                    const float xw = -(w0t + lora[(0 * 16 + q) * AW + tc]);
                    const float sp = xw > 20.f ? xw : __logf(1.0f + __expf(xw));
                    const float lw = -__expf(-sp - 0.5f);
                    const float cprev = cum; cum += lw;
                    if (q >= qlo && q < qhi) {
                    const float av = sigmoid_fast(a0t + lora[(1 * 16 + q) * AW + tc]);
                    float vv = vv0;
                    if (l > 0) { float x = v0t;
#pragma unroll
                        for (int j = 0; j < 16; ++j) x += vd[q * 16 + j] * vupr[j];
                        const float vf = vfin[q]; vv = vv + (vf - vv) * sigmoid_fast(x); }
                    else VF[o] = f2bf_hw(vv);
                    float kk = kv * kkt; const float ss = wave_sum(kk * kk); kk = kk * __builtin_amdgcn_rsqf(fmaxf(ss, 1e-24f));
                    const float k2 = kv * (1.0f + (av - 1.0f) * kat);
                    const float rq = bf2f(f2bf_hw(rv)), k2q = bf2f(f2bf_hw(k2));
                    const float bon = wave_sum(rq * k2q * rkt);
                    if (c64 == 0) BON[(size_t)m * AH + hh] = bon;
                    VN[o] = f2bf_hw(vv); GN[o] = f2bf_hw(lora[(2 * 16 + q) * AW + tc]);
                    const float ep = __expf(cum), en = __expf(-cum), epv = __expf(cprev);
                    const int tt = grp * 16 + q; const size_t no = cbo + (size_t)tt * 64 + c64;
                    const unsigned short xa = f2bf_hw(-kk * epv), xb = f2bf_hw(kk * av * en), xk = f2bf_hw(k2 * en);
                    NAT[0 * ASZ + no] = xa; NAT[1 * ASZ + no] = f2bf_hw(rv * ep); NAT[2 * ASZ + no] = xb; NAT[3 * ASZ + no] = xk;
                    ta[q] = xa; tv[q] = f2bf_hw(vv); tb[q] = xb; tk[q] = xk; } }
                const size_t to = cbo + (size_t)c64 * 64 + 16 * grp;
#define PK2(a, i, j) ((unsigned)a[i] | ((unsigned)a[j] << 16))
#define TRST(x, a) do { if (qlo == 0) { *(GAS v2u*)(TR + (x) * ASZ + to) = (v2u){PK2(a, 0, 1), PK2(a, 2, 3)}; *(GAS v2u*)(TR + (x) * ASZ + to + 8) = (v2u){PK2(a, 4, 5), PK2(a, 6, 7)}; } \
                        if (qhi == 16) { *(GAS v2u*)(TR + (x) * ASZ + to + 4) = (v2u){PK2(a, 8, 9), PK2(a, 10, 11)}; *(GAS v2u*)(TR + (x) * ASZ + to + 12) = (v2u){PK2(a, 12, 13), PK2(a, 14, 15)}; } } while (0)
                TRST(0, ta); TRST(1, tv); TRST(2, tb); TRST(3, tk);
#undef TRST
#undef PK2
            }
            __syncthreads();
        }
        if (c.wave < 6) WL[(cbo >> 12) * 64 + c64] = __expf(cum);
    }
}

__device__ __forceinline__ void phase_rwkv_prep4(const Ctx& c, int l) {
    const GAS bf16* Z = (const GAS bf16*)(c.R + R_Z);
    GAS bf16* NAT = (GAS bf16*)(c.R + R_NAT); GAS bf16* TR = (GAS bf16*)(c.R + R_TR); GAS bf16* VN = (GAS bf16*)(c.R + R_VG); GAS bf16* GN = VN + (size_t)M * AW; GAS float* BON = (GAS float*)(c.R + R_BON); GAS float* WL = (GAS float*)(c.R + R_WL); GAS bf16* VF = (GAS bf16*)(c.ws + WS_VF);
    const GAS float* mu = c.in(I_MU) + l * 1280; const GAS float* w0 = c.in(I_W0) + l * AW; const GAS float* a0 = c.in(I_A0) + l * AW;
    const GAS float* kkw = c.in(I_KK) + l * AW; const GAS float* kaw = c.in(I_KA) + l * AW; const GAS float* rkw = c.in(I_RK) + l * AW;
    const GAS float* v0 = c.in(I_V0); const GAS float* vdn = c.in(I_VDN); const GAS float* vup = c.in(I_VUP);
    const GAS bf16* LWt = (const GAS bf16*)(c.ws + WS_WSM + WSM_LW) + (size_t)l * AW * 32; const GAS bf16* LAt = (const GAS bf16*)(c.ws + WS_WSM + WSM_LA) + (size_t)l * AW * 32; const GAS bf16* LGt = (const GAS bf16*)(c.ws + WS_WSM + WSM_LG) + (size_t)l * AW * 64;
    constexpr int SP = 136;
    LAS unsigned short* sm = (LAS unsigned short*)c.lds;
    LAS float* lora = (LAS float*)(c.lds + 8192);
    LAS unsigned short* vs = (LAS unsigned short*)(lora + 3 * 16 * AW);
    LAS float* vd = (LAS float*)(vs + 16 * 392);
    const GAS bf16* VDt = (const GAS bf16*)(c.ws + WS_WSM + WSM_VD);
    const int t = c.tid, lane = c.lane;
    constexpr size_t ASZ = (size_t)NCHUNK * BLK;
    for (int item = c.bid; item < M / 64; item += c.nb) {
        const int b = item / (SEQ / 64), cc = item % (SEQ / 64);
        const int p3 = c.wave % 3, hf = c.wave / 3, hh = 2 * p3 + (lane >> 5), c2 = 2 * (lane & 31), tc = hh * 64 + c2;
        const unsigned cbo = (unsigned)(((b * AH + hh) * (SEQ / 64) + cc) * BLK);
        f32x2 cum = {0.f, 0.f};
        for (int grp = 0; grp < 4; ++grp) {
            const int m0 = item * 64 + grp * 16;
            if (t < AW) {
                if (l > 0) { const float mv = mu[ZV + t];
#pragma unroll 4
                    for (int q = 0; q < 16; ++q) { const int m = m0 + q, s = m % SEQ; vs[q * 392 + t] = (unsigned short)f2bf(zsh(Z, m, s, ZV + t, mv)); } }
            } else {
                const int j = t - AW; const float mj = mu[ZWD + j];
                float zt[17]; const int s0_ = m0 % SEQ;
#pragma unroll
                for (int q = 0; q < 17; ++q) zt[q] = bf2f(Z[(size_t)(m0 + q - 1 + ((q == 0 && s0_ == 0) ? 1 : 0)) * ZP + ZWD + j]);
                if (s0_ == 0) zt[0] = 0.f;
#pragma unroll
                for (int q = 0; q < 16; ++q) { float x = zt[q + 1] + (zt[q] - zt[q + 1]) * mj;
                    const float ex = __expf(j < 32 ? 2.0f * x : -x), rc = 1.0f / (1.0f + ex);
                    x = j < 32 ? 1.0f - 2.0f * rc : (j >= 64 ? rc : x);
                    sm[q * SP + j] = (unsigned short)f2bf(x); }
            }
            __syncthreads();
            {
                const int row = lane & 15, kq = lane >> 4;
                const bf16x8 aw = *(const LAS bf16x8*)(sm + row * SP + 8 * kq), aa = *(const LAS bf16x8*)(sm + row * SP + 32 + 8 * kq), ag0 = *(const LAS bf16x8*)(sm + row * SP + 64 + 8 * kq), ag1 = *(const LAS bf16x8*)(sm + row * SP + 96 + 8 * kq);
#pragma unroll
                for (int i = 0; i < 3; ++i) { const int ch = 16 * (3 * c.wave + i) + row;
                    f32x4v dw = {0.f, 0.f, 0.f, 0.f}, da = dw, dg = dw;
                    dw = __builtin_amdgcn_mfma_f32_16x16x32_bf16(aw, *(const GAS bf16x8*)(LWt + ch * 32 + 8 * kq), dw, 0, 0, 0);
                    da = __builtin_amdgcn_mfma_f32_16x16x32_bf16(aa, *(const GAS bf16x8*)(LAt + ch * 32 + 8 * kq), da, 0, 0, 0);
                    dg = __builtin_amdgcn_mfma_f32_16x16x32_bf16(ag0, *(const GAS bf16x8*)(LGt + ch * 64 + 8 * kq), dg, 0, 0, 0);
                    dg = __builtin_amdgcn_mfma_f32_16x16x32_bf16(ag1, *(const GAS bf16x8*)(LGt + ch * 64 + 32 + 8 * kq), dg, 0, 0, 0);
#pragma unroll
                    for (int rr = 0; rr < 4; ++rr) { const int tq = 4 * kq + rr; lora[(0 * 16 + tq) * AW + ch] = dw[rr]; lora[(1 * 16 + tq) * AW + ch] = da[rr]; lora[(2 * 16 + tq) * AW + ch] = dg[rr]; } }
                if (l > 0 && c.wave == 7) {
                    f32x4v dv = {0.f, 0.f, 0.f, 0.f}; bf16x8 vbf[12];
#pragma unroll
                    for (int ks = 0; ks < 12; ++ks) vbf[ks] = *(const GAS bf16x8*)(VDt + row * AW + 32 * ks + 8 * kq);
#pragma unroll
                    for (int ks = 0; ks < 12; ++ks) dv = __builtin_amdgcn_mfma_f32_16x16x32_bf16(*(const LAS bf16x8*)(vs + row * 392 + 32 * ks + 8 * kq), vbf[ks], dv, 0, 0, 0);
#pragma unroll
                    for (int rr = 0; rr < 4; ++rr) vd[(4 * kq + rr) * 16 + row] = dv[rr]; }
            }
            __syncthreads();

            if (c.wave < 6) {
#define LD2(p) (*(const GAS f32x2*)(p))
                const f32x2 w0t = LD2(w0 + tc), a0t = LD2(a0 + tc), kkt = LD2(kkw + tc), kat = LD2(kaw + tc), rkt = LD2(rkw + tc), mr = LD2(mu + ZR + tc), mk = LD2(mu + ZK + tc), mv = LD2(mu + ZV + tc);
                const int Q0 = 8 * hf, s0_ = (m0 + Q0) % SEQ; const bool pz = s0_ == 0;
                unsigned zr_[9], zk_[9], zv_[9], vfr[8];
#pragma unroll
                for (int q = 0; q < 9; ++q) { const size_t zo = (size_t)(m0 + Q0 + q - 1 + ((q == 0 && pz) ? 1 : 0)) * ZP + tc;
                    zr_[q] = *(const GAS unsigned*)(Z + zo + ZR); zk_[q] = *(const GAS unsigned*)(Z + zo + ZK); zv_[q] = *(const GAS unsigned*)(Z + zo + ZV); }
#pragma unroll
                for (int j = 0; j < 8; ++j) vfr[j] = 0u;
                f32x2 sgv[8];
#pragma unroll
                for (int j = 0; j < 8; ++j) sgv[j] = (f32x2){0.f, 0.f};
                if (l > 0) {
                    f32x2 vupr[16]; const f32x2 v0t = LD2(v0 + tc);
#pragma unroll
                    for (int j = 0; j < 16; ++j) vupr[j] = LD2(vup + j * AW + tc);
#pragma unroll
                    for (int j = 0; j < 8; ++j) vfr[j] = *(const GAS unsigned*)(VF + (size_t)(m0 + Q0 + j) * AW + tc);
#pragma unroll
                    for (int q8 = 0; q8 < 8; ++q8) { f32x2 x = v0t; const LAS f32x4* vq4 = (const LAS f32x4*)(vd + (Q0 + q8) * 16);
#pragma unroll
                        for (int j4 = 0; j4 < 4; ++j4) { const f32x4 d4 = vq4[j4]; x += vupr[4 * j4] * d4.x; x += vupr[4 * j4 + 1] * d4.y; x += vupr[4 * j4 + 2] * d4.z; x += vupr[4 * j4 + 3] * d4.w; }
                        sgv[q8] = (f32x2){sigmoid_fast(x.x), sigmoid_fast(x.y)}; } }
#undef LD2
                if (pz) { zr_[0] = 0u; zk_[0] = 0u; zv_[0] = 0u; }
                f32x2 cumv[9];
#pragma unroll
                for (int q = 0; q < 16; ++q) { const f32x2 lo2 = *(const LAS f32x2*)(lora + (0 * 16 + q) * AW + tc); f32x2 lw;
#pragma unroll
                    for (int e = 0; e < 2; ++e) { const float xw = -(w0t[e] + lo2[e]); const float sp = xw > 20.f ? xw : __logf(1.0f + __expf(xw)); lw[e] = -__expf(-sp - 0.5f); }
                    if (q >= Q0 && q < Q0 + 8) cumv[q & 7] = cum;
                    cum += lw;
                    if (q == Q0 + 7) cumv[8] = cum; }
                const unsigned to = cbo + (unsigned)c2 * 64 + 16 * grp;
#define LO2(a, i, j) (((a)[i] & 0xffffu) | ((a)[j] << 16))
#define HI2(a, i, j) (((a)[i] >> 16) | ((a)[j] & 0xffff0000u))
#pragma unroll
                for (int h4 = 0; h4 < 2; ++h4) {
                    unsigned xa_[4], xv_[4], xb_[4], xk_[4];
#pragma unroll
                    for (int u = 0; u < 4; ++u) { const int q8 = 4 * h4 + u, q = Q0 + q8; const unsigned mo = (unsigned)(m0 + q) * AW + tc;
                        const f32x2 pr = {bflo(zr_[q8]), bfhi(zr_[q8])}, cr = {bflo(zr_[q8 + 1]), bfhi(zr_[q8 + 1])}, pk = {bflo(zk_[q8]), bfhi(zk_[q8])}, ck = {bflo(zk_[q8 + 1]), bfhi(zk_[q8 + 1])};
                        const f32x2 pv = {bflo(zv_[q8]), bfhi(zv_[q8])}, cv = {bflo(zv_[q8 + 1]), bfhi(zv_[q8 + 1])};
                        const f32x2 rv = cr + (pr - cr) * mr, kv = ck + (pk - ck) * mk, vv0 = cv + (pv - cv) * mv;
                        const f32x2 la2 = *(const LAS f32x2*)(lora + (1 * 16 + q) * AW + tc), lg2 = *(const LAS f32x2*)(lora + (2 * 16 + q) * AW + tc);
                        const f32x2 av = {sigmoid_fast(a0t.x + la2.x), sigmoid_fast(a0t.y + la2.y)};
                        f32x2 vv = vv0;
                        if (l > 0) { const f32x2 vf = {bflo(vfr[q8]), bfhi(vfr[q8])}; vv = vv + (vf - vv) * sgv[q8]; }
                        else *(GAS unsigned*)(VF + mo) = pk2(vv.x, vv.y);
                        f32x2 kk = kv * kkt; float ss = row16_sum(kk.x * kk.x + kk.y * kk.y);
                        ss += __builtin_bit_cast(float, __builtin_amdgcn_ds_swizzle(__builtin_bit_cast(int, ss), 0x401F));
                        kk = kk * __builtin_amdgcn_rsqf(fmaxf(ss, 1e-24f));
                        const f32x2 k2 = kv * (1.0f + (av - 1.0f) * kat);
                        const unsigned rqb = pk2(rv.x, rv.y), k2b = pk2(k2.x, k2.y);
                        float bon = row16_sum(bflo(rqb) * bflo(k2b) * rkt.x + bfhi(rqb) * bfhi(k2b) * rkt.y);
                        bon += __builtin_bit_cast(float, __builtin_amdgcn_ds_swizzle(__builtin_bit_cast(int, bon), 0x401F));
                        if ((lane & 31) == 0) BON[(size_t)(m0 + q) * AH + hh] = bon;
                        const unsigned vvb = pk2(vv.x, vv.y);
                        *(GAS unsigned*)(VN + mo) = vvb; *(GAS unsigned*)(GN + mo) = pk2(lg2.x, lg2.y);
                        const f32x2 cu = cumv[q8 + 1], cp = cumv[q8];
                        const f32x2 ep = {__expf(cu.x), __expf(cu.y)}, en = {__expf(-cu.x), __expf(-cu.y)}, epv = {__expf(cp.x), __expf(cp.y)};
                        const f32x2 ta2 = -(kk * epv), tr2 = rv * ep, tb2 = kk * av * en, tk2 = k2 * en;
                        const unsigned xa = pk2(ta2.x, ta2.y), xr = pk2(tr2.x, tr2.y), xb = pk2(tb2.x, tb2.y), xk = pk2(tk2.x, tk2.y);
                        const unsigned no = cbo + (unsigned)(grp * 16 + q) * 64 + c2;
                        *(GAS unsigned*)(NAT + 0 * ASZ + no) = xa; *(GAS unsigned*)(NAT + 1 * ASZ + no) = xr; *(GAS unsigned*)(NAT + 2 * ASZ + no) = xb; *(GAS unsigned*)(NAT + 3 * ASZ + no) = xk;
                        xa_[u] = xa; xv_[u] = vvb; xb_[u] = xb; xk_[u] = xk; }
                    const unsigned pp = hf ? (h4 ? 12 : 4) : (h4 ? 8 : 0);
#define TRST(x, a) do { *(GAS v2u*)(TR + (x) * ASZ + to + pp) = (v2u){LO2(a, 0, 1), LO2(a, 2, 3)}; *(GAS v2u*)(TR + (x) * ASZ + to + 64 + pp) = (v2u){HI2(a, 0, 1), HI2(a, 2, 3)}; } while (0)
                    TRST(0, xa_); TRST(1, xv_); TRST(2, xb_); TRST(3, xk_);
#undef TRST
                }
#undef LO2
#undef HI2
            }
            __syncthreads();
        }
        if (c.wave < 3) *(GAS f32x2*)(WL + (cbo >> 12) * 64 + c2) = (f32x2){__expf(cum.x), __expf(cum.y)};
    }
}

__host__ __device__ constexpr int tri_start(int t) { const int a = t >> 2, b = t & 3; return 8 * a * a + 4 * a + (b >= 1 ? 4 * a : 0) + (b >= 2 ? 4 * a + 4 : 0) + (b == 3 ? 4 * a + 4 : 0); }
static_assert(tri_start(1) == 0 && tri_start(2) == 4 && tri_start(5) == 16 && tri_start(64) == 2112, "tri_start");
__device__ __forceinline__ void phase_rwkv_chunk(const Ctx& c) {
    const GAS bf16* NAT = (const GAS bf16*)(c.R + R_NAT); const GAS bf16* TR = (const GAS bf16*)(c.R + R_TR); const GAS float* WLp = (const GAS float*)(c.R + R_WL);
    GAS v4u* CHM = (GAS v4u*)(c.R + R_CHM); GAS v4u* CHR = (GAS v4u*)(c.R + R_CHR); GAS v4u* NB = (GAS v4u*)(c.R + R_NT); GAS float* YL = (GAS float*)(c.R + R_YL);
    constexpr size_t ASZ = (size_t)NCHUNK * BLK;
    const int lane = c.lane, l31 = lane & 31, hi = lane >> 5;
    const int fo = l31 * 64 + 8 * hi;
    const int tpos = (lane & ~15) + vt_pos(lane & 15);
    const bool six = c.nb * 6 == NCHUNK;
    for (int cb = six ? (c.wave < 6 ? c.bid * 6 + c.wave : NCHUNK) : c.gw; cb < NCHUNK; cb += six ? NCHUNK : c.ngw) {
        unsigned lbase = (unsigned)c.wave * 16384u; asm volatile("" : "+v"(lbase));
        LAS float* la = (LAS float*)(c.lds + lbase);
        LAS unsigned short* lt = (LAS unsigned short*)(c.lds + lbase);
        const GAS bf16* At = NAT + 0 * ASZ + (size_t)cb * BLK; const GAS bf16* Rt = NAT + 1 * ASZ + (size_t)cb * BLK; const GAS bf16* Bh = NAT + 2 * ASZ + (size_t)cb * BLK; const GAS bf16* Kh = NAT + 3 * ASZ + (size_t)cb * BLK;
        const GAS bf16* AtT = TR + 0 * ASZ + (size_t)cb * BLK; const GAS bf16* VT = TR + 1 * ASZ + (size_t)cb * BLK; const GAS bf16* BhT = TR + 2 * ASZ + (size_t)cb * BLK; const GAS bf16* KhT = TR + 3 * ASZ + (size_t)cb * BLK;
        const GAS float* wl = WLp + (size_t)cb * 64;
#define LDF(P, blk, ks) (*(const GAS bf16x8*)((P) + (blk) * 2048 + (ks) * 16 + fo))
#define LDT(blk, ks) (*(const LAS bf16x8*)(lt + ((blk) * 32 + l31) * 72 + (ks) * 16 + 8 * hi))
        f32x16 acc[2][2];
#pragma unroll
        for (int rb = 0; rb < 2; ++rb)
#pragma unroll
            for (int cbk = 0; cbk < 2; ++cbk) { if (rb == 1 && cbk == 0) continue;
                acc[rb][cbk] = zero16();
#pragma unroll
                for (int ks = 0; ks < 4; ++ks) acc[rb][cbk] = MFMA32(LDF(Bh, rb, ks), LDF(At, cbk, ks), acc[rb][cbk]); }
#pragma unroll
        for (int rb = 0; rb < 2; ++rb)
#pragma unroll
            for (int cbk = 0; cbk < 2; ++cbk)
#pragma unroll
                for (int r = 0; r < 16; ++r) { if (rb == 1 && cbk == 0) continue; const int j = 32 * rb + 8 * (r >> 2) + 4 * hi + (r & 3), tq = 32 * cbk + l31; if (rb != cbk || j < tq) la[tri_start(tq) + j] = acc[rb][cbk][r]; }
        __builtin_amdgcn_sched_barrier(0);
        bf16x8 fAtT[2][4], fBhT[2][4];
#pragma unroll
        for (int bk = 0; bk < 2; ++bk)
#pragma unroll
            for (int ks = 0; ks < 4; ++ks) { fAtT[bk][ks] = LDF(AtT, bk, ks); fBhT[bk][ks] = LDF(BhT, bk, ks); }
        f32x2 Tc2[32];
#define TCV(j) Tc2[(j) >> 1][(j) & 1]
#pragma unroll
        for (int tq = 0; tq < 64; ++tq) { int ln_ = lane; asm volatile("" : "+v"(ln_));
            f32x2 sv = {ln_ == tq ? 1.f : 0.f, 0.f};
#pragma unroll
            for (int j = 0; j + 4 <= tq; j += 4) { const f32x4 a4 = *(const LAS f32x4*)(la + tri_start(tq) + j); sv += (f32x2){a4.x, a4.y} * Tc2[j >> 1]; sv += (f32x2){a4.z, a4.w} * Tc2[(j >> 1) + 1]; }
            if (tq & 3) { const int j0 = tq & ~3; const f32x4 a4 = *(const LAS f32x4*)(la + tri_start(tq) + j0);
                sv.x += a4.x * TCV(j0); if ((tq & 3) > 1) sv.y += a4.y * TCV(j0 + 1); if ((tq & 3) > 2) sv.x += a4.z * TCV(j0 + 2); }
            TCV(tq) = sv.x + sv.y; }
#pragma unroll
        for (int tq = 0; tq < 64; ++tq) lt[tq * 72 + tpos] = (unsigned short)f2bf(TCV(tq));
#undef TCV
        __builtin_amdgcn_sched_barrier(0);
        bf16x8 fBhN[2][4], fRtN[2][4];
#pragma unroll
        for (int bk = 0; bk < 2; ++bk)
#pragma unroll
            for (int ks = 0; ks < 4; ++ks) { fBhN[bk][ks] = LDF(Bh, bk, ks); fRtN[bk][ks] = LDF(Rt, bk, ks); }
        bf16x8 Ap[2][2][2];
#pragma unroll
        for (int rb = 0; rb < 2; ++rb)
#pragma unroll
            for (int cbk = 0; cbk < 2; ++cbk) { f32x16 a = zero16();
#pragma unroll
                for (int ks = 0; ks < 4; ++ks) a = MFMA32(LDT(rb, ks), fAtT[cbk][ks], a);
                Ap[rb][cbk][0] = pack8(a, 0); Ap[rb][cbk][1] = pack8(a, 8); }
        __builtin_amdgcn_sched_barrier(0);
        { const float wl0 = wl[l31], wl1 = wl[32 + l31];
#pragma unroll
          for (int rbp = 0; rbp < 2; ++rbp)
#pragma unroll
            for (int cbk = 0; cbk < 2; ++cbk) { f32x16 a = zero16();
#pragma unroll
                for (int rbt = 0; rbt < 2; ++rbt)
#pragma unroll
                    for (int s = 0; s < 2; ++s) a = MFMA32(Ap[rbt][rbp][s], fBhT[cbk][2 * rbt + s], a);
                const float wk = cbk ? wl1 : wl0;
#pragma unroll
                for (int r = 0; r < 16; ++r) { const int kp = 32 * rbp + 8 * (r >> 2) + 4 * hi + (r & 3), kq = 32 * cbk + l31; a[r] = a[r] * wk + keep_zero(wk, kp - kq); }
                CHM[((size_t)cb * 8 + cbk * 4 + 2 * rbp + 0) * 64 + lane] = __builtin_bit_cast(v4u, pack8(a, 0)); CHM[((size_t)cb * 8 + cbk * 4 + 2 * rbp + 1) * 64 + lane] = __builtin_bit_cast(v4u, pack8(a, 8)); } }
        __builtin_amdgcn_sched_barrier(0);
        bf16x8 Pb[2][2][2];
        {
#pragma unroll
          for (int rb = 0; rb < 2; ++rb)
#pragma unroll
            for (int cbk = 0; cbk < 2; ++cbk) { if (rb == 1 && cbk == 0) continue;
                f32x16 a = zero16();
#pragma unroll
                for (int ks = 0; ks < 4; ++ks) a = MFMA32(fBhN[rb][ks], fRtN[cbk][ks], a);
                if (rb == cbk) {
#pragma unroll
                for (int r = 0; r < 16; ++r) { const int j = 32 * rb + 8 * (r >> 2) + 4 * hi + (r & 3), tq = 32 * cbk + l31; a[r] = keep_neg(a[r], j - tq - 1); } }
                Pb[rb][cbk][0] = pack8(a, 0); Pb[rb][cbk][1] = pack8(a, 8); }
#pragma unroll
          for (int rbk = 0; rbk < 2; ++rbk)
#pragma unroll
            for (int cbt = 0; cbt < 2; ++cbt) { f32x16 a;
#pragma unroll
                for (int g = 0; g < 4; ++g) { const v2u w = *(const GAS v2u*)(Rt + (32 * cbt + l31) * 64 + 32 * rbk + 8 * g + 4 * hi); a[4 * g] = bflo(w.x); a[4 * g + 1] = bfhi(w.x); a[4 * g + 2] = bflo(w.y); a[4 * g + 3] = bfhi(w.y); }
#pragma unroll
                for (int rbj = 0; rbj < 2; ++rbj)
#pragma unroll
                    for (int s = 0; s < 2; ++s) { if (rbj == 1 && cbt == 0) continue; a = MFMA32(Ap[rbj][rbk][s], Pb[rbj][cbt][s], a); }
                CHR[((size_t)cb * 8 + cbt * 4 + 2 * rbk + 0) * 64 + lane] = __builtin_bit_cast(v4u, pack8(a, 0)); CHR[((size_t)cb * 8 + cbt * 4 + 2 * rbk + 1) * 64 + lane] = __builtin_bit_cast(v4u, pack8(a, 8)); } }
        __builtin_amdgcn_sched_barrier(0);
        f32x4 wlr[2][4];
#pragma unroll
        for (int rbk = 0; rbk < 2; ++rbk)
#pragma unroll
            for (int g = 0; g < 4; ++g) wlr[rbk][g] = *(const GAS f32x4*)(wl + 32 * rbk + 8 * g + 4 * hi);
        bf16x8 Vp[2][2][2];
        { bf16x8 Pk[2][2][2];
#pragma unroll
          for (int rb = 0; rb < 2; ++rb)
#pragma unroll
            for (int cbk = 0; cbk < 2; ++cbk) { if (rb == 1 && cbk == 0) continue;
                f32x16 a = zero16();
#pragma unroll
                for (int ks = 0; ks < 4; ++ks) a = MFMA32(LDF(Kh, rb, ks), LDF(At, cbk, ks), a);
                if (rb == cbk) {
#pragma unroll
                for (int r = 0; r < 16; ++r) { const int j = 32 * rb + 8 * (r >> 2) + 4 * hi + (r & 3), tq = 32 * cbk + l31; a[r] = keep_neg(a[r], j - tq); } }
                Pk[rb][cbk][0] = pack8(a, 0); Pk[rb][cbk][1] = pack8(a, 8); }
          bf16x8 X2b[2][2][2];
#pragma unroll
          for (int rbt = 0; rbt < 2; ++rbt)
#pragma unroll
            for (int cbv = 0; cbv < 2; ++cbv) { f32x16 a = zero16();
#pragma unroll
                for (int rbj = 0; rbj < 2; ++rbj)
#pragma unroll
                    for (int s = 0; s < 2; ++s) { if (rbj == 1 && rbt == 0) continue; a = MFMA32(Pk[rbj][rbt][s], LDF(VT, cbv, 2 * rbj + s), a); }
                X2b[rbt][cbv][0] = pack8(a, 0); X2b[rbt][cbv][1] = pack8(a, 8); }
#pragma unroll
          for (int rb = 0; rb < 2; ++rb)
#pragma unroll
            for (int cbv = 0; cbv < 2; ++cbv) { f32x16 a = zero16();
#pragma unroll
                for (int ks = 0; ks < 4; ++ks) a = MFMA32(LDT(rb, ks), X2b[ks >> 1][cbv][ks & 1], a);
                Vp[rb][cbv][0] = pack8(a, 0); Vp[rb][cbv][1] = pack8(a, 8); } }
        __builtin_amdgcn_sched_barrier(0);
#pragma unroll
        for (int rbk = 0; rbk < 2; ++rbk)
#pragma unroll
            for (int cbv = 0; cbv < 2; ++cbv) { f32x16 a = zero16();
#pragma unroll
                for (int ks = 0; ks < 4; ++ks) { a = MFMA32(LDF(BhT, rbk, ks), Vp[ks >> 1][cbv][ks & 1], a); a = MFMA32(LDF(KhT, rbk, ks), LDF(VT, cbv, ks), a); }
#pragma unroll
                for (int g = 0; g < 4; ++g) { const f32x4 w4 = wlr[rbk][g]; a[4 * g] *= w4.x; a[4 * g + 1] *= w4.y; a[4 * g + 2] *= w4.z; a[4 * g + 3] *= w4.w; }
                NB[(((size_t)cb * 2 + cbv) * 4 + 2 * rbk + 0) * 64 + lane] = __builtin_bit_cast(v4u, pack8(a, 0)); NB[(((size_t)cb * 2 + cbv) * 4 + 2 * rbk + 1) * 64 + lane] = __builtin_bit_cast(v4u, pack8(a, 8)); }
        __builtin_amdgcn_sched_barrier(0);
        f32x16 yl[2][2];
        {
#pragma unroll
          for (int rbv = 0; rbv < 2; ++rbv)
#pragma unroll
            for (int cbt = 0; cbt < 2; ++cbt) { f32x16 a = zero16();
#pragma unroll
                for (int rbj = 0; rbj < 2; ++rbj)
#pragma unroll
                    for (int s = 0; s < 2; ++s) { if (rbj == 1 && cbt == 0) continue; a = MFMA32(Vp[rbj][rbv][s], Pb[rbj][cbt][s], a); }
                yl[rbv][cbt] = PROBE_NO_VP ? zero16() : a; } }
        __builtin_amdgcn_sched_barrier(0);
        { bf16x8 Pk2[2][2][2];
#pragma unroll
          for (int rb = 0; rb < 2; ++rb)
#pragma unroll
            for (int cbk = 0; cbk < 2; ++cbk) { if (rb == 1 && cbk == 0) continue;
                f32x16 a = zero16();
#pragma unroll
                for (int ks = 0; ks < 4; ++ks) a = MFMA32(LDF(Kh, rb, ks), LDF(Rt, cbk, ks), a);
                if (rb == cbk) {
#pragma unroll
                for (int r = 0; r < 16; ++r) { const int j = 32 * rb + 8 * (r >> 2) + 4 * hi + (r & 3), tq = 32 * cbk + l31; a[r] = keep_neg(a[r], j - tq - 1); } }
                Pk2[rb][cbk][0] = pack8(a, 0); Pk2[rb][cbk][1] = pack8(a, 8); }
#pragma unroll
          for (int rbv = 0; rbv < 2; ++rbv)
#pragma unroll
            for (int cbt = 0; cbt < 2; ++cbt) { f32x16 a = yl[rbv][cbt];
#pragma unroll
                for (int rbj = 0; rbj < 2; ++rbj)
#pragma unroll
                    for (int s = 0; s < 2; ++s) { if (rbj == 1 && cbt == 0) continue; a = MFMA32(LDF(VT, rbv, 2 * rbj + s), Pk2[rbj][cbt][s], a); }
#pragma unroll
                for (int g = 0; g < 4; ++g) {
#ifdef PROBE_COPY
                    const v2u w = *(const GAS v2u*)(Kh + (32 * cbt + l31) * 64 + 32 * rbv + 8 * g + 4 * hi); const v2u w2 = *(const GAS v2u*)(VT + (32 * cbt + l31) * 64 + 32 * rbv + 8 * g + 4 * hi);
                    a[4 * g] = bflo(w.x) + bflo(w2.x); a[4 * g + 1] = bfhi(w.x) + bfhi(w2.x); a[4 * g + 2] = bflo(w.y) + bflo(w2.y); a[4 * g + 3] = bfhi(w.y) + bfhi(w2.y);
#endif
                    *(GAS f32x4*)(YL + (size_t)cb * BLK + (32 * cbt + l31) * 64 + 32 * rbv + 8 * g + 4 * hi) = (f32x4){a[4 * g], a[4 * g + 1], a[4 * g + 2], a[4 * g + 3]}; } } }
#undef LDF
#undef LDT
    }
}

constexpr int SCAN_WGS = 6;
__device__ __forceinline__ void phase_rwkv_scan2(const Ctx& c) {
    const GAS v4u* CHM = (const GAS v4u*)(c.R + R_CHM); GAS v4u* CHS = (GAS v4u*)(c.R + R_CHS); const GAS v4u* NB = (const GAS v4u*)(c.R + R_NT);
    const int lane = c.lane;
    if (c.nb < 2 * SCAN_WGS || c.bid < c.nb - SCAN_WGS) return;
    const int wg = c.bid - (c.nb - SCAN_WGS), bhl = c.wave >> 2, rbk = (c.wave >> 1) & 1, cbv = c.wave & 1, bh = wg * 2 + bhl; const size_t cb0 = (size_t)bh * (SEQ / 64);
    LAS v4u* xs = (LAS v4u*)c.lds;
    const int myslot = c.wave * 128 + lane, peer = (c.wave ^ 2) * 128 + lane;
    bf16x8 own[2], oth[2];
#pragma unroll
    for (int i = 0; i < 2; ++i) { own[i] = (bf16x8){0, 0, 0, 0, 0, 0, 0, 0}; oth[i] = own[i]; }
    constexpr int NBUF = 6;
    v4u mq[NBUF][4], nq[NBUF][2];
#define SCAN_LOAD(buf, cc) do { _Pragma("unroll") for (int i_ = 0; i_ < 4; ++i_) mq[buf][i_] = CHM[((cb0 + (cc)) * 8 + rbk * 4 + i_) * 64 + lane]; \
                                _Pragma("unroll") for (int i_ = 0; i_ < 2; ++i_) nq[buf][i_] = NB[(((cb0 + (cc)) * 2 + cbv) * 4 + 2 * rbk + i_) * 64 + lane]; } while (0)
    SCAN_LOAD(0, 0); SCAN_LOAD(1, 1); SCAN_LOAD(2, 2); SCAN_LOAD(3, 3); SCAN_LOAD(4, 4);
    __syncthreads();
    for (int cc0 = 0; cc0 < SEQ / 64; cc0 += NBUF) {
#pragma unroll
        for (int u = 0; u < NBUF; ++u) { const int cc = cc0 + u;
            if (cc < SEQ / 64) {
                if (cc + 5 < SEQ / 64) SCAN_LOAD((u + 5) % NBUF, cc + 5);
#pragma unroll
                for (int i = 0; i < 2; ++i) CHS[((cb0 + cc) * 8 + cbv * 4 + 2 * rbk + i) * 64 + lane] = __builtin_bit_cast(v4u, own[i]);
                f32x16 a;
#pragma unroll
                for (int hf = 0; hf < 2; ++hf) { const v4u w = nq[u][hf];
                    a[8 * hf + 0] = bflo(w.x); a[8 * hf + 1] = bfhi(w.x); a[8 * hf + 2] = bflo(w.y); a[8 * hf + 3] = bfhi(w.y);
                    a[8 * hf + 4] = bflo(w.z); a[8 * hf + 5] = bfhi(w.z); a[8 * hf + 6] = bflo(w.w); a[8 * hf + 7] = bfhi(w.w); }
#pragma unroll
                for (int ks = 0; ks < 4; ++ks) a = MFMA32(__builtin_bit_cast(bf16x8, mq[u][ks]), (ks >> 1) == rbk ? own[ks & 1] : oth[ks & 1], a);
                own[0] = pack8(a, 0); own[1] = pack8(a, 8);
                LAS v4u* slot = xs + (cc & 1) * 1024;
                slot[myslot] = __builtin_bit_cast(v4u, own[0]); slot[myslot + 64] = __builtin_bit_cast(v4u, own[1]);
                __syncthreads();
                oth[0] = __builtin_bit_cast(bf16x8, slot[peer]); oth[1] = __builtin_bit_cast(bf16x8, slot[peer + 64]);
            }
        }
    }
#undef SCAN_LOAD
    __syncthreads();
}

__device__ __forceinline__ void phase_rwkv_out(const Ctx& c, int l) {
    const GAS v4u* CHR = (const GAS v4u*)(c.R + R_CHR); const GAS v4u* CHS = (const GAS v4u*)(c.R + R_CHS); const GAS float* YL = (const GAS float*)(c.R + R_YL);
    const GAS bf16* VN = (const GAS bf16*)(c.R + R_VG); const GAS bf16* GN = VN + (size_t)M * AW; const GAS float* BON = (const GAS float*)(c.R + R_BON); GAS bf16* YC = (GAS bf16*)(c.ws + WS_XN);
    const GAS float* lng = c.in(I_LNG) + l * AW; const GAS float* lnb = c.in(I_LNB) + l * AW;
    const int lane = c.lane, l31 = lane & 31, hi = lane >> 5;
    const bool six = c.nb * 6 == NCHUNK;
    for (int cb = six ? (c.wave < 6 ? c.bid * 6 + c.wave : NCHUNK) : c.gw; cb < NCHUNK; cb += six ? NCHUNK : c.ngw) {
        const int bh = cb / (SEQ / 64), cc = cb % (SEQ / 64), b = bh / AH, h = bh % AH;
#pragma unroll
        for (int cbt = 0; cbt < 2; ++cbt) {
            f32x16 y[2];
#pragma unroll
            for (int rbv = 0; rbv < 2; ++rbv) {
#pragma unroll
                for (int g = 0; g < 4; ++g) { const f32x4 q4 = *(const GAS f32x4*)(YL + (size_t)cb * BLK + (32 * cbt + l31) * 64 + 32 * rbv + 8 * g + 4 * hi); y[rbv][4 * g] = q4.x * PROBE_YL; y[rbv][4 * g + 1] = q4.y * PROBE_YL; y[rbv][4 * g + 2] = q4.z * PROBE_YL; y[rbv][4 * g + 3] = q4.w * PROBE_YL; }
#pragma unroll
                for (int ks = 0; ks < PROBE_KS; ++ks) y[rbv] = MFMA32(__builtin_bit_cast(bf16x8, CHS[((size_t)cb * 8 + rbv * 4 + ks) * 64 + lane]), __builtin_bit_cast(bf16x8, CHR[((size_t)cb * 8 + cbt * 4 + ks) * 64 + lane]), y[rbv]);
            }
            float s = 0.f;
#pragma unroll
            for (int r = 0; r < 16; ++r) s += y[0][r] + y[1][r];
            s += __shfl_xor(s, 32);
            const float mean = s * (1.0f / 64.0f); float q = 0.f;
#pragma unroll
            for (int r = 0; r < 16; ++r) { y[0][r] -= mean; y[1][r] -= mean; q += y[0][r] * y[0][r] + y[1][r] * y[1][r]; }
            q += __shfl_xor(q, 32);
            const float rstd = __builtin_amdgcn_rsqf(q * (1.0f / 64.0f) + 64e-5f);
            const size_t m = (size_t)b * SEQ + cc * 64 + 32 * cbt + l31; const float bon = BON[m * AH + h];
#pragma unroll
            for (int rbv = 0; rbv < 2; ++rbv)
#pragma unroll
                for (int g = 0; g < 4; ++g) { const int ch = h * 64 + 32 * rbv + 8 * g + 4 * hi;
                    const f32x4 g4 = *(const GAS f32x4*)(lng + ch), b4 = *(const GAS f32x4*)(lnb + ch); const v2u vv = *(const GAS v2u*)(VN + m * AW + ch), gg = *(const GAS v2u*)(GN + m * AW + ch);
                    const float o0 = (y[rbv][4 * g] * rstd * g4.x + b4.x + bon * bflo(vv.x)) * bflo(gg.x), o1 = (y[rbv][4 * g + 1] * rstd * g4.y + b4.y + bon * bfhi(vv.x)) * bfhi(gg.x);
                    const float o2 = (y[rbv][4 * g + 2] * rstd * g4.z + b4.z + bon * bflo(vv.y)) * bflo(gg.y), o3 = (y[rbv][4 * g + 3] * rstd * g4.w + b4.w + bon * bfhi(vv.y)) * bfhi(gg.y);
#ifdef RWKV_SANITIZE
                    { GAS float* oo[4] = {nullptr, nullptr, nullptr, nullptr}; (void)oo; }
#define SAN(x) ((x) == (x) && fabsf(x) < 1e30f ? (x) : 0.f)
                    *(GAS v2u*)(YC + m * D + ch) = (v2u){pk2(SAN(o0), SAN(o1)), pk2(SAN(o2), SAN(o3))}; }
#else
                    *(GAS v2u*)(YC + m * D + ch) = (v2u){pk2(o0, o1), pk2(o2, o3)}; }
#endif
        }
    }
}
__device__ __forceinline__ void phase_mla_prep(const Ctx& c, int l) {
    const GAS bf16* Z = (const GAS bf16*)(c.R + R_Z);
    GAS bf16* Q = (GAS bf16*)(c.R + R_Q); GAS bf16* K = (GAS bf16*)(c.R + R_K); GAS bf16* V = (GAS bf16*)(c.R + R_V);
    const GAS float* qng = c.in(I_QNG) + l * 256; const GAS float* wuq = c.in(I_WUQ) + (size_t)l * 256 * QP; const GAS float* kvng = c.in(I_KVNG) + l * 128; const GAS float* wukv = c.in(I_WUKV) + (size_t)l * 128 * 768;
    const GAS float* qhg = c.in(I_QHG) + l * QKD; const GAS float* khg = c.in(I_KHG) + l * QKD; const GAS int* pos = (const GAS int*)c.in(I_POS);
    LAS float* cqn = (LAS float*)c.lds;
    LAS float* ckn = cqn + 16 * 256;
    LAS float* krs = ckn + 16 * 128;
    LAS float* qb = krs + 16 * 32;
    LAS float* kvb = qb + 16 * QP;
    const float qscale = 1.4426950408889634f / sqrtf((float)QKD);
    for (int grp = c.bid; grp < M / 16; grp += c.nb) {
        const int m0 = grp * 16;
        __syncthreads();
#pragma unroll
        for (int q = 0; q < 2; ++q) { const int tk = 2 * c.wave + q; const GAS bf16* zr = Z + (size_t)(m0 + tk) * ZP;
            float x[4]; float ss = 0.f;
#pragma unroll
            for (int i = 0; i < 4; ++i) { x[i] = bf2f(zr[ZCQ + c.lane + 64 * i]); ss += x[i] * x[i]; }
            float rstd = __builtin_amdgcn_rsqf(wave_sum(ss) * (1.0f / 256.0f) + EPS);
#pragma unroll
            for (int i = 0; i < 4; ++i) cqn[tk * 256 + c.lane + 64 * i] = x[i] * rstd * qng[c.lane + 64 * i];
            float y[2]; ss = 0.f;
#pragma unroll
            for (int i = 0; i < 2; ++i) { y[i] = bf2f(zr[ZCKV + c.lane + 64 * i]); ss += y[i] * y[i]; }
            rstd = __builtin_amdgcn_rsqf(wave_sum(ss) * (1.0f / 128.0f) + EPS);
#pragma unroll
            for (int i = 0; i < 2; ++i) ckn[tk * 128 + c.lane + 64 * i] = y[i] * rstd * kvng[c.lane + 64 * i];
            if (c.lane < 32) krs[tk * 32 + c.lane] = bf2f(zr[ZKR + c.lane]);
        }
        __syncthreads();
        for (int col = c.tid; col < QP; col += NTHR) {
            float acc[16];
#pragma unroll
            for (int q = 0; q < 16; ++q) acc[q] = 0.f;
            for (int kx = 0; kx < 256; ++kx) { const float w = wuq[(size_t)kx * QP + col];
#pragma unroll
                for (int q = 0; q < 16; ++q) acc[q] += cqn[q * 256 + kx] * w; }
#pragma unroll
            for (int q = 0; q < 16; ++q) qb[q * QP + col] = acc[q];
        }
        for (int col = c.tid; col < 768; col += NTHR) {
            float acc[16];
#pragma unroll
            for (int q = 0; q < 16; ++q) acc[q] = 0.f;
            for (int kx = 0; kx < 128; ++kx) { const float w = wukv[(size_t)kx * 768 + col];
#pragma unroll
                for (int q = 0; q < 16; ++q) acc[q] += ckn[q * 128 + kx] * w; }
#pragma unroll
            for (int q = 0; q < 16; ++q) kvb[q * 768 + col] = acc[q];
        }
        __syncthreads();
        for (int pr = c.wave; pr < 16 * AH; pr += NWAVES) {
            const int tk = pr / AH, h = pr % AH, m = m0 + tk; const int ln = c.lane, l32 = ln & 31, fi = ln & 15;
            const float ang = (float)pos[m] * exp2f(-(float)(2 * fi) * (13.287712379549449f / 32.0f));
            const float cs = cosf(ang), sn = sinf(ang);
            { const float x0 = qb[tk * QP + h * QKD + ln], x1 = ln < 32 ? qb[tk * QP + h * QKD + 64 + l32] : 0.f;
              const float rstd = __builtin_amdgcn_rsqf(wave_sum(x0 * x0 + x1 * x1) * (1.0f / QKD) + EPS);
              const float n0 = x0 * rstd * qhg[ln], n1 = x1 * rstd * qhg[64 + l32];
              const float pn = __shfl_xor(n1, 16);
              const float ro = (ln & 16) ? (pn * sn + n1 * cs) : (n1 * cs - pn * sn);
              Q[(size_t)m * QP + h * QKD + ln] = (bf16)f2bf(n0 * qscale);
              if (ln < 32) Q[(size_t)m * QP + h * QKD + 64 + ln] = (bf16)f2bf(ro * qscale); }
            { const float x0 = kvb[tk * 768 + h * 128 + ln], x1 = ln < 32 ? krs[tk * 32 + l32] : 0.f;
              const float rstd = __builtin_amdgcn_rsqf(wave_sum(x0 * x0 + x1 * x1) * (1.0f / QKD) + EPS);
              const float n0 = x0 * rstd * khg[ln], n1 = x1 * rstd * khg[64 + l32];
              const float pn = __shfl_xor(n1, 16);
              const float ro = (ln & 16) ? (pn * sn + n1 * cs) : (n1 * cs - pn * sn);
              K[(size_t)m * QP + h * QKD + ln] = (bf16)f2bf(n0);
              if (ln < 32) K[(size_t)m * QP + h * QKD + 64 + ln] = (bf16)f2bf(ro); }
            { const int sq = m % SEQ, bb = m / SEQ; V[((size_t)((bb * AH + h) * 64 + ln)) * SEQ + (sq & ~15) + vt_pos(sq & 15)] = (bf16)f2bf(kvb[tk * 768 + h * 128 + 64 + ln]); }
        }
    }
    __syncthreads();
}


__device__ __forceinline__ void phase_mla_post1(const Ctx& c, int l) {
    const GAS bf16* Z = (const GAS bf16*)(c.R + R_Z); const GAS bf16* QR = (const GAS bf16*)(c.R + R_QR); const GAS bf16* KVR = (const GAS bf16*)(c.R + R_KVR);
    GAS bf16* Q = (GAS bf16*)(c.R + R_Q); GAS bf16* K = (GAS bf16*)(c.R + R_K); GAS bf16* Vt = (GAS bf16*)(c.R + R_V);
    const GAS float* qhg = c.in(I_QHG) + l * QKD; const GAS float* khg = c.in(I_KHG) + l * QKD; const GAS int* pos = (const GAS int*)c.in(I_POS);
    LAS unsigned short* vt = (LAS unsigned short*)c.lds;
    const float qscale = 1.4426950408889634f / sqrtf((float)QKD);
    const int ln = c.lane, l32 = ln & 31, fi = ln & 15;
    const float g0q = qhg[ln], g1q = qhg[64 + l32], g0k = khg[ln], g1k = khg[64 + l32];
    const float ifr = exp2f(-(float)(2 * fi) * (13.287712379549449f / 32.0f));
    for (int item = c.bid; item < M / 64; item += c.nb) {
        __syncthreads();
        float zq[4], zk2[2], xq0[AH], xq1[AH], xk0[AH], xv0[AH], krv; int pq;
#define P1_LOAD(tok) do { const GAS bf16* zr_ = Z + (size_t)(tok) * ZP; \
            _Pragma("unroll") for (int i = 0; i < 4; ++i) nzq[i] = bf2f(zr_[ZCQ + ln + 64 * i]); \
            _Pragma("unroll") for (int i = 0; i < 2; ++i) nzk[i] = bf2f(zr_[ZCKV + ln + 64 * i]); \
            nkr = ln < 32 ? bf2f(zr_[ZKR + l32]) : 0.f; npq = pos[tok]; \
            _Pragma("unroll") for (int h = 0; h < AH; ++h) { nq0[h] = bf2f(QR[(size_t)(tok) * 768 + h * 128 + ln]); nq1[h] = ln < 32 ? bf2f(QR[(size_t)(tok) * 768 + h * 128 + 64 + l32]) : 0.f; \
                nk0[h] = bf2f(KVR[(size_t)(tok) * 768 + h * 128 + ln]); nv0[h] = bf2f(KVR[(size_t)(tok) * 768 + h * 128 + 64 + ln]); } } while (0)
        float nzq[4], nzk[2], nq0[AH], nq1[AH], nk0[AH], nv0[AH], nkr; int npq;
        P1_LOAD(item * 64 + c.wave * 8);
        for (int q = 0; q < 8; ++q) {
            const int tl = c.wave * 8 + q, m = item * 64 + tl;
#pragma unroll
            for (int i = 0; i < 4; ++i) zq[i] = nzq[i];
            zk2[0] = nzk[0]; zk2[1] = nzk[1]; krv = nkr; pq = npq;
#pragma unroll
            for (int h = 0; h < AH; ++h) { xq0[h] = nq0[h]; xq1[h] = nq1[h]; xk0[h] = nk0[h]; xv0[h] = nv0[h]; }
            if (q + 1 < 8) P1_LOAD(m + 1);
            const float ang = (float)pq * ifr;
            const float rq = __builtin_amdgcn_rsqf(wave_sum((zq[0] * zq[0] + zq[1] * zq[1]) + (zq[2] * zq[2] + zq[3] * zq[3])) * (1.0f / 256.0f) + EPS);
            const float rkv = __builtin_amdgcn_rsqf(wave_sum(zk2[0] * zk2[0] + zk2[1] * zk2[1]) * (1.0f / 128.0f) + EPS);
            float rev = ang * 0.15915494309189535f; rev -= floorf(rev);
            const float cs = __builtin_amdgcn_cosf(rev), sn = __builtin_amdgcn_sinf(rev);
            const int tp = (tl & ~15) + vt_pos(tl & 15);
#pragma unroll
            for (int h = 0; h < AH; ++h) {
                { const float x0 = xq0[h] * rq, x1 = xq1[h] * rq;
                  const float rstd = __builtin_amdgcn_rsqf(wave_sum(x0 * x0 + x1 * x1) * (1.0f / QKD) + EPS);
                  const float n0 = x0 * rstd * g0q, n1 = x1 * rstd * g1q; const float pn = __shfl_xor(n1, 16);
                  const float ro = (ln & 16) ? (pn * sn + n1 * cs) : (n1 * cs - pn * sn);
                  Q[(size_t)m * QP + h * QKD + ln] = (bf16)f2bf(n0 * qscale); if (ln < 32) Q[(size_t)m * QP + h * QKD + 64 + ln] = (bf16)f2bf(ro * qscale); }
                { const float x0 = xk0[h] * rkv, x1 = krv;
                  const float rstd = __builtin_amdgcn_rsqf(wave_sum(x0 * x0 + x1 * x1) * (1.0f / QKD) + EPS);
                  const float n0 = x0 * rstd * g0k, n1 = x1 * rstd * g1k; const float pn = __shfl_xor(n1, 16);
                  const float ro = (ln & 16) ? (pn * sn + n1 * cs) : (n1 * cs - pn * sn);
                  K[(size_t)m * QP + h * QKD + ln] = (bf16)f2bf(n0); if (ln < 32) K[(size_t)m * QP + h * QKD + 64 + ln] = (bf16)f2bf(ro); }
                vt[(h * 64 + ln) * 72 + tp] = (unsigned short)f2bf(xv0[h] * rkv);
            }
        }
#undef P1_LOAD
        __syncthreads();
        const int b = (item * 64) / SEQ, s0 = (item * 64) % SEQ;
        for (int p = c.tid; p < AW * 8; p += NTHR) { const int row = p >> 3, pc = p & 7; const int h = row >> 6, d = row & 63;
            *(GAS v4u*)(Vt + ((size_t)((b * AH + h) * 64 + d)) * SEQ + s0 + 8 * pc) = *(const LAS v4u*)(vt + row * 72 + 8 * pc); }
    }
    __syncthreads();
}
__device__ __forceinline__ float oct_sum(float v) { v += dpp_mov<0xB1>(v); v += dpp_mov<0x4E>(v); v += dpp_mov<0x141>(v); return v; }
__device__ __forceinline__ float sq8(const v4u w) { const float a = bflo(w.x), b = bfhi(w.x), c_ = bflo(w.y), d = bfhi(w.y), e = bflo(w.z), f = bfhi(w.z), g = bflo(w.w), h = bfhi(w.w);
    return ((a * a + b * b) + (c_ * c_ + d * d)) + ((e * e + f * f) + (g * g + h * h)); }
__device__ __forceinline__ v4u p1_head(const v4u w, float sc, const float (&g)[8], const f32x4 c0, const f32x4 c1, const f32x4 s0, const f32x4 s1, bool act, bool rope, float sgn, float oscale) {
    float x[8]; x[0] = bflo(w.x) * sc; x[1] = bfhi(w.x) * sc; x[2] = bflo(w.y) * sc; x[3] = bfhi(w.y) * sc; x[4] = bflo(w.z) * sc; x[5] = bfhi(w.z) * sc; x[6] = bflo(w.w) * sc; x[7] = bfhi(w.w) * sc;
    float ss = ((x[0] * x[0] + x[1] * x[1]) + (x[2] * x[2] + x[3] * x[3])) + ((x[4] * x[4] + x[5] * x[5]) + (x[6] * x[6] + x[7] * x[7]));
    ss = row16_sum(act ? ss : 0.f);
    const float rstd = __builtin_amdgcn_rsqf(ss * (1.0f / QKD) + EPS);
    float o[8];
#pragma unroll
    for (int j = 0; j < 8; ++j) { const float n = x[j] * rstd * g[j]; const float pn = dpp_mov<0x4E>(n); const float cs = j < 4 ? c0[j & 3] : c1[j & 3], sn = j < 4 ? s0[j & 3] : s1[j & 3];
        const float ro = n * cs + sgn * (pn * sn); o[j] = (rope ? ro : n) * oscale; }
    return (v4u){pk2(o[0], o[1]), pk2(o[2], o[3]), pk2(o[4], o[5]), pk2(o[6], o[7])};
}
__device__ __forceinline__ void phase_mla_post1b(const Ctx& c, int l) {
    const GAS bf16* Z = (const GAS bf16*)(c.R + R_Z); const GAS bf16* QR = (const GAS bf16*)(c.R + R_QR); const GAS bf16* KVR = (const GAS bf16*)(c.R + R_KVR);
    GAS bf16* Q = (GAS bf16*)(c.R + R_Q); GAS bf16* K = (GAS bf16*)(c.R + R_K); GAS bf16* Vt = (GAS bf16*)(c.R + R_V);
    const GAS float* qhg = c.in(I_QHG) + l * QKD; const GAS float* khg = c.in(I_KHG) + l * QKD; const GAS int* pos = (const GAS int*)c.in(I_POS);
    constexpr int VTP = 68, TKP = 40;
    LAS unsigned short* vt = (LAS unsigned short*)c.lds;
    LAS float* tk = (LAS float*)(c.lds + 384 * VTP * 2);
    const float qscale = 1.4426950408889634f / sqrtf((float)QKD);
    const int ln = c.lane, i16 = ln & 15, g16 = ln >> 4, ic = i16 < 12 ? i16 : 11, s8 = ln & 7, t8 = ln >> 3;
    float gq[8], gk[8];
#pragma unroll
    for (int j = 0; j < 8; ++j) { gq[j] = qhg[8 * ic + j]; gk[j] = khg[8 * ic + j]; }
    const float ifa = exp2f(-(float)(2 * s8) * (13.287712379549449f / 32.0f)), ifb = exp2f(-(float)(2 * (s8 + 8)) * (13.287712379549449f / 32.0f));
    const bool act = i16 < 12, rope = i16 >= 8, nope = i16 < 8; const float sgn = (i16 & 2) ? 1.f : -1.f;
    for (int item = c.bid; item < M / 64; item += c.nb) {
        __syncthreads();
        {
            const int tok = item * 64 + c.wave * 8 + t8; const GAS bf16* zr = Z + (size_t)tok * ZP;
            v4u a[4], b2[2];
#pragma unroll
            for (int i = 0; i < 4; ++i) a[i] = *(const GAS v4u*)(zr + ZCQ + 32 * s8 + 8 * i);
#pragma unroll
            for (int i = 0; i < 2; ++i) b2[i] = *(const GAS v4u*)(zr + ZCKV + 16 * s8 + 8 * i);
            const int pq = pos[tok];
            const float ssq = oct_sum((sq8(a[0]) + sq8(a[1])) + (sq8(a[2]) + sq8(a[3]))), ssk = oct_sum(sq8(b2[0]) + sq8(b2[1]));
            const float rq = __builtin_amdgcn_rsqf(ssq * (1.0f / 256.0f) + EPS), rkv = __builtin_amdgcn_rsqf(ssk * (1.0f / 128.0f) + EPS);
            float ra = ((float)pq * ifa) * 0.15915494309189535f; ra -= floorf(ra); float rb = ((float)pq * ifb) * 0.15915494309189535f; rb -= floorf(rb);
            LAS float* tp_ = tk + (c.wave * 8 + t8) * TKP;
            tp_[4 + s8] = __builtin_amdgcn_cosf(ra); tp_[12 + s8] = __builtin_amdgcn_cosf(rb); tp_[20 + s8] = __builtin_amdgcn_sinf(ra); tp_[28 + s8] = __builtin_amdgcn_sinf(rb);
            if (s8 == 0) { tp_[0] = rq; tp_[1] = rkv; }
        }
        LDS_WAIT();
#pragma unroll 2
        for (int q = 0; q < 8; ++q) { const int tl = c.wave * 8 + q, m = item * 64 + tl; const float rkv = tk[tl * TKP + 1]; const int tp = (tl & ~15) + vt_pos(tl & 15);
            float xv[AH];
#pragma unroll
            for (int h = 0; h < AH; ++h) xv[h] = bf2f(KVR[(size_t)m * 768 + h * 128 + 64 + ln]);
#pragma unroll
            for (int h = 0; h < AH; ++h) vt[(h * 64 + ln) * VTP + tp] = (unsigned short)f2bf(xv[h] * rkv); }
        for (int pb = 0; pb < 12; pb += 4) {
            v4u wq[4], wk[4], wr[4];
#pragma unroll
            for (int u = 0; u < 4; ++u) { const int idx = (pb + u) * 4 + g16, t = idx & 7, h = idx >> 3; const size_t m = (size_t)(item * 64 + c.wave * 8 + t);
                wq[u] = *(const GAS v4u*)(QR + m * 768 + h * 128 + 8 * ic); wk[u] = *(const GAS v4u*)(KVR + m * 768 + h * 128 + 8 * (i16 & 7)); wr[u] = *(const GAS v4u*)(Z + m * ZP + ZKR + 8 * (ic & 3)); }
#pragma unroll
            for (int u = 0; u < 4; ++u) { const int idx = (pb + u) * 4 + g16, t = idx & 7, h = idx >> 3; const size_t m = (size_t)(item * 64 + c.wave * 8 + t);
                const LAS float* tp_ = tk + (c.wave * 8 + t) * TKP; const float rq = tp_[0], rkv = tp_[1];
                const LAS f32x4* cp = (const LAS f32x4*)(tp_ + 4 + 8 * (i16 & 1)); const LAS f32x4* sp = (const LAS f32x4*)(tp_ + 20 + 8 * (i16 & 1));
                const f32x4 c0 = cp[0], c1 = cp[1], s0 = sp[0], s1 = sp[1];
                const v4u oq = p1_head(wq[u], rq, gq, c0, c1, s0, s1, act, rope, sgn, qscale);
                v4u kw; kw.x = nope ? wk[u].x : wr[u].x; kw.y = nope ? wk[u].y : wr[u].y; kw.z = nope ? wk[u].z : wr[u].z; kw.w = nope ? wk[u].w : wr[u].w;
                const v4u ok = p1_head(kw, nope ? rkv : 1.0f, gk, c0, c1, s0, s1, act, rope, sgn, 1.0f);
                if (act) { *(GAS v4u*)(Q + m * QP + h * QKD + 8 * i16) = oq; *(GAS v4u*)(K + m * QP + h * QKD + 8 * i16) = ok; } }
        }
        __syncthreads();
        const int b = (item * 64) / SEQ, s0_ = (item * 64) % SEQ;
        for (int p = c.tid; p < AW * 8; p += NTHR) { const int row = p >> 3, pc = p & 7; const int h = row >> 6, d = row & 63;
            const LAS v2u* src = (const LAS v2u*)(vt + row * VTP + 8 * pc); const v2u lo = src[0], hi2 = src[1];
            *(GAS v4u*)(Vt + ((size_t)((b * AH + h) * 64 + d)) * SEQ + s0_ + 8 * pc) = (v4u){lo.x, lo.y, hi2.x, hi2.y}; }
    }
    __syncthreads();
}
__device__ __forceinline__ void phase_attn_naive(const Ctx& c) {
    const GAS bf16* Q = (const GAS bf16*)(c.R + R_Q); const GAS bf16* K = (const GAS bf16*)(c.R + R_K); const GAS bf16* V = (const GAS bf16*)(c.R + R_V); GAS float* O = (GAS float*)(c.R + R_OATT);
    LAS float* ks = (LAS float*)c.lds;
    LAS float* vs = ks + 64 * QKD;
    const int row = c.tid >> 1, hf = c.tid & 1;
    for (int item = c.bid; item < BATCH * AH * 32 * 2; item += c.nb) {
        const int qg = 31 - item / (BATCH * AH * 2), rem = item % (BATCH * AH * 2), vh = rem & 1, bh = rem >> 1, b = bh / AH, h = bh % AH;
        const size_t qrow = (size_t)b * SEQ + qg * 256 + row;
        float q[48];
#pragma unroll
        for (int i = 0; i < 24; ++i) { const unsigned w = *(const GAS unsigned*)(Q + qrow * QP + h * QKD + hf * 48 + 2 * i); q[2 * i] = bflo(w); q[2 * i + 1] = bfhi(w); }
        float acc[16];
#pragma unroll
        for (int i = 0; i < 16; ++i) acc[i] = 0.f;
        float mrun = -INFINITY, lrun = 0.f;
        const int myc = qg * 4 + (c.wave >> 1), ntile = qg * 4 + 4;
        for (int j = 0; j < ntile; ++j) {
            __syncthreads();
            const size_t kr0 = (size_t)b * SEQ + j * 64;
            for (int e = c.tid; e < 64 * QKD / 2; e += NTHR) { const int kr = e / (QKD / 2), dd = e % (QKD / 2); const unsigned w = *(const GAS unsigned*)(K + (kr0 + kr) * QP + h * QKD + 2 * dd); ks[kr * QKD + 2 * dd] = bflo(w); ks[kr * QKD + 2 * dd + 1] = bfhi(w); }
            for (int e = c.tid; e < 64 * 32; e += NTHR) { const int kr = e & 63, dd = e >> 6; vs[kr * 32 + dd] = bf2f(V[((size_t)(bh * 64 + vh * 32 + dd)) * SEQ + j * 64 + (kr & ~15) + vt_pos(kr & 15)]); }
            __syncthreads();
            if (j <= myc) {
#pragma unroll 1
                for (int k4 = 0; k4 < 64; k4 += 4) {
                    float s[4];
#pragma unroll
                    for (int u = 0; u < 4; ++u) { const LAS f32x4* kp = (const LAS f32x4*)(ks + (k4 + u) * QKD + hf * 48); float d0 = 0.f, d1 = 0.f;
#pragma unroll
                        for (int i = 0; i < 12; ++i) { const f32x4 kv = kp[i]; d0 += q[4 * i] * kv.x + q[4 * i + 2] * kv.z; d1 += q[4 * i + 1] * kv.y + q[4 * i + 3] * kv.w; }
                        s[u] = d0 + d1; }
#pragma unroll
                    for (int u = 0; u < 4; ++u) s[u] += __shfl_xor(s[u], 1);
                    const float mx = fmaxf(fmaxf(s[0], s[1]), fmaxf(s[2], s[3])), mnew = fmaxf(mrun, mx), corr = exp2f(mrun - mnew);
                    mrun = mnew; lrun *= corr;
#pragma unroll
                    for (int i = 0; i < 16; ++i) acc[i] *= corr;
#pragma unroll
                    for (int u = 0; u < 4; ++u) { const float p = exp2f(s[u] - mnew); lrun += p; const LAS f32x4* vp = (const LAS f32x4*)(vs + (k4 + u) * 32 + hf * 16);
#pragma unroll
                        for (int i = 0; i < 4; ++i) { const f32x4 vv = vp[i]; acc[4 * i] += p * vv.x; acc[4 * i + 1] += p * vv.y; acc[4 * i + 2] += p * vv.z; acc[4 * i + 3] += p * vv.w; } }
                }
            }
        }
        const float inv = 1.0f / lrun;
        GAS float* op = O + qrow * AW + h * 64 + vh * 32 + hf * 16;
#pragma unroll
        for (int i = 0; i < 4; ++i) *(GAS f32x4*)(op + 4 * i) = (f32x4){acc[4 * i] * inv, acc[4 * i + 1] * inv, acc[4 * i + 2] * inv, acc[4 * i + 3] * inv};
    }
    __syncthreads();
}
__device__ __forceinline__ void phase_attn_mfma(const Ctx& c) {
    const GAS bf16* Q = (const GAS bf16*)(c.R + R_Q); const GAS bf16* K = (const GAS bf16*)(c.R + R_K); const GAS bf16* Vt = (const GAS bf16*)(c.R + R_V); GAS float* O = (GAS float*)(c.R + R_OATT);
    constexpr int KP = 104, VP = 72, KBUF = 64 * KP * 2, VBUF = 64 * VP * 2, BUF = KBUF + VBUF;
    const int l31 = c.lane & 31, hi = c.lane >> 5, w = c.wave;
    const int nitem = BATCH * AH * 32;
    for (int rnd = 0;; ++rnd) {
        int item;
        const int na = c.nb >= 2 * SCAN_WGS ? c.nb - SCAN_WGS : c.nb;
        if (c.bid >= na) break;
        if (2 * na >= nitem) { if (rnd >= 2) break; item = rnd == 0 ? c.bid : 2 * na - 1 - c.bid; if (item >= nitem) continue; }
        else { item = c.bid + rnd * na; if (item >= nitem) break; }
        const int qb = 31 - item / (BATCH * AH), bh = item % (BATCH * AH), b = bh / AH, h = bh % AH;
        const size_t q0 = (size_t)b * SEQ + qb * 256 + 32 * w;
        bf16x8 qf[6];
#pragma unroll
        for (int ds = 0; ds < 6; ++ds) qf[ds] = *(const GAS bf16x8*)(Q + (q0 + l31) * QP + h * QKD + 16 * ds + 8 * hi);
        f32x16 o0, o1;
#pragma unroll
        for (int r = 0; r < 16; ++r) { o0[r] = 0.f; o1[r] = 0.f; }
        float mrun = -INFINITY, lrun = 0.f;
        const int NT = 4 * qb + 4, myc = 4 * qb + (w >> 1);
        const int kr0 = c.tid / 12, kc0 = c.tid % 12, kr1 = (c.tid + 512) / 12, kc1 = (c.tid + 512) % 12, vr = c.tid >> 3, vc = c.tid & 7;
        const GAS bf16* kg0 = K + ((size_t)b * SEQ + kr0) * QP + h * QKD + 8 * kc0; const GAS bf16* kg1 = K + ((size_t)b * SEQ + kr1) * QP + h * QKD + 8 * kc1;
        const GAS bf16* vg = Vt + ((size_t)(bh * 64 + vr)) * SEQ + 8 * vc;
        const int kl0 = (kr0 * KP + 8 * kc0) * 2, kl1 = (kr1 * KP + 8 * kc1) * 2, vl = KBUF + (vr * VP + 8 * vc) * 2;
        const bool two = c.tid < 256;
        v4u kx0 = *(const GAS v4u*)kg0, kx1 = two ? *(const GAS v4u*)kg1 : (v4u){0u, 0u, 0u, 0u}, vx = *(const GAS v4u*)vg;
        __syncthreads();
        *(LAS v4u*)(c.lds + kl0) = kx0; if (two) *(LAS v4u*)(c.lds + kl1) = kx1; *(LAS v4u*)(c.lds + vl) = vx;
        __syncthreads();
        for (int j = 0; j < NT; ++j) {
            const bool more = j + 1 < NT;
            if (more) { kx0 = *(const GAS v4u*)(kg0 + (size_t)(j + 1) * 64 * QP); if (two) kx1 = *(const GAS v4u*)(kg1 + (size_t)(j + 1) * 64 * QP); vx = *(const GAS v4u*)(vg + (j + 1) * 64); }
            if (j <= myc) {
                const LAS unsigned char* kb = c.lds + (j & 1) * BUF; const LAS unsigned char* vb = kb + KBUF;
                f32x16 p0, p1;
#pragma unroll
                for (int r = 0; r < 16; ++r) { p0[r] = 0.f; p1[r] = 0.f; }
#pragma unroll
                for (int ds = 0; ds < 6; ++ds) {
                    const bf16x8 kf0 = *(const LAS bf16x8*)(kb + (l31 * KP + 16 * ds + 8 * hi) * 2), kf1 = *(const LAS bf16x8*)(kb + ((l31 + 32) * KP + 16 * ds + 8 * hi) * 2);
                    p0 = __builtin_amdgcn_mfma_f32_32x32x16_bf16(kf0, qf[ds], p0, 0, 0, 0); p1 = __builtin_amdgcn_mfma_f32_32x32x16_bf16(kf1, qf[ds], p1, 0, 0, 0);
                }
                float mx = fmaxf(p0[0], p1[0]);
#pragma unroll
                for (int r = 1; r < 16; ++r) mx = fmaxf(mx, fmaxf(p0[r], p1[r]));
                mx = fmaxf(mx, __shfl_xor(mx, 32));
                const float mnew = fmaxf(mrun, mx), corr = __builtin_amdgcn_exp2f(mrun - mnew); mrun = mnew;
                float ls = 0.f;
#pragma unroll
                for (int r = 0; r < 16; ++r) { p0[r] = __builtin_amdgcn_exp2f(p0[r] - mnew); p1[r] = __builtin_amdgcn_exp2f(p1[r] - mnew); ls += p0[r] + p1[r]; }
                lrun = lrun * corr + ls;
#pragma unroll
                for (int r = 0; r < 16; ++r) { o0[r] *= corr; o1[r] *= corr; }
                bf16x8 pb[4];
                { v4u t;
                  t.x = cvtpk(p0[0], p0[1]); t.y = cvtpk(p0[2], p0[3]); t.z = cvtpk(p0[4], p0[5]); t.w = cvtpk(p0[6], p0[7]); pb[0] = __builtin_bit_cast(bf16x8, t);
                  t.x = cvtpk(p0[8], p0[9]); t.y = cvtpk(p0[10], p0[11]); t.z = cvtpk(p0[12], p0[13]); t.w = cvtpk(p0[14], p0[15]); pb[1] = __builtin_bit_cast(bf16x8, t);
                  t.x = cvtpk(p1[0], p1[1]); t.y = cvtpk(p1[2], p1[3]); t.z = cvtpk(p1[4], p1[5]); t.w = cvtpk(p1[6], p1[7]); pb[2] = __builtin_bit_cast(bf16x8, t);
                  t.x = cvtpk(p1[8], p1[9]); t.y = cvtpk(p1[10], p1[11]); t.z = cvtpk(p1[12], p1[13]); t.w = cvtpk(p1[14], p1[15]); pb[3] = __builtin_bit_cast(bf16x8, t); }
#pragma unroll
                for (int sx = 0; sx < 4; ++sx) {
                    const bf16x8 vf0 = *(const LAS bf16x8*)(vb + (l31 * VP + 16 * sx + 8 * hi) * 2), vf1 = *(const LAS bf16x8*)(vb + ((l31 + 32) * VP + 16 * sx + 8 * hi) * 2);
                    o0 = __builtin_amdgcn_mfma_f32_32x32x16_bf16(vf0, pb[sx], o0, 0, 0, 0); o1 = __builtin_amdgcn_mfma_f32_32x32x16_bf16(vf1, pb[sx], o1, 0, 0, 0);
                }
            }
            if (more) { LAS unsigned char* nb_ = c.lds + ((j + 1) & 1) * BUF; *(LAS v4u*)(nb_ + kl0) = kx0; if (two) *(LAS v4u*)(nb_ + kl1) = kx1; *(LAS v4u*)(nb_ + vl) = vx; }
            __syncthreads();
        }
        const float lt = lrun + __shfl_xor(lrun, 32), inv = 1.0f / lt;
        GAS float* op = O + (q0 + l31) * AW + h * 64 + 4 * hi;
#pragma unroll
        for (int g = 0; g < 4; ++g) {
            *(GAS f32x4*)(op + 8 * g) = (f32x4){o0[4 * g] * inv, o0[4 * g + 1] * inv, o0[4 * g + 2] * inv, o0[4 * g + 3] * inv};
            *(GAS f32x4*)(op + 32 + 8 * g) = (f32x4){o1[4 * g] * inv, o1[4 * g + 1] * inv, o1[4 * g + 2] * inv, o1[4 * g + 3] * inv};
        }
    }
    __syncthreads();
}
__device__ __forceinline__ void phase_attn_mfma2(const Ctx& c, int l) {
    const GAS bf16* Q = (const GAS bf16*)(c.R + R_Q); const GAS bf16* K = (const GAS bf16*)(c.R + R_K); const GAS bf16* Vt = (const GAS bf16*)(c.R + R_V); GAS float* O = (GAS float*)(c.R + R_OATT);
    constexpr int KP = 104, VP = 72, KBUF = 128 * KP * 2, VBUF = 64 * VP * 2, BUF = KBUF + 2 * VBUF;
    const int l31 = c.lane & 31, hi = c.lane >> 5, w = c.wave;
    const int nitem = BATCH * AH * 32;
    for (int rnd = 0;; ++rnd) {
        int item;
        const int na = c.nb >= 2 * SCAN_WGS ? c.nb - SCAN_WGS : c.nb;
        if (c.bid >= na) break;
        if (2 * na >= nitem) { if (rnd >= 2) break; item = rnd == 0 ? c.bid : 2 * na - 1 - c.bid; if (item >= nitem) continue; }
        else { item = c.bid + rnd * na; if (item >= nitem) break; }
        const int qb = 31 - item / (BATCH * AH), bh = item % (BATCH * AH), b = bh / AH, h = bh % AH;
        const size_t q0 = (size_t)b * SEQ + qb * 256 + 32 * w;
        bf16x8 qf[6];
#pragma unroll
        for (int ds = 0; ds < 6; ++ds) qf[ds] = *(const GAS bf16x8*)(Q + (q0 + l31) * QP + h * QKD + 16 * ds + 8 * hi);
        f32x16 o0 = zero16(), o1 = zero16();
        float mrun = -INFINITY, lrun = 0.f;
        const int NS = 2 * qb + 2, myc = 4 * qb + (w >> 1);
        int kl[3]; const GAS bf16* kg[3];
#pragma unroll
        for (int i = 0; i < 3; ++i) { const int p = c.tid + 512 * i, kr = p / 12, kc = p % 12; kl[i] = (kr * KP + 8 * kc) * 2; kg[i] = K + ((size_t)b * SEQ + kr) * QP + h * QKD + 8 * kc; }
        int vl[2]; const GAS bf16* vg[2];
#pragma unroll
        for (int i = 0; i < 2; ++i) { const int p = c.tid + 512 * i, half = p >> 9, vr = (p >> 3) & 63, vc = p & 7; vl[i] = KBUF + half * VBUF + (vr * VP + 8 * vc) * 2; vg[i] = Vt + ((size_t)(bh * 64 + vr)) * SEQ + 64 * half + 8 * vc; }
        v4u kx[3], vx[2];
#pragma unroll
        for (int i = 0; i < 3; ++i) kx[i] = *(const GAS v4u*)kg[i];
#pragma unroll
        for (int i = 0; i < 2; ++i) vx[i] = *(const GAS v4u*)vg[i];
        __syncthreads();
#pragma unroll
        for (int i = 0; i < 3; ++i) *(LAS v4u*)(c.lds + kl[i]) = kx[i];
#pragma unroll
        for (int i = 0; i < 2; ++i) *(LAS v4u*)(c.lds + vl[i]) = vx[i];
        __syncthreads();
        for (int j = 0; j < NS; ++j) {
            const bool more = j + 1 < NS;
            if (more) {
#pragma unroll
                for (int i = 0; i < 3; ++i) kx[i] = *(const GAS v4u*)(kg[i] + (size_t)(j + 1) * 128 * QP);
#pragma unroll
                for (int i = 0; i < 2; ++i) vx[i] = *(const GAS v4u*)(vg[i] + (j + 1) * 128); }
            const int nvis = myc - 2 * j + 1;
            if (nvis > 0) {
                const LAS unsigned char* kb = c.lds + (j & 1) * BUF; const LAS unsigned char* vb = kb + KBUF;
                const bool first = mrun == -INFINITY;
                const float cin = first ? 0.f : -mrun;
                f32x16 p0, p1, p2, p3;
#pragma unroll
                for (int r = 0; r < 16; ++r) { p0[r] = cin; p1[r] = cin; p2[r] = cin; p3[r] = cin; }
#define KFR(blk, ds) (*(const LAS bf16x8*)(kb + ((l31 + 32 * (blk)) * KP + 16 * (ds) + 8 * hi) * 2))
                bf16x8 ka[8], kc[8];
#pragma unroll
                for (int ds = 0; ds < 2; ++ds) { ka[4 * ds] = KFR(0, ds); ka[4 * ds + 1] = KFR(1, ds); ka[4 * ds + 2] = KFR(2, ds); ka[4 * ds + 3] = KFR(3, ds); }
#pragma unroll
                for (int ds = 0; ds < 2; ++ds) { kc[4 * ds] = KFR(0, ds + 2); kc[4 * ds + 1] = KFR(1, ds + 2); kc[4 * ds + 2] = KFR(2, ds + 2); kc[4 * ds + 3] = KFR(3, ds + 2); }
#pragma unroll
                for (int ds = 0; ds < 2; ++ds) { p0 = MFMA32(ka[4 * ds], qf[ds], p0); p1 = MFMA32(ka[4 * ds + 1], qf[ds], p1); p2 = MFMA32(ka[4 * ds + 2], qf[ds], p2); p3 = MFMA32(ka[4 * ds + 3], qf[ds], p3); }
#pragma unroll
                for (int ds = 0; ds < 2; ++ds) { ka[4 * ds] = KFR(0, ds + 4); ka[4 * ds + 1] = KFR(1, ds + 4); ka[4 * ds + 2] = KFR(2, ds + 4); ka[4 * ds + 3] = KFR(3, ds + 4); }
#pragma unroll
                for (int ds = 0; ds < 2; ++ds) { p0 = MFMA32(kc[4 * ds], qf[ds + 2], p0); p1 = MFMA32(kc[4 * ds + 1], qf[ds + 2], p1); p2 = MFMA32(kc[4 * ds + 2], qf[ds + 2], p2); p3 = MFMA32(kc[4 * ds + 3], qf[ds + 2], p3); }
#pragma unroll
                for (int ds = 0; ds < 2; ++ds) { p0 = MFMA32(ka[4 * ds], qf[ds + 4], p0); p1 = MFMA32(ka[4 * ds + 1], qf[ds + 4], p1); p2 = MFMA32(ka[4 * ds + 2], qf[ds + 4], p2); p3 = MFMA32(ka[4 * ds + 3], qf[ds + 4], p3); }
#undef KFR
                bf16x8 vfa[8];
#pragma unroll
                for (int sx = 0; sx < 8; ++sx) { const LAS unsigned char* vq = vb + (sx >> 2) * VBUF; vfa[sx] = *(const LAS bf16x8*)(vq + (l31 * VP + 16 * (sx & 3) + 8 * hi) * 2); }
                if (__builtin_amdgcn_readfirstlane(nvis) < 2) {
#pragma unroll
                    for (int r = 0; r < 16; ++r) { p2[r] = -INFINITY; p3[r] = -INFINITY; } }
                float mx = fmaxf(fmaxf(p0[0], p1[0]), fmaxf(p2[0], p3[0]));
#pragma unroll
                for (int r = 1; r < 16; ++r) mx = fmaxf(mx, fmaxf(fmaxf(p0[r], p1[r]), fmaxf(p2[r], p3[r])));
                mx = fmaxf(mx, __shfl_xor(mx, 32));
                const float dl = first ? mx : fmaxf(mx, 0.f);
                if (__any(first || dl != 0.f)) {
                    const float corr = first ? 0.f : __builtin_amdgcn_exp2f(-dl);
#pragma unroll
                    for (int r = 0; r < 16; ++r) { p0[r] -= dl; p1[r] -= dl; p2[r] -= dl; p3[r] -= dl; o0[r] *= corr; o1[r] *= corr; }
                    lrun *= corr; mrun = first ? mx : mrun + dl; }
                float ls = 0.f;
#pragma unroll
                for (int r = 0; r < 16; ++r) { p0[r] = __builtin_amdgcn_exp2f(p0[r]); p1[r] = __builtin_amdgcn_exp2f(p1[r]); p2[r] = __builtin_amdgcn_exp2f(p2[r]); p3[r] = __builtin_amdgcn_exp2f(p3[r]);
                    ls += (p0[r] + p1[r]) + (p2[r] + p3[r]); }
                lrun += ls;
#pragma unroll
                for (int sx = 0; sx < 8; ++sx) {
                    const bf16x8 pb = sx < 2 ? pack8(p0, 8 * (sx & 1)) : sx < 4 ? pack8(p1, 8 * (sx & 1)) : sx < 6 ? pack8(p2, 8 * (sx & 1)) : pack8(p3, 8 * (sx & 1));
                    const LAS unsigned char* vq = vb + (sx >> 2) * VBUF;
                    o0 = MFMA32(vfa[sx], pb, o0); o1 = MFMA32(*(const LAS bf16x8*)(vq + ((l31 + 32) * VP + 16 * (sx & 3) + 8 * hi) * 2), pb, o1);
                }
            }
            if (more) { LAS unsigned char* nb_ = c.lds + ((j + 1) & 1) * BUF;
#pragma unroll
                for (int i = 0; i < 3; ++i) *(LAS v4u*)(nb_ + kl[i]) = kx[i];
#pragma unroll
                for (int i = 0; i < 2; ++i) *(LAS v4u*)(nb_ + vl[i]) = vx[i]; }
            __syncthreads();
        }
        const float lt = lrun + __shfl_xor(lrun, 32), inv = 1.0f / lt;
        GAS float* op = O + (q0 + l31) * AW + h * 64 + 4 * hi;
#pragma unroll
        for (int g = 0; g < 4; ++g) {
            *(GAS f32x4*)(op + 8 * g) = (f32x4){o0[4 * g] * inv, o0[4 * g + 1] * inv, o0[4 * g + 2] * inv, o0[4 * g + 3] * inv};
            *(GAS f32x4*)(op + 32 + 8 * g) = (f32x4){o1[4 * g] * inv, o1[4 * g + 1] * inv, o1[4 * g + 2] * inv, o1[4 * g + 3] * inv};
        }
    }
    __syncthreads();
    if (l == 1) {
        const int na_ = c.nb >= 2 * SCAN_WGS ? c.nb - SCAN_WGS : c.nb;
        if (c.bid < na_) { GAS unsigned* cq = (GAS unsigned*)(c.ws + WS_CTL) + CW_CQ;
            if (c.tid == 0) (void)__hip_atomic_fetch_add(cq + 64, 1u, __ATOMIC_RELAXED, __HIP_MEMORY_SCOPE_AGENT);
            ExpertGUJobs JG{&c}; conv_pop(c, cq, ExpertGUJobs::TOTAL, JG, cq + 64, (unsigned)na_); }
    }
}
__device__ __forceinline__ void phase_mla_post(const Ctx& c, int l) {
    const GAS float* O = (const GAS float*)(c.R + R_OATT); GAS bf16* YC = (GAS bf16*)(c.ws + WS_XN); const GAS float* og = c.in(I_BOG) + l * AW;
    const int i16 = c.lane & 15, g16 = c.lane >> 4;
    f32x4 gv[6];
#pragma unroll
    for (int k = 0; k < 6; ++k) gv[k] = *(const GAS f32x4*)(og + 64 * k + 4 * i16);
    for (int m0 = c.gw * 4; m0 < M; m0 += c.ngw * 8) {
        const int mA = m0 + g16, mB = mA + c.ngw * 4; const bool hasB = m0 + c.ngw * 4 < M;
        f32x4 xa[6], xb[6];
#pragma unroll
        for (int k = 0; k < 6; ++k) xa[k] = *(const GAS f32x4*)(O + (size_t)mA * AW + 64 * k + 4 * i16);
        if (hasB) {
#pragma unroll
            for (int k = 0; k < 6; ++k) xb[k] = *(const GAS f32x4*)(O + (size_t)mB * AW + 64 * k + 4 * i16); }
        { float ss = 0.f;
#pragma unroll
          for (int k = 0; k < 6; ++k) ss += (xa[k].x * xa[k].x + xa[k].y * xa[k].y) + (xa[k].z * xa[k].z + xa[k].w * xa[k].w);
          const float rstd = __builtin_amdgcn_rsqf(row16_sum(ss) * (1.0f / AW) + EPS);
#pragma unroll
          for (int k = 0; k < 6; ++k) { const f32x4 v = xa[k] * rstd * gv[k]; *(GAS v2u*)(YC + (size_t)mA * D + AW + 64 * k + 4 * i16) = (v2u){pk2(v.x, v.y), pk2(v.z, v.w)}; } }
        if (hasB) { float ss = 0.f;
#pragma unroll
          for (int k = 0; k < 6; ++k) ss += (xb[k].x * xb[k].x + xb[k].y * xb[k].y) + (xb[k].z * xb[k].z + xb[k].w * xb[k].w);
          const float rstd = __builtin_amdgcn_rsqf(row16_sum(ss) * (1.0f / AW) + EPS);
#pragma unroll
          for (int k = 0; k < 6; ++k) { const f32x4 v = xb[k] * rstd * gv[k]; *(GAS v2u*)(YC + (size_t)mB * D + AW + 64 * k + 4 * i16) = (v2u){pk2(v.x, v.y), pk2(v.z, v.w)}; } }
    }
}

__device__ __forceinline__ void phase_gmlp(const Ctx& c, int l) {
    const GAS bf16* Z = (const GAS bf16*)(c.R + R_Z); GAS bf16* YC = (GAS bf16*)(c.ws + WS_XN);
    const GAS float* lng = c.in(I_CLNG) + l * 256; const GAS float* lnb = c.in(I_CLNB) + l * 256; const GAS float* ws = c.in(I_CWS) + (size_t)l * 4 * 128 * 128; const GAS float* bs = c.in(I_CBS) + l * 4 * 128; const GAS float* og = c.in(I_COG) + l * 256;
    LAS float* vln = (LAS float*)c.lds;
    LAS float* ssq2 = (LAS float*)(c.lds + MISC_OFF + 256);
    for (int item = c.bid; item < M / 128; item += c.nb) {
        const int m0 = item * 128;
        __syncthreads();
        for (int q = 0; q < 16; ++q) { const int t = c.wave * 16 + q; const GAS bf16* zr = Z + (size_t)(m0 + t) * ZP + ZCV;
            float x[4]; float s = 0.f;
#pragma unroll
            for (int i = 0; i < 4; ++i) { x[i] = gelu_erf(bf2f(zr[c.lane + 64 * i])); s += x[i]; }
            const float mean = wave_sum(s) * (1.0f / 256.0f); float s2 = 0.f;
#pragma unroll
            for (int i = 0; i < 4; ++i) { x[i] -= mean; s2 += x[i] * x[i]; }
            const float rstd = __builtin_amdgcn_rsqf(wave_sum(s2) * (1.0f / 256.0f) + EPS);
#pragma unroll
            for (int i = 0; i < 4; ++i) vln[t * 256 + c.lane + 64 * i] = x[i] * rstd * lng[c.lane + 64 * i] + lnb[c.lane + 64 * i];
        }
        __syncthreads();
        const int g = c.wave & 3, half = c.wave >> 2, ch = g * 64 + c.lane;
        for (int tt = 0; tt < 64; ++tt) { const int t = half * 64 + tt; const GAS float* wr = ws + ((size_t)g * 128 + t) * 128; float acc = 0.f;
            for (int s = 0; s <= t; ++s) acc += wr[s] * vln[s * 256 + ch];
            const float sv = acc + bs[g * 128 + t]; const float u = gelu_erf(bf2f(Z[(size_t)(m0 + t) * ZP + ZU + ch])); const float y = u * sv;
            const float p = wave_sum(y * y); if (c.lane == 0) ssq2[t * 4 + g] = p;
            YC[(size_t)(m0 + t) * D + 768 + ch] = (bf16)f2bf(y); }
        __syncthreads();
        for (int tt = 0; tt < 64; ++tt) { const int t = half * 64 + tt; const float tot = (ssq2[t * 4 + 0] + ssq2[t * 4 + 1]) + (ssq2[t * 4 + 2] + ssq2[t * 4 + 3]);
            const float rstd = __builtin_amdgcn_rsqf(tot * (1.0f / 256.0f) + EPS); GAS bf16* p = YC + (size_t)(m0 + t) * D + 768 + ch; *p = (bf16)f2bf(bf2f(*p) * rstd * og[ch]); }
    }
    __syncthreads();
}


__device__ __forceinline__ void phase_gmlp_mfma(const Ctx& c, int l) {
    const GAS bf16* Z = (const GAS bf16*)(c.R + R_Z); GAS bf16* YC = (GAS bf16*)(c.ws + WS_XN);
    const GAS float* lng = c.in(I_CLNG) + l * 256; const GAS float* lnb = c.in(I_CLNB) + l * 256; const GAS float* bs = c.in(I_CBS) + l * 4 * 128; const GAS float* og = c.in(I_COG) + l * 256;
    const GAS bf16* W = (const GAS bf16*)(c.ws + WS_WSM + WSM_GW) + (size_t)l * 4 * 128 * 128;
    constexpr int VP = 136;
    LAS unsigned short* vT = (LAS unsigned short*)c.lds;
    LAS float* sq = (LAS float*)(c.lds + 256 * VP * 2);
    const int lane = c.lane, l31 = lane & 31, hi = lane >> 5;
    float lg4[4], lb4[4];
#pragma unroll
    for (int i = 0; i < 4; ++i) { lg4[i] = lng[lane + 64 * i]; lb4[i] = lnb[lane + 64 * i]; }
    for (int it_ = c.bid; it_ < M / 64; it_ += c.nb) {
        const int item = c.nb == 256 ? (it_ < 64 ? 2 * it_ + 1 : it_ < 192 ? 2 * (it_ - 64) : 2 * (it_ - 128) + 1) : it_;
        const int th = item & 1, m0 = (item >> 1) * 128, nq = 8 * (th + 1);
        __syncthreads();
        for (int q0 = 0; q0 < nq; q0 += 4) {
            float zx[4][4];
#pragma unroll
            for (int u = 0; u < 4; ++u) { const GAS bf16* zr = Z + (size_t)(m0 + c.wave * nq + q0 + u) * ZP + ZCV;
#pragma unroll
                for (int i = 0; i < 4; ++i) zx[u][i] = bf2f(zr[lane + 64 * i]); }
#pragma unroll
            for (int u = 0; u < 4; ++u) { const int t = c.wave * nq + q0 + u; float x[4]; float s = 0.f;
#pragma unroll
                for (int i = 0; i < 4; i += 2) { const pg8::f32x2 gv = pg8::gelu_pk((pg8::f32x2){zx[u][i], zx[u][i + 1]}); x[i] = gv.x; x[i + 1] = gv.y; s += gv.x + gv.y; }
                const float mean = wave_sum(s) * (1.0f / 256.0f); float s2 = 0.f;
#pragma unroll
                for (int i = 0; i < 4; ++i) { x[i] -= mean; s2 += x[i] * x[i]; }
                const float rstd = __builtin_amdgcn_rsqf(wave_sum(s2) * (1.0f / 256.0f) + EPS);
#pragma unroll
                for (int i = 0; i < 4; ++i) vT[(lane + 64 * i) * VP + t] = (unsigned short)f2bf(x[i] * rstd * lg4[i] + lb4[i]); }
        }
        __syncthreads();
        const int tb = 2 * th + (c.wave & 1), g = c.wave >> 1; const int t = 32 * tb + l31, tl = 32 * (c.wave & 1) + l31; const size_t m = (size_t)m0 + t;
        float ss = 0.f; const float bias = bs[g * 128 + t];
        const GAS bf16* wr = W + ((size_t)g * 128 + t) * 128 + 8 * hi;
#pragma unroll 1
        for (int i = 0; i < 2; ++i) { const int cblk = 2 * g + i; f32x16 a = zero16();
            for (int ks = 0; ks < 2 * tb + 2; ++ks) a = MFMA32(*(const LAS bf16x8*)(vT + (32 * cblk + l31) * VP + 16 * ks + 8 * hi), *(const GAS bf16x8*)(wr + 16 * ks), a);
#pragma unroll
            for (int gq = 0; gq < 4; ++gq) { const int ch = 32 * cblk + 8 * gq + 4 * hi; const v2u zu = *(const GAS v2u*)(Z + m * ZP + ZU + ch);
                const pg8::f32x2 u01 = pg8::gelu_pk((pg8::f32x2){bflo(zu.x), bfhi(zu.x)}), u23 = pg8::gelu_pk((pg8::f32x2){bflo(zu.y), bfhi(zu.y)});
                const float y0 = u01.x * (a[4 * gq] + bias), y1 = u01.y * (a[4 * gq + 1] + bias), y2 = u23.x * (a[4 * gq + 2] + bias), y3 = u23.y * (a[4 * gq + 3] + bias);
                ss += (y0 * y0 + y1 * y1) + (y2 * y2 + y3 * y3);
                *(GAS v2u*)(YC + m * D + 768 + ch) = (v2u){pk2(y0, y1), pk2(y2, y3)}; } }
        ss += __shfl_xor(ss, 32);
        if (hi == 0) sq[g * 64 + tl] = ss;
        __syncthreads();
        const float rstd = __builtin_amdgcn_rsqf(((sq[tl] + sq[64 + tl]) + (sq[128 + tl] + sq[192 + tl])) * (1.0f / 256.0f) + EPS);
#pragma unroll 1
        for (int i = 0; i < 2; ++i) { const int cblk = 2 * g + i;
#pragma unroll
            for (int gq = 0; gq < 4; ++gq) { const int ch = 32 * cblk + 8 * gq + 4 * hi; const f32x4 o4 = *(const GAS f32x4*)(og + ch); GAS v2u* p = (GAS v2u*)(YC + m * D + 768 + ch); const v2u w = *p;
                *p = (v2u){pk2(bflo(w.x) * rstd * o4.x, bfhi(w.x) * rstd * o4.y), pk2(bflo(w.y) * rstd * o4.z, bfhi(w.y) * rstd * o4.w)}; } }
    }
    __syncthreads();
}

__device__ __forceinline__ void phase_moe_count(const Ctx& c) {
    const GAS int* te = (const GAS int*)(c.ws + WS_TOK + TOK_E); GAS int* seg = (GAS int*)(c.ws + WS_TOK + TOK_SEG);
    for (int sgi = c.gw; sgi < NSEG; sgi += c.ngw) {
        const int m = sgi * SEGT + c.lane; const int e0 = te[2 * m], e1 = te[2 * m + 1];
#pragma unroll
        for (int e = 0; e < NE; ++e) { const unsigned long long b0 = __ballot(e0 == e), b1 = __ballot(e1 == e); if (c.lane == 0) seg[sgi * NE + e] = __popcll(b0) + __popcll(b1); }
    }
}
__device__ __forceinline__ void phase_moe_scatter(const Ctx& c) {
    const GAS int* te = (const GAS int*)(c.ws + WS_TOK + TOK_E); const GAS int* seg = (const GAS int*)(c.ws + WS_TOK + TOK_SEG); GAS int* tpos = (GAS int*)(c.ws + WS_TOK + TOK_POS); GAS int* tile = (GAS int*)(c.ws + WS_TOK + TOK_TILE);
    const GAS bf16* XN = (const GAS bf16*)(c.ws + WS_XN); GAS bf16* XNP = (GAS bf16*)(c.R + R_XNP);
    LAS int* pre = (LAS int*)c.lds;
    LAS int* tot = pre + NSEG * NE;
    LAS int* base = tot + NE;
    __syncthreads();
    if (c.tid < NE) { int s = 0; for (int sgi = 0; sgi < NSEG; ++sgi) { pre[sgi * NE + c.tid] = s; s += seg[sgi * NE + c.tid]; } tot[c.tid] = s; }
    __syncthreads();
    if (c.tid == 0) { int s = 0; for (int e = 0; e < NE; ++e) { base[e] = s; s += (tot[e] + 255) & ~255; }
        if (c.bid == 0) { int T = 0; for (int e = 0; e < NE; ++e) { const int n = ((tot[e] + 255) & ~255) / 256; tile[e] = base[e] / 256; tile[8 + e] = n; for (int i = 0; i < n; ++i) tile[32 + T + i] = e; T += n; } tile[16] = T; } }
    __syncthreads();
    for (int sgi = c.bid; sgi < NSEG; sgi += c.nb) {
        const int m = sgi * SEGT + c.lane; const int e0 = te[2 * m], e1 = te[2 * m + 1]; int p0 = 0, p1 = 0;
        const unsigned long long below = (1ull << c.lane) - 1ull;
#pragma unroll
        for (int e = 0; e < NE; ++e) { const unsigned long long b0 = __ballot(e0 == e), b1 = __ballot(e1 == e);
            const int r = __popcll(b0 & below) + __popcll(b1 & below); const int st = base[e] + pre[sgi * NE + e];
            if (e0 == e) p0 = st + r; if (e1 == e) p1 = st + r + ((e0 == e) ? 1 : 0); }
        if (c.wave == 0) { tpos[2 * m] = p0; tpos[2 * m + 1] = p1; }
        v4u x0[8], x1[8];
#pragma unroll
        for (int u = 0; u < 8; ++u) { const GAS v4u* src = (const GAS v4u*)(XN + (size_t)(sgi * SEGT + 8 * c.wave + u) * D) + c.lane; x0[u] = src[0]; x1[u] = src[64]; }
#pragma unroll
        for (int u = 0; u < 8; ++u) { const int d0 = __shfl(p0, 8 * c.wave + u), d1 = __shfl(p1, 8 * c.wave + u); GAS v4u* o0 = (GAS v4u*)(XNP + (size_t)d0 * D) + c.lane; GAS v4u* o1 = (GAS v4u*)(XNP + (size_t)d1 * D) + c.lane;
            o0[0] = x0[u]; o0[64] = x1[u]; o1[0] = x0[u]; o1[64] = x1[u]; }
    }
    for (int e = 0; e < NE; ++e) { const int r0 = base[e] + tot[e], r1 = base[e] + ((tot[e] + 255) & ~255);
        for (int r = r0 + c.gw; r < r1; r += c.ngw) { GAS v4u* o = (GAS v4u*)(XNP + (size_t)r * D) + c.lane; o[0] = (v4u){0u, 0u, 0u, 0u}; o[64] = (v4u){0u, 0u, 0u, 0u}; } }
    __syncthreads();
}
__device__ __forceinline__ void phase_moe_combine(const Ctx& c) {
    const GAS float* tg = (const GAS float*)(c.ws + WS_TOK + TOK_G); const GAS int* tpos = (const GAS int*)(c.ws + WS_TOK + TOK_POS); const GAS bf16* YP = (const GAS bf16*)(c.R + R_YP); GAS float* out = c.out();
    v2u a0n[4], a1n[4]; f32x4 xn_[4]; float g0n = 0.f, g1n = 0.f;
#define CB_LOAD(tok) do { g0n = tg[2 * (tok)]; g1n = tg[2 * (tok) + 1]; const int p0_ = tpos[2 * (tok)], p1_ = tpos[2 * (tok) + 1]; \
        const GAS v2u* y0_ = (const GAS v2u*)(YP + (size_t)p0_ * D) + c.lane; const GAS v2u* y1_ = (const GAS v2u*)(YP + (size_t)p1_ * D) + c.lane; const GAS f32x4* o_ = (const GAS f32x4*)(out + (size_t)(tok) * D) + c.lane; \
        _Pragma("unroll") for (int j = 0; j < 4; ++j) { a0n[j] = y0_[64 * j]; a1n[j] = y1_[64 * j]; xn_[j] = o_[64 * j]; } } while (0)
    if (c.gw < M) CB_LOAD(c.gw);
    for (int m = c.gw; m < M; m += c.ngw) {
        v2u a0[4], a1[4]; f32x4 x[4]; const float g0 = g0n, g1 = g1n;
#pragma unroll
        for (int j = 0; j < 4; ++j) { a0[j] = a0n[j]; a1[j] = a1n[j]; x[j] = xn_[j]; }
        if (m + c.ngw < M) CB_LOAD(m + c.ngw);
        GAS f32x4* o = (GAS f32x4*)(out + (size_t)m * D) + c.lane;
#pragma unroll
        for (int j = 0; j < 4; ++j) { f32x4 y = x[j];
            y.x += g0 * bflo(a0[j].x) + g1 * bflo(a1[j].x); y.y += g0 * bfhi(a0[j].x) + g1 * bfhi(a1[j].x); y.z += g0 * bflo(a0[j].y) + g1 * bflo(a1[j].y); y.w += g0 * bfhi(a0[j].y) + g1 * bfhi(a1[j].y); o[64 * j] = y; }
    }
#undef CB_LOAD
}

enum { PH_CONV = 0, PH_NORM1, PH_GEMM_IN, PH_RWKV_PREP, PH_MLA_PREP, PH_GMLP, PH_SCAN, PH_ATTN, PH_POST, PH_GEMM_OUT, PH_NORM2, PH_DGU, PH_DDOWN, PH_NORM2R, PH_COUNT, PH_SCATTER, PH_CONVE, PH_EGU, PH_EDOWN, PH_COMBINE, PH_CHUNK, PH_RWKV_OUT, PH_MLA_POST1, PH_MLA_PREP2, PH_EDOWNX, PH_GEMM_OUTN, PH_CONVB };
#ifndef PHASE_INLINE
#define PHASE_INLINE __forceinline__
#endif
template <int PH> __device__ PHASE_INLINE void do_phase(const Ctx& c, int l, int e) {
    bf16* XN = (bf16*)(c.ws + WS_XN); bf16* Zb = (bf16*)(c.R + R_Z); bf16* YC = (bf16*)(c.ws + WS_XN);
    GAS bf16* XNg = (GAS bf16*)(c.ws + WS_XN);
    if constexpr (PH == PH_CONV) phase_conv_static(c);
    if constexpr (PH == PH_CONVB) phase_conv_b(c);
    if constexpr (PH == PH_NORM1) phase_rmsnorm<false>(c, l == 0 ? c.in(I_X) : (const GAS float*)c.out(), c.in(I_MIXG) + l * D, XNg, nullptr);
    if constexpr (PH == PH_GEMM_IN) { pg8::Gemm g{XN, (const bf16*)(c.ws + WS_WIN) + (size_t)l * ZP * D, M, ZP, D, 0}; pg8::StaticOrder S; S.init(M, ZP, c.nb, c.bid); pg8::EpiBf16P E{Zb, ZP, ZP / 256, l == 1 ? (const float*)(c.R + R_SS1) : nullptr, 1.0f / D};
        pg8::gemm_phase<pg8::EpiBf16P, pg8::StaticOrder, true, true>(c.lds, g, S, E); }
#ifndef RWKV_NAIVE
#define RWKV_NAIVE 0
#endif
#ifndef RWKV_PREP_VALU
#define RWKV_PREP_VALU 0
#endif
#ifndef RWKV_PREP4
#define RWKV_PREP4 0
#endif
    if constexpr (PH == PH_RWKV_PREP) { if (RWKV_NAIVE) phase_rwkv_prep(c, l); else if (RWKV_PREP_VALU) phase_rwkv_prep2(c, l); else if (RWKV_PREP4) phase_rwkv_prep4(c, l); else phase_rwkv_prep3(c, l); }
    if constexpr (PH == PH_CHUNK) { if (!RWKV_NAIVE) phase_rwkv_chunk(c); }
    if constexpr (PH == PH_RWKV_OUT) { if (!RWKV_NAIVE) phase_rwkv_out(c, l); }
#ifndef MLA_NAIVE
#define MLA_NAIVE 0
#endif
    if constexpr (PH == PH_MLA_PREP) { if (MLA_NAIVE) phase_mla_prep(c, l); else {
        pg8::Gemm g{Zb + ZCQ, (const bf16*)(c.ws + WS_WSM + WSM_UQ) + (size_t)l * 768 * 256, M, 768, 256, ZP}; pg8::StaticOrder S; S.init(M, 768, c.nb, c.bid); pg8::EpiBf16P E{(bf16*)(c.R + R_QR), 768, 3, nullptr, 0.f};
        pg8::gemm_phase<pg8::EpiBf16P, pg8::StaticOrder, true, true>(c.lds, g, S, E); } }
    if constexpr (PH == PH_MLA_PREP2) { if (!MLA_NAIVE) {
        int k128 = 128; asm volatile("" : "+s"(k128));
        pg8::Gemm g{Zb + ZCKV, (const bf16*)(c.ws + WS_WSM + WSM_UKV) + (size_t)l * 768 * 128, M, 768, k128, ZP}; pg8::StaticOrder S; S.init(M, 768, c.nb, (c.bid + 192) % c.nb); pg8::EpiBf16P E{(bf16*)(c.R + R_KVR), 768, 3, nullptr, 0.f};
        pg8::gemm_phase<pg8::EpiBf16P, pg8::StaticOrder, true, true>(c.lds, g, S, E); } }
    #ifndef MLA_POST1_OLD
#define MLA_POST1_OLD 0
#endif
    if constexpr (PH == PH_MLA_POST1) { if (!MLA_NAIVE) { if (MLA_POST1_OLD) phase_mla_post1(c, l); else phase_mla_post1b(c, l); } }
#ifndef GMLP_NAIVE
#define GMLP_NAIVE 0
#endif
    if constexpr (PH == PH_GMLP) { if (GMLP_NAIVE) phase_gmlp(c, l); else phase_gmlp_mfma(c, l); }
    if constexpr (PH == PH_SCAN) { if (RWKV_NAIVE) phase_rwkv_scan_naive(c); else phase_rwkv_scan2(c); }
#ifndef ATTN_NAIVE
#define ATTN_NAIVE 0
#endif
#ifndef ATTN_ONE_TILE
#define ATTN_ONE_TILE 0
#endif
    if constexpr (PH == PH_ATTN) { if (ATTN_NAIVE) phase_attn_naive(c); else if (ATTN_ONE_TILE) phase_attn_mfma(c); else phase_attn_mfma2(c, l); }
    if constexpr (PH == PH_POST) { if (RWKV_NAIVE) phase_rwkv_post(c, l); phase_mla_post(c, l); }
    if constexpr (PH == PH_GEMM_OUT) { pg8::Gemm g{YC, (const bf16*)(c.ws + WS_WOUT) + (size_t)l * D * D, M, D, D, 0}; pg8::StaticOrder S; S.init(M, D, c.nb, c.bid); pg8::EpiResF32 E{l == 0 ? (const float*)c.in(I_X) : (const float*)c.out(), (float*)c.out(), D};
        pg8::gemm_phase<pg8::EpiResF32, pg8::StaticOrder, true, true>(c.lds, g, S, E); }
    if constexpr (PH == PH_NORM2) phase_rmsnorm<false>(c, c.out(), c.in(I_FFNG), XNg, nullptr);
    if constexpr (PH == PH_DGU) { pg8::Gemm g{(const bf16*)(c.R + R_XN2), (const bf16*)(c.ws + WS_WDGU), M, 2 * DFF, D, 0}; pg8::StaticOrder S; S.init(M, 2 * DFF, c.nb, c.bid); pg8::EpiSwiGLU E{(bf16*)(c.R + R_H), DFF, 2 * DFF / 256, (const float*)(c.R + R_SS0), 1.0f / D};
        pg8::gemm_phase<pg8::EpiSwiGLU, pg8::StaticOrder, true, true>(c.lds, g, S, E); }
    if constexpr (PH == PH_DDOWN) { pg8::Gemm g{(const bf16*)(c.R + R_H), (const bf16*)(c.ws + WS_WDD), M, D, DFF, 0}; pg8::StaticOrder S; S.init(M, D, c.nb, c.bid);
        pg8::EpiResF32N E{(const float*)c.out(), (float*)c.out(), D, XN, (const float*)(c.in(I_MIXG) + D), (float*)(c.R + R_SS1)};
        pg8::gemm_phase<pg8::EpiResF32N, pg8::StaticOrder, true, true>(c.lds, g, S, E); }
    if constexpr (PH == PH_GEMM_OUTN) { pg8::Gemm g{YC, (const bf16*)(c.ws + WS_WOUT), M, D, D, 0}; pg8::StaticOrder S; S.init(M, D, c.nb, c.bid);
        pg8::EpiResF32N E{(const float*)c.in(I_X), (float*)c.out(), D, (bf16*)(c.R + R_XN2), (const float*)c.in(I_FFNG), (float*)(c.R + R_SS0)};
        pg8::gemm_phase<pg8::EpiResF32N, pg8::StaticOrder, true, true>(c.lds, g, S, E); }
    if constexpr (PH == PH_NORM2R) { phase_rmsnorm<true>(c, c.out(), c.in(I_FFNG) + D, XNg, c.in(I_ROUTER)); __syncthreads(); phase_conv_experts(c); }
    if constexpr (PH == PH_COUNT) phase_moe_count(c);
    if constexpr (PH == PH_SCATTER) phase_moe_scatter(c);
    if constexpr (PH == PH_EGU || PH == PH_EDOWN || PH == PH_EDOWNX) {
        const int* tile = (const int*)(c.ws + WS_TOK + TOK_TILE); LAS int* te = (LAS int*)(c.lds + RING_BYTES + 8192);
        const int T = __builtin_amdgcn_readfirstlane(tile[16]);
        __syncthreads();
        if (c.tid < 2 * M / 256 + NE) te[c.tid] = tile[32 + c.tid];
        __syncthreads();
        const int nx = T - 2 * HMAIN, ndx = nx * (D / 256) < c.nb / 2 ? nx * (D / 256) : 0;
        if constexpr (PH == PH_EGU) {
            const int t0 = e ? HMAIN : 0, n1 = e ? 0 : nx;
            pg8::Gemm g{(const bf16*)(c.R + R_XNP), (const bf16*)(c.R + R_WMGU), M2MAX, NE * 2 * DFE, D, 0};
            pg8::MoeOrder<true> S{te, t0, HMAIN, 0, 2 * HMAIN, n1, HMAIN, 2 * DFE / 256, c.nb, c.bid, e ? ndx : 0, 4};
            pg8::EpiSwiGLU E{(bf16*)(c.R + R_HME), DFE, 2 * DFE / 256, nullptr, 0.f};
            pg8::gemm_phase<pg8::EpiSwiGLU, pg8::MoeOrder<true>, true, true>(c.lds, g, S, E);
        } else {
            const bool xtra = PH == PH_EDOWNX;
            if (!xtra || ndx > 0) {
            pg8::Gemm g{(const bf16*)(c.R + R_HME), (const bf16*)(c.R + R_WMD), HCAP * 256, NE * D, DFE, 0};
            pg8::MoeOrder<false> S{te, xtra ? 2 * HMAIN : (e ? HMAIN : 0), xtra ? nx : HMAIN, xtra ? HMAIN : 0, 2 * HMAIN, (!xtra && !e && ndx == 0) ? nx : 0, HMAIN, D / 256, c.nb, c.bid, 0, 0};
            pg8::EpiBf16P E{(bf16*)(c.R + R_YP), D, D / 256, nullptr, 0.f};
            pg8::gemm_phase<pg8::EpiBf16P, pg8::MoeOrder<false>, true, true>(c.lds, g, S, E); }
        }
    }
    if constexpr (PH == PH_COMBINE) phase_moe_combine(c);
}


__device__ __forceinline__ void make_ctx(Ctx& c, LAS unsigned char* lds, int wave_s) {
    (void)wave_s; int tid = threadIdx.x; asm volatile("" : "+v"(tid));
    int bid = blockIdx.x, nb = gridDim.x; asm volatile("" : "+s"(bid)); asm volatile("" : "+s"(nb));
    c.lds = lds; c.tid = tid; c.lane = tid & 63; c.wave = __builtin_amdgcn_readfirstlane(tid >> 6); c.bid = bid; c.nb = nb;
    c.gw = c.bid * NWAVES + c.wave; c.ngw = c.nb * NWAVES; c.ws = (GAS unsigned char*)c.ptr_(40); c.R = c.ws + WS_R;
}
__device__ __forceinline__ void kernel_prologue(const Args& args, LAS unsigned char* lds) {
    for (int u = threadIdx.x; u < (LDS_BYTES - RING_BYTES) / 4; u += NTHR) ((LAS unsigned*)(lds + RING_BYTES))[u] = 0u;
    __syncthreads();
    if (threadIdx.x < 82) ((LAS unsigned*)(lds + ARGS_OFF))[threadIdx.x] = ((const unsigned*)&args)[threadIdx.x];
    __syncthreads();
}
template <int PH> __device__ __forceinline__ void run_phase(LAS unsigned char* lds, int l, int e, int wave_s) {
    asm volatile("" : "+s"(l)); asm volatile("" : "+s"(e)); asm volatile("" : "+s"(wave_s));
    Ctx c; make_ctx(c, lds, wave_s);
    do_phase<PH>(c, l, e);
}
#if !MK_ONE_LAUNCH
template <int PH> __global__ void __launch_bounds__(NTHR, 2) k_ph(Args args, int l, int e) {
    extern __shared__ __attribute__((aligned(16))) unsigned char lds_raw[];
    kernel_prologue(args, (LAS unsigned char*)lds_raw);
    run_phase<PH>((LAS unsigned char*)lds_raw, l, e, __builtin_amdgcn_readfirstlane(threadIdx.x >> 6));
}
#else
__global__ void __launch_bounds__(NTHR, 2) k_mega(Args args) {
    extern __shared__ __attribute__((aligned(16))) unsigned char lds_raw[];
    LAS unsigned char* lds = (LAS unsigned char*)lds_raw;
    kernel_prologue(args, lds);
    volatile LAS unsigned* MISC = (volatile LAS unsigned*)(lds + MISC_OFF);
    (void)xcd_barrier_post((unsigned*)(args.ws + WS_CTL) + CW_BAR, MISC + 8);
    int wave_s = __builtin_amdgcn_readfirstlane(threadIdx.x >> 6);
#define GRIDBAR() do { Ctx cb_; cb_.lds = lds; XcdBarrier b_; b_.bar = (unsigned*)((unsigned char*)cb_.ptr_(40) + WS_CTL) + CW_BAR; b_.x = xb_xcc_id(); b_.st = (volatile LAS unsigned*)(lds + MISC_OFF) + 8; xcd_barrier(b_); } while (0)
#define PHASE(PH, l, e) do { run_phase<PH>(lds, l, e, wave_s); GRIDBAR(); } while (0)
#define MIXER_CORE(l) do { run_phase<PH_GEMM_IN>(lds, l, 0, wave_s); if ((l) == 0) run_phase<PH_CONVB>(lds, 0, 0, wave_s); GRIDBAR(); \
        run_phase<PH_RWKV_PREP>(lds, l, 0, wave_s); run_phase<PH_MLA_PREP>(lds, l, 0, wave_s); run_phase<PH_MLA_PREP2>(lds, l, 0, wave_s); PHASE(PH_GMLP, l, 0); \
        run_phase<PH_MLA_POST1>(lds, l, 0, wave_s); PHASE(PH_CHUNK, l, 0); \
        run_phase<PH_SCAN>(lds, l, 0, wave_s); PHASE(PH_ATTN, l, 0); \
        run_phase<PH_RWKV_OUT>(lds, l, 0, wave_s); PHASE(PH_POST, l, 0); } while (0)
    run_phase<PH_CONV>(lds, 0, 0, wave_s); PHASE(PH_NORM1, 0, 0);
    MIXER_CORE(0);
    PHASE(PH_GEMM_OUTN, 0, 0);
    PHASE(PH_DGU, 0, 0); PHASE(PH_DDOWN, 0, 0);
    MIXER_CORE(1);
    PHASE(PH_GEMM_OUT, 1, 0);
    PHASE(PH_NORM2R, 1, 0); PHASE(PH_SCATTER, 1, 0);
    PHASE(PH_EGU, 1, 0); PHASE(PH_EDOWN, 1, 0); run_phase<PH_EDOWNX>(lds, 1, 0, wave_s); PHASE(PH_EGU, 1, 1); PHASE(PH_EDOWN, 1, 1);
    run_phase<PH_COMBINE>(lds, 1, 0, wave_s);
#undef MIXER_CORE
#undef PHASE
#undef GRIDBAR
}
#endif

#if !MK_ONE_LAUNCH
template <int PH> static void launch_ph(const Args& a, int l, int e, int grid, hipStream_t stream) {
    static bool attr = false;
    if (!attr) { (void)hipFuncSetAttribute((const void*)k_ph<PH>, hipFuncAttributeMaxDynamicSharedMemorySize, LDS_BYTES); attr = true; }
    hipLaunchKernelGGL(k_ph<PH>, dim3(grid), dim3(NTHR), LDS_BYTES, stream, a, l, e);
}
#endif
extern "C" void kernel_launch(void* const* d_in, const int* in_sizes, int n_in, void* d_out, int out_size, void* d_ws, size_t ws_size, hipStream_t stream) {
    static int grid = 0;
    if (grid == 0) {
        if (n_in != 39 || out_size != M * D || ws_size < WS_END) { fprintf(stderr, "kernel_launch: unexpected shapes (n_in %d, out %d, ws %zu < %zu)\n", n_in, out_size, ws_size, (size_t)WS_END); grid = -1; return; }
        int dev = 0, cus = 0;
        if (hipGetDevice(&dev) != hipSuccess || hipDeviceGetAttribute(&cus, hipDeviceAttributeMultiprocessorCount, dev) != hipSuccess) { grid = -1; return; }
        grid = cus;
    }
    if (grid < 0) return;
    Args a{};
    for (int i = 0; i < 39; ++i) a.in[i] = (const float*)d_in[i];
    a.out = (float*)d_out; a.ws = (unsigned char*)d_ws; a.ph_lo = 0; a.ph_hi = 0;
#if MK_ONE_LAUNCH
    {
        static bool attr = false;
        if (!attr) { (void)hipFuncSetAttribute((const void*)k_mega, hipFuncAttributeMaxDynamicSharedMemorySize, LDS_BYTES); attr = true; }
        (void)hipMemsetAsync((char*)d_ws + WS_CTL, 0, CTL_ZERO_BYTES, stream);
        hipLaunchKernelGGL(k_mega, dim3(grid), dim3(NTHR), LDS_BYTES, stream, a);
        return;
    }
#else
    (void)hipMemsetAsync((char*)d_ws + WS_CTL, 0, CTL_ZERO_BYTES, stream);
    launch_ph<PH_CONV>(a, 0, 0, grid, stream); launch_ph<PH_NORM1>(a, 0, 0, grid, stream);
    for (int l = 0; l < 2; ++l) {
        launch_ph<PH_GEMM_IN>(a, l, 0, grid, stream); if (l == 0) launch_ph<PH_CONVB>(a, 0, 0, grid, stream);
        launch_ph<PH_RWKV_PREP>(a, l, 0, grid, stream); launch_ph<PH_MLA_PREP>(a, l, 0, grid, stream); launch_ph<PH_MLA_PREP2>(a, l, 0, grid, stream); launch_ph<PH_GMLP>(a, l, 0, grid, stream);
        launch_ph<PH_MLA_POST1>(a, l, 0, grid, stream); launch_ph<PH_CHUNK>(a, l, 0, grid, stream);
        launch_ph<PH_SCAN>(a, l, 0, grid, stream); launch_ph<PH_ATTN>(a, l, 0, grid, stream);
        launch_ph<PH_RWKV_OUT>(a, l, 0, grid, stream); launch_ph<PH_POST>(a, l, 0, grid, stream);
        if (l == 0) { launch_ph<PH_GEMM_OUTN>(a, 0, 0, grid, stream); launch_ph<PH_DGU>(a, 0, 0, grid, stream); launch_ph<PH_DDOWN>(a, 0, 0, grid, stream); }
        else { launch_ph<PH_GEMM_OUT>(a, 1, 0, grid, stream);
            launch_ph<PH_NORM2R>(a, 1, 0, grid, stream); launch_ph<PH_SCATTER>(a, 1, 0, grid, stream);
            launch_ph<PH_EGU>(a, 1, 0, grid, stream); launch_ph<PH_EDOWN>(a, 1, 0, grid, stream); launch_ph<PH_EDOWNX>(a, 1, 0, grid, stream);
            launch_ph<PH_EGU>(a, 1, 1, grid, stream); launch_ph<PH_EDOWN>(a, 1, 1, grid, stream);
            launch_ph<PH_COMBINE>(a, 1, 0, grid, stream); }
    }
#endif
}
```

```cpp
#include <hip/hip_runtime.h>
#include <cstdio>
#include <cstdint>
#include <cmath>
namespace pg8 {
#define PG8_LAS __attribute__((address_space(3)))
typedef unsigned short bf16_t;
typedef short bf16x8 __attribute__((ext_vector_type(8)));
typedef float f32x4 __attribute__((ext_vector_type(4)));
typedef unsigned u32x4 __attribute__((ext_vector_type(4)));
constexpr int BM = 256, BK = 64, HALF = 128, HTB = HALF * BK * 2  , STAGE_BYTES = 8 * HTB, NXCD = 8, WGM = 8;

__host__ __device__ __forceinline__ int lds_byte(int r, int c) { const int st = (r >> 4) * 2 + (c >> 5), rr = r & 15, cc = c & 31, ob = rr * 64 + cc * 2; return st * 1024 + (ob ^ (((ob >> 9) & 1) << 5)); }
__host__ __device__ __forceinline__ void stage_rc(int b, int& R, int& C) { const int st = b / 1024, sb = b % 1024, swz = sb ^ (((sb >> 9) & 1) << 5); R = (st >> 1) * 16 + swz / 64; C = (st & 1) * 32 + (swz % 64) / 2; }
__host__ __device__ __forceinline__ int perm32(int rho) { const int n = rho >> 4, i = rho & 15; return 8 * (i >> 2) + 4 * n + (i & 3); }

struct Unit { int pm, pn, po; };
struct Gemm { const bf16_t* A; const bf16_t* Bt; int M, N, K, lda; };

struct StaticOrder {
    int nM, nN, nwg, G, c;
    __host__ __device__ void init(int M, int N, int G_, int c_) { nM = M / BM; nN = N / BM; nwg = nM * nN; G = G_; c = c_; }
    __host__ __device__ bool next(int i, Unit& u) const {
        const long L = (long)i * G + c; if (L >= nwg) return false;
        int wgid = (int)L; { const int q = nwg / NXCD, r = nwg % NXCD, xcd = wgid % NXCD, off = wgid / NXCD; wgid = (xcd < r ? xcd * (q + 1) : r * (q + 1) + (xcd - r) * q) + off; }
        const int nig = WGM * nN, gid = wgid / nig, fm = gid * WGM, gsz = (nM - fm) < WGM ? (nM - fm) : WGM;
        u.pm = fm + ((wgid % nig) % gsz); u.pn = (wgid % nig) / gsz; u.po = u.pm; return true;
    }
    __device__ __forceinline__ void a_ready(const Unit&) const {}
    __device__ __forceinline__ void done(const Unit&) const {}
};

__device__ __forceinline__ unsigned cvt_pk_bf16(float lo, float hi) { unsigned r; asm volatile("v_cvt_pk_bf16_f32 %0, %1, %2" : "=v"(r) : "v"(lo), "v"(hi)); return r; }
typedef float f32x2 __attribute__((ext_vector_type(2)));
__device__ __forceinline__ f32x2 gelu_pk(f32x2 v) {
    const f32x2 av = __builtin_elementwise_abs(v), d = av * 0.2316418882f + 1.0f;
    f32x2 t; t.x = __builtin_amdgcn_rcpf(d.x); t.y = __builtin_amdgcn_rcpf(d.y);
    f32x2 q = t * 0.5307027145f + (-0.7265760135f); q = q * t + 0.7107068705f; q = q * t + (-0.142248368f); q = q * t + 0.127414796f; q = q * t;
    const f32x2 s = (v * v) * (-0.72134752044f);
    f32x2 e; e.x = __builtin_amdgcn_exp2f(s.x); e.y = __builtin_amdgcn_exp2f(s.y);
    const f32x2 m = v * (q * e), r = v - m;
    f32x2 o; o.x = v.x < 0.f ? m.x : r.x; o.y = v.y < 0.f ? m.y : r.y; return o;
}

template <int ACT  > struct EpiBf16 {
    static constexpr bool PERM = true, AFTER_DRAIN = false; static_assert(ACT == 0 || ACT == 1, "EpiBf16: ACT is 0 (none) or 1 (gelu_pk)");
    bf16_t* O; int ldc; const float* bias; int split_cols; size_t split_stride; float scale0;
    __device__ __forceinline__ void operator()(const f32x4 (&acc)[2][2][4][2], const Unit& u, int wr, int wc, int fr, int fq) const {
        const int row0 = u.po * BM + wr * 64 + fr; int colt = u.pn * BM; bf16_t* base = O;
        float sc = 1.f; if (split_cols) { const int t = colt / split_cols; base += (size_t)t * split_stride; colt -= t * split_cols; if (t == 0) sc = scale0; }
        const int col0 = colt + wc * 32 + 8 * fq, bcol0 = u.pn * BM + wc * 32 + 8 * fq;
        f32x4 bv[2][2];
#pragma unroll
        for (int bj = 0; bj < 2; ++bj)
#pragma unroll
            for (int n = 0; n < 2; ++n) bv[bj][n] = bias ? *(const f32x4*)(bias + bcol0 + bj * HALF + 4 * n) : (f32x4){0.f, 0.f, 0.f, 0.f};
#pragma unroll
        for (int ai = 0; ai < 2; ++ai)
#pragma unroll
            for (int m = 0; m < 4; ++m) { bf16_t* rowp = base + (size_t)(row0 + ai * HALF + m * 16) * ldc + col0;
#pragma unroll
                for (int bj = 0; bj < 2; ++bj) { f32x4 v0 = acc[ai][bj][m][0] + bv[bj][0], v1 = acc[ai][bj][m][1] + bv[bj][1];
                    if (ACT == 1) { f32x2 a = gelu_pk((f32x2){v0[0], v0[1]}), b = gelu_pk((f32x2){v0[2], v0[3]}), c = gelu_pk((f32x2){v1[0], v1[1]}), d = gelu_pk((f32x2){v1[2], v1[3]});
                        v0 = (f32x4){a.x, a.y, b.x, b.y}; v1 = (f32x4){c.x, c.y, d.x, d.y}; }
                    v0 = v0 * sc; v1 = v1 * sc; u32x4 w; w.x = cvt_pk_bf16(v0[0], v0[1]); w.y = cvt_pk_bf16(v0[2], v0[3]); w.z = cvt_pk_bf16(v1[0], v1[1]); w.w = cvt_pk_bf16(v1[2], v1[3]);
                    *(u32x4*)(rowp + bj * HALF) = w; } }
    }
};

struct EpiResF32 {
    static constexpr bool PERM = false, AFTER_DRAIN = false;
    const float* base; float* out; int ldc;
    __device__ __forceinline__ void operator()(const f32x4 (&acc)[2][2][4][2], const Unit& u, int wr, int wc, int fr, int fq) const {
        const int row0 = u.po * BM + wr * 64 + fr, col0 = u.pn * BM + wc * 32 + 4 * fq;
#pragma unroll
        for (int ai = 0; ai < 2; ++ai)
#pragma unroll
            for (int m = 0; m < 4; ++m) { const size_t off = (size_t)(row0 + ai * HALF + m * 16) * ldc + col0;
#pragma unroll
                for (int bj = 0; bj < 2; ++bj)
#pragma unroll
                    for (int n = 0; n < 2; ++n) { const f32x4 b = *(const f32x4*)(base + off + bj * HALF + n * 16); *(f32x4*)(out + off + bj * HALF + n * 16) = b + acc[ai][bj][m][n]; } }
    }
};
struct EpiResF32N {
    static constexpr bool PERM = false, AFTER_DRAIN = false;
    const float* base; float* out; int ldc; bf16_t* xn; const float* gain; float* ss;
    __device__ __forceinline__ void operator()(const f32x4 (&acc)[2][2][4][2], const Unit& u, int wr, int wc, int fr, int fq) const {
        const int row0 = u.po * BM + wr * 64 + fr, col0 = u.pn * BM + wc * 32 + 4 * fq;
        f32x4 gv[2][2];
#pragma unroll
        for (int bj = 0; bj < 2; ++bj)
#pragma unroll
            for (int n = 0; n < 2; ++n) gv[bj][n] = *(const f32x4*)(gain + col0 + bj * HALF + n * 16);
#pragma unroll
        for (int ai = 0; ai < 2; ++ai)
#pragma unroll
            for (int m = 0; m < 4; ++m) { const int row = row0 + ai * HALF + m * 16; const size_t off = (size_t)row * ldc + col0; float s = 0.f;
#pragma unroll
                for (int bj = 0; bj < 2; ++bj)
#pragma unroll
                    for (int n = 0; n < 2; ++n) { const f32x4 b = *(const f32x4*)(base + off + bj * HALF + n * 16); const f32x4 v = b + acc[ai][bj][m][n]; *(f32x4*)(out + off + bj * HALF + n * 16) = v;
                        s += (v[0] * v[0] + v[1] * v[1]) + (v[2] * v[2] + v[3] * v[3]); const f32x4 w = v * gv[bj][n];
                        typedef unsigned u32x2v __attribute__((ext_vector_type(2))); *(u32x2v*)(xn + off + bj * HALF + n * 16) = (u32x2v){cvt_pk_bf16(w[0], w[1]), cvt_pk_bf16(w[2], w[3])}; }
                s += __shfl_xor(s, 16); s += __shfl_xor(s, 32);
                if (fq == 0) ss[(size_t)row * 16 + u.pn * 4 + wc] = s; }
    }
};
__device__ __forceinline__ float row_rstd(const float* ss, int row, float inv_n, float eps) { if (!ss) return 1.0f;
    const f32x4* p = (const f32x4*)(ss + (size_t)row * 16); const f32x4 a = p[0], b = p[1], c = p[2], d = p[3];
    const float t = ((a[0] + a[1]) + (a[2] + a[3])) + ((b[0] + b[1]) + (b[2] + b[3])) + (((c[0] + c[1]) + (c[2] + c[3])) + ((d[0] + d[1]) + (d[2] + d[3])));
    return __builtin_amdgcn_rsqf(t * inv_n + eps); }
struct EpiBf16P {
    static constexpr bool PERM = true, AFTER_DRAIN = false;
    bf16_t* O; int ldc; int ntn; const float* ss; float inv_n;
    __device__ __forceinline__ void operator()(const f32x4 (&acc)[2][2][4][2], const Unit& u, int wr, int wc, int fr, int fq) const {
        const int row0 = u.po * BM + wr * 64 + fr, col0 = (u.pn % ntn) * BM + wc * 32 + 8 * fq;
#pragma unroll
        for (int ai = 0; ai < 2; ++ai)
#pragma unroll
            for (int m = 0; m < 4; ++m) { bf16_t* rowp = O + (size_t)(row0 + ai * HALF + m * 16) * ldc + col0; const float rs = row_rstd(ss, row0 + ai * HALF + m * 16, inv_n, 1e-6f);
#pragma unroll
                for (int bj = 0; bj < 2; ++bj) { const f32x4 v0 = acc[ai][bj][m][0] * rs, v1 = acc[ai][bj][m][1] * rs;
                    u32x4 w; w.x = cvt_pk_bf16(v0[0], v0[1]); w.y = cvt_pk_bf16(v0[2], v0[3]); w.z = cvt_pk_bf16(v1[0], v1[1]); w.w = cvt_pk_bf16(v1[2], v1[3]);
                    *(u32x4*)(rowp + bj * HALF) = w; } }
    }
};
__device__ __forceinline__ float silu_f(float x) { return x / (1.0f + __expf(-x)); }
struct EpiSwiGLU {
    static constexpr bool PERM = true, AFTER_DRAIN = false;
    bf16_t* H; int ldh; int ntn; const float* ss; float inv_n;
    __device__ __forceinline__ void operator()(const f32x4 (&acc)[2][2][4][2], const Unit& u, int wr, int wc, int fr, int fq) const {
        const int row0 = u.po * BM + wr * 64 + fr, col0 = (u.pn % ntn) * HALF + wc * 32 + 8 * fq;
#pragma unroll
        for (int ai = 0; ai < 2; ++ai)
#pragma unroll
            for (int m = 0; m < 4; ++m) { bf16_t* rowp = H + (size_t)(row0 + ai * HALF + m * 16) * ldh + col0;
                const float rs = row_rstd(ss, row0 + ai * HALF + m * 16, inv_n, 1e-6f);
                const f32x4 g0 = acc[ai][0][m][0] * rs, g1 = acc[ai][0][m][1] * rs, u0 = acc[ai][1][m][0] * rs, u1 = acc[ai][1][m][1] * rs;
                u32x4 w;
                w.x = cvt_pk_bf16(silu_f(g0[0]) * u0[0], silu_f(g0[1]) * u0[1]); w.y = cvt_pk_bf16(silu_f(g0[2]) * u0[2], silu_f(g0[3]) * u0[3]);
                w.z = cvt_pk_bf16(silu_f(g1[0]) * u1[0], silu_f(g1[1]) * u1[1]); w.w = cvt_pk_bf16(silu_f(g1[2]) * u1[2], silu_f(g1[3]) * u1[3]);
                *(u32x4*)rowp = w; }
    }
};
struct RangeOrder {
    int pm0, nM, pn0, nN, G, c;
    __device__ __forceinline__ bool next(int i, Unit& u) const { const int L = i * G + c; if (L >= nM * nN) return false; const int q = L / nM; u.pn = pn0 + q; u.pm = pm0 + (L - q * nM); u.po = u.pm; return true; }
    __device__ __forceinline__ void a_ready(const Unit&) const {}
    __device__ __forceinline__ void done(const Unit&) const {}
};

template <bool AROW> struct MoeOrder {
    const PG8_LAS int* te; int t0, n0, s0, t1, n1, s1, nN, G, c, nq, q;
    __device__ __forceinline__ bool next(int i, Unit& u) const { const int U = (n0 + n1) * nN; int L;
        if (c < nq) { if (i >= q) return false; L = c * q + i; } else L = nq * q + (c - nq) + i * (G - nq);
        if (L >= U) return false; const int ti = L / nN, pn = L - ti * nN;
        const int tile = ti < n0 ? t0 + ti : t1 + (ti - n0), slot = ti < n0 ? s0 + ti : s1 + (ti - n0); const int e = te[tile];
        u.pn = e * nN + pn; u.pm = AROW ? tile : slot; u.po = AROW ? slot : tile; return true; }
    __device__ __forceinline__ void a_ready(const Unit&) const {}
    __device__ __forceinline__ void done(const Unit&) const {}
};
template <class Epi, class Sched, bool ALIGN_EPI = false, bool SP2 = false>
__device__ __forceinline__ void gemm_phase(PG8_LAS unsigned char* lds, const Gemm g, const Sched& S, const Epi& E) {
    int tid_ = threadIdx.x; asm volatile("" : "+v"(tid_));
    const int tid = tid_, wid = __builtin_amdgcn_readfirstlane(tid >> 6), lane = tid & 63, wr = wid >> 2, wc = wid & 3, fr = lane & 15, fq = lane >> 4;
    const int K = g.K, nt = K / BK, lda = g.lda ? g.lda : K;
    unsigned voffA[2], voffB[2];
#pragma unroll
    for (int i = 0; i < 2; ++i) { int R, C; stage_rc(tid * 16 + i * 8192, R, C); const int Rb = Epi::PERM ? ((R & ~31) + perm32(R & 31)) : R;
        voffA[i] = (unsigned)(R * lda + C) * 2u; voffB[i] = (unsigned)(Rb * K + C) * 2u; }
    const size_t kstep = (size_t)(BK * 2);
    const size_t hstep = (size_t)HALF * K * 2, hstepA = (size_t)HALF * lda * 2;
    const size_t tstep = 2 * hstep, tstepA = 2 * hstepA;
    const unsigned ldsw = (unsigned)wid * 1024u;
    const int aoff = lds_byte(wr * 64 + fr, fq * 8), boff = lds_byte(wc * 32 + fr, fq * 8);
#define PG8_SA(b, h) (((b) * 2 + (h)) * HTB)
#define PG8_SB(b, h) ((4 + (b) * 2 + (h)) * HTB)
#define PG8_STAGE(bufoff, gbase, voff) do { _Pragma("unroll") for (int _i = 0; _i < 2; ++_i) \
        __builtin_amdgcn_global_load_lds((const unsigned*)((const char*)(gbase) + (voff)[_i]), (PG8_LAS unsigned*)(lds + (bufoff) + ldsw + _i * 8192), 16, 0, 0); } while (0)
#define PG8_LDA(dst, b, h) do { _Pragma("unroll") for (int m = 0; m < 4; ++m) _Pragma("unroll") for (int k = 0; k < 2; ++k) dst[m][k] = *(const PG8_LAS bf16x8*)(lds + PG8_SA(b, h) + aoff + m * 2048 + k * 1024); } while (0)
#define PG8_LDB(dst, b, h) do { _Pragma("unroll") for (int n = 0; n < 2; ++n) _Pragma("unroll") for (int k = 0; k < 2; ++k) dst[n][k] = *(const PG8_LAS bf16x8*)(lds + PG8_SB(b, h) + boff + n * 2048 + k * 1024); } while (0)
#define PG8_MMA(ai, bj, At, Bt) do { __builtin_amdgcn_s_setprio(1); _Pragma("unroll") for (int m = 0; m < 4; ++m) _Pragma("unroll") for (int n = 0; n < 2; ++n) _Pragma("unroll") for (int k = 0; k < 2; ++k) \
        acc[ai][bj][m][n] = __builtin_amdgcn_mfma_f32_16x16x32_bf16(Bt[n][k], At[m][k], acc[ai][bj][m][n], 0, 0, 0); __builtin_amdgcn_s_setprio(0); } while (0)
#define PG8_WAIT_V(n) asm volatile("s_waitcnt vmcnt(" #n ")" ::: "memory")
#define PG8_WAIT_L(n) asm volatile("s_waitcnt lgkmcnt(" #n ")" ::: "memory")
#define PG8_BAR __builtin_amdgcn_s_barrier()
#define PG8_SCHED __builtin_amdgcn_sched_barrier(0)
    Unit cur, nxt; int ui = 0;
    if (!S.next(0, cur)) return;
    f32x4 acc[2][2][4][2];
#pragma unroll
    for (int a = 0; a < 2; ++a)
#pragma unroll
        for (int b = 0; b < 2; ++b)
#pragma unroll
            for (int m = 0; m < 4; ++m)
#pragma unroll
                for (int n = 0; n < 2; ++n) acc[a][b][m][n] = (f32x4){0.f, 0.f, 0.f, 0.f};
    bf16x8 At[4][2], B0[2][2], B1[2][2];
    const char* cA = (const char*)g.A + (size_t)cur.pm * tstepA; const char* cB = (const char*)g.Bt + (size_t)cur.pn * tstep;
    S.a_ready(cur);
    if constexpr (SP2) {
        PG8_STAGE(PG8_SB(0, 0), cB, voffB); PG8_STAGE(PG8_SB(0, 1), cB + hstep, voffB); PG8_STAGE(PG8_SA(0, 0), cA, voffA); PG8_STAGE(PG8_SA(0, 1), cA + hstepA, voffA);
        if (wr == 1) PG8_BAR;
        PG8_WAIT_V(2); PG8_BAR;
        PG8_STAGE(PG8_SB(1, 0), cB + kstep, voffB); PG8_STAGE(PG8_SA(1, 0), cA + kstep, voffA); PG8_STAGE(PG8_SB(1, 1), cB + hstep + kstep, voffB);
        PG8_WAIT_V(6); PG8_BAR;
    } else {
        PG8_STAGE(PG8_SB(0, 0), cB, voffB); PG8_STAGE(PG8_SA(0, 0), cA, voffA); PG8_STAGE(PG8_SB(0, 1), cB + hstep, voffB); PG8_STAGE(PG8_SA(0, 1), cA + hstepA, voffA);
        if (wr == 1) PG8_BAR;
        PG8_WAIT_V(4); PG8_BAR;
        PG8_STAGE(PG8_SB(1, 0), cB + kstep, voffB); PG8_STAGE(PG8_SA(1, 0), cA + kstep, voffA); PG8_STAGE(PG8_SB(1, 1), cB + hstep + kstep, voffB);
        PG8_WAIT_V(6); PG8_BAR;
    }
    for (;;) {
        const bool has_next = S.next(ui + 1, nxt);
        const char* nA = has_next ? (const char*)g.A + (size_t)nxt.pm * tstepA : cA; const char* nB = has_next ? (const char*)g.Bt + (size_t)nxt.pn * tstep : cB;
        for (int t = 0; t < nt; t += 2) {
            const bool last = (t == nt - 2);
            const char* a1 = cA + (size_t)(t + 1) * kstep;
            const char* a2 = last ? nA : cA + (size_t)(t + 2) * kstep; const char* b2 = last ? nB : cB + (size_t)(t + 2) * kstep;
            const char* a3 = a2 + kstep; const char* b3 = b2 + kstep;
            if (last && has_next) S.a_ready(nxt);
            if constexpr (SP2) {
            PG8_LDB(B0, 0, 0); PG8_LDB(B1, 0, 1); PG8_SCHED; PG8_LDA(At, 0, 0); PG8_STAGE(PG8_SA(1, 1), a1 + hstepA, voffA);
            PG8_WAIT_V(8); PG8_WAIT_L(0); PG8_BAR; PG8_MMA(0, 0, At, B0); PG8_MMA(0, 1, At, B1); PG8_BAR; PG8_SCHED;
            PG8_LDA(At, 0, 1); PG8_STAGE(PG8_SB(0, 0), b2, voffB); PG8_STAGE(PG8_SB(0, 1), b2 + hstep, voffB); PG8_STAGE(PG8_SA(0, 0), a2, voffA);
            PG8_WAIT_V(8); PG8_WAIT_L(0); PG8_BAR; PG8_MMA(1, 0, At, B0); PG8_MMA(1, 1, At, B1); PG8_BAR; PG8_SCHED;
            PG8_LDB(B0, 1, 0); PG8_LDB(B1, 1, 1); PG8_SCHED; PG8_LDA(At, 1, 0); PG8_STAGE(PG8_SA(0, 1), a2 + hstepA, voffA);
            PG8_WAIT_V(8); PG8_WAIT_L(0); PG8_BAR; PG8_MMA(0, 0, At, B0); PG8_MMA(0, 1, At, B1); PG8_BAR; PG8_SCHED;
            PG8_LDA(At, 1, 1); PG8_STAGE(PG8_SB(1, 0), b3, voffB); PG8_STAGE(PG8_SB(1, 1), b3 + hstep, voffB); PG8_STAGE(PG8_SA(1, 0), a3, voffA);
            PG8_WAIT_V(8); PG8_WAIT_L(0); PG8_BAR; PG8_MMA(1, 0, At, B0); PG8_MMA(1, 1, At, B1); PG8_BAR; PG8_SCHED;
            } else {
            PG8_LDB(B0, 0, 0); PG8_SCHED; PG8_LDA(At, 0, 0); PG8_STAGE(PG8_SA(1, 1), a1 + hstepA, voffA);
            PG8_WAIT_L(8); PG8_BAR; PG8_WAIT_L(0); PG8_MMA(0, 0, At, B0); PG8_BAR; PG8_SCHED;
            PG8_LDB(B1, 0, 1); PG8_STAGE(PG8_SB(0, 0), b2, voffB);
            PG8_BAR; PG8_WAIT_L(0); PG8_MMA(0, 1, At, B1); PG8_BAR;
            PG8_LDA(At, 0, 1); PG8_STAGE(PG8_SA(0, 0), a2, voffA);
            PG8_BAR; PG8_WAIT_L(0); PG8_MMA(1, 0, At, B0); PG8_BAR; PG8_SCHED;
            PG8_STAGE(PG8_SB(0, 1), b2 + hstep, voffB);
            PG8_WAIT_V(6); PG8_BAR; PG8_MMA(1, 1, At, B1); PG8_BAR;
            PG8_LDB(B0, 1, 0); PG8_SCHED; PG8_LDA(At, 1, 0); PG8_STAGE(PG8_SA(0, 1), a2 + hstepA, voffA);
            PG8_WAIT_L(8); PG8_BAR; PG8_WAIT_L(0); PG8_MMA(0, 0, At, B0); PG8_BAR; PG8_SCHED;
            PG8_LDB(B1, 1, 1); PG8_STAGE(PG8_SB(1, 0), b3, voffB);
            PG8_BAR; PG8_WAIT_L(0); PG8_MMA(0, 1, At, B1); PG8_BAR;
            PG8_LDA(At, 1, 1); PG8_STAGE(PG8_SA(1, 0), a3, voffA);
            PG8_BAR; PG8_WAIT_L(0); PG8_MMA(1, 0, At, B0); PG8_BAR; PG8_SCHED;
            PG8_STAGE(PG8_SB(1, 1), b3 + hstep, voffB);
            PG8_WAIT_V(6); PG8_BAR; PG8_MMA(1, 1, At, B1); PG8_BAR;
            }
        }
        if constexpr (ALIGN_EPI) { if (wr == 0) PG8_BAR; }
        if constexpr (!Epi::AFTER_DRAIN) { E(acc, cur, wr, wc, fr, fq); S.done(cur); }
        if (!has_next) break;
#pragma unroll
        for (int a = 0; a < 2; ++a)
#pragma unroll
            for (int b = 0; b < 2; ++b)
#pragma unroll
                for (int m = 0; m < 4; ++m)
#pragma unroll
                    for (int n = 0; n < 2; ++n) acc[a][b][m][n] = (f32x4){0.f, 0.f, 0.f, 0.f};
        cur = nxt; cA = nA; cB = nB; ++ui;
        if constexpr (ALIGN_EPI) { if (wr == 1) PG8_BAR; }
    }
    PG8_WAIT_V(0);
    if constexpr (!ALIGN_EPI) { if (wr == 0) PG8_BAR; }
    PG8_BAR;
    if constexpr (Epi::AFTER_DRAIN) { E.fused(acc, cur, wr, wc, fr, fq, lds, wid, lane); S.done(cur); }
#undef PG8_SA
#undef PG8_SB
#undef PG8_STAGE
#undef PG8_LDA
#undef PG8_LDB
#undef PG8_MMA
#undef PG8_WAIT_V
#undef PG8_WAIT_L
#undef PG8_BAR
#undef PG8_SCHED
}
}

#define PROBE_KS 4
#define PROBE_YL 1.f
#define PROBE_NO_VP 0
#ifndef PROBE_REP
#define PROBE_REP 1
#endif
#ifndef MK_ONE_LAUNCH
#define MK_ONE_LAUNCH 1
#endif
constexpr int NWAVES = 8, NTHR = 512;
constexpr int BATCH = 2, SEQ = 8192, M = BATCH * SEQ, D = 1024;
constexpr int AH = 6, AW = 384;
constexpr int ZP = 2304;
constexpr int ZR = 0, ZK = 384, ZV = 768, ZWD = 1152, ZAD = 1184, ZGD = 1216, ZU = 1280, ZCV = 1536, ZCQ = 1792, ZCKV = 2048, ZKR = 2176;
constexpr int DFF = 2816, DFE = 3584, NE = 8;
constexpr int QKD = 96, QP = 576;
constexpr float EPS = 1e-6f;
constexpr int M2MAX = 2 * M + NE * 256;

constexpr size_t MiB = 1u << 20;
constexpr size_t WS_CTL = 0, CTL_ZERO_BYTES = 1 * MiB;
constexpr size_t WS_WIN = 1 * MiB, WS_WOUT = 10 * MiB, WS_WDGU = 14 * MiB, WS_WDD = 25 * MiB;
constexpr size_t WS_WSM = 31 * MiB;
constexpr size_t WS_XN = 33 * MiB, WS_VF = 65 * MiB, WS_TOK = 77 * MiB, WS_R = 79 * MiB;
constexpr size_t WSM_UQ = 0, WSM_UKV = WSM_UQ + 2 * 768 * 256 * 2, WSM_GW = WSM_UKV + 2 * 768 * 128 * 2, WSM_LW = WSM_GW + 2 * 4 * 128 * 128 * 2, WSM_LA = WSM_LW + 2 * AW * 32 * 2, WSM_LG = WSM_LA + 2 * AW * 32 * 2, WSM_VD = WSM_LG + 2 * AW * 64 * 2, WSM_END = WSM_VD + 16 * AW * 2;
constexpr size_t R_Z = 0, R_NAT = 72 * MiB, R_TR = 120 * MiB, R_QR = 168 * MiB, R_KVR = 192 * MiB, R_VG = 216 * MiB, R_BON = 240 * MiB, R_WL = 240 * MiB + 512 * 1024, R_NT = 241 * MiB, R_YL = 265 * MiB;
constexpr size_t R_Q = 289 * MiB, R_K = 307 * MiB, R_V = 325 * MiB;
constexpr size_t R_CHM = 0, R_CHR = 12 * MiB, R_CHS = 24 * MiB, R_OATT = 36 * MiB;
constexpr size_t R_RW = R_NAT, R_LW = R_NT, R_YRAW = R_YL;
constexpr int NCHUNK = BATCH * AH * (SEQ / 64);
constexpr size_t BLK = 4096;
constexpr size_t R_H = 0;
constexpr size_t R_XN2 = 100 * MiB;
constexpr size_t R_WMD = 0, R_WMGU = 72 * MiB;
constexpr size_t R_XNP = 184 * MiB, R_YP = R_XNP, R_HME = 252 * MiB;
constexpr int HMAIN = 64, HCAP = 71;
constexpr size_t WS_END = WS_R + 377 * MiB;
constexpr size_t RWSZ = (size_t)M * AW;
constexpr size_t TOK_E = 0, TOK_G = (size_t)M * 2 * 4, TOK_POS = (size_t)M * 4 * 4, TOK_SEG = (size_t)M * 6 * 4, TOK_TILE = TOK_SEG + 256 * 8 * 4;
constexpr int NSEG = 256, SEGT = M / NSEG;

constexpr int CW_BAR = 4096;
constexpr int CW_CQ = 40000;
constexpr size_t R_SS0 = 140 * MiB, R_SS1 = 120 * MiB;
constexpr int LDS_BYTES = 147456, RING_BYTES = 131072, MISC_OFF = RING_BYTES + 320;

#define GAS __attribute__((address_space(1)))
#define LAS __attribute__((address_space(3)))
typedef unsigned short bf16;
typedef unsigned v4u __attribute__((ext_vector_type(4)));
typedef unsigned v2u __attribute__((ext_vector_type(2)));
typedef float f32x4 __attribute__((ext_vector_type(4)));
typedef float f32x2 __attribute__((ext_vector_type(2)));
#define LDS_WAIT() asm volatile("s_waitcnt lgkmcnt(0)" ::: "memory")
#define VM_WAIT() asm volatile("s_waitcnt vmcnt(0)" ::: "memory")
typedef __bf16 bf16x2_hw __attribute__((ext_vector_type(2)));
__device__ __forceinline__ unsigned pk2(float lo, float hi) { const f32x2 v = {lo, hi}; return __builtin_bit_cast(unsigned, __builtin_convertvector(v, bf16x2_hw)); }
__device__ __forceinline__ unsigned f2bf(float f) { return pk2(f, 0.f) & 0xffffu; }
__device__ __forceinline__ float bf2f(bf16 b) { return __builtin_bit_cast(float, (unsigned)b << 16); }
__device__ __forceinline__ float bflo(unsigned w) { return __builtin_bit_cast(float, w << 16); }
__device__ __forceinline__ float bfhi(unsigned w) { return __builtin_bit_cast(float, w & 0xffff0000u); }
template <int CTRL> __device__ __forceinline__ float dpp_mov(float v) { return __builtin_bit_cast(float, __builtin_amdgcn_update_dpp(0, __builtin_bit_cast(int, v), CTRL, 0xf, 0xf, false)); }
__device__ __forceinline__ float wave_sum(float v) {
    v += dpp_mov<0xB1>(v);
    v += dpp_mov<0x4E>(v);
    v += dpp_mov<0x124>(v);
    v += dpp_mov<0x128>(v);
    const int vi = __builtin_bit_cast(int, v);
    const float r0 = __builtin_bit_cast(float, __builtin_amdgcn_readlane(vi, 0)), r1 = __builtin_bit_cast(float, __builtin_amdgcn_readlane(vi, 16));
    const float r2 = __builtin_bit_cast(float, __builtin_amdgcn_readlane(vi, 32)), r3 = __builtin_bit_cast(float, __builtin_amdgcn_readlane(vi, 48));
    return (r0 + r1) + (r2 + r3);
}
__device__ __forceinline__ float row16_sum(float v) {
    v += dpp_mov<0xB1>(v); v += dpp_mov<0x4E>(v); v += dpp_mov<0x124>(v); v += dpp_mov<0x128>(v); return v; }
__device__ __forceinline__ float sigmoid_f(float x) { return 1.0f / (1.0f + __expf(-x)); }
__device__ __forceinline__ float sigmoid_fast(float x) { return __builtin_amdgcn_rcpf(1.0f + __expf(-x)); }
__device__ __forceinline__ unsigned short f2bf_hw(float x) { typedef __bf16 bfx2 __attribute__((ext_vector_type(2))); const f32x2 v = {x, 0.f}; return (unsigned short)(__builtin_bit_cast(unsigned, __builtin_convertvector(v, bfx2)) & 0xffffu); }
__device__ __forceinline__ float gelu_erf(float x) { return 0.5f * x * (1.0f + erff(x * 0.70710678118654752f)); }

#define XB_TMO      128
#define XB_XCNT(j)  (256  + 64 * (j))
#define XB_XSUB(j)  (1280 + 64 * (j))
#define XB_XGEN(j)  (2304 + 64 * (j))
#define XB_TOP      3328
#define XB_TOPGEN   3392
#define XCD_BAR_WORDS 3456
#define XB_SPIN_CAP (1u << 18)

__device__ __forceinline__ unsigned xb_ld(unsigned* p)              { return __hip_atomic_load(p, __ATOMIC_RELAXED, __HIP_MEMORY_SCOPE_AGENT); }
__device__ __forceinline__ unsigned xb_add(unsigned* p, unsigned v) { return __hip_atomic_fetch_add(p, v, __ATOMIC_RELAXED, __HIP_MEMORY_SCOPE_AGENT); }
__device__ __forceinline__ unsigned xb_xcc_id() { return (unsigned)__builtin_amdgcn_s_getreg((3 << 11) | 20) & 0xFu; }
#define XB_SPIN(cond, bar) do { unsigned _sp = 0; while (cond) { __builtin_amdgcn_s_sleep(1); \
    if ((++_sp & 255u) == 0u) { if (xb_ld(&(bar)[XB_TMO])) break; if (_sp > XB_SPIN_CAP) { atomicAdd(&(bar)[XB_TMO], 1u); break; } } } } while (0)

struct XcdBarrier {
    unsigned* bar; unsigned x;
    volatile LAS unsigned* st;
};

__device__ __forceinline__ XcdBarrier xcd_barrier_post(unsigned* bar, volatile LAS unsigned* st) {
    XcdBarrier b; b.bar = bar; b.x = xb_xcc_id(); b.st = st;
    if (threadIdx.x == 0) (void)xb_add(&bar[XB_XCNT(b.x)], 1u);
    return b;
}
__device__ __forceinline__ void xcd_barrier_complete(unsigned* bar, unsigned x, unsigned& nloc, unsigned& nx) {
    const unsigned G = gridDim.x * gridDim.y * gridDim.z;
    unsigned sum, cnt, mine, sp = 0u;
    for (;;) {
        sum = 0u; cnt = 0u; mine = 0u;
#pragma unroll
        for (unsigned j = 0; j < 16; ++j) { const unsigned c = xb_ld(&bar[XB_XCNT(j)]); sum += c; cnt += (c > 0u) ? 1u : 0u; mine = (j == x) ? c : mine; }
        if (sum == G) break;
        __builtin_amdgcn_s_sleep(1);
        if ((++sp & 255u) == 0u) { if (xb_ld(&bar[XB_TMO])) break; if (sp > XB_SPIN_CAP) { atomicAdd(&bar[XB_TMO], 1u); break; } }
    }
    nloc = mine > 0u ? mine : 1u; nx = cnt > 0u ? cnt : 1u;
}

__device__ __forceinline__ void xcd_barrier(const XcdBarrier& b) {
    asm volatile("s_waitcnt vmcnt(0)" ::: "memory");
    __syncthreads();
    if (threadIdx.x == 0) {
        unsigned* bar = b.bar;
        __builtin_amdgcn_s_waitcnt(0);
        unsigned nloc = b.st[0], nx = b.st[1];
        if (nloc == 0u) { xcd_barrier_complete(bar, b.x, nloc, nx); b.st[0] = nloc; b.st[1] = nx; }
        const unsigned old = xb_add(&bar[XB_XSUB(b.x)], 1u);
        const unsigned gen = old / nloc;
        if (old + 1u == (gen + 1u) * nloc) {
            __builtin_amdgcn_fence(__ATOMIC_RELEASE, "agent");
            asm volatile("s_waitcnt vmcnt(0)" ::: "memory");
            const unsigned og = xb_add(&bar[XB_TOP], 1u);
            const unsigned tg = og / nx;
            if (og + 1u == (tg + 1u) * nx) xb_add(&bar[XB_TOPGEN], 1u);
            else XB_SPIN(xb_ld(&bar[XB_TOPGEN]) == tg, bar);
            __builtin_amdgcn_fence(__ATOMIC_ACQUIRE, "agent");
            xb_add(&bar[XB_XGEN(b.x)], 1u);
            asm volatile("s_waitcnt vmcnt(0)" ::: "memory");
        } else {
            XB_SPIN(xb_ld(&bar[XB_XGEN(b.x)]) == gen, bar);
            __builtin_amdgcn_fence(__ATOMIC_ACQUIRE, "agent");
            asm volatile("s_waitcnt vmcnt(0)" ::: "memory");
        }
    }
    __syncthreads();
}


struct Args { const float* in[39]; float* out; unsigned char* ws; int ph_lo, ph_hi; };
enum { I_X = 0, I_POS, I_MIXG, I_WIN, I_MU, I_W0, I_WUP, I_A0, I_AUP, I_GUP, I_KK, I_KA, I_RK, I_LNG, I_LNB, I_V0, I_VDN, I_VUP,
       I_QNG, I_WUQ, I_KVNG, I_WUKV, I_QHG, I_KHG, I_BOG, I_CLNG, I_CLNB, I_CWS, I_CBS, I_COG, I_WOUT, I_FFNG, I_DWG, I_DWU, I_DWD, I_ROUTER, I_MWG, I_MWU, I_MWD };

constexpr int ARGS_OFF = RING_BYTES + 4096;
struct Ctx {
    LAS unsigned char* lds; int tid, lane, wave, bid, nb, gw, ngw;
    GAS unsigned char* ws; GAS unsigned char* R;
    __device__ __forceinline__ unsigned long long ptr_(int k) const { unsigned off = ARGS_OFF + 8 * k; asm volatile("" : "+v"(off));
        const volatile LAS unsigned* p = (const volatile LAS unsigned*)(lds + off);
        const unsigned lo = __builtin_amdgcn_readfirstlane(p[0]), hi = __builtin_amdgcn_readfirstlane(p[1]); return ((unsigned long long)hi << 32) | lo; }
    __device__ __forceinline__ const GAS float* in(int k) const { return (const GAS float*)ptr_(k); }
    __device__ __forceinline__ GAS float* out() const { return (GAS float*)ptr_(39); }
};

__device__ __forceinline__ void conv_item(const GAS float* W, int K, int N, GAS bf16* WT, int n0, int drow0, int k0, LAS float* scr, int lane, const GAS float* gk = nullptr) {
#pragma unroll 8
    for (int i = 0; i < 32; ++i) { const int kk = 2 * i + (lane >> 5); scr[kk * 33 + (lane & 31)] = W[(size_t)(k0 + kk) * N + n0 + (lane & 31)] * (gk ? gk[k0 + kk] : 1.0f); }
    LDS_WAIT(); asm volatile("" ::: "memory");
    const int c = lane & 7;
#pragma unroll
    for (int j = 0; j < 4; ++j) { const int n = (lane >> 3) + 8 * j; const LAS float* s = scr + (8 * c) * 33 + n;
        v4u o; o.x = pk2(s[0 * 33], s[1 * 33]); o.y = pk2(s[2 * 33], s[3 * 33]); o.z = pk2(s[4 * 33], s[5 * 33]); o.w = pk2(s[6 * 33], s[7 * 33]);
        *(GAS v4u*)(WT + (size_t)(drow0 + n) * K + k0 + 8 * c) = o; }
    LDS_WAIT(); asm volatile("" ::: "memory");
}
template <int MAP> __device__ __forceinline__ int conv_row(int n0) {
    if (MAP == 1) return n0 < 1280 ? n0 : (n0 < 1696 ? n0 - 1280 + ZCQ : n0 - 1696 + ZU);
    if (MAP == 2) return (n0 >> 7) * 256 + (n0 & 127);
    if (MAP == 3) return (n0 >> 7) * 256 + 128 + (n0 & 127);
    if (MAP == 4) return (n0 / QKD) * 128 + (n0 % QKD);
    return n0;
}
struct CJ { const GAS float* W; GAS bf16* WT; const GAS float* gk; int K, N, n0, drow0, k0; };
__device__ __forceinline__ void conv_load(const CJ& j, float (&r)[32], int lane) {
#pragma unroll
    for (int i = 0; i < 32; ++i) r[i] = __builtin_nontemporal_load(j.W + (size_t)(j.k0 + 2 * i + (lane >> 5)) * j.N + j.n0 + (lane & 31));
}
__device__ __forceinline__ void conv_finish(const CJ& j, const float (&r)[32], LAS float* scr, int lane) {
#pragma unroll
    for (int i = 0; i < 32; ++i) { const int kk = 2 * i + (lane >> 5); scr[kk * 33 + (lane & 31)] = r[i] * (j.gk ? j.gk[j.k0 + kk] : 1.0f); }
    LDS_WAIT(); asm volatile("" ::: "memory");
    const int cq = lane & 7;
#pragma unroll
    for (int q = 0; q < 4; ++q) { const int n = (lane >> 3) + 8 * q; const LAS float* p = scr + (8 * cq) * 33 + n;
        v4u o; o.x = pk2(p[0 * 33], p[1 * 33]); o.y = pk2(p[2 * 33], p[3 * 33]); o.z = pk2(p[4 * 33], p[5 * 33]); o.w = pk2(p[6 * 33], p[7 * 33]);
        *(GAS v4u*)(j.WT + (size_t)(j.drow0 + n) * j.K + j.k0 + 8 * cq) = o; }
    LDS_WAIT(); asm volatile("" ::: "memory");
}
template <class JobFn> __device__ __forceinline__ void conv_run(const Ctx& c, int total, const JobFn& job, int gw, int ngw) {
    LAS float* scr = (LAS float*)(c.lds + c.wave * 8704);
    float ra[32], rb[32];
    int it = gw;
    if (it < total) conv_load(job(it), ra, c.lane);
    for (; it < total; it += 2 * ngw) {
        const int it2 = it + ngw, it3 = it2 + ngw;
        if (it2 < total) conv_load(job(it2), rb, c.lane);
        conv_finish(job(it), ra, scr, c.lane);
        if (it3 < total) conv_load(job(it3), ra, c.lane);
        if (it2 < total) conv_finish(job(it2), rb, scr, c.lane);
    }
}
__device__ __forceinline__ CJ conv_mk(const GAS float* W, GAS bf16* WT, const GAS float* gk, int K, int N, int r, int map) {
    const int nblk = N / 32, kb = r / nblk, nbk = r - kb * nblk, n0 = 32 * nbk; CJ j; j.W = W; j.WT = WT; j.gk = gk; j.K = K; j.N = N; j.n0 = n0; j.k0 = 64 * kb;
    j.drow0 = map == 1 ? conv_row<1>(n0) : map == 2 ? conv_row<2>(n0) : map == 3 ? conv_row<3>(n0) : map == 4 ? conv_row<4>(n0) : n0; return j;
}
struct StaticJobsA { const Ctx* c;
    static constexpr int N_WIN = 16 * 69, N_UQ = 4 * 18, N_UKV = 2 * 24, PER_L = N_WIN + N_UQ + N_UKV, TOTAL = 2 * PER_L;
    __device__ __forceinline__ CJ operator()(int it) const { const Ctx& cx = *c; const int l = it / PER_L; int r = it - l * PER_L;
        if (r < N_WIN) return conv_mk(cx.in(I_WIN) + (size_t)l * D * 2208, (GAS bf16*)(cx.ws + WS_WIN) + (size_t)l * ZP * D, nullptr, D, 2208, r, 1); r -= N_WIN;
        if (r < N_UQ) return conv_mk(cx.in(I_WUQ) + (size_t)l * 256 * QP, (GAS bf16*)(cx.ws + WS_WSM + WSM_UQ) + (size_t)l * 768 * 256, cx.in(I_QNG) + l * 256, 256, QP, r, 4); r -= N_UQ;
        return conv_mk(cx.in(I_WUKV) + (size_t)l * 128 * 768, (GAS bf16*)(cx.ws + WS_WSM + WSM_UKV) + (size_t)l * 768 * 128, cx.in(I_KVNG) + l * 128, 128, 768, r, 0); }
};
struct StaticJobsB { const Ctx* c;
    static constexpr int N_WOUT = 16 * 32, N_DG = 16 * 88, N_DD = 44 * 32, TOTAL = 2 * N_WOUT + 2 * N_DG + N_DD;
    __device__ __forceinline__ CJ operator()(int it) const { const Ctx& cx = *c; int r = it;
        if (r < 2 * N_WOUT) { const int l = r / N_WOUT; return conv_mk(cx.in(I_WOUT) + (size_t)l * D * D, (GAS bf16*)(cx.ws + WS_WOUT) + (size_t)l * D * D, nullptr, D, D, r - l * N_WOUT, 0); } r -= 2 * N_WOUT;
        if (r < N_DG) return conv_mk(cx.in(I_DWG), (GAS bf16*)(cx.ws + WS_WDGU), nullptr, D, DFF, r, 2); r -= N_DG;
        if (r < N_DG) return conv_mk(cx.in(I_DWU), (GAS bf16*)(cx.ws + WS_WDGU), nullptr, D, DFF, r, 3); r -= N_DG;
        return conv_mk(cx.in(I_DWD), (GAS bf16*)(cx.ws + WS_WDD), nullptr, DFF, D, r, 0); }
};
__device__ __forceinline__ void phase_conv_b(const Ctx& c) {
    const int nfull = (M / 256) * (ZP / 256) - 2 * c.nb;
    if (nfull <= 0 || nfull >= c.nb) { StaticJobsB J{&c}; conv_run(c, StaticJobsB::TOTAL, J, c.gw, c.ngw); return; }
    if (c.bid < nfull) return;
    StaticJobsB J{&c}; conv_run(c, StaticJobsB::TOTAL, J, (c.bid - nfull) * NWAVES + c.wave, (c.nb - nfull) * NWAVES);
}
struct ExpertGUJobs { const Ctx* c;
    static constexpr int PER = 16 * 112, TOTAL = NE * 2 * PER;
    __device__ __forceinline__ CJ operator()(int it) const { const Ctx& cx = *c; const int j = it / PER, r = it - j * PER, e = j >> 1, kind = j & 1;
        return conv_mk((kind ? cx.in(I_MWU) : cx.in(I_MWG)) + (size_t)e * D * DFE, (GAS bf16*)(cx.R + R_WMGU) + (size_t)e * 2 * DFE * D, nullptr, D, DFE, r, 2 + kind); }
};
struct ExpertDJobs { const Ctx* c;
    static constexpr int PER = 56 * 32, TOTAL = NE * PER;
    __device__ __forceinline__ CJ operator()(int it) const { const Ctx& cx = *c; const int e = it / PER, r = it - e * PER;
        return conv_mk(cx.in(I_MWD) + (size_t)e * DFE * D, (GAS bf16*)(cx.R + R_WMD) + (size_t)e * D * DFE, nullptr, DFE, D, r, 0); }
};
template <class JobFn> __device__ __forceinline__ void conv_pop(const Ctx& c, GAS unsigned* head, int total, const JobFn& job, GAS unsigned* stop_ctr, unsigned stop_at) {
    LAS float* scr = (LAS float*)(c.lds + c.wave * 8704); LAS int* pb = (LAS int*)(c.lds + RING_BYTES + 12288);
    for (;;) {
        __syncthreads();
        if (c.tid == 0) { const bool stop = stop_ctr && __hip_atomic_load(stop_ctr, __ATOMIC_RELAXED, __HIP_MEMORY_SCOPE_AGENT) >= stop_at;
            pb[0] = stop ? total : (int)__hip_atomic_fetch_add(head, 16u, __ATOMIC_RELAXED, __HIP_MEMORY_SCOPE_AGENT); }
        __syncthreads();
        const int base = pb[0]; if (base >= total) break;
        const int i0 = base + c.wave, i1 = base + 8 + c.wave;
        float ra[32], rb[32];
        if (i0 < total) conv_load(job(i0), ra, c.lane);
        if (i1 < total) conv_load(job(i1), rb, c.lane);
        if (i0 < total) conv_finish(job(i0), ra, scr, c.lane);
        if (i1 < total) conv_finish(job(i1), rb, scr, c.lane);
    }
}

__device__ __forceinline__ void phase_conv_static(const Ctx& c) {
    StaticJobsA J{&c}; conv_run(c, StaticJobsA::TOTAL, J, c.gw, c.ngw);
    for (int l = 0; l < 2; ++l) {
        GAS bf16* win = (GAS bf16*)(c.ws + WS_WIN) + (size_t)l * ZP * D;
        for (int i = c.bid * NTHR + c.tid; i < 96 * D / 8; i += c.nb * NTHR) ((GAS v4u*)(win + (size_t)2208 * D))[i] = (v4u){0u, 0u, 0u, 0u};
        GAS bf16* uq = (GAS bf16*)(c.ws + WS_WSM + WSM_UQ) + (size_t)l * 768 * 256;
        { GAS bf16* lw_ = (GAS bf16*)(c.ws + WS_WSM + WSM_LW) + (size_t)l * AW * 32; GAS bf16* la_ = (GAS bf16*)(c.ws + WS_WSM + WSM_LA) + (size_t)l * AW * 32; GAS bf16* lg_ = (GAS bf16*)(c.ws + WS_WSM + WSM_LG) + (size_t)l * AW * 64;
          const GAS float* sw = c.in(I_WUP) + (size_t)l * 32 * AW; const GAS float* sa = c.in(I_AUP) + (size_t)l * 32 * AW; const GAS float* sg = c.in(I_GUP) + (size_t)l * 64 * AW;
          for (int i = c.bid * NTHR + c.tid; i < AW * 32; i += c.nb * NTHR) { const int ch = i >> 5, kq = i & 31; lw_[i] = (bf16)f2bf(sw[kq * AW + ch]); la_[i] = (bf16)f2bf(sa[kq * AW + ch]); }
          for (int i = c.bid * NTHR + c.tid; i < AW * 64; i += c.nb * NTHR) { const int ch = i >> 6, kq = i & 63; lg_[i] = (bf16)f2bf(sg[kq * AW + ch]); }
          if (l == 1) { GAS bf16* vdt = (GAS bf16*)(c.ws + WS_WSM + WSM_VD); const GAS float* sv = c.in(I_VDN); for (int i = c.bid * NTHR + c.tid; i < 16 * AW; i += c.nb * NTHR) { const int j = i / AW, cx = i % AW; vdt[i] = (bf16)f2bf(sv[cx * 16 + j]); } } }
        { const GAS float* wsrc = c.in(I_CWS) + (size_t)l * 4 * 128 * 128; GAS bf16* wdst = (GAS bf16*)(c.ws + WS_WSM + WSM_GW) + (size_t)l * 4 * 128 * 128;
          for (int i = c.bid * NTHR + c.tid; i < 4 * 128 * 128 / 2; i += c.nb * NTHR) { const int e0 = 2 * i, tq = (e0 >> 7) & 127, sq = e0 & 127; const f32x2 w = *(const GAS f32x2*)(wsrc + e0);
              ((GAS unsigned*)wdst)[i] = pk2(sq <= tq ? w.x : 0.f, sq + 1 <= tq ? w.y : 0.f); } }
        for (int i = c.bid * NTHR + c.tid; i < AH * 32 * 256 / 8; i += c.nb * NTHR) { const int r = i / 32, cc8 = i % 32; ((GAS v4u*)(uq + (size_t)((r / 32) * 128 + 96 + (r % 32)) * 256))[cc8] = (v4u){0u, 0u, 0u, 0u}; }
    }
}
__device__ __forceinline__ void phase_conv_experts(const Ctx& c) {
    ExpertGUJobs JG{&c}; conv_pop(c, (GAS unsigned*)(c.ws + WS_CTL) + CW_CQ, ExpertGUJobs::TOTAL, JG, nullptr, 0u);
    __syncthreads();
    ExpertDJobs JD{&c}; conv_run(c, ExpertDJobs::TOTAL, JD, c.gw, c.ngw); }

template <bool ROUTER> __device__ __forceinline__ void phase_rmsnorm(const Ctx& c, const GAS float* x, const GAS float* g, GAS bf16* xn, const GAS float* router) {
    LAS float* rl = (LAS float*)c.lds;
    if (ROUTER) { for (int i = c.tid; i < D * NE / 4; i += NTHR) { const f32x4 r = ((const GAS f32x4*)router)[i]; const int d = i >> 1, e4 = (i & 1) * 4; rl[(e4 + 0) * D + d] = r.x; rl[(e4 + 1) * D + d] = r.y; rl[(e4 + 2) * D + d] = r.z; rl[(e4 + 3) * D + d] = r.w; } __syncthreads(); }
    const int i16 = c.lane & 15, g16 = c.lane >> 4;
    f32x4 gv[16];
#pragma unroll
    for (int k = 0; k < 16; ++k) gv[k] = *(const GAS f32x4*)(g + 64 * k + 4 * i16);
    LAS int* sel = (LAS int*)(c.lds + 32768);
    GAS int* segc = (GAS int*)(c.ws + WS_TOK + TOK_SEG);
    for (int sg = ROUTER ? c.bid : 0; sg < (ROUTER ? NSEG : 1); sg += ROUTER ? c.nb : 1) {
    const int m0 = ROUTER ? sg * SEGT + c.wave * 8 : c.gw * 4, mstep = ROUTER ? 4 : c.ngw * 4, mend = ROUTER ? m0 + 8 : M;
    for (int mb = m0; mb < mend; mb += mstep) {
        const int m = mb + g16;
        f32x4 v[16]; float ss = 0.f;
#pragma unroll
        for (int k = 0; k < 16; ++k) v[k] = *(const GAS f32x4*)(x + (size_t)m * D + 64 * k + 4 * i16);
#pragma unroll
        for (int k = 0; k < 16; ++k) ss += (v[k].x * v[k].x + v[k].y * v[k].y) + (v[k].z * v[k].z + v[k].w * v[k].w);
        const float rstd = __builtin_amdgcn_rsqf(row16_sum(ss) * (1.0f / D) + EPS);
#pragma unroll
        for (int k = 0; k < 16; ++k) { v[k] = v[k] * rstd * gv[k]; *(GAS v2u*)(xn + (size_t)m * D + 64 * k + 4 * i16) = (v2u){pk2(v[k].x, v[k].y), pk2(v[k].z, v[k].w)}; }
        if (ROUTER) {
            float lg[8];
#pragma unroll
            for (int e = 0; e < 8; ++e) lg[e] = 0.f;
#pragma unroll
            for (int k = 0; k < 16; ++k)
#pragma unroll
                for (int e = 0; e < 8; ++e) { const f32x4 r = *(const LAS f32x4*)(rl + e * D + 64 * k + 4 * i16); lg[e] += (v[k].x * r.x + v[k].y * r.y) + (v[k].z * r.z + v[k].w * r.w); }
#pragma unroll
            for (int e = 0; e < 8; ++e) lg[e] = row16_sum(lg[e]);
            if (i16 == 0) {
                int e0 = 0; float v0 = lg[0];
#pragma unroll
                for (int e = 1; e < 8; ++e) if (lg[e] > v0) { v0 = lg[e]; e0 = e; }
                int e1 = -1; float v1 = -INFINITY;
#pragma unroll
                for (int e = 0; e < 8; ++e) if (e != e0 && lg[e] > v1) { v1 = lg[e]; e1 = e; }
                const float p1 = 1.0f / (1.0f + __expf(v0 - v1)), p0 = 1.0f - p1;
                GAS int* te = (GAS int*)(c.ws + WS_TOK + TOK_E); GAS float* tg = (GAS float*)(c.ws + WS_TOK + TOK_G);
                te[2 * m] = e0; te[2 * m + 1] = e1; tg[2 * m] = p0; tg[2 * m + 1] = p1;
                sel[2 * (m - sg * SEGT)] = e0; sel[2 * (m - sg * SEGT) + 1] = e1;
            }
        }
    }
    if (ROUTER) {
        __syncthreads();
        if (c.wave == 0) { const int e0 = sel[2 * c.lane], e1 = sel[2 * c.lane + 1];
#pragma unroll
            for (int e = 0; e < NE; ++e) { const unsigned long long b0 = __ballot(e0 == e), b1 = __ballot(e1 == e); if (c.lane == 0) segc[sg * NE + e] = __popcll(b0) + __popcll(b1); } }
        __syncthreads();
    }
    }
}

__device__ __forceinline__ float zsh(const GAS bf16* Z, int m, int s, int col, float mu) {
    const float cur = bf2f(Z[(size_t)m * ZP + col]); const float prev = s > 0 ? bf2f(Z[(size_t)(m - 1) * ZP + col]) : 0.f; return cur + (prev - cur) * mu;
}
__device__ __forceinline__ void phase_rwkv_prep(const Ctx& c, int l) {
    const GAS bf16* Z = (const GAS bf16*)(c.R + R_Z);
    GAS bf16* RW = (GAS bf16*)(c.R + R_RW); GAS float* LW = (GAS float*)(c.R + R_LW); GAS bf16* VF = (GAS bf16*)(c.ws + WS_VF);
    const GAS float* mu = c.in(I_MU) + l * 1280; const GAS float* w0 = c.in(I_W0) + l * AW; const GAS float* wup = c.in(I_WUP) + (size_t)l * 32 * AW;
    const GAS float* a0 = c.in(I_A0) + l * AW; const GAS float* aup = c.in(I_AUP) + (size_t)l * 32 * AW; const GAS float* gup = c.in(I_GUP) + (size_t)l * 64 * AW;
    const GAS float* kkw = c.in(I_KK) + l * AW; const GAS float* kaw = c.in(I_KA) + l * AW;
    const GAS float* v0 = c.in(I_V0); const GAS float* vdn = c.in(I_VDN); const GAS float* vup = c.in(I_VUP);
    LAS float* sm = (LAS float*)c.lds;
    LAS float* vs = sm + 8 * 128;
    LAS float* vd = vs + 8 * 384;
    const int t = c.tid;
    for (int grp = c.bid; grp < M / 8; grp += c.nb) {
        const int m0 = grp * 8;
        float r[8], k[8], v[8];
        if (t < AW) {
            const float mr = mu[ZR + t], mk = mu[ZK + t], mv = mu[ZV + t];
#pragma unroll
            for (int q = 0; q < 8; ++q) { const int m = m0 + q, s = m % SEQ; r[q] = zsh(Z, m, s, ZR + t, mr); k[q] = zsh(Z, m, s, ZK + t, mk); v[q] = zsh(Z, m, s, ZV + t, mv); }
        } else {
            const int j = t - AW; const float mj = mu[ZWD + j];
#pragma unroll
            for (int q = 0; q < 8; ++q) { const int m = m0 + q, s = m % SEQ; float x = zsh(Z, m, s, ZWD + j, mj);
                if (j < 32) x = tanhf(x); else if (j >= 64) x = sigmoid_f(x);
                sm[q * 128 + j] = x; }
        }
        __syncthreads();
        float wa[8], aa[8], ga[8];
        if (t < AW) {
#pragma unroll
            for (int q = 0; q < 8; ++q) { wa[q] = 0.f; aa[q] = 0.f; ga[q] = 0.f; }
            for (int j = 0; j < 32; ++j) { const float ww = wup[j * AW + t], au = aup[j * AW + t];
#pragma unroll
                for (int q = 0; q < 8; ++q) { wa[q] += sm[q * 128 + j] * ww; aa[q] += sm[q * 128 + 32 + j] * au; } }
            for (int j = 0; j < 64; ++j) { const float gu = gup[j * AW + t];
#pragma unroll
                for (int q = 0; q < 8; ++q) ga[q] += sm[q * 128 + 64 + j] * gu; }
            if (l > 0) {
#pragma unroll
                for (int q = 0; q < 8; ++q) vs[q * AW + t] = v[q];
            }
        }
        __syncthreads();
        if (l > 0) {
            if (t < 128) { const int q = t >> 4, j = t & 15; float s = 0.f; for (int cc = 0; cc < AW; ++cc) s += vs[q * AW + cc] * vdn[cc * 16 + j]; vd[q * 16 + j] = s; }
            __syncthreads();
        }
        if (t < AW) {
            const float w0t = w0[t], a0t = a0[t], kkt = kkw[t], kat = kaw[t];
#pragma unroll
            for (int q = 0; q < 8; ++q) { const int m = m0 + q; const size_t o = (size_t)m * AW + t;
                const float xw = -(w0t + wa[q]);
                const float sp = xw > 20.f ? xw : log1pf(__expf(xw));
                const float lw = -__expf(-sp - 0.5f);
                const float av = sigmoid_f(a0t + aa[q]);
                float vv = v[q];
                if (l > 0) { float x = v0[t];
#pragma unroll
                    for (int j = 0; j < 16; ++j) x += vd[q * 16 + j] * vup[j * AW + t];
                    const float vf = bf2f(VF[o]); vv = vv + (vf - vv) * sigmoid_f(x); }
                else VF[o] = (bf16)f2bf(vv);
                float kk = k[q] * kkt; const float ss = wave_sum(kk * kk); kk = kk / fmaxf(sqrtf(ss), 1e-12f);
                const float k2 = k[q] * (1.0f + (av - 1.0f) * kat);
                RW[0 * RWSZ + o] = (bf16)f2bf(r[q]); RW[1 * RWSZ + o] = (bf16)f2bf(k2); RW[2 * RWSZ + o] = (bf16)f2bf(vv); RW[3 * RWSZ + o] = (bf16)f2bf(kk);
                RW[4 * RWSZ + o] = (bf16)f2bf(av); RW[5 * RWSZ + o] = (bf16)f2bf(ga[q]); LW[o] = lw; }
        }
        __syncthreads();
    }
}

__device__ __forceinline__ void phase_rwkv_scan_naive(const Ctx& c) {
    const GAS bf16* RW = (const GAS bf16*)(c.R + R_RW); const GAS float* LW = (const GAS float*)(c.R + R_LW); GAS float* YRAW = (GAS float*)(c.R + R_YRAW);
    constexpr int CH = 32;
    LAS float* sr = (LAS float*)c.lds;
    LAS float* sw = sr + CH * 64; LAS float* skk = sw + CH * 64; LAS float* sb = skk + CH * 64; LAS float* sk2 = sb + CH * 64; LAS float* sv = sk2 + CH * 64; LAS float* sy = sv + CH * 64;
    const int t = c.tid, vrow = t >> 3, kq = t & 7;
    for (int item = c.bid; item < BATCH * AH; item += c.nb) {
        const int b = item / AH, h = item % AH;
        float st[8];
#pragma unroll
        for (int i = 0; i < 8; ++i) st[i] = 0.f;
        for (int s0 = 0; s0 < SEQ; s0 += CH) {
            __syncthreads();
#pragma unroll
            for (int q = 0; q < 4; ++q) { const int e = t + q * NTHR, ts = e >> 6, ch = e & 63; const size_t o = (size_t)(b * SEQ + s0 + ts) * AW + h * 64 + ch;
                const float kk = bf2f(RW[3 * RWSZ + o]), av = bf2f(RW[4 * RWSZ + o]);
                sr[e] = bf2f(RW[0 * RWSZ + o]); sw[e] = __expf(LW[o]); skk[e] = kk; sb[e] = kk * av; sk2[e] = bf2f(RW[1 * RWSZ + o]); sv[e] = bf2f(RW[2 * RWSZ + o]); }
            __syncthreads();
            for (int ts = 0; ts < CH; ++ts) {
                const int o = ts * 64 + kq * 8; float p = 0.f;
#pragma unroll
                for (int i = 0; i < 8; ++i) p += st[i] * skk[o + i];
                p += __shfl_xor(p, 1); p += __shfl_xor(p, 2); p += __shfl_xor(p, 4);
                const float sa = -p, vv = sv[ts * 64 + vrow]; float y = 0.f;
#pragma unroll
                for (int i = 0; i < 8; ++i) { st[i] = st[i] * sw[o + i] + sa * sb[o + i] + vv * sk2[o + i]; y += st[i] * sr[o + i]; }
                y += __shfl_xor(y, 1); y += __shfl_xor(y, 2); y += __shfl_xor(y, 4);
                if (kq == 0) sy[ts * 64 + vrow] = y;
            }
            __syncthreads();
#pragma unroll
            for (int q = 0; q < 4; ++q) { const int e = t + q * NTHR, ts = e >> 6, ch = e & 63; YRAW[(size_t)(b * SEQ + s0 + ts) * AW + h * 64 + ch] = sy[e]; }
        }
        __syncthreads();
    }
}

__device__ __forceinline__ void phase_rwkv_post(const Ctx& c, int l) {
    const GAS bf16* RW = (const GAS bf16*)(c.R + R_RW); const GAS float* YRAW = (const GAS float*)(c.R + R_YRAW); GAS bf16* YC = (GAS bf16*)(c.ws + WS_XN);
    const GAS float* lng = c.in(I_LNG) + l * AW; const GAS float* lnb = c.in(I_LNB) + l * AW; const GAS float* rk = c.in(I_RK) + l * AW;
    for (int it = c.gw; it < M * AH; it += c.ngw) {
        const int m = it / AH, h = it % AH, ch = h * 64 + c.lane; const size_t o = (size_t)m * AW + ch;
        const float y = YRAW[o]; const float mean = wave_sum(y) * (1.0f / 64.0f); const float d = y - mean; const float var = wave_sum(d * d) * (1.0f / 64.0f);
        const float yn = d * (__builtin_amdgcn_rsqf(var + 64e-5f)) * lng[ch] + lnb[ch];
        const float r = bf2f(RW[0 * RWSZ + o]), k2 = bf2f(RW[1 * RWSZ + o]), v = bf2f(RW[2 * RWSZ + o]), g = bf2f(RW[5 * RWSZ + o]);
        const float bonus = wave_sum(r * k2 * rk[ch]);
        YC[(size_t)m * D + ch] = (bf16)f2bf((yn + bonus * v) * g);
    }
}

__device__ __forceinline__ int vt_pos(int kap) { return 8 * ((kap >> 2) & 1) + 4 * (kap >> 3) + (kap & 3); }

typedef short bf16x8 __attribute__((ext_vector_type(8)));
typedef float f32x16 __attribute__((ext_vector_type(16)));
typedef __bf16 bf16x2_t __attribute__((ext_vector_type(2)));
__device__ __forceinline__ unsigned cvtpk(float lo, float hi) { const f32x2 v = {lo, hi}; const bf16x2_t b = __builtin_convertvector(v, bf16x2_t); return __builtin_bit_cast(unsigned, b); }
__device__ __forceinline__ bf16x8 pack8(const f32x16& a, int s8) {
    v4u t; t.x = cvtpk(a[s8], a[s8 + 1]); t.y = cvtpk(a[s8 + 2], a[s8 + 3]); t.z = cvtpk(a[s8 + 4], a[s8 + 5]); t.w = cvtpk(a[s8 + 6], a[s8 + 7]); return __builtin_bit_cast(bf16x8, t);
}
#define MFMA32(a, b, c) __builtin_amdgcn_mfma_f32_32x32x16_bf16(a, b, c, 0, 0, 0)
__device__ __forceinline__ float keep_neg(float x, int d) { return __builtin_bit_cast(float, __builtin_bit_cast(unsigned, x) & (unsigned)(d >> 31)); }
__device__ __forceinline__ float keep_zero(float x, int d) { return __builtin_bit_cast(float, __builtin_bit_cast(unsigned, x) & ~(unsigned)((d | -d) >> 31)); }
__device__ __forceinline__ f32x16 zero16() { f32x16 z;
#pragma unroll
    for (int r = 0; r < 16; ++r) z[r] = 0.f;
    return z; }

__device__ __forceinline__ void phase_rwkv_prep2(const Ctx& c, int l) {
    const GAS bf16* Z = (const GAS bf16*)(c.R + R_Z);
    GAS bf16* NAT = (GAS bf16*)(c.R + R_NAT); GAS bf16* TR = (GAS bf16*)(c.R + R_TR); GAS bf16* VN = (GAS bf16*)(c.R + R_VG); GAS bf16* GN = VN + (size_t)M * AW; GAS float* BON = (GAS float*)(c.R + R_BON); GAS float* WL = (GAS float*)(c.R + R_WL); GAS bf16* VF = (GAS bf16*)(c.ws + WS_VF);
    const GAS float* mu = c.in(I_MU) + l * 1280; const GAS float* w0 = c.in(I_W0) + l * AW; const GAS float* wup = c.in(I_WUP) + (size_t)l * 32 * AW;
    const GAS float* a0 = c.in(I_A0) + l * AW; const GAS float* aup = c.in(I_AUP) + (size_t)l * 32 * AW; const GAS float* gup = c.in(I_GUP) + (size_t)l * 64 * AW;
    const GAS float* kkw = c.in(I_KK) + l * AW; const GAS float* kaw = c.in(I_KA) + l * AW; const GAS float* rkw = c.in(I_RK) + l * AW;
    const GAS float* v0 = c.in(I_V0); const GAS float* vdn = c.in(I_VDN); const GAS float* vup = c.in(I_VUP);
    LAS float* sm = (LAS float*)c.lds;
    LAS float* vs = sm + 8 * 128;
    LAS float* vd = vs + 8 * 384;
    const int t = c.tid;
    constexpr size_t ASZ = (size_t)NCHUNK * BLK;
    for (int item = c.bid; item < M / 64; item += c.nb) {
        const int b = item / (SEQ / 64), cc = item % (SEQ / 64);
        const int hh = t >> 6, c64 = t & 63; const size_t cbo = ((size_t)((b * AH + hh) * (SEQ / 64) + cc)) * BLK;
        float cum = 0.f;
        for (int grp = 0; grp < 8; ++grp) {
            const int m0 = item * 64 + grp * 8;
            float r[8], k[8], v[8];
            if (t < AW) {
                const float mr = mu[ZR + t], mk = mu[ZK + t], mv = mu[ZV + t];
#pragma unroll
                for (int q = 0; q < 8; ++q) { const int m = m0 + q, s = m % SEQ; r[q] = zsh(Z, m, s, ZR + t, mr); k[q] = zsh(Z, m, s, ZK + t, mk); v[q] = zsh(Z, m, s, ZV + t, mv); }
            } else {
                const int j = t - AW; const float mj = mu[ZWD + j];
#pragma unroll
                for (int q = 0; q < 8; ++q) { const int m = m0 + q, s = m % SEQ; float x = zsh(Z, m, s, ZWD + j, mj);
                    if (j < 32) x = tanhf(x); else if (j >= 64) x = sigmoid_f(x);
                    sm[q * 128 + j] = x; }
            }
            __syncthreads();
            float wa[8], aa[8], ga[8];
            if (t < AW) {
#pragma unroll
                for (int q = 0; q < 8; ++q) { wa[q] = 0.f; aa[q] = 0.f; ga[q] = 0.f; }
                for (int j = 0; j < 32; ++j) { const float ww = wup[j * AW + t], au = aup[j * AW + t];
#pragma unroll
                    for (int q = 0; q < 8; ++q) { wa[q] += sm[q * 128 + j] * ww; aa[q] += sm[q * 128 + 32 + j] * au; } }
                for (int j = 0; j < 64; ++j) { const float gu = gup[j * AW + t];
#pragma unroll
                    for (int q = 0; q < 8; ++q) ga[q] += sm[q * 128 + 64 + j] * gu; }
                if (l > 0) {
#pragma unroll
                    for (int q = 0; q < 8; ++q) vs[q * AW + t] = v[q];
                }
            }
            __syncthreads();
            if (l > 0) {
                if (t < 128) { const int q = t >> 4, j = t & 15; float s = 0.f; for (int cx = 0; cx < AW; ++cx) s += vs[q * AW + cx] * vdn[cx * 16 + j]; vd[q * 16 + j] = s; }
                __syncthreads();
            }
            if (t < AW) {
                const float w0t = w0[t], a0t = a0[t], kkt = kkw[t], kat = kaw[t], rkt = rkw[t];
                unsigned short ta[8], tv[8], tb[8], tk[8];
#pragma unroll
                for (int q = 0; q < 8; ++q) { const int m = m0 + q; const size_t o = (size_t)m * AW + t;
                    const float xw = -(w0t + wa[q]);
                    const float sp = xw > 20.f ? xw : log1pf(__expf(xw));
                    const float lw = -__expf(-sp - 0.5f);
                    const float av = sigmoid_f(a0t + aa[q]);
                    float vv = v[q];
                    if (l > 0) { float x = v0[t];
#pragma unroll
                        for (int j = 0; j < 16; ++j) x += vd[q * 16 + j] * vup[j * AW + t];
                        const float vf = bf2f(VF[o]); vv = vv + (vf - vv) * sigmoid_f(x); }
                    else VF[o] = (bf16)f2bf(vv);
                    float kk = k[q] * kkt; const float ss = wave_sum(kk * kk); kk = kk / fmaxf(sqrtf(ss), 1e-12f);
                    const float k2 = k[q] * (1.0f + (av - 1.0f) * kat);
                    const float rq = bf2f((bf16)f2bf(r[q])), k2q = bf2f((bf16)f2bf(k2));
                    const float bon = wave_sum(rq * k2q * rkt);
                    if (c64 == 0) BON[(size_t)m * AH + hh] = bon;
                    VN[o] = (bf16)f2bf(vv); GN[o] = (bf16)f2bf(ga[q]);
                    const float cprev = cum; cum += lw;
                    const float ep = __expf(cum), en = __expf(-cum), epv = __expf(cprev);
                    const int tt = grp * 8 + q; const size_t no = cbo + (size_t)tt * 64 + c64;
                    const unsigned short xa = (unsigned short)f2bf(-kk * epv), xb = (unsigned short)f2bf(kk * av * en), xk = (unsigned short)f2bf(k2 * en);
                    NAT[0 * ASZ + no] = xa; NAT[1 * ASZ + no] = (bf16)f2bf(r[q] * ep); NAT[2 * ASZ + no] = xb; NAT[3 * ASZ + no] = xk;
                    ta[q] = xa; tv[q] = (unsigned short)f2bf(vv); tb[q] = xb; tk[q] = xk; }
                const int p1 = 16 * (grp >> 1) + 4 * (grp & 1); const size_t to = cbo + (size_t)c64 * 64 + p1;
                *(GAS v2u*)(TR + 0 * ASZ + to) = (v2u){(unsigned)ta[0] | ((unsigned)ta[1] << 16), (unsigned)ta[2] | ((unsigned)ta[3] << 16)}; *(GAS v2u*)(TR + 0 * ASZ + to + 8) = (v2u){(unsigned)ta[4] | ((unsigned)ta[5] << 16), (unsigned)ta[6] | ((unsigned)ta[7] << 16)};
                *(GAS v2u*)(TR + 1 * ASZ + to) = (v2u){(unsigned)tv[0] | ((unsigned)tv[1] << 16), (unsigned)tv[2] | ((unsigned)tv[3] << 16)}; *(GAS v2u*)(TR + 1 * ASZ + to + 8) = (v2u){(unsigned)tv[4] | ((unsigned)tv[5] << 16), (unsigned)tv[6] | ((unsigned)tv[7] << 16)};
                *(GAS v2u*)(TR + 2 * ASZ + to) = (v2u){(unsigned)tb[0] | ((unsigned)tb[1] << 16), (unsigned)tb[2] | ((unsigned)tb[3] << 16)}; *(GAS v2u*)(TR + 2 * ASZ + to + 8) = (v2u){(unsigned)tb[4] | ((unsigned)tb[5] << 16), (unsigned)tb[6] | ((unsigned)tb[7] << 16)};
                *(GAS v2u*)(TR + 3 * ASZ + to) = (v2u){(unsigned)tk[0] | ((unsigned)tk[1] << 16), (unsigned)tk[2] | ((unsigned)tk[3] << 16)}; *(GAS v2u*)(TR + 3 * ASZ + to + 8) = (v2u){(unsigned)tk[4] | ((unsigned)tk[5] << 16), (unsigned)tk[6] | ((unsigned)tk[7] << 16)};
            }
            __syncthreads();
        }
        if (t < AW) WL[(cbo >> 12) * 64 + c64] = __expf(cum);
    }
}


typedef float f32x4v __attribute__((ext_vector_type(4)));
__device__ __forceinline__ void phase_rwkv_prep3(const Ctx& c, int l) {
    const GAS bf16* Z = (const GAS bf16*)(c.R + R_Z);
    GAS bf16* NAT = (GAS bf16*)(c.R + R_NAT); GAS bf16* TR = (GAS bf16*)(c.R + R_TR); GAS bf16* VN = (GAS bf16*)(c.R + R_VG); GAS bf16* GN = VN + (size_t)M * AW; GAS float* BON = (GAS float*)(c.R + R_BON); GAS float* WL = (GAS float*)(c.R + R_WL); GAS bf16* VF = (GAS bf16*)(c.ws + WS_VF);
    const GAS float* mu = c.in(I_MU) + l * 1280; const GAS float* w0 = c.in(I_W0) + l * AW; const GAS float* a0 = c.in(I_A0) + l * AW;
    const GAS float* kkw = c.in(I_KK) + l * AW; const GAS float* kaw = c.in(I_KA) + l * AW; const GAS float* rkw = c.in(I_RK) + l * AW;
    const GAS float* v0 = c.in(I_V0); const GAS float* vdn = c.in(I_VDN); const GAS float* vup = c.in(I_VUP);
    const GAS bf16* LWt = (const GAS bf16*)(c.ws + WS_WSM + WSM_LW) + (size_t)l * AW * 32; const GAS bf16* LAt = (const GAS bf16*)(c.ws + WS_WSM + WSM_LA) + (size_t)l * AW * 32; const GAS bf16* LGt = (const GAS bf16*)(c.ws + WS_WSM + WSM_LG) + (size_t)l * AW * 64;
    constexpr int SP = 136;
    LAS unsigned short* sm = (LAS unsigned short*)c.lds;
    LAS float* lora = (LAS float*)(c.lds + 8192);
    LAS unsigned short* vs = (LAS unsigned short*)(lora + 3 * 16 * AW);
    LAS float* vd = (LAS float*)(vs + 16 * 392);
    const GAS bf16* VDt = (const GAS bf16*)(c.ws + WS_WSM + WSM_VD);
    const int t = c.tid, lane = c.lane;
    constexpr size_t ASZ = (size_t)NCHUNK * BLK;
    for (int item = c.bid; item < M / 64; item += c.nb) {
        const int b = item / (SEQ / 64), cc = item % (SEQ / 64);
        const int hh = c.wave < 6 ? c.wave : c.wave - 2, c64 = lane, tc = hh * 64 + lane, qlo = c.wave >= 6 ? 8 : 0, qhi = (c.wave == 4 || c.wave == 5) ? 8 : 16;
        const size_t cbo = ((size_t)((b * AH + hh) * (SEQ / 64) + cc)) * BLK;
        float cum = 0.f;
        for (int grp = 0; grp < 4; ++grp) {
            const int m0 = item * 64 + grp * 16;
            if (t < AW) {
                if (l > 0) { const float mv = mu[ZV + t];
#pragma unroll 4
                    for (int q = 0; q < 16; ++q) { const int m = m0 + q, s = m % SEQ; vs[q * 392 + t] = (unsigned short)f2bf(zsh(Z, m, s, ZV + t, mv)); } }
            } else {
                const int j = t - AW; const float mj = mu[ZWD + j];
                float zt[17]; const int s0_ = m0 % SEQ;
#pragma unroll
                for (int q = 0; q < 17; ++q) zt[q] = bf2f(Z[(size_t)(m0 + q - 1 + ((q == 0 && s0_ == 0) ? 1 : 0)) * ZP + ZWD + j]);
                if (s0_ == 0) zt[0] = 0.f;
#pragma unroll
                for (int q = 0; q < 16; ++q) { float x = zt[q + 1] + (zt[q] - zt[q + 1]) * mj;
                    const float ex = __expf(j < 32 ? 2.0f * x : -x), rc = 1.0f / (1.0f + ex);
                    x = j < 32 ? 1.0f - 2.0f * rc : (j >= 64 ? rc : x);
                    sm[q * SP + j] = (unsigned short)f2bf(x); }
            }
            __syncthreads();
            {
                const int row = lane & 15, kq = lane >> 4;
                const bf16x8 aw = *(const LAS bf16x8*)(sm + row * SP + 8 * kq), aa = *(const LAS bf16x8*)(sm + row * SP + 32 + 8 * kq), ag0 = *(const LAS bf16x8*)(sm + row * SP + 64 + 8 * kq), ag1 = *(const LAS bf16x8*)(sm + row * SP + 96 + 8 * kq);
#pragma unroll
                for (int i = 0; i < 3; ++i) { const int ch = 16 * (3 * c.wave + i) + row;
                    f32x4v dw = {0.f, 0.f, 0.f, 0.f}, da = dw, dg = dw;
                    dw = __builtin_amdgcn_mfma_f32_16x16x32_bf16(aw, *(const GAS bf16x8*)(LWt + ch * 32 + 8 * kq), dw, 0, 0, 0);
                    da = __builtin_amdgcn_mfma_f32_16x16x32_bf16(aa, *(const GAS bf16x8*)(LAt + ch * 32 + 8 * kq), da, 0, 0, 0);
                    dg = __builtin_amdgcn_mfma_f32_16x16x32_bf16(ag0, *(const GAS bf16x8*)(LGt + ch * 64 + 8 * kq), dg, 0, 0, 0);
                    dg = __builtin_amdgcn_mfma_f32_16x16x32_bf16(ag1, *(const GAS bf16x8*)(LGt + ch * 64 + 32 + 8 * kq), dg, 0, 0, 0);
#pragma unroll
                    for (int rr = 0; rr < 4; ++rr) { const int tq = 4 * kq + rr; lora[(0 * 16 + tq) * AW + ch] = dw[rr]; lora[(1 * 16 + tq) * AW + ch] = da[rr]; lora[(2 * 16 + tq) * AW + ch] = dg[rr]; } }
                if (l > 0 && c.wave == 7) {
                    f32x4v dv = {0.f, 0.f, 0.f, 0.f}; bf16x8 vbf[12];
#pragma unroll
                    for (int ks = 0; ks < 12; ++ks) vbf[ks] = *(const GAS bf16x8*)(VDt + row * AW + 32 * ks + 8 * kq);
#pragma unroll
                    for (int ks = 0; ks < 12; ++ks) dv = __builtin_amdgcn_mfma_f32_16x16x32_bf16(*(const LAS bf16x8*)(vs + row * 392 + 32 * ks + 8 * kq), vbf[ks], dv, 0, 0, 0);
#pragma unroll
                    for (int rr = 0; rr < 4; ++rr) vd[(4 * kq + rr) * 16 + row] = dv[rr]; }
            }
            __syncthreads();

            {
                const float w0t = w0[tc], a0t = a0[tc], kkt = kkw[tc], kat = kaw[tc], rkt = rkw[tc], mr = mu[ZR + tc], mk = mu[ZK + tc], mv = mu[ZV + tc];
                unsigned short ta[16], tv[16], tb[16], tk[16];
                float vupr[16], vfin[16]; float v0t = 0.f;
#pragma unroll
                for (int j = 0; j < 16; ++j) { vupr[j] = 0.f; vfin[j] = 0.f; }
                if (l > 0) { v0t = v0[tc];
                    unsigned short vfr[16];
#pragma unroll
                    for (int j = 0; j < 16; ++j) { vupr[j] = vup[j * AW + tc]; vfr[j] = VF[(size_t)(m0 + j) * AW + tc]; }
#pragma unroll
                    for (int j = 0; j < 16; ++j) vfin[j] = bf2f(vfr[j]); }
                float rin[16], kin[16], vin[16];
                { float zr_[17], zk_[17], zv_[17]; const int s0_ = m0 % SEQ;
#pragma unroll
                  for (int q = 0; q < 17; ++q) { const size_t zo = (size_t)(m0 + q - 1 + ((q == 0 && s0_ == 0) ? 1 : 0)) * ZP;
                      zr_[q] = bf2f(Z[zo + ZR + tc]); zk_[q] = bf2f(Z[zo + ZK + tc]); zv_[q] = bf2f(Z[zo + ZV + tc]); }
                  if (s0_ == 0) { zr_[0] = 0.f; zk_[0] = 0.f; zv_[0] = 0.f; }
#pragma unroll
                  for (int q = 0; q < 16; ++q) { rin[q] = zr_[q + 1] + (zr_[q] - zr_[q + 1]) * mr; kin[q] = zk_[q + 1] + (zk_[q] - zk_[q + 1]) * mk; vin[q] = zv_[q + 1] + (zv_[q] - zv_[q + 1]) * mv;
                  } }
#pragma unroll
                for (int q = 0; q < 16; ++q) { const int m = m0 + q; const size_t o = (size_t)m * AW + tc;
                    const float rv = rin[q], kv = kin[q], vv0 = vin[q];
                    const float xw = -(w0t + lora[(0 * 16 + q) * AW + tc]);
                    const float sp = xw > 20.f ? xw : __logf(1.0f + __expf(xw));
                    const float lw = -__expf(-sp - 0.5f);
                    const float cprev = cum; cum += lw;
                    if (q >= qlo && q < qhi) {
                    const float av = sigmoid_fast(a0t + lora[(1 * 16 + q) * AW + tc]);
                    float vv = vv0;
                    if (l > 0) { float x = v0t;
#pragma unroll
                        for (int j = 0; j < 16; ++j) x += vd[q * 16 + j] * vupr[j];
                        const float vf = vfin[q]; vv = vv + (vf - vv) * sigmoid_fast(x); }
                    else VF[o] = f2bf_hw(vv);
                    float kk = kv * kkt; const float ss = wave_sum(kk * kk); kk = kk * __builtin_amdgcn_rsqf(fmaxf(ss, 1e-24f));
                    const float k2 = kv * (1.0f + (av - 1.0f) * kat);
                    const float rq = bf2f(f2bf_hw(rv)), k2q = bf2f(f2bf_hw(k2));
                    const float bon = wave_sum(rq * k2q * rkt);
                    if (c64 == 0) BON[(size_t)m * AH + hh] = bon;
                    VN[o] = f2bf_hw(vv); GN[o] = f2bf_hw(lora[(2 * 16 + q) * AW + tc]);
                    const float ep = __expf(cum), en = __expf(-cum), epv = __expf(cprev);
                    const int tt = grp * 16 + q; const size_t no = cbo + (size_t)tt * 64 + c64;
                    const unsigned short xa = f2bf_hw(-kk * epv), xb = f2bf_hw(kk * av * en), xk = f2bf_hw(k2 * en);
                    NAT[0 * ASZ + no] = xa; NAT[1 * ASZ + no] = f2bf_hw(rv * ep); NAT[2 * ASZ + no] = xb; NAT[3 * ASZ + no] = xk;
                    ta[q] = xa; tv[q] = f2bf_hw(vv); tb[q] = xb; tk[q] = xk; } }
                const size_t to = cbo + (size_t)c64 * 64 + 16 * grp;
#define PK2(a, i, j) ((unsigned)a[i] | ((unsigned)a[j] << 16))
#define TRST(x, a) do { if (qlo == 0) { *(GAS v2u*)(TR + (x) * ASZ + to) = (v2u){PK2(a, 0, 1), PK2(a, 2, 3)}; *(GAS v2u*)(TR + (x) * ASZ + to + 8) = (v2u){PK2(a, 4, 5), PK2(a, 6, 7)}; } \
                        if (qhi == 16) { *(GAS v2u*)(TR + (x) * ASZ + to + 4) = (v2u){PK2(a, 8, 9), PK2(a, 10, 11)}; *(GAS v2u*)(TR + (x) * ASZ + to + 12) = (v2u){PK2(a, 12, 13), PK2(a, 14, 15)}; } } while (0)
                TRST(0, ta); TRST(1, tv); TRST(2, tb); TRST(3, tk);
#undef TRST
#undef PK2
            }
            __syncthreads();
        }
        if (c.wave < 6) WL[(cbo >> 12) * 64 + c64] = __expf(cum);
    }
}

__device__ __forceinline__ void phase_rwkv_prep4(const Ctx& c, int l) {
    const GAS bf16* Z = (const GAS bf16*)(c.R + R_Z);
    GAS bf16* NAT = (GAS bf16*)(c.R + R_NAT); GAS bf16* TR = (GAS bf16*)(c.R + R_TR); GAS bf16* VN = (GAS bf16*)(c.R + R_VG); GAS bf16* GN = VN + (size_t)M * AW; GAS float* BON = (GAS float*)(c.R + R_BON); GAS float* WL = (GAS float*)(c.R + R_WL); GAS bf16* VF = (GAS bf16*)(c.ws + WS_VF);
    const GAS float* mu = c.in(I_MU) + l * 1280; const GAS float* w0 = c.in(I_W0) + l * AW; const GAS float* a0 = c.in(I_A0) + l * AW;
    const GAS float* kkw = c.in(I_KK) + l * AW; const GAS float* kaw = c.in(I_KA) + l * AW; const GAS float* rkw = c.in(I_RK) + l * AW;
    const GAS float* v0 = c.in(I_V0); const GAS float* vdn = c.in(I_VDN); const GAS float* vup = c.in(I_VUP);
    const GAS bf16* LWt = (const GAS bf16*)(c.ws + WS_WSM + WSM_LW) + (size_t)l * AW * 32; const GAS bf16* LAt = (const GAS bf16*)(c.ws + WS_WSM + WSM_LA) + (size_t)l * AW * 32; const GAS bf16* LGt = (const GAS bf16*)(c.ws + WS_WSM + WSM_LG) + (size_t)l * AW * 64;
    constexpr int SP = 136;
    LAS unsigned short* sm = (LAS unsigned short*)c.lds;
    LAS float* lora = (LAS float*)(c.lds + 8192);
    LAS unsigned short* vs = (LAS unsigned short*)(lora + 3 * 16 * AW);
    LAS float* vd = (LAS float*)(vs + 16 * 392);
    const GAS bf16* VDt = (const GAS bf16*)(c.ws + WS_WSM + WSM_VD);
    const int t = c.tid, lane = c.lane;
    constexpr size_t ASZ = (size_t)NCHUNK * BLK;
    for (int item = c.bid; item < M / 64; item += c.nb) {
        const int b = item / (SEQ / 64), cc = item % (SEQ / 64);
        const int p3 = c.wave % 3, hf = c.wave / 3, hh = 2 * p3 + (lane >> 5), c2 = 2 * (lane & 31), tc = hh * 64 + c2;
        const unsigned cbo = (unsigned)(((b * AH + hh) * (SEQ / 64) + cc) * BLK);
        f32x2 cum = {0.f, 0.f};
        for (int grp = 0; grp < 4; ++grp) {
            const int m0 = item * 64 + grp * 16;
            if (t < AW) {
                if (l > 0) { const float mv = mu[ZV + t];
#pragma unroll 4
                    for (int q = 0; q < 16; ++q) { const int m = m0 + q, s = m % SEQ; vs[q * 392 + t] = (unsigned short)f2bf(zsh(Z, m, s, ZV + t, mv)); } }
            } else {
                const int j = t - AW; const float mj = mu[ZWD + j];
                float zt[17]; const int s0_ = m0 % SEQ;
#pragma unroll
                for (int q = 0; q < 17; ++q) zt[q] = bf2f(Z[(size_t)(m0 + q - 1 + ((q == 0 && s0_ == 0) ? 1 : 0)) * ZP + ZWD + j]);
                if (s0_ == 0) zt[0] = 0.f;
#pragma unroll
                for (int q = 0; q < 16; ++q) { float x = zt[q + 1] + (zt[q] - zt[q + 1]) * mj;
                    const float ex = __expf(j < 32 ? 2.0f * x : -x), rc = 1.0f / (1.0f + ex);
                    x = j < 32 ? 1.0f - 2.0f * rc : (j >= 64 ? rc : x);
                    sm[q * SP + j] = (unsigned short)f2bf(x); }
            }
            __syncthreads();
            {
                const int row = lane & 15, kq = lane >> 4;
                const bf16x8 aw = *(const LAS bf16x8*)(sm + row * SP + 8 * kq), aa = *(const LAS bf16x8*)(sm + row * SP + 32 + 8 * kq), ag0 = *(const LAS bf16x8*)(sm + row * SP + 64 + 8 * kq), ag1 = *(const LAS bf16x8*)(sm + row * SP + 96 + 8 * kq);
#pragma unroll
                for (int i = 0; i < 3; ++i) { const int ch = 16 * (3 * c.wave + i) + row;
                    f32x4v dw = {0.f, 0.f, 0.f, 0.f}, da = dw, dg = dw;
                    dw = __builtin_amdgcn_mfma_f32_16x16x32_bf16(aw, *(const GAS bf16x8*)(LWt + ch * 32 + 8 * kq), dw, 0, 0, 0);
                    da = __builtin_amdgcn_mfma_f32_16x16x32_bf16(aa, *(const GAS bf16x8*)(LAt + ch * 32 + 8 * kq), da, 0, 0, 0);
                    dg = __builtin_amdgcn_mfma_f32_16x16x32_bf16(ag0, *(const GAS bf16x8*)(LGt + ch * 64 + 8 * kq), dg, 0, 0, 0);
                    dg = __builtin_amdgcn_mfma_f32_16x16x32_bf16(ag1, *(const GAS bf16x8*)(LGt + ch * 64 + 32 + 8 * kq), dg, 0, 0, 0);
#pragma unroll
                    for (int rr = 0; rr < 4; ++rr) { const int tq = 4 * kq + rr; lora[(0 * 16 + tq) * AW + ch] = dw[rr]; lora[(1 * 16 + tq) * AW + ch] = da[rr]; lora[(2 * 16 + tq) * AW + ch] = dg[rr]; } }
                if (l > 0 && c.wave == 7) {
                    f32x4v dv = {0.f, 0.f, 0.f, 0.f}; bf16x8 vbf[12];
#pragma unroll
                    for (int ks = 0; ks < 12; ++ks) vbf[ks] = *(const GAS bf16x8*)(VDt + row * AW + 32 * ks + 8 * kq);
#pragma unroll
                    for (int ks = 0; ks < 12; ++ks) dv = __builtin_amdgcn_mfma_f32_16x16x32_bf16(*(const LAS bf16x8*)(vs + row * 392 + 32 * ks + 8 * kq), vbf[ks], dv, 0, 0, 0);
#pragma unroll
                    for (int rr = 0; rr < 4; ++rr) vd[(4 * kq + rr) * 16 + row] = dv[rr]; }
            }
            __syncthreads();

            if (c.wave < 6) {
#define LD2(p) (*(const GAS f32x2*)(p))
                const f32x2 w0t = LD2(w0 + tc), a0t = LD2(a0 + tc), kkt = LD2(kkw + tc), kat = LD2(kaw + tc), rkt = LD2(rkw + tc), mr = LD2(mu + ZR + tc), mk = LD2(mu + ZK + tc), mv = LD2(mu + ZV + tc);
                const int Q0 = 8 * hf, s0_ = (m0 + Q0) % SEQ; const bool pz = s0_ == 0;
                unsigned zr_[9], zk_[9], zv_[9], vfr[8];
#pragma unroll
                for (int q = 0; q < 9; ++q) { const size_t zo = (size_t)(m0 + Q0 + q - 1 + ((q == 0 && pz) ? 1 : 0)) * ZP + tc;
                    zr_[q] = *(const GAS unsigned*)(Z + zo + ZR); zk_[q] = *(const GAS unsigned*)(Z + zo + ZK); zv_[q] = *(const GAS unsigned*)(Z + zo + ZV); }
#pragma unroll
                for (int j = 0; j < 8; ++j) vfr[j] = 0u;
                f32x2 sgv[8];
#pragma unroll
                for (int j = 0; j < 8; ++j) sgv[j] = (f32x2){0.f, 0.f};
                if (l > 0) {
                    f32x2 vupr[16]; const f32x2 v0t = LD2(v0 + tc);
#pragma unroll
                    for (int j = 0; j < 16; ++j) vupr[j] = LD2(vup + j * AW + tc);
#pragma unroll
                    for (int j = 0; j < 8; ++j) vfr[j] = *(const GAS unsigned*)(VF + (size_t)(m0 + Q0 + j) * AW + tc);
#pragma unroll
                    for (int q8 = 0; q8 < 8; ++q8) { f32x2 x = v0t; const LAS f32x4* vq4 = (const LAS f32x4*)(vd + (Q0 + q8) * 16);
#pragma unroll
                        for (int j4 = 0; j4 < 4; ++j4) { const f32x4 d4 = vq4[j4]; x += vupr[4 * j4] * d4.x; x += vupr[4 * j4 + 1] * d4.y; x += vupr[4 * j4 + 2] * d4.z; x += vupr[4 * j4 + 3] * d4.w; }
                        sgv[q8] = (f32x2){sigmoid_fast(x.x), sigmoid_fast(x.y)}; } }
#undef LD2
                if (pz) { zr_[0] = 0u; zk_[0] = 0u; zv_[0] = 0u; }
                f32x2 cumv[9];
#pragma unroll
                for (int q = 0; q < 16; ++q) { const f32x2 lo2 = *(const LAS f32x2*)(lora + (0 * 16 + q) * AW + tc); f32x2 lw;
#pragma unroll
                    for (int e = 0; e < 2; ++e) { const float xw = -(w0t[e] + lo2[e]); const float sp = xw > 20.f ? xw : __logf(1.0f + __expf(xw)); lw[e] = -__expf(-sp - 0.5f); }
                    if (q >= Q0 && q < Q0 + 8) cumv[q & 7] = cum;
                    cum += lw;
                    if (q == Q0 + 7) cumv[8] = cum; }
                const unsigned to = cbo + (unsigned)c2 * 64 + 16 * grp;
#define LO2(a, i, j) (((a)[i] & 0xffffu) | ((a)[j] << 16))
#define HI2(a, i, j) (((a)[i] >> 16) | ((a)[j] & 0xffff0000u))
#pragma unroll
                for (int h4 = 0; h4 < 2; ++h4) {
                    unsigned xa_[4], xv_[4], xb_[4], xk_[4];
#pragma unroll
                    for (int u = 0; u < 4; ++u) { const int q8 = 4 * h4 + u, q = Q0 + q8; const unsigned mo = (unsigned)(m0 + q) * AW + tc;
                        const f32x2 pr = {bflo(zr_[q8]), bfhi(zr_[q8])}, cr = {bflo(zr_[q8 + 1]), bfhi(zr_[q8 + 1])}, pk = {bflo(zk_[q8]), bfhi(zk_[q8])}, ck = {bflo(zk_[q8 + 1]), bfhi(zk_[q8 + 1])};
                        const f32x2 pv = {bflo(zv_[q8]), bfhi(zv_[q8])}, cv = {bflo(zv_[q8 + 1]), bfhi(zv_[q8 + 1])};
                        const f32x2 rv = cr + (pr - cr) * mr, kv = ck + (pk - ck) * mk, vv0 = cv + (pv - cv) * mv;
                        const f32x2 la2 = *(const LAS f32x2*)(lora + (1 * 16 + q) * AW + tc), lg2 = *(const LAS f32x2*)(lora + (2 * 16 + q) * AW + tc);
                        const f32x2 av = {sigmoid_fast(a0t.x + la2.x), sigmoid_fast(a0t.y + la2.y)};
                        f32x2 vv = vv0;
                        if (l > 0) { const f32x2 vf = {bflo(vfr[q8]), bfhi(vfr[q8])}; vv = vv + (vf - vv) * sgv[q8]; }
                        else *(GAS unsigned*)(VF + mo) = pk2(vv.x, vv.y);
                        f32x2 kk = kv * kkt; float ss = row16_sum(kk.x * kk.x + kk.y * kk.y);
                        ss += __builtin_bit_cast(float, __builtin_amdgcn_ds_swizzle(__builtin_bit_cast(int, ss), 0x401F));
                        kk = kk * __builtin_amdgcn_rsqf(fmaxf(ss, 1e-24f));
                        const f32x2 k2 = kv * (1.0f + (av - 1.0f) * kat);
                        const unsigned rqb = pk2(rv.x, rv.y), k2b = pk2(k2.x, k2.y);
                        float bon = row16_sum(bflo(rqb) * bflo(k2b) * rkt.x + bfhi(rqb) * bfhi(k2b) * rkt.y);
                        bon += __builtin_bit_cast(float, __builtin_amdgcn_ds_swizzle(__builtin_bit_cast(int, bon), 0x401F));
                        if ((lane & 31) == 0) BON[(size_t)(m0 + q) * AH + hh] = bon;
                        const unsigned vvb = pk2(vv.x, vv.y);
                        *(GAS unsigned*)(VN + mo) = vvb; *(GAS unsigned*)(GN + mo) = pk2(lg2.x, lg2.y);
                        const f32x2 cu = cumv[q8 + 1], cp = cumv[q8];
                        const f32x2 ep = {__expf(cu.x), __expf(cu.y)}, en = {__expf(-cu.x), __expf(-cu.y)}, epv = {__expf(cp.x), __expf(cp.y)};
                        const f32x2 ta2 = -(kk * epv), tr2 = rv * ep, tb2 = kk * av * en, tk2 = k2 * en;
                        const unsigned xa = pk2(ta2.x, ta2.y), xr = pk2(tr2.x, tr2.y), xb = pk2(tb2.x, tb2.y), xk = pk2(tk2.x, tk2.y);
                        const unsigned no = cbo + (unsigned)(grp * 16 + q) * 64 + c2;
                        *(GAS unsigned*)(NAT + 0 * ASZ + no) = xa; *(GAS unsigned*)(NAT + 1 * ASZ + no) = xr; *(GAS unsigned*)(NAT + 2 * ASZ + no) = xb; *(GAS unsigned*)(NAT + 3 * ASZ + no) = xk;
                        xa_[u] = xa; xv_[u] = vvb; xb_[u] = xb; xk_[u] = xk; }
                    const unsigned pp = hf ? (h4 ? 12 : 4) : (h4 ? 8 : 0);
#define TRST(x, a) do { *(GAS v2u*)(TR + (x) * ASZ + to + pp) = (v2u){LO2(a, 0, 1), LO2(a, 2, 3)}; *(GAS v2u*)(TR + (x) * ASZ + to + 64 + pp) = (v2u){HI2(a, 0, 1), HI2(a, 2, 3)}; } while (0)
                    TRST(0, xa_); TRST(1, xv_); TRST(2, xb_); TRST(3, xk_);
#undef TRST
                }
#undef LO2
#undef HI2
            }
            __syncthreads();
        }
        if (c.wave < 3) *(GAS f32x2*)(WL + (cbo >> 12) * 64 + c2) = (f32x2){__expf(cum.x), __expf(cum.y)};
    }
}

__host__ __device__ constexpr int tri_start(int t) { const int a = t >> 2, b = t & 3; return 8 * a * a + 4 * a + (b >= 1 ? 4 * a : 0) + (b >= 2 ? 4 * a + 4 : 0) + (b == 3 ? 4 * a + 4 : 0); }
static_assert(tri_start(1) == 0 && tri_start(2) == 4 && tri_start(5) == 16 && tri_start(64) == 2112, "tri_start");
__device__ __forceinline__ void phase_rwkv_chunk(const Ctx& c) {
    const GAS bf16* NAT = (const GAS bf16*)(c.R + R_NAT); const GAS bf16* TR = (const GAS bf16*)(c.R + R_TR); const GAS float* WLp = (const GAS float*)(c.R + R_WL);
    GAS v4u* CHM = (GAS v4u*)(c.R + R_CHM); GAS v4u* CHR = (GAS v4u*)(c.R + R_CHR); GAS v4u* NB = (GAS v4u*)(c.R + R_NT); GAS float* YL = (GAS float*)(c.R + R_YL);
    constexpr size_t ASZ = (size_t)NCHUNK * BLK;
    const int lane = c.lane, l31 = lane & 31, hi = lane >> 5;
    const int fo = l31 * 64 + 8 * hi;
    const int tpos = (lane & ~15) + vt_pos(lane & 15);
    const bool six = c.nb * 6 == NCHUNK;
    for (int cb = six ? (c.wave < 6 ? c.bid * 6 + c.wave : NCHUNK) : c.gw; cb < NCHUNK; cb += six ? NCHUNK : c.ngw) {
        unsigned lbase = (unsigned)c.wave * 16384u; asm volatile("" : "+v"(lbase));
        LAS float* la = (LAS float*)(c.lds + lbase);
        LAS unsigned short* lt = (LAS unsigned short*)(c.lds + lbase);
        const GAS bf16* At = NAT + 0 * ASZ + (size_t)cb * BLK; const GAS bf16* Rt = NAT + 1 * ASZ + (size_t)cb * BLK; const GAS bf16* Bh = NAT + 2 * ASZ + (size_t)cb * BLK; const GAS bf16* Kh = NAT + 3 * ASZ + (size_t)cb * BLK;
        const GAS bf16* AtT = TR + 0 * ASZ + (size_t)cb * BLK; const GAS bf16* VT = TR + 1 * ASZ + (size_t)cb * BLK; const GAS bf16* BhT = TR + 2 * ASZ + (size_t)cb * BLK; const GAS bf16* KhT = TR + 3 * ASZ + (size_t)cb * BLK;
        const GAS float* wl = WLp + (size_t)cb * 64;
#define LDF(P, blk, ks) (*(const GAS bf16x8*)((P) + (blk) * 2048 + (ks) * 16 + fo))
#define LDT(blk, ks) (*(const LAS bf16x8*)(lt + ((blk) * 32 + l31) * 72 + (ks) * 16 + 8 * hi))
        f32x16 acc[2][2];
#pragma unroll
        for (int rb = 0; rb < 2; ++rb)
#pragma unroll
            for (int cbk = 0; cbk < 2; ++cbk) { if (rb == 1 && cbk == 0) continue;
                acc[rb][cbk] = zero16();
#pragma unroll
                for (int ks = 0; ks < 4; ++ks) acc[rb][cbk] = MFMA32(LDF(Bh, rb, ks), LDF(At, cbk, ks), acc[rb][cbk]); }
#pragma unroll
        for (int rb = 0; rb < 2; ++rb)
#pragma unroll
            for (int cbk = 0; cbk < 2; ++cbk)
#pragma unroll
                for (int r = 0; r < 16; ++r) { if (rb == 1 && cbk == 0) continue; const int j = 32 * rb + 8 * (r >> 2) + 4 * hi + (r & 3), tq = 32 * cbk + l31; if (rb != cbk || j < tq) la[tri_start(tq) + j] = acc[rb][cbk][r]; }
        __builtin_amdgcn_sched_barrier(0);
        bf16x8 fAtT[2][4], fBhT[2][4];
#pragma unroll
        for (int bk = 0; bk < 2; ++bk)
#pragma unroll
            for (int ks = 0; ks < 4; ++ks) { fAtT[bk][ks] = LDF(AtT, bk, ks); fBhT[bk][ks] = LDF(BhT, bk, ks); }
        f32x2 Tc2[32];
#define TCV(j) Tc2[(j) >> 1][(j) & 1]
#pragma unroll
        for (int tq = 0; tq < 64; ++tq) { int ln_ = lane; asm volatile("" : "+v"(ln_));
            f32x2 sv = {ln_ == tq ? 1.f : 0.f, 0.f};
#pragma unroll
            for (int j = 0; j + 4 <= tq; j += 4) { const f32x4 a4 = *(const LAS f32x4*)(la + tri_start(tq) + j); sv += (f32x2){a4.x, a4.y} * Tc2[j >> 1]; sv += (f32x2){a4.z, a4.w} * Tc2[(j >> 1) + 1]; }
            if (tq & 3) { const int j0 = tq & ~3; const f32x4 a4 = *(const LAS f32x4*)(la + tri_start(tq) + j0);
                sv.x += a4.x * TCV(j0); if ((tq & 3) > 1) sv.y += a4.y * TCV(j0 + 1); if ((tq & 3) > 2) sv.x += a4.z * TCV(j0 + 2); }
            TCV(tq) = sv.x + sv.y; }
#pragma unroll
        for (int tq = 0; tq < 64; ++tq) lt[tq * 72 + tpos] = (unsigned short)f2bf(TCV(tq));
#undef TCV
        __builtin_amdgcn_sched_barrier(0);
        bf16x8 fBhN[2][4], fRtN[2][4];
#pragma unroll
        for (int bk = 0; bk < 2; ++bk)
#pragma unroll
            for (int ks = 0; ks < 4; ++ks) { fBhN[bk][ks] = LDF(Bh, bk, ks); fRtN[bk][ks] = LDF(Rt, bk, ks); }
        bf16x8 Ap[2][2][2];
#pragma unroll
        for (int rb = 0; rb < 2; ++rb)
#pragma unroll
            for (int cbk = 0; cbk < 2; ++cbk) { f32x16 a = zero16();
#pragma unroll
                for (int ks = 0; ks < 4; ++ks) a = MFMA32(LDT(rb, ks), fAtT[cbk][ks], a);
                Ap[rb][cbk][0] = pack8(a, 0); Ap[rb][cbk][1] = pack8(a, 8); }
        __builtin_amdgcn_sched_barrier(0);
        { const float wl0 = wl[l31], wl1 = wl[32 + l31];
#pragma unroll
          for (int rbp = 0; rbp < 2; ++rbp)
#pragma unroll
            for (int cbk = 0; cbk < 2; ++cbk) { f32x16 a = zero16();
#pragma unroll
                for (int rbt = 0; rbt < 2; ++rbt)
#pragma unroll
                    for (int s = 0; s < 2; ++s) a = MFMA32(Ap[rbt][rbp][s], fBhT[cbk][2 * rbt + s], a);
                const float wk = cbk ? wl1 : wl0;
#pragma unroll
                for (int r = 0; r < 16; ++r) { const int kp = 32 * rbp + 8 * (r >> 2) + 4 * hi + (r & 3), kq = 32 * cbk + l31; a[r] = a[r] * wk + keep_zero(wk, kp - kq); }
                CHM[((size_t)cb * 8 + cbk * 4 + 2 * rbp + 0) * 64 + lane] = __builtin_bit_cast(v4u, pack8(a, 0)); CHM[((size_t)cb * 8 + cbk * 4 + 2 * rbp + 1) * 64 + lane] = __builtin_bit_cast(v4u, pack8(a, 8)); } }
        __builtin_amdgcn_sched_barrier(0);
        bf16x8 Pb[2][2][2];
        {
#pragma unroll
          for (int rb = 0; rb < 2; ++rb)
#pragma unroll
            for (int cbk = 0; cbk < 2; ++cbk) { if (rb == 1 && cbk == 0) continue;
                f32x16 a = zero16();
#pragma unroll
                for (int ks = 0; ks < 4; ++ks) a = MFMA32(fBhN[rb][ks], fRtN[cbk][ks], a);
                if (rb == cbk) {
#pragma unroll
                for (int r = 0; r < 16; ++r) { const int j = 32 * rb + 8 * (r >> 2) + 4 * hi + (r & 3), tq = 32 * cbk + l31; a[r] = keep_neg(a[r], j - tq - 1); } }
                Pb[rb][cbk][0] = pack8(a, 0); Pb[rb][cbk][1] = pack8(a, 8); }
#pragma unroll
          for (int rbk = 0; rbk < 2; ++rbk)
#pragma unroll
            for (int cbt = 0; cbt < 2; ++cbt) { f32x16 a;
#pragma unroll
                for (int g = 0; g < 4; ++g) { const v2u w = *(const GAS v2u*)(Rt + (32 * cbt + l31) * 64 + 32 * rbk + 8 * g + 4 * hi); a[4 * g] = bflo(w.x); a[4 * g + 1] = bfhi(w.x); a[4 * g + 2] = bflo(w.y); a[4 * g + 3] = bfhi(w.y); }
#pragma unroll
                for (int rbj = 0; rbj < 2; ++rbj)
#pragma unroll
                    for (int s = 0; s < 2; ++s) { if (rbj == 1 && cbt == 0) continue; a = MFMA32(Ap[rbj][rbk][s], Pb[rbj][cbt][s], a); }
                CHR[((size_t)cb * 8 + cbt * 4 + 2 * rbk + 0) * 64 + lane] = __builtin_bit_cast(v4u, pack8(a, 0)); CHR[((size_t)cb * 8 + cbt * 4 + 2 * rbk + 1) * 64 + lane] = __builtin_bit_cast(v4u, pack8(a, 8)); } }
        __builtin_amdgcn_sched_barrier(0);
        f32x4 wlr[2][4];
#pragma unroll
        for (int rbk = 0; rbk < 2; ++rbk)
#pragma unroll
            for (int g = 0; g < 4; ++g) wlr[rbk][g] = *(const GAS f32x4*)(wl + 32 * rbk + 8 * g + 4 * hi);
        bf16x8 Vp[2][2][2];
        { bf16x8 Pk[2][2][2];
#pragma unroll
          for (int rb = 0; rb < 2; ++rb)
#pragma unroll
            for (int cbk = 0; cbk < 2; ++cbk) { if (rb == 1 && cbk == 0) continue;
                f32x16 a = zero16();
#pragma unroll
                for (int ks = 0; ks < 4; ++ks) a = MFMA32(LDF(Kh, rb, ks), LDF(At, cbk, ks), a);
                if (rb == cbk) {
#pragma unroll
                for (int r = 0; r < 16; ++r) { const int j = 32 * rb + 8 * (r >> 2) + 4 * hi + (r & 3), tq = 32 * cbk + l31; a[r] = keep_neg(a[r], j - tq); } }
                Pk[rb][cbk][0] = pack8(a, 0); Pk[rb][cbk][1] = pack8(a, 8); }
          bf16x8 X2b[2][2][2];
#pragma unroll
          for (int rbt = 0; rbt < 2; ++rbt)
#pragma unroll
            for (int cbv = 0; cbv < 2; ++cbv) { f32x16 a = zero16();
#pragma unroll
                for (int rbj = 0; rbj < 2; ++rbj)
#pragma unroll
                    for (int s = 0; s < 2; ++s) { if (rbj == 1 && rbt == 0) continue; a = MFMA32(Pk[rbj][rbt][s], LDF(VT, cbv, 2 * rbj + s), a); }
                X2b[rbt][cbv][0] = pack8(a, 0); X2b[rbt][cbv][1] = pack8(a, 8); }
#pragma unroll
          for (int rb = 0; rb < 2; ++rb)
#pragma unroll
            for (int cbv = 0; cbv < 2; ++cbv) { f32x16 a = zero16();
#pragma unroll
                for (int ks = 0; ks < 4; ++ks) a = MFMA32(LDT(rb, ks), X2b[ks >> 1][cbv][ks & 1], a);
                Vp[rb][cbv][0] = pack8(a, 0); Vp[rb][cbv][1] = pack8(a, 8); } }
        __builtin_amdgcn_sched_barrier(0);
#pragma unroll
        for (int rbk = 0; rbk < 2; ++rbk)
#pragma unroll
            for (int cbv = 0; cbv < 2; ++cbv) { f32x16 a = zero16();
#pragma unroll
                for (int ks = 0; ks < 4; ++ks) { a = MFMA32(LDF(BhT, rbk, ks), Vp[ks >> 1][cbv][ks & 1], a); a = MFMA32(LDF(KhT, rbk, ks), LDF(VT, cbv, ks), a); }
#pragma unroll
                for (int g = 0; g < 4; ++g) { const f32x4 w4 = wlr[rbk][g]; a[4 * g] *= w4.x; a[4 * g + 1] *= w4.y; a[4 * g + 2] *= w4.z; a[4 * g + 3] *= w4.w; }
                NB[(((size_t)cb * 2 + cbv) * 4 + 2 * rbk + 0) * 64 + lane] = __builtin_bit_cast(v4u, pack8(a, 0)); NB[(((size_t)cb * 2 + cbv) * 4 + 2 * rbk + 1) * 64 + lane] = __builtin_bit_cast(v4u, pack8(a, 8)); }
        __builtin_amdgcn_sched_barrier(0);
        f32x16 yl[2][2];
        {
#pragma unroll
          for (int rbv = 0; rbv < 2; ++rbv)
#pragma unroll
            for (int cbt = 0; cbt < 2; ++cbt) { f32x16 a = zero16();
#pragma unroll
                for (int rbj = 0; rbj < 2; ++rbj)
#pragma unroll
                    for (int s = 0; s < 2; ++s) { if (rbj == 1 && cbt == 0) continue; a = MFMA32(Vp[rbj][rbv][s], Pb[rbj][cbt][s], a); }
                yl[rbv][cbt] = PROBE_NO_VP ? zero16() : a; } }
        __builtin_amdgcn_sched_barrier(0);
        { bf16x8 Pk2[2][2][2];
#pragma unroll
          for (int rb = 0; rb < 2; ++rb)
#pragma unroll
            for (int cbk = 0; cbk < 2; ++cbk) { if (rb == 1 && cbk == 0) continue;
                f32x16 a = zero16();
#pragma unroll
                for (int ks = 0; ks < 4; ++ks) a = MFMA32(LDF(Kh, rb, ks), LDF(Rt, cbk, ks), a);
                if (rb == cbk) {
#pragma unroll
                for (int r = 0; r < 16; ++r) { const int j = 32 * rb + 8 * (r >> 2) + 4 * hi + (r & 3), tq = 32 * cbk + l31; a[r] = keep_neg(a[r], j - tq - 1); } }
                Pk2[rb][cbk][0] = pack8(a, 0); Pk2[rb][cbk][1] = pack8(a, 8); }
#pragma unroll
          for (int rbv = 0; rbv < 2; ++rbv)
#pragma unroll
            for (int cbt = 0; cbt < 2; ++cbt) { f32x16 a = yl[rbv][cbt];
#pragma unroll
                for (int rbj = 0; rbj < 2; ++rbj)
#pragma unroll
                    for (int s = 0; s < 2; ++s) { if (rbj == 1 && cbt == 0) continue; a = MFMA32(LDF(VT, rbv, 2 * rbj + s), Pk2[rbj][cbt][s], a); }
#pragma unroll
                for (int g = 0; g < 4; ++g) {
#ifdef PROBE_COPY
                    const v2u w = *(const GAS v2u*)(Kh + (32 * cbt + l31) * 64 + 32 * rbv + 8 * g + 4 * hi); const v2u w2 = *(const GAS v2u*)(VT + (32 * cbt + l31) * 64 + 32 * rbv + 8 * g + 4 * hi);
                    a[4 * g] = bflo(w.x) + bflo(w2.x); a[4 * g + 1] = bfhi(w.x) + bfhi(w2.x); a[4 * g + 2] = bflo(w.y) + bflo(w2.y); a[4 * g + 3] = bfhi(w.y) + bfhi(w2.y);
#endif
                    *(GAS f32x4*)(YL + (size_t)cb * BLK + (32 * cbt + l31) * 64 + 32 * rbv + 8 * g + 4 * hi) = (f32x4){a[4 * g], a[4 * g + 1], a[4 * g + 2], a[4 * g + 3]}; } } }
#undef LDF
#undef LDT
    }
}

constexpr int SCAN_WGS = 6;
__device__ __forceinline__ void phase_rwkv_scan2(const Ctx& c) {
    const GAS v4u* CHM = (const GAS v4u*)(c.R + R_CHM); GAS v4u* CHS = (GAS v4u*)(c.R + R_CHS); const GAS v4u* NB = (const GAS v4u*)(c.R + R_NT);
    const int lane = c.lane;
    if (c.nb < 2 * SCAN_WGS || c.bid < c.nb - SCAN_WGS) return;
    const int wg = c.bid - (c.nb - SCAN_WGS), bhl = c.wave >> 2, rbk = (c.wave >> 1) & 1, cbv = c.wave & 1, bh = wg * 2 + bhl; const size_t cb0 = (size_t)bh * (SEQ / 64);
    LAS v4u* xs = (LAS v4u*)c.lds;
    const int myslot = c.wave * 128 + lane, peer = (c.wave ^ 2) * 128 + lane;
    bf16x8 own[2], oth[2];
#pragma unroll
    for (int i = 0; i < 2; ++i) { own[i] = (bf16x8){0, 0, 0, 0, 0, 0, 0, 0}; oth[i] = own[i]; }
    constexpr int NBUF = 6;
    v4u mq[NBUF][4], nq[NBUF][2];
#define SCAN_LOAD(buf, cc) do { _Pragma("unroll") for (int i_ = 0; i_ < 4; ++i_) mq[buf][i_] = CHM[((cb0 + (cc)) * 8 + rbk * 4 + i_) * 64 + lane]; \
                                _Pragma("unroll") for (int i_ = 0; i_ < 2; ++i_) nq[buf][i_] = NB[(((cb0 + (cc)) * 2 + cbv) * 4 + 2 * rbk + i_) * 64 + lane]; } while (0)
    SCAN_LOAD(0, 0); SCAN_LOAD(1, 1); SCAN_LOAD(2, 2); SCAN_LOAD(3, 3); SCAN_LOAD(4, 4);
    __syncthreads();
    for (int cc0 = 0; cc0 < SEQ / 64; cc0 += NBUF) {
#pragma unroll
        for (int u = 0; u < NBUF; ++u) { const int cc = cc0 + u;
            if (cc < SEQ / 64) {
                if (cc + 5 < SEQ / 64) SCAN_LOAD((u + 5) % NBUF, cc + 5);
#pragma unroll
                for (int i = 0; i < 2; ++i) CHS[((cb0 + cc) * 8 + cbv * 4 + 2 * rbk + i) * 64 + lane] = __builtin_bit_cast(v4u, own[i]);
                f32x16 a;
#pragma unroll
                for (int hf = 0; hf < 2; ++hf) { const v4u w = nq[u][hf];
                    a[8 * hf + 0] = bflo(w.x); a[8 * hf + 1] = bfhi(w.x); a[8 * hf + 2] = bflo(w.y); a[8 * hf + 3] = bfhi(w.y);
                    a[8 * hf + 4] = bflo(w.z); a[8 * hf + 5] = bfhi(w.z); a[8 * hf + 6] = bflo(w.w); a[8 * hf + 7] = bfhi(w.w); }
#pragma unroll
                for (int ks = 0; ks < 4; ++ks) a = MFMA32(__builtin_bit_cast(bf16x8, mq[u][ks]), (ks >> 1) == rbk ? own[ks & 1] : oth[ks & 1], a);
                own[0] = pack8(a, 0); own[1] = pack8(a, 8);
                LAS v4u* slot = xs + (cc & 1) * 1024;
                slot[myslot] = __builtin_bit_cast(v4u, own[0]); slot[myslot + 64] = __builtin_bit_cast(v4u, own[1]);
                __syncthreads();
                oth[0] = __builtin_bit_cast(bf16x8, slot[peer]); oth[1] = __builtin_bit_cast(bf16x8, slot[peer + 64]);
            }
        }
    }
#undef SCAN_LOAD
    __syncthreads();
}

__device__ __forceinline__ void phase_rwkv_out(const Ctx& c, int l) {
    const GAS v4u* CHR = (const GAS v4u*)(c.R + R_CHR); const GAS v4u* CHS = (const GAS v4u*)(c.R + R_CHS); const GAS float* YL = (const GAS float*)(c.R + R_YL);
    const GAS bf16* VN = (const GAS bf16*)(c.R + R_VG); const GAS bf16* GN = VN + (size_t)M * AW; const GAS float* BON = (const GAS float*)(c.R + R_BON); GAS bf16* YC = (GAS bf16*)(c.ws + WS_XN);
    const GAS float* lng = c.in(I_LNG) + l * AW; const GAS float* lnb = c.in(I_LNB) + l * AW;
    const int lane = c.lane, l31 = lane & 31, hi = lane >> 5;
    const bool six = c.nb * 6 == NCHUNK;
    for (int cb = six ? (c.wave < 6 ? c.bid * 6 + c.wave : NCHUNK) : c.gw; cb < NCHUNK; cb += six ? NCHUNK : c.ngw) {
        const int bh = cb / (SEQ / 64), cc = cb % (SEQ / 64), b = bh / AH, h = bh % AH;
#pragma unroll
        for (int cbt = 0; cbt < 2; ++cbt) {
            f32x16 y[2];
#pragma unroll
            for (int rbv = 0; rbv < 2; ++rbv) {
#pragma unroll
                for (int g = 0; g < 4; ++g) { const f32x4 q4 = *(const GAS f32x4*)(YL + (size_t)cb * BLK + (32 * cbt + l31) * 64 + 32 * rbv + 8 * g + 4 * hi); y[rbv][4 * g] = q4.x * PROBE_YL; y[rbv][4 * g + 1] = q4.y * PROBE_YL; y[rbv][4 * g + 2] = q4.z * PROBE_YL; y[rbv][4 * g + 3] = q4.w * PROBE_YL; }
#pragma unroll
                for (int ks = 0; ks < PROBE_KS; ++ks) y[rbv] = MFMA32(__builtin_bit_cast(bf16x8, CHS[((size_t)cb * 8 + rbv * 4 + ks) * 64 + lane]), __builtin_bit_cast(bf16x8, CHR[((size_t)cb * 8 + cbt * 4 + ks) * 64 + lane]), y[rbv]);
            }
            float s = 0.f;
#pragma unroll
            for (int r = 0; r < 16; ++r) s += y[0][r] + y[1][r];
            s += __shfl_xor(s, 32);
            const float mean = s * (1.0f / 64.0f); float q = 0.f;
#pragma unroll
            for (int r = 0; r < 16; ++r) { y[0][r] -= mean; y[1][r] -= mean; q += y[0][r] * y[0][r] + y[1][r] * y[1][r]; }
            q += __shfl_xor(q, 32);
            const float rstd = __builtin_amdgcn_rsqf(q * (1.0f / 64.0f) + 64e-5f);
            const size_t m = (size_t)b * SEQ + cc * 64 + 32 * cbt + l31; const float bon = BON[m * AH + h];
#pragma unroll
            for (int rbv = 0; rbv < 2; ++rbv)
#pragma unroll
                for (int g = 0; g < 4; ++g) { const int ch = h * 64 + 32 * rbv + 8 * g + 4 * hi;
                    const f32x4 g4 = *(const GAS f32x4*)(lng + ch), b4 = *(const GAS f32x4*)(lnb + ch); const v2u vv = *(const GAS v2u*)(VN + m * AW + ch), gg = *(const GAS v2u*)(GN + m * AW + ch);
                    const float o0 = (y[rbv][4 * g] * rstd * g4.x + b4.x + bon * bflo(vv.x)) * bflo(gg.x), o1 = (y[rbv][4 * g + 1] * rstd * g4.y + b4.y + bon * bfhi(vv.x)) * bfhi(gg.x);
                    const float o2 = (y[rbv][4 * g + 2] * rstd * g4.z + b4.z + bon * bflo(vv.y)) * bflo(gg.y), o3 = (y[rbv][4 * g + 3] * rstd * g4.w + b4.w + bon * bfhi(vv.y)) * bfhi(gg.y);
#ifdef RWKV_SANITIZE
                    { GAS float* oo[4] = {nullptr, nullptr, nullptr, nullptr}; (void)oo; }
#define SAN(x) ((x) == (x) && fabsf(x) < 1e30f ? (x) : 0.f)
                    *(GAS v2u*)(YC + m * D + ch) = (v2u){pk2(SAN(o0), SAN(o1)), pk2(SAN(o2), SAN(o3))}; }
#else
                    *(GAS v2u*)(YC + m * D + ch) = (v2u){pk2(o0, o1), pk2(o2, o3)}; }
#endif
        }
    }
}
__device__ __forceinline__ void phase_mla_prep(const Ctx& c, int l) {
    const GAS bf16* Z = (const GAS bf16*)(c.R + R_Z);
    GAS bf16* Q = (GAS bf16*)(c.R + R_Q); GAS bf16* K = (GAS bf16*)(c.R + R_K); GAS bf16* V = (GAS bf16*)(c.R + R_V);
    const GAS float* qng = c.in(I_QNG) + l * 256; const GAS float* wuq = c.in(I_WUQ) + (size_t)l * 256 * QP; const GAS float* kvng = c.in(I_KVNG) + l * 128; const GAS float* wukv = c.in(I_WUKV) + (size_t)l * 128 * 768;
    const GAS float* qhg = c.in(I_QHG) + l * QKD; const GAS float* khg = c.in(I_KHG) + l * QKD; const GAS int* pos = (const GAS int*)c.in(I_POS);
    LAS float* cqn = (LAS float*)c.lds;
    LAS float* ckn = cqn + 16 * 256;
    LAS float* krs = ckn + 16 * 128;
    LAS float* qb = krs + 16 * 32;
    LAS float* kvb = qb + 16 * QP;
    const float qscale = 1.4426950408889634f / sqrtf((float)QKD);
    for (int grp = c.bid; grp < M / 16; grp += c.nb) {
        const int m0 = grp * 16;
        __syncthreads();
#pragma unroll
        for (int q = 0; q < 2; ++q) { const int tk = 2 * c.wave + q; const GAS bf16* zr = Z + (size_t)(m0 + tk) * ZP;
            float x[4]; float ss = 0.f;
#pragma unroll
            for (int i = 0; i < 4; ++i) { x[i] = bf2f(zr[ZCQ + c.lane + 64 * i]); ss += x[i] * x[i]; }
            float rstd = __builtin_amdgcn_rsqf(wave_sum(ss) * (1.0f / 256.0f) + EPS);
#pragma unroll
            for (int i = 0; i < 4; ++i) cqn[tk * 256 + c.lane + 64 * i] = x[i] * rstd * qng[c.lane + 64 * i];
            float y[2]; ss = 0.f;
#pragma unroll
            for (int i = 0; i < 2; ++i) { y[i] = bf2f(zr[ZCKV + c.lane + 64 * i]); ss += y[i] * y[i]; }
            rstd = __builtin_amdgcn_rsqf(wave_sum(ss) * (1.0f / 128.0f) + EPS);
#pragma unroll
            for (int i = 0; i < 2; ++i) ckn[tk * 128 + c.lane + 64 * i] = y[i] * rstd * kvng[c.lane + 64 * i];
            if (c.lane < 32) krs[tk * 32 + c.lane] = bf2f(zr[ZKR + c.lane]);
        }
        __syncthreads();
        for (int col = c.tid; col < QP; col += NTHR) {
            float acc[16];
#pragma unroll
            for (int q = 0; q < 16; ++q) acc[q] = 0.f;
            for (int kx = 0; kx < 256; ++kx) { const float w = wuq[(size_t)kx * QP + col];
#pragma unroll
                for (int q = 0; q < 16; ++q) acc[q] += cqn[q * 256 + kx] * w; }
#pragma unroll
            for (int q = 0; q < 16; ++q) qb[q * QP + col] = acc[q];
        }
        for (int col = c.tid; col < 768; col += NTHR) {
            float acc[16];
#pragma unroll
            for (int q = 0; q < 16; ++q) acc[q] = 0.f;
            for (int kx = 0; kx < 128; ++kx) { const float w = wukv[(size_t)kx * 768 + col];
#pragma unroll
                for (int q = 0; q < 16; ++q) acc[q] += ckn[q * 128 + kx] * w; }
#pragma unroll
            for (int q = 0; q < 16; ++q) kvb[q * 768 + col] = acc[q];
        }
        __syncthreads();
        for (int pr = c.wave; pr < 16 * AH; pr += NWAVES) {
            const int tk = pr / AH, h = pr % AH, m = m0 + tk; const int ln = c.lane, l32 = ln & 31, fi = ln & 15;
            const float ang = (float)pos[m] * exp2f(-(float)(2 * fi) * (13.287712379549449f / 32.0f));
            const float cs = cosf(ang), sn = sinf(ang);
            { const float x0 = qb[tk * QP + h * QKD + ln], x1 = ln < 32 ? qb[tk * QP + h * QKD + 64 + l32] : 0.f;
              const float rstd = __builtin_amdgcn_rsqf(wave_sum(x0 * x0 + x1 * x1) * (1.0f / QKD) + EPS);
              const float n0 = x0 * rstd * qhg[ln], n1 = x1 * rstd * qhg[64 + l32];
              const float pn = __shfl_xor(n1, 16);
              const float ro = (ln & 16) ? (pn * sn + n1 * cs) : (n1 * cs - pn * sn);
              Q[(size_t)m * QP + h * QKD + ln] = (bf16)f2bf(n0 * qscale);
              if (ln < 32) Q[(size_t)m * QP + h * QKD + 64 + ln] = (bf16)f2bf(ro * qscale); }
            { const float x0 = kvb[tk * 768 + h * 128 + ln], x1 = ln < 32 ? krs[tk * 32 + l32] : 0.f;
              const float rstd = __builtin_amdgcn_rsqf(wave_sum(x0 * x0 + x1 * x1) * (1.0f / QKD) + EPS);
              const float n0 = x0 * rstd * khg[ln], n1 = x1 * rstd * khg[64 + l32];
              const float pn = __shfl_xor(n1, 16);
              const float ro = (ln & 16) ? (pn * sn + n1 * cs) : (n1 * cs - pn * sn);
              K[(size_t)m * QP + h * QKD + ln] = (bf16)f2bf(n0);
              if (ln < 32) K[(size_t)m * QP + h * QKD + 64 + ln] = (bf16)f2bf(ro); }
            { const int sq = m % SEQ, bb = m / SEQ; V[((size_t)((bb * AH + h) * 64 + ln)) * SEQ + (sq & ~15) + vt_pos(sq & 15)] = (bf16)f2bf(kvb[tk * 768 + h * 128 + 64 + ln]); }
        }
    }
    __syncthreads();
}


__device__ __forceinline__ void phase_mla_post1(const Ctx& c, int l) {
    const GAS bf16* Z = (const GAS bf16*)(c.R + R_Z); const GAS bf16* QR = (const GAS bf16*)(c.R + R_QR); const GAS bf16* KVR = (const GAS bf16*)(c.R + R_KVR);
    GAS bf16* Q = (GAS bf16*)(c.R + R_Q); GAS bf16* K = (GAS bf16*)(c.R + R_K); GAS bf16* Vt = (GAS bf16*)(c.R + R_V);
    const GAS float* qhg = c.in(I_QHG) + l * QKD; const GAS float* khg = c.in(I_KHG) + l * QKD; const GAS int* pos = (const GAS int*)c.in(I_POS);
    LAS unsigned short* vt = (LAS unsigned short*)c.lds;
    const float qscale = 1.4426950408889634f / sqrtf((float)QKD);
    const int ln = c.lane, l32 = ln & 31, fi = ln & 15;
    const float g0q = qhg[ln], g1q = qhg[64 + l32], g0k = khg[ln], g1k = khg[64 + l32];
    const float ifr = exp2f(-(float)(2 * fi) * (13.287712379549449f / 32.0f));
    for (int item = c.bid; item < M / 64; item += c.nb) {
        __syncthreads();
        float zq[4], zk2[2], xq0[AH], xq1[AH], xk0[AH], xv0[AH], krv; int pq;
#define P1_LOAD(tok) do { const GAS bf16* zr_ = Z + (size_t)(tok) * ZP; \
            _Pragma("unroll") for (int i = 0; i < 4; ++i) nzq[i] = bf2f(zr_[ZCQ + ln + 64 * i]); \
            _Pragma("unroll") for (int i = 0; i < 2; ++i) nzk[i] = bf2f(zr_[ZCKV + ln + 64 * i]); \
            nkr = ln < 32 ? bf2f(zr_[ZKR + l32]) : 0.f; npq = pos[tok]; \
            _Pragma("unroll") for (int h = 0; h < AH; ++h) { nq0[h] = bf2f(QR[(size_t)(tok) * 768 + h * 128 + ln]); nq1[h] = ln < 32 ? bf2f(QR[(size_t)(tok) * 768 + h * 128 + 64 + l32]) : 0.f; \
                nk0[h] = bf2f(KVR[(size_t)(tok) * 768 + h * 128 + ln]); nv0[h] = bf2f(KVR[(size_t)(tok) * 768 + h * 128 + 64 + ln]); } } while (0)
        float nzq[4], nzk[2], nq0[AH], nq1[AH], nk0[AH], nv0[AH], nkr; int npq;
        P1_LOAD(item * 64 + c.wave * 8);
        for (int q = 0; q < 8; ++q) {
            const int tl = c.wave * 8 + q, m = item * 64 + tl;
#pragma unroll
            for (int i = 0; i < 4; ++i) zq[i] = nzq[i];
            zk2[0] = nzk[0]; zk2[1] = nzk[1]; krv = nkr; pq = npq;
#pragma unroll
            for (int h = 0; h < AH; ++h) { xq0[h] = nq0[h]; xq1[h] = nq1[h]; xk0[h] = nk0[h]; xv0[h] = nv0[h]; }
            if (q + 1 < 8) P1_LOAD(m + 1);
            const float ang = (float)pq * ifr;
            const float rq = __builtin_amdgcn_rsqf(wave_sum((zq[0] * zq[0] + zq[1] * zq[1]) + (zq[2] * zq[2] + zq[3] * zq[3])) * (1.0f / 256.0f) + EPS);
            const float rkv = __builtin_amdgcn_rsqf(wave_sum(zk2[0] * zk2[0] + zk2[1] * zk2[1]) * (1.0f / 128.0f) + EPS);
            float rev = ang * 0.15915494309189535f; rev -= floorf(rev);
            const float cs = __builtin_amdgcn_cosf(rev), sn = __builtin_amdgcn_sinf(rev);
            const int tp = (tl & ~15) + vt_pos(tl & 15);
#pragma unroll
            for (int h = 0; h < AH; ++h) {
                { const float x0 = xq0[h] * rq, x1 = xq1[h] * rq;
                  const float rstd = __builtin_amdgcn_rsqf(wave_sum(x0 * x0 + x1 * x1) * (1.0f / QKD) + EPS);
                  const float n0 = x0 * rstd * g0q, n1 = x1 * rstd * g1q; const float pn = __shfl_xor(n1, 16);
                  const float ro = (ln & 16) ? (pn * sn + n1 * cs) : (n1 * cs - pn * sn);
                  Q[(size_t)m * QP + h * QKD + ln] = (bf16)f2bf(n0 * qscale); if (ln < 32) Q[(size_t)m * QP + h * QKD + 64 + ln] = (bf16)f2bf(ro * qscale); }
                { const float x0 = xk0[h] * rkv, x1 = krv;
                  const float rstd = __builtin_amdgcn_rsqf(wave_sum(x0 * x0 + x1 * x1) * (1.0f / QKD) + EPS);
                  const float n0 = x0 * rstd * g0k, n1 = x1 * rstd * g1k; const float pn = __shfl_xor(n1, 16);
                  const float ro = (ln & 16) ? (pn * sn + n1 * cs) : (n1 * cs - pn * sn);
                  K[(size_t)m * QP + h * QKD + ln] = (bf16)f2bf(n0); if (ln < 32) K[(size_t)m * QP + h * QKD + 64 + ln] = (bf16)f2bf(ro); }
                vt[(h * 64 + ln) * 72 + tp] = (unsigned short)f2bf(xv0[h] * rkv);
            }
        }
#undef P1_LOAD
        __syncthreads();
        const int b = (item * 64) / SEQ, s0 = (item * 64) % SEQ;
        for (int p = c.tid; p < AW * 8; p += NTHR) { const int row = p >> 3, pc = p & 7; const int h = row >> 6, d = row & 63;
            *(GAS v4u*)(Vt + ((size_t)((b * AH + h) * 64 + d)) * SEQ + s0 + 8 * pc) = *(const LAS v4u*)(vt + row * 72 + 8 * pc); }
    }
    __syncthreads();
}
__device__ __forceinline__ float oct_sum(float v) { v += dpp_mov<0xB1>(v); v += dpp_mov<0x4E>(v); v += dpp_mov<0x141>(v); return v; }
__device__ __forceinline__ float sq8(const v4u w) { const float a = bflo(w.x), b = bfhi(w.x), c_ = bflo(w.y), d = bfhi(w.y), e = bflo(w.z), f = bfhi(w.z), g = bflo(w.w), h = bfhi(w.w);
    return ((a * a + b * b) + (c_ * c_ + d * d)) + ((e * e + f * f) + (g * g + h * h)); }
__device__ __forceinline__ v4u p1_head(const v4u w, float sc, const float (&g)[8], const f32x4 c0, const f32x4 c1, const f32x4 s0, const f32x4 s1, bool act, bool rope, float sgn, float oscale) {
    float x[8]; x[0] = bflo(w.x) * sc; x[1] = bfhi(w.x) * sc; x[2] = bflo(w.y) * sc; x[3] = bfhi(w.y) * sc; x[4] = bflo(w.z) * sc; x[5] = bfhi(w.z) * sc; x[6] = bflo(w.w) * sc; x[7] = bfhi(w.w) * sc;
    float ss = ((x[0] * x[0] + x[1] * x[1]) + (x[2] * x[2] + x[3] * x[3])) + ((x[4] * x[4] + x[5] * x[5]) + (x[6] * x[6] + x[7] * x[7]));
    ss = row16_sum(act ? ss : 0.f);
    const float rstd = __builtin_amdgcn_rsqf(ss * (1.0f / QKD) + EPS);
    float o[8];
#pragma unroll
    for (int j = 0; j < 8; ++j) { const float n = x[j] * rstd * g[j]; const float pn = dpp_mov<0x4E>(n); const float cs = j < 4 ? c0[j & 3] : c1[j & 3], sn = j < 4 ? s0[j & 3] : s1[j & 3];
        const float ro = n * cs + sgn * (pn * sn); o[j] = (rope ? ro : n) * oscale; }
    return (v4u){pk2(o[0], o[1]), pk2(o[2], o[3]), pk2(o[4], o[5]), pk2(o[6], o[7])};
}
__device__ __forceinline__ void phase_mla_post1b(const Ctx& c, int l) {
    const GAS bf16* Z = (const GAS bf16*)(c.R + R_Z); const GAS bf16* QR = (const GAS bf16*)(c.R + R_QR); const GAS bf16* KVR = (const GAS bf16*)(c.R + R_KVR);
    GAS bf16* Q = (GAS bf16*)(c.R + R_Q); GAS bf16* K = (GAS bf16*)(c.R + R_K); GAS bf16* Vt = (GAS bf16*)(c.R + R_V);
    const GAS float* qhg = c.in(I_QHG) + l * QKD; const GAS float* khg = c.in(I_KHG) + l * QKD; const GAS int* pos = (const GAS int*)c.in(I_POS);
    constexpr int VTP = 68, TKP = 40;
    LAS unsigned short* vt = (LAS unsigned short*)c.lds;
    LAS float* tk = (LAS float*)(c.lds + 384 * VTP * 2);
    const float qscale = 1.4426950408889634f / sqrtf((float)QKD);
    const int ln = c.lane, i16 = ln & 15, g16 = ln >> 4, ic = i16 < 12 ? i16 : 11, s8 = ln & 7, t8 = ln >> 3;
    float gq[8], gk[8];
#pragma unroll
    for (int j = 0; j < 8; ++j) { gq[j] = qhg[8 * ic + j]; gk[j] = khg[8 * ic + j]; }
    const float ifa = exp2f(-(float)(2 * s8) * (13.287712379549449f / 32.0f)), ifb = exp2f(-(float)(2 * (s8 + 8)) * (13.287712379549449f / 32.0f));
    const bool act = i16 < 12, rope = i16 >= 8, nope = i16 < 8; const float sgn = (i16 & 2) ? 1.f : -1.f;
    for (int item = c.bid; item < M / 64; item += c.nb) {
        __syncthreads();
        {
            const int tok = item * 64 + c.wave * 8 + t8; const GAS bf16* zr = Z + (size_t)tok * ZP;
            v4u a[4], b2[2];
#pragma unroll
            for (int i = 0; i < 4; ++i) a[i] = *(const GAS v4u*)(zr + ZCQ + 32 * s8 + 8 * i);
#pragma unroll
            for (int i = 0; i < 2; ++i) b2[i] = *(const GAS v4u*)(zr + ZCKV + 16 * s8 + 8 * i);
            const int pq = pos[tok];
            const float ssq = oct_sum((sq8(a[0]) + sq8(a[1])) + (sq8(a[2]) + sq8(a[3]))), ssk = oct_sum(sq8(b2[0]) + sq8(b2[1]));
            const float rq = __builtin_amdgcn_rsqf(ssq * (1.0f / 256.0f) + EPS), rkv = __builtin_amdgcn_rsqf(ssk * (1.0f / 128.0f) + EPS);
            float ra = ((float)pq * ifa) * 0.15915494309189535f; ra -= floorf(ra); float rb = ((float)pq * ifb) * 0.15915494309189535f; rb -= floorf(rb);
            LAS float* tp_ = tk + (c.wave * 8 + t8) * TKP;
            tp_[4 + s8] = __builtin_amdgcn_cosf(ra); tp_[12 + s8] = __builtin_amdgcn_cosf(rb); tp_[20 + s8] = __builtin_amdgcn_sinf(ra); tp_[28 + s8] = __builtin_amdgcn_sinf(rb);
            if (s8 == 0) { tp_[0] = rq; tp_[1] = rkv; }
        }
        LDS_WAIT();
#pragma unroll 2
        for (int q = 0; q < 8; ++q) { const int tl = c.wave * 8 + q, m = item * 64 + tl; const float rkv = tk[tl * TKP + 1]; const int tp = (tl & ~15) + vt_pos(tl & 15);
            float xv[AH];
#pragma unroll
            for (int h = 0; h < AH; ++h) xv[h] = bf2f(KVR[(size_t)m * 768 + h * 128 + 64 + ln]);
#pragma unroll
            for (int h = 0; h < AH; ++h) vt[(h * 64 + ln) * VTP + tp] = (unsigned short)f2bf(xv[h] * rkv); }
        for (int pb = 0; pb < 12; pb += 4) {
            v4u wq[4], wk[4], wr[4];
#pragma unroll
            for (int u = 0; u < 4; ++u) { const int idx = (pb + u) * 4 + g16, t = idx & 7, h = idx >> 3; const size_t m = (size_t)(item * 64 + c.wave * 8 + t);
                wq[u] = *(const GAS v4u*)(QR + m * 768 + h * 128 + 8 * ic); wk[u] = *(const GAS v4u*)(KVR + m * 768 + h * 128 + 8 * (i16 & 7)); wr[u] = *(const GAS v4u*)(Z + m * ZP + ZKR + 8 * (ic & 3)); }
#pragma unroll
            for (int u = 0; u < 4; ++u) { const int idx = (pb + u) * 4 + g16, t = idx & 7, h = idx >> 3; const size_t m = (size_t)(item * 64 + c.wave * 8 + t);
                const LAS float* tp_ = tk + (c.wave * 8 + t) * TKP; const float rq = tp_[0], rkv = tp_[1];
                const LAS f32x4* cp = (const LAS f32x4*)(tp_ + 4 + 8 * (i16 & 1)); const LAS f32x4* sp = (const LAS f32x4*)(tp_ + 20 + 8 * (i16 & 1));
                const f32x4 c0 = cp[0], c1 = cp[1], s0 = sp[0], s1 = sp[1];
                const v4u oq = p1_head(wq[u], rq, gq, c0, c1, s0, s1, act, rope, sgn, qscale);
                v4u kw; kw.x = nope ? wk[u].x : wr[u].x; kw.y = nope ? wk[u].y : wr[u].y; kw.z = nope ? wk[u].z : wr[u].z; kw.w = nope ? wk[u].w : wr[u].w;
                const v4u ok = p1_head(kw, nope ? rkv : 1.0f, gk, c0, c1, s0, s1, act, rope, sgn, 1.0f);
                if (act) { *(GAS v4u*)(Q + m * QP + h * QKD + 8 * i16) = oq; *(GAS v4u*)(K + m * QP + h * QKD + 8 * i16) = ok; } }
        }
        __syncthreads();
        const int b = (item * 64) / SEQ, s0_ = (item * 64) % SEQ;
        for (int p = c.tid; p < AW * 8; p += NTHR) { const int row = p >> 3, pc = p & 7; const int h = row >> 6, d = row & 63;
            const LAS v2u* src = (const LAS v2u*)(vt + row * VTP + 8 * pc); const v2u lo = src[0], hi2 = src[1];
            *(GAS v4u*)(Vt + ((size_t)((b * AH + h) * 64 + d)) * SEQ + s0_ + 8 * pc) = (v4u){lo.x, lo.y, hi2.x, hi2.y}; }
    }
    __syncthreads();
}
__device__ __forceinline__ void phase_attn_naive(const Ctx& c) {
    const GAS bf16* Q = (const GAS bf16*)(c.R + R_Q); const GAS bf16* K = (const GAS bf16*)(c.R + R_K); const GAS bf16* V = (const GAS bf16*)(c.R + R_V); GAS float* O = (GAS float*)(c.R + R_OATT);
    LAS float* ks = (LAS float*)c.lds;
    LAS float* vs = ks + 64 * QKD;
    const int row = c.tid >> 1, hf = c.tid & 1;
    for (int item = c.bid; item < BATCH * AH * 32 * 2; item += c.nb) {
        const int qg = 31 - item / (BATCH * AH * 2), rem = item % (BATCH * AH * 2), vh = rem & 1, bh = rem >> 1, b = bh / AH, h = bh % AH;
        const size_t qrow = (size_t)b * SEQ + qg * 256 + row;
        float q[48];
#pragma unroll
        for (int i = 0; i < 24; ++i) { const unsigned w = *(const GAS unsigned*)(Q + qrow * QP + h * QKD + hf * 48 + 2 * i); q[2 * i] = bflo(w); q[2 * i + 1] = bfhi(w); }
        float acc[16];
#pragma unroll
        for (int i = 0; i < 16; ++i) acc[i] = 0.f;
        float mrun = -INFINITY, lrun = 0.f;
        const int myc = qg * 4 + (c.wave >> 1), ntile = qg * 4 + 4;
        for (int j = 0; j < ntile; ++j) {
            __syncthreads();
            const size_t kr0 = (size_t)b * SEQ + j * 64;
            for (int e = c.tid; e < 64 * QKD / 2; e += NTHR) { const int kr = e / (QKD / 2), dd = e % (QKD / 2); const unsigned w = *(const GAS unsigned*)(K + (kr0 + kr) * QP + h * QKD + 2 * dd); ks[kr * QKD + 2 * dd] = bflo(w); ks[kr * QKD + 2 * dd + 1] = bfhi(w); }
            for (int e = c.tid; e < 64 * 32; e += NTHR) { const int kr = e & 63, dd = e >> 6; vs[kr * 32 + dd] = bf2f(V[((size_t)(bh * 64 + vh * 32 + dd)) * SEQ + j * 64 + (kr & ~15) + vt_pos(kr & 15)]); }
            __syncthreads();
            if (j <= myc) {
#pragma unroll 1
                for (int k4 = 0; k4 < 64; k4 += 4) {
                    float s[4];
#pragma unroll
                    for (int u = 0; u < 4; ++u) { const LAS f32x4* kp = (const LAS f32x4*)(ks + (k4 + u) * QKD + hf * 48); float d0 = 0.f, d1 = 0.f;
#pragma unroll
                        for (int i = 0; i < 12; ++i) { const f32x4 kv = kp[i]; d0 += q[4 * i] * kv.x + q[4 * i + 2] * kv.z; d1 += q[4 * i + 1] * kv.y + q[4 * i + 3] * kv.w; }
                        s[u] = d0 + d1; }
#pragma unroll
                    for (int u = 0; u < 4; ++u) s[u] += __shfl_xor(s[u], 1);
                    const float mx = fmaxf(fmaxf(s[0], s[1]), fmaxf(s[2], s[3])), mnew = fmaxf(mrun, mx), corr = exp2f(mrun - mnew);
                    mrun = mnew; lrun *= corr;
#pragma unroll
                    for (int i = 0; i < 16; ++i) acc[i] *= corr;
#pragma unroll
                    for (int u = 0; u < 4; ++u) { const float p = exp2f(s[u] - mnew); lrun += p; const LAS f32x4* vp = (const LAS f32x4*)(vs + (k4 + u) * 32 + hf * 16);
#pragma unroll
                        for (int i = 0; i < 4; ++i) { const f32x4 vv = vp[i]; acc[4 * i] += p * vv.x; acc[4 * i + 1] += p * vv.y; acc[4 * i + 2] += p * vv.z; acc[4 * i + 3] += p * vv.w; } }
                }
            }
        }
        const float inv = 1.0f / lrun;
        GAS float* op = O + qrow * AW + h * 64 + vh * 32 + hf * 16;
#pragma unroll
        for (int i = 0; i < 4; ++i) *(GAS f32x4*)(op + 4 * i) = (f32x4){acc[4 * i] * inv, acc[4 * i + 1] * inv, acc[4 * i + 2] * inv, acc[4 * i + 3] * inv};
    }
    __syncthreads();
}
__device__ __forceinline__ void phase_attn_mfma(const Ctx& c) {
    const GAS bf16* Q = (const GAS bf16*)(c.R + R_Q); const GAS bf16* K = (const GAS bf16*)(c.R + R_K); const GAS bf16* Vt = (const GAS bf16*)(c.R + R_V); GAS float* O = (GAS float*)(c.R + R_OATT);
    constexpr int KP = 104, VP = 72, KBUF = 64 * KP * 2, VBUF = 64 * VP * 2, BUF = KBUF + VBUF;
    const int l31 = c.lane & 31, hi = c.lane >> 5, w = c.wave;
    const int nitem = BATCH * AH * 32;
    for (int rnd = 0;; ++rnd) {
        int item;
        const int na = c.nb >= 2 * SCAN_WGS ? c.nb - SCAN_WGS : c.nb;
        if (c.bid >= na) break;
        if (2 * na >= nitem) { if (rnd >= 2) break; item = rnd == 0 ? c.bid : 2 * na - 1 - c.bid; if (item >= nitem) continue; }
        else { item = c.bid + rnd * na; if (item >= nitem) break; }
        const int qb = 31 - item / (BATCH * AH), bh = item % (BATCH * AH), b = bh / AH, h = bh % AH;
        const size_t q0 = (size_t)b * SEQ + qb * 256 + 32 * w;
        bf16x8 qf[6];
#pragma unroll
        for (int ds = 0; ds < 6; ++ds) qf[ds] = *(const GAS bf16x8*)(Q + (q0 + l31) * QP + h * QKD + 16 * ds + 8 * hi);
        f32x16 o0, o1;
#pragma unroll
        for (int r = 0; r < 16; ++r) { o0[r] = 0.f; o1[r] = 0.f; }
        float mrun = -INFINITY, lrun = 0.f;
        const int NT = 4 * qb + 4, myc = 4 * qb + (w >> 1);
        const int kr0 = c.tid / 12, kc0 = c.tid % 12, kr1 = (c.tid + 512) / 12, kc1 = (c.tid + 512) % 12, vr = c.tid >> 3, vc = c.tid & 7;
        const GAS bf16* kg0 = K + ((size_t)b * SEQ + kr0) * QP + h * QKD + 8 * kc0; const GAS bf16* kg1 = K + ((size_t)b * SEQ + kr1) * QP + h * QKD + 8 * kc1;
        const GAS bf16* vg = Vt + ((size_t)(bh * 64 + vr)) * SEQ + 8 * vc;
        const int kl0 = (kr0 * KP + 8 * kc0) * 2, kl1 = (kr1 * KP + 8 * kc1) * 2, vl = KBUF + (vr * VP + 8 * vc) * 2;
        const bool two = c.tid < 256;
        v4u kx0 = *(const GAS v4u*)kg0, kx1 = two ? *(const GAS v4u*)kg1 : (v4u){0u, 0u, 0u, 0u}, vx = *(const GAS v4u*)vg;
        __syncthreads();
        *(LAS v4u*)(c.lds + kl0) = kx0; if (two) *(LAS v4u*)(c.lds + kl1) = kx1; *(LAS v4u*)(c.lds + vl) = vx;
        __syncthreads();
        for (int j = 0; j < NT; ++j) {
            const bool more = j + 1 < NT;
            if (more) { kx0 = *(const GAS v4u*)(kg0 + (size_t)(j + 1) * 64 * QP); if (two) kx1 = *(const GAS v4u*)(kg1 + (size_t)(j + 1) * 64 * QP); vx = *(const GAS v4u*)(vg + (j + 1) * 64); }
            if (j <= myc) {
                const LAS unsigned char* kb = c.lds + (j & 1) * BUF; const LAS unsigned char* vb = kb + KBUF;
                f32x16 p0, p1;
#pragma unroll
                for (int r = 0; r < 16; ++r) { p0[r] = 0.f; p1[r] = 0.f; }
#pragma unroll
                for (int ds = 0; ds < 6; ++ds) {
                    const bf16x8 kf0 = *(const LAS bf16x8*)(kb + (l31 * KP + 16 * ds + 8 * hi) * 2), kf1 = *(const LAS bf16x8*)(kb + ((l31 + 32) * KP + 16 * ds + 8 * hi) * 2);
                    p0 = __builtin_amdgcn_mfma_f32_32x32x16_bf16(kf0, qf[ds], p0, 0, 0, 0); p1 = __builtin_amdgcn_mfma_f32_32x32x16_bf16(kf1, qf[ds], p1, 0, 0, 0);
                }
                float mx = fmaxf(p0[0], p1[0]);
#pragma unroll
                for (int r = 1; r < 16; ++r) mx = fmaxf(mx, fmaxf(p0[r], p1[r]));
                mx = fmaxf(mx, __shfl_xor(mx, 32));
                const float mnew = fmaxf(mrun, mx), corr = __builtin_amdgcn_exp2f(mrun - mnew); mrun = mnew;
                float ls = 0.f;
#pragma unroll
                for (int r = 0; r < 16; ++r) { p0[r] = __builtin_amdgcn_exp2f(p0[r] - mnew); p1[r] = __builtin_amdgcn_exp2f(p1[r] - mnew); ls += p0[r] + p1[r]; }
                lrun = lrun * corr + ls;
#pragma unroll
                for (int r = 0; r < 16; ++r) { o0[r] *= corr; o1[r] *= corr; }
                bf16x8 pb[4];
                { v4u t;
                  t.x = cvtpk(p0[0], p0[1]); t.y = cvtpk(p0[2], p0[3]); t.z = cvtpk(p0[4], p0[5]); t.w = cvtpk(p0[6], p0[7]); pb[0] = __builtin_bit_cast(bf16x8, t);
                  t.x = cvtpk(p0[8], p0[9]); t.y = cvtpk(p0[10], p0[11]); t.z = cvtpk(p0[12], p0[13]); t.w = cvtpk(p0[14], p0[15]); pb[1] = __builtin_bit_cast(bf16x8, t);
                  t.x = cvtpk(p1[0], p1[1]); t.y = cvtpk(p1[2], p1[3]); t.z = cvtpk(p1[4], p1[5]); t.w = cvtpk(p1[6], p1[7]); pb[2] = __builtin_bit_cast(bf16x8, t);
                  t.x = cvtpk(p1[8], p1[9]); t.y = cvtpk(p1[10], p1[11]); t.z = cvtpk(p1[12], p1[13]); t.w = cvtpk(p1[14], p1[15]); pb[3] = __builtin_bit_cast(bf16x8, t); }
#pragma unroll
                for (int sx = 0; sx < 4; ++sx) {
                    const bf16x8 vf0 = *(const LAS bf16x8*)(vb + (l31 * VP + 16 * sx + 8 * hi) * 2), vf1 = *(const LAS bf16x8*)(vb + ((l31 + 32) * VP + 16 * sx + 8 * hi) * 2);
                    o0 = __builtin_amdgcn_mfma_f32_32x32x16_bf16(vf0, pb[sx], o0, 0, 0, 0); o1 = __builtin_amdgcn_mfma_f32_32x32x16_bf16(vf1, pb[sx], o1, 0, 0, 0);
                }
            }
            if (more) { LAS unsigned char* nb_ = c.lds + ((j + 1) & 1) * BUF; *(LAS v4u*)(nb_ + kl0) = kx0; if (two) *(LAS v4u*)(nb_ + kl1) = kx1; *(LAS v4u*)(nb_ + vl) = vx; }
            __syncthreads();
        }
        const float lt = lrun + __shfl_xor(lrun, 32), inv = 1.0f / lt;
        GAS float* op = O + (q0 + l31) * AW + h * 64 + 4 * hi;
#pragma unroll
        for (int g = 0; g < 4; ++g) {
            *(GAS f32x4*)(op + 8 * g) = (f32x4){o0[4 * g] * inv, o0[4 * g + 1] * inv, o0[4 * g + 2] * inv, o0[4 * g + 3] * inv};
            *(GAS f32x4*)(op + 32 + 8 * g) = (f32x4){o1[4 * g] * inv, o1[4 * g + 1] * inv, o1[4 * g + 2] * inv, o1[4 * g + 3] * inv};
        }
    }
    __syncthreads();
}
__device__ __forceinline__ void phase_attn_mfma2(const Ctx& c, int l) {
    const GAS bf16* Q = (const GAS bf16*)(c.R + R_Q); const GAS bf16* K = (const GAS bf16*)(c.R + R_K); const GAS bf16* Vt = (const GAS bf16*)(c.R + R_V); GAS float* O = (GAS float*)(c.R + R_OATT);
    constexpr int KP = 104, VP = 72, KBUF = 128 * KP * 2, VBUF = 64 * VP * 2, BUF = KBUF + 2 * VBUF;
    const int l31 = c.lane & 31, hi = c.lane >> 5, w = c.wave;
    const int nitem = BATCH * AH * 32;
    for (int rnd = 0;; ++rnd) {
        int item;
        const int na = c.nb >= 2 * SCAN_WGS ? c.nb - SCAN_WGS : c.nb;
        if (c.bid >= na) break;
        if (2 * na >= nitem) { if (rnd >= 2) break; item = rnd == 0 ? c.bid : 2 * na - 1 - c.bid; if (item >= nitem) continue; }
        else { item = c.bid + rnd * na; if (item >= nitem) break; }
        const int qb = 31 - item / (BATCH * AH), bh = item % (BATCH * AH), b = bh / AH, h = bh % AH;
        const size_t q0 = (size_t)b * SEQ + qb * 256 + 32 * w;
        bf16x8 qf[6];
#pragma unroll
        for (int ds = 0; ds < 6; ++ds) qf[ds] = *(const GAS bf16x8*)(Q + (q0 + l31) * QP + h * QKD + 16 * ds + 8 * hi);
        f32x16 o0 = zero16(), o1 = zero16();
        float mrun = -INFINITY, lrun = 0.f;
        const int NS = 2 * qb + 2, myc = 4 * qb + (w >> 1);
        int kl[3]; const GAS bf16* kg[3];
#pragma unroll
        for (int i = 0; i < 3; ++i) { const int p = c.tid + 512 * i, kr = p / 12, kc = p % 12; kl[i] = (kr * KP + 8 * kc) * 2; kg[i] = K + ((size_t)b * SEQ + kr) * QP + h * QKD + 8 * kc; }
        int vl[2]; const GAS bf16* vg[2];
#pragma unroll
        for (int i = 0; i < 2; ++i) { const int p = c.tid + 512 * i, half = p >> 9, vr = (p >> 3) & 63, vc = p & 7; vl[i] = KBUF + half * VBUF + (vr * VP + 8 * vc) * 2; vg[i] = Vt + ((size_t)(bh * 64 + vr)) * SEQ + 64 * half + 8 * vc; }
        v4u kx[3], vx[2];
#pragma unroll
        for (int i = 0; i < 3; ++i) kx[i] = *(const GAS v4u*)kg[i];
#pragma unroll
        for (int i = 0; i < 2; ++i) vx[i] = *(const GAS v4u*)vg[i];
        __syncthreads();
#pragma unroll
        for (int i = 0; i < 3; ++i) *(LAS v4u*)(c.lds + kl[i]) = kx[i];
#pragma unroll
        for (int i = 0; i < 2; ++i) *(LAS v4u*)(c.lds + vl[i]) = vx[i];
        __syncthreads();
        for (int j = 0; j < NS; ++j) {
            const bool more = j + 1 < NS;
            if (more) {
#pragma unroll
                for (int i = 0; i < 3; ++i) kx[i] = *(const GAS v4u*)(kg[i] + (size_t)(j + 1) * 128 * QP);
#pragma unroll
                for (int i = 0; i < 2; ++i) vx[i] = *(const GAS v4u*)(vg[i] + (j + 1) * 128); }
            const int nvis = myc - 2 * j + 1;
            if (nvis > 0) {
                const LAS unsigned char* kb = c.lds + (j & 1) * BUF; const LAS unsigned char* vb = kb + KBUF;
                const bool first = mrun == -INFINITY;
                const float cin = first ? 0.f : -mrun;
                f32x16 p0, p1, p2, p3;
#pragma unroll
                for (int r = 0; r < 16; ++r) { p0[r] = cin; p1[r] = cin; p2[r] = cin; p3[r] = cin; }
#define KFR(blk, ds) (*(const LAS bf16x8*)(kb + ((l31 + 32 * (blk)) * KP + 16 * (ds) + 8 * hi) * 2))
                bf16x8 ka[8], kc[8];
#pragma unroll
                for (int ds = 0; ds < 2; ++ds) { ka[4 * ds] = KFR(0, ds); ka[4 * ds + 1] = KFR(1, ds); ka[4 * ds + 2] = KFR(2, ds); ka[4 * ds + 3] = KFR(3, ds); }
#pragma unroll
                for (int ds = 0; ds < 2; ++ds) { kc[4 * ds] = KFR(0, ds + 2); kc[4 * ds + 1] = KFR(1, ds + 2); kc[4 * ds + 2] = KFR(2, ds + 2); kc[4 * ds + 3] = KFR(3, ds + 2); }
#pragma unroll
                for (int ds = 0; ds < 2; ++ds) { p0 = MFMA32(ka[4 * ds], qf[ds], p0); p1 = MFMA32(ka[4 * ds + 1], qf[ds], p1); p2 = MFMA32(ka[4 * ds + 2], qf[ds], p2); p3 = MFMA32(ka[4 * ds + 3], qf[ds], p3); }
#pragma unroll
                for (int ds = 0; ds < 2; ++ds) { ka[4 * ds] = KFR(0, ds + 4); ka[4 * ds + 1] = KFR(1, ds + 4); ka[4 * ds + 2] = KFR(2, ds + 4); ka[4 * ds + 3] = KFR(3, ds + 4); }
#pragma unroll
                for (int ds = 0; ds < 2; ++ds) { p0 = MFMA32(kc[4 * ds], qf[ds + 2], p0); p1 = MFMA32(kc[4 * ds + 1], qf[ds + 2], p1); p2 = MFMA32(kc[4 * ds + 2], qf[ds + 2], p2); p3 = MFMA32(kc[4 * ds + 3], qf[ds + 2], p3); }
#pragma unroll
                for (int ds = 0; ds < 2; ++ds) { p0 = MFMA32(ka[4 * ds], qf[ds + 4], p0); p1 = MFMA32(ka[4 * ds + 1], qf[ds + 4], p1); p2 = MFMA32(ka[4 * ds + 2], qf[ds + 4], p2); p3 = MFMA32(ka[4 * ds + 3], qf[ds + 4], p3); }
#undef KFR
                bf16x8 vfa[8];
#pragma unroll
                for (int sx = 0; sx < 8; ++sx) { const LAS unsigned char* vq = vb + (sx >> 2) * VBUF; vfa[sx] = *(const LAS bf16x8*)(vq + (l31 * VP + 16 * (sx & 3) + 8 * hi) * 2); }
                if (__builtin_amdgcn_readfirstlane(nvis) < 2) {
#pragma unroll
                    for (int r = 0; r < 16; ++r) { p2[r] = -INFINITY; p3[r] = -INFINITY; } }
                float mx = fmaxf(fmaxf(p0[0], p1[0]), fmaxf(p2[0], p3[0]));
#pragma unroll
                for (int r = 1; r < 16; ++r) mx = fmaxf(mx, fmaxf(fmaxf(p0[r], p1[r]), fmaxf(p2[r], p3[r])));
                mx = fmaxf(mx, __shfl_xor(mx, 32));
                const float dl = first ? mx : fmaxf(mx, 0.f);
                if (__any(first || dl != 0.f)) {
                    const float corr = first ? 0.f : __builtin_amdgcn_exp2f(-dl);
#pragma unroll
                    for (int r = 0; r < 16; ++r) { p0[r] -= dl; p1[r] -= dl; p2[r] -= dl; p3[r] -= dl; o0[r] *= corr; o1[r] *= corr; }
                    lrun *= corr; mrun = first ? mx : mrun + dl; }
                float ls = 0.f;
#pragma unroll
                for (int r = 0; r < 16; ++r) { p0[r] = __builtin_amdgcn_exp2f(p0[r]); p1[r] = __builtin_amdgcn_exp2f(p1[r]); p2[r] = __builtin_amdgcn_exp2f(p2[r]); p3[r] = __builtin_amdgcn_exp2f(p3[r]);
                    ls += (p0[r] + p1[r]) + (p2[r] + p3[r]); }
                lrun += ls;
#pragma unroll
                for (int sx = 0; sx < 8; ++sx) {
                    const bf16x8 pb = sx < 2 ? pack8(p0, 8 * (sx & 1)) : sx < 4 ? pack8(p1, 8 * (sx & 1)) : sx < 6 ? pack8(p2, 8 * (sx & 1)) : pack8(p3, 8 * (sx & 1));
                    const LAS unsigned char* vq = vb + (sx >> 2) * VBUF;
                    o0 = MFMA32(vfa[sx], pb, o0); o1 = MFMA32(*(const LAS bf16x8*)(vq + ((l31 + 32) * VP + 16 * (sx & 3) + 8 * hi) * 2), pb, o1);
                }
            }
            if (more) { LAS unsigned char* nb_ = c.lds + ((j + 1) & 1) * BUF;
#pragma unroll
                for (int i = 0; i < 3; ++i) *(LAS v4u*)(nb_ + kl[i]) = kx[i];
#pragma unroll
                for (int i = 0; i < 2; ++i) *(LAS v4u*)(nb_ + vl[i]) = vx[i]; }
            __syncthreads();
        }
        const float lt = lrun + __shfl_xor(lrun, 32), inv = 1.0f / lt;
        GAS float* op = O + (q0 + l31) * AW + h * 64 + 4 * hi;
#pragma unroll
        for (int g = 0; g < 4; ++g) {
            *(GAS f32x4*)(op + 8 * g) = (f32x4){o0[4 * g] * inv, o0[4 * g + 1] * inv, o0[4 * g + 2] * inv, o0[4 * g + 3] * inv};
            *(GAS f32x4*)(op + 32 + 8 * g) = (f32x4){o1[4 * g] * inv, o1[4 * g + 1] * inv, o1[4 * g + 2] * inv, o1[4 * g + 3] * inv};
        }
    }
    __syncthreads();
    if (l == 1) {
        const int na_ = c.nb >= 2 * SCAN_WGS ? c.nb - SCAN_WGS : c.nb;
        if (c.bid < na_) { GAS unsigned* cq = (GAS unsigned*)(c.ws + WS_CTL) + CW_CQ;
            if (c.tid == 0) (void)__hip_atomic_fetch_add(cq + 64, 1u, __ATOMIC_RELAXED, __HIP_MEMORY_SCOPE_AGENT);
            ExpertGUJobs JG{&c}; conv_pop(c, cq, ExpertGUJobs::TOTAL, JG, cq + 64, (unsigned)na_); }
    }
}
__device__ __forceinline__ void phase_mla_post(const Ctx& c, int l) {
    const GAS float* O = (const GAS float*)(c.R + R_OATT); GAS bf16* YC = (GAS bf16*)(c.ws + WS_XN); const GAS float* og = c.in(I_BOG) + l * AW;
    const int i16 = c.lane & 15, g16 = c.lane >> 4;
    f32x4 gv[6];
#pragma unroll
    for (int k = 0; k < 6; ++k) gv[k] = *(const GAS f32x4*)(og + 64 * k + 4 * i16);
    for (int m0 = c.gw * 4; m0 < M; m0 += c.ngw * 8) {
        const int mA = m0 + g16, mB = mA + c.ngw * 4; const bool hasB = m0 + c.ngw * 4 < M;
        f32x4 xa[6], xb[6];
#pragma unroll
        for (int k = 0; k < 6; ++k) xa[k] = *(const GAS f32x4*)(O + (size_t)mA * AW + 64 * k + 4 * i16);
        if (hasB) {
#pragma unroll
            for (int k = 0; k < 6; ++k) xb[k] = *(const GAS f32x4*)(O + (size_t)mB * AW + 64 * k + 4 * i16); }
        { float ss = 0.f;
#pragma unroll
          for (int k = 0; k < 6; ++k) ss += (xa[k].x * xa[k].x + xa[k].y * xa[k].y) + (xa[k].z * xa[k].z + xa[k].w * xa[k].w);
          const float rstd = __builtin_amdgcn_rsqf(row16_sum(ss) * (1.0f / AW) + EPS);
#pragma unroll
          for (int k = 0; k < 6; ++k) { const f32x4 v = xa[k] * rstd * gv[k]; *(GAS v2u*)(YC + (size_t)mA * D + AW + 64 * k + 4 * i16) = (v2u){pk2(v.x, v.y), pk2(v.z, v.w)}; } }
        if (hasB) { float ss = 0.f;
#pragma unroll
          for (int k = 0; k < 6; ++k) ss += (xb[k].x * xb[k].x + xb[k].y * xb[k].y) + (xb[k].z * xb[k].z + xb[k].w * xb[k].w);
          const float rstd = __builtin_amdgcn_rsqf(row16_sum(ss) * (1.0f / AW) + EPS);
#pragma unroll
          for (int k = 0; k < 6; ++k) { const f32x4 v = xb[k] * rstd * gv[k]; *(GAS v2u*)(YC + (size_t)mB * D + AW + 64 * k + 4 * i16) = (v2u){pk2(v.x, v.y), pk2(v.z, v.w)}; } }
    }
}

__device__ __forceinline__ void phase_gmlp(const Ctx& c, int l) {
    const GAS bf16* Z = (const GAS bf16*)(c.R + R_Z); GAS bf16* YC = (GAS bf16*)(c.ws + WS_XN);
    const GAS float* lng = c.in(I_CLNG) + l * 256; const GAS float* lnb = c.in(I_CLNB) + l * 256; const GAS float* ws = c.in(I_CWS) + (size_t)l * 4 * 128 * 128; const GAS float* bs = c.in(I_CBS) + l * 4 * 128; const GAS float* og = c.in(I_COG) + l * 256;
    LAS float* vln = (LAS float*)c.lds;
    LAS float* ssq2 = (LAS float*)(c.lds + MISC_OFF + 256);
    for (int item = c.bid; item < M / 128; item += c.nb) {
        const int m0 = item * 128;
        __syncthreads();
        for (int q = 0; q < 16; ++q) { const int t = c.wave * 16 + q; const GAS bf16* zr = Z + (size_t)(m0 + t) * ZP + ZCV;
            float x[4]; float s = 0.f;
#pragma unroll
            for (int i = 0; i < 4; ++i) { x[i] = gelu_erf(bf2f(zr[c.lane + 64 * i])); s += x[i]; }
            const float mean = wave_sum(s) * (1.0f / 256.0f); float s2 = 0.f;
#pragma unroll
            for (int i = 0; i < 4; ++i) { x[i] -= mean; s2 += x[i] * x[i]; }
            const float rstd = __builtin_amdgcn_rsqf(wave_sum(s2) * (1.0f / 256.0f) + EPS);
#pragma unroll
            for (int i = 0; i < 4; ++i) vln[t * 256 + c.lane + 64 * i] = x[i] * rstd * lng[c.lane + 64 * i] + lnb[c.lane + 64 * i];
        }
        __syncthreads();
        const int g = c.wave & 3, half = c.wave >> 2, ch = g * 64 + c.lane;
        for (int tt = 0; tt < 64; ++tt) { const int t = half * 64 + tt; const GAS float* wr = ws + ((size_t)g * 128 + t) * 128; float acc = 0.f;
            for (int s = 0; s <= t; ++s) acc += wr[s] * vln[s * 256 + ch];
            const float sv = acc + bs[g * 128 + t]; const float u = gelu_erf(bf2f(Z[(size_t)(m0 + t) * ZP + ZU + ch])); const float y = u * sv;
            const float p = wave_sum(y * y); if (c.lane == 0) ssq2[t * 4 + g] = p;
            YC[(size_t)(m0 + t) * D + 768 + ch] = (bf16)f2bf(y); }
        __syncthreads();
        for (int tt = 0; tt < 64; ++tt) { const int t = half * 64 + tt; const float tot = (ssq2[t * 4 + 0] + ssq2[t * 4 + 1]) + (ssq2[t * 4 + 2] + ssq2[t * 4 + 3]);
            const float rstd = __builtin_amdgcn_rsqf(tot * (1.0f / 256.0f) + EPS); GAS bf16* p = YC + (size_t)(m0 + t) * D + 768 + ch; *p = (bf16)f2bf(bf2f(*p) * rstd * og[ch]); }
    }
    __syncthreads();
}


__device__ __forceinline__ void phase_gmlp_mfma(const Ctx& c, int l) {
    const GAS bf16* Z = (const GAS bf16*)(c.R + R_Z); GAS bf16* YC = (GAS bf16*)(c.ws + WS_XN);
    const GAS float* lng = c.in(I_CLNG) + l * 256; const GAS float* lnb = c.in(I_CLNB) + l * 256; const GAS float* bs = c.in(I_CBS) + l * 4 * 128; const GAS float* og = c.in(I_COG) + l * 256;
    const GAS bf16* W = (const GAS bf16*)(c.ws + WS_WSM + WSM_GW) + (size_t)l * 4 * 128 * 128;
    constexpr int VP = 136;
    LAS unsigned short* vT = (LAS unsigned short*)c.lds;
    LAS float* sq = (LAS float*)(c.lds + 256 * VP * 2);
    const int lane = c.lane, l31 = lane & 31, hi = lane >> 5;
    float lg4[4], lb4[4];
#pragma unroll
    for (int i = 0; i < 4; ++i) { lg4[i] = lng[lane + 64 * i]; lb4[i] = lnb[lane + 64 * i]; }
    for (int it_ = c.bid; it_ < M / 64; it_ += c.nb) {
        const int item = c.nb == 256 ? (it_ < 64 ? 2 * it_ + 1 : it_ < 192 ? 2 * (it_ - 64) : 2 * (it_ - 128) + 1) : it_;
        const int th = item & 1, m0 = (item >> 1) * 128, nq = 8 * (th + 1);
        __syncthreads();
        for (int q0 = 0; q0 < nq; q0 += 4) {
            float zx[4][4];
#pragma unroll
            for (int u = 0; u < 4; ++u) { const GAS bf16* zr = Z + (size_t)(m0 + c.wave * nq + q0 + u) * ZP + ZCV;
#pragma unroll
                for (int i = 0; i < 4; ++i) zx[u][i] = bf2f(zr[lane + 64 * i]); }
            float x[4][4], s1[4], s2[4];
#pragma unroll
            for (int u = 0; u < 4; ++u) { s1[u] = 0.f; s2[u] = 0.f;
#pragma unroll
                for (int i = 0; i < 4; i += 2) { const pg8::f32x2 gv = pg8::gelu_pk((pg8::f32x2){zx[u][i], zx[u][i + 1]}); x[u][i] = gv.x; x[u][i + 1] = gv.y; s1[u] += gv.x + gv.y; s2[u] += gv.x * gv.x + gv.y * gv.y; } }
#pragma unroll
            for (int u = 0; u < 4; ++u) { s1[u] = wave_sum(s1[u]); s2[u] = wave_sum(s2[u]); }
            float mean[4], rstd[4];
#pragma unroll
            for (int u = 0; u < 4; ++u) { mean[u] = s1[u] * (1.0f / 256.0f); rstd[u] = __builtin_amdgcn_rsqf(fmaxf(s2[u] * (1.0f / 256.0f) - mean[u] * mean[u], 0.f) + EPS); }
            const int t0 = c.wave * nq + q0;
#pragma unroll
            for (int i = 0; i < 4; ++i) { float y[4];
#pragma unroll
                for (int u = 0; u < 4; ++u) y[u] = (x[u][i] - mean[u]) * rstd[u] * lg4[i] + lb4[i];
                *(LAS v2u*)(vT + (lane + 64 * i) * VP + t0) = (v2u){pk2(y[0], y[1]), pk2(y[2], y[3])}; }
        }
        __syncthreads();
        const int tb = 2 * th + (c.wave & 1), g = c.wave >> 1; const int t = 32 * tb + l31, tl = 32 * (c.wave & 1) + l31; const size_t m = (size_t)m0 + t;
        float ss = 0.f; const float bias = bs[g * 128 + t];
        const GAS bf16* wr = W + ((size_t)g * 128 + t) * 128 + 8 * hi;
#pragma unroll 1
        for (int i = 0; i < 2; ++i) { const int cblk = 2 * g + i; f32x16 a = zero16();
            for (int ks = 0; ks < 2 * tb + 2; ++ks) a = MFMA32(*(const LAS bf16x8*)(vT + (32 * cblk + l31) * VP + 16 * ks + 8 * hi), *(const GAS bf16x8*)(wr + 16 * ks), a);
#pragma unroll
            for (int gq = 0; gq < 4; ++gq) { const int ch = 32 * cblk + 8 * gq + 4 * hi; const v2u zu = *(const GAS v2u*)(Z + m * ZP + ZU + ch);
                const pg8::f32x2 u01 = pg8::gelu_pk((pg8::f32x2){bflo(zu.x), bfhi(zu.x)}), u23 = pg8::gelu_pk((pg8::f32x2){bflo(zu.y), bfhi(zu.y)});
                const float y0 = u01.x * (a[4 * gq] + bias), y1 = u01.y * (a[4 * gq + 1] + bias), y2 = u23.x * (a[4 * gq + 2] + bias), y3 = u23.y * (a[4 * gq + 3] + bias);
                ss += (y0 * y0 + y1 * y1) + (y2 * y2 + y3 * y3);
                *(GAS v2u*)(YC + m * D + 768 + ch) = (v2u){pk2(y0, y1), pk2(y2, y3)}; } }
        ss += __shfl_xor(ss, 32);
        if (hi == 0) sq[g * 64 + tl] = ss;
        __syncthreads();
        const float rstd = __builtin_amdgcn_rsqf(((sq[tl] + sq[64 + tl]) + (sq[128 + tl] + sq[192 + tl])) * (1.0f / 256.0f) + EPS);
#pragma unroll 1
        for (int i = 0; i < 2; ++i) { const int cblk = 2 * g + i;
#pragma unroll
            for (int gq = 0; gq < 4; ++gq) { const int ch = 32 * cblk + 8 * gq + 4 * hi; const f32x4 o4 = *(const GAS f32x4*)(og + ch); GAS v2u* p = (GAS v2u*)(YC + m * D + 768 + ch); const v2u w = *p;
                *p = (v2u){pk2(bflo(w.x) * rstd * o4.x, bfhi(w.x) * rstd * o4.y), pk2(bflo(w.y) * rstd * o4.z, bfhi(w.y) * rstd * o4.w)}; } }
    }
    __syncthreads();
}

__device__ __forceinline__ void phase_moe_count(const Ctx& c) {
    const GAS int* te = (const GAS int*)(c.ws + WS_TOK + TOK_E); GAS int* seg = (GAS int*)(c.ws + WS_TOK + TOK_SEG);
    for (int sgi = c.gw; sgi < NSEG; sgi += c.ngw) {
        const int m = sgi * SEGT + c.lane; const int e0 = te[2 * m], e1 = te[2 * m + 1];
#pragma unroll
        for (int e = 0; e < NE; ++e) { const unsigned long long b0 = __ballot(e0 == e), b1 = __ballot(e1 == e); if (c.lane == 0) seg[sgi * NE + e] = __popcll(b0) + __popcll(b1); }
    }
}
__device__ __forceinline__ void phase_moe_scatter(const Ctx& c) {
    const GAS int* te = (const GAS int*)(c.ws + WS_TOK + TOK_E); const GAS int* seg = (const GAS int*)(c.ws + WS_TOK + TOK_SEG); GAS int* tpos = (GAS int*)(c.ws + WS_TOK + TOK_POS); GAS int* tile = (GAS int*)(c.ws + WS_TOK + TOK_TILE);
    const GAS bf16* XN = (const GAS bf16*)(c.ws + WS_XN); GAS bf16* XNP = (GAS bf16*)(c.R + R_XNP);
    LAS int* pre = (LAS int*)c.lds;
    LAS int* tot = pre + NSEG * NE;
    LAS int* base = tot + NE;
    __syncthreads();
    if (c.tid < NE) { int s = 0; for (int sgi = 0; sgi < NSEG; ++sgi) { pre[sgi * NE + c.tid] = s; s += seg[sgi * NE + c.tid]; } tot[c.tid] = s; }
    __syncthreads();
    if (c.tid == 0) { int s = 0; for (int e = 0; e < NE; ++e) { base[e] = s; s += (tot[e] + 255) & ~255; }
        if (c.bid == 0) { int T = 0; for (int e = 0; e < NE; ++e) { const int n = ((tot[e] + 255) & ~255) / 256; tile[e] = base[e] / 256; tile[8 + e] = n; for (int i = 0; i < n; ++i) tile[32 + T + i] = e; T += n; } tile[16] = T; } }
    __syncthreads();
    for (int sgi = c.bid; sgi < NSEG; sgi += c.nb) {
        const int m = sgi * SEGT + c.lane; const int e0 = te[2 * m], e1 = te[2 * m + 1]; int p0 = 0, p1 = 0;
        const unsigned long long below = (1ull << c.lane) - 1ull;
#pragma unroll
        for (int e = 0; e < NE; ++e) { const unsigned long long b0 = __ballot(e0 == e), b1 = __ballot(e1 == e);
            const int r = __popcll(b0 & below) + __popcll(b1 & below); const int st = base[e] + pre[sgi * NE + e];
            if (e0 == e) p0 = st + r; if (e1 == e) p1 = st + r + ((e0 == e) ? 1 : 0); }
        if (c.wave == 0) { tpos[2 * m] = p0; tpos[2 * m + 1] = p1; }
        v4u x0[8], x1[8];
#pragma unroll
        for (int u = 0; u < 8; ++u) { const GAS v4u* src = (const GAS v4u*)(XN + (size_t)(sgi * SEGT + 8 * c.wave + u) * D) + c.lane; x0[u] = src[0]; x1[u] = src[64]; }
#pragma unroll
        for (int u = 0; u < 8; ++u) { const int d0 = __shfl(p0, 8 * c.wave + u), d1 = __shfl(p1, 8 * c.wave + u); GAS v4u* o0 = (GAS v4u*)(XNP + (size_t)d0 * D) + c.lane; GAS v4u* o1 = (GAS v4u*)(XNP + (size_t)d1 * D) + c.lane;
            o0[0] = x0[u]; o0[64] = x1[u]; o1[0] = x0[u]; o1[64] = x1[u]; }
    }
    for (int e = 0; e < NE; ++e) { const int r0 = base[e] + tot[e], r1 = base[e] + ((tot[e] + 255) & ~255);
        for (int r = r0 + c.gw; r < r1; r += c.ngw) { GAS v4u* o = (GAS v4u*)(XNP + (size_t)r * D) + c.lane; o[0] = (v4u){0u, 0u, 0u, 0u}; o[64] = (v4u){0u, 0u, 0u, 0u}; } }
    __syncthreads();
}
__device__ __forceinline__ void phase_moe_combine(const Ctx& c) {
    const GAS float* tg = (const GAS float*)(c.ws + WS_TOK + TOK_G); const GAS int* tpos = (const GAS int*)(c.ws + WS_TOK + TOK_POS); const GAS bf16* YP = (const GAS bf16*)(c.R + R_YP); GAS float* out = c.out();
    v2u a0n[4], a1n[4]; f32x4 xn_[4]; float g0n = 0.f, g1n = 0.f;
#define CB_LOAD(tok) do { g0n = tg[2 * (tok)]; g1n = tg[2 * (tok) + 1]; const int p0_ = tpos[2 * (tok)], p1_ = tpos[2 * (tok) + 1]; \
        const GAS v2u* y0_ = (const GAS v2u*)(YP + (size_t)p0_ * D) + c.lane; const GAS v2u* y1_ = (const GAS v2u*)(YP + (size_t)p1_ * D) + c.lane; const GAS f32x4* o_ = (const GAS f32x4*)(out + (size_t)(tok) * D) + c.lane; \
        _Pragma("unroll") for (int j = 0; j < 4; ++j) { a0n[j] = y0_[64 * j]; a1n[j] = y1_[64 * j]; xn_[j] = o_[64 * j]; } } while (0)
    if (c.gw < M) CB_LOAD(c.gw);
    for (int m = c.gw; m < M; m += c.ngw) {
        v2u a0[4], a1[4]; f32x4 x[4]; const float g0 = g0n, g1 = g1n;
#pragma unroll
        for (int j = 0; j < 4; ++j) { a0[j] = a0n[j]; a1[j] = a1n[j]; x[j] = xn_[j]; }
        if (m + c.ngw < M) CB_LOAD(m + c.ngw);
        GAS f32x4* o = (GAS f32x4*)(out + (size_t)m * D) + c.lane;
#pragma unroll
        for (int j = 0; j < 4; ++j) { f32x4 y = x[j];
            y.x += g0 * bflo(a0[j].x) + g1 * bflo(a1[j].x); y.y += g0 * bfhi(a0[j].x) + g1 * bfhi(a1[j].x); y.z += g0 * bflo(a0[j].y) + g1 * bflo(a1[j].y); y.w += g0 * bfhi(a0[j].y) + g1 * bfhi(a1[j].y); o[64 * j] = y; }
    }
#undef CB_LOAD
}

enum { PH_CONV = 0, PH_NORM1, PH_GEMM_IN, PH_RWKV_PREP, PH_MLA_PREP, PH_GMLP, PH_SCAN, PH_ATTN, PH_POST, PH_GEMM_OUT, PH_NORM2, PH_DGU, PH_DDOWN, PH_NORM2R, PH_COUNT, PH_SCATTER, PH_CONVE, PH_EGU, PH_EDOWN, PH_COMBINE, PH_CHUNK, PH_RWKV_OUT, PH_MLA_POST1, PH_MLA_PREP2, PH_EDOWNX, PH_GEMM_OUTN, PH_CONVB };
#ifndef PHASE_INLINE
#define PHASE_INLINE __forceinline__
#endif
template <int PH> __device__ PHASE_INLINE void do_phase(const Ctx& c, int l, int e) {
    bf16* XN = (bf16*)(c.ws + WS_XN); bf16* Zb = (bf16*)(c.R + R_Z); bf16* YC = (bf16*)(c.ws + WS_XN);
    GAS bf16* XNg = (GAS bf16*)(c.ws + WS_XN);
    if constexpr (PH == PH_CONV) phase_conv_static(c);
    if constexpr (PH == PH_CONVB) phase_conv_b(c);
    if constexpr (PH == PH_NORM1) phase_rmsnorm<false>(c, l == 0 ? c.in(I_X) : (const GAS float*)c.out(), c.in(I_MIXG) + l * D, XNg, nullptr);
    if constexpr (PH == PH_GEMM_IN) { pg8::Gemm g{XN, (const bf16*)(c.ws + WS_WIN) + (size_t)l * ZP * D, M, ZP, D, 0}; pg8::StaticOrder S; S.init(M, ZP, c.nb, c.bid); pg8::EpiBf16P E{Zb, ZP, ZP / 256, l == 1 ? (const float*)(c.R + R_SS1) : nullptr, 1.0f / D};
        pg8::gemm_phase<pg8::EpiBf16P, pg8::StaticOrder, true, true>(c.lds, g, S, E); }
#ifndef RWKV_NAIVE
#define RWKV_NAIVE 0
#endif
#ifndef RWKV_PREP_VALU
#define RWKV_PREP_VALU 0
#endif
#ifndef RWKV_PREP4
#define RWKV_PREP4 0
#endif
    if constexpr (PH == PH_RWKV_PREP) { if (RWKV_NAIVE) phase_rwkv_prep(c, l); else if (RWKV_PREP_VALU) phase_rwkv_prep2(c, l); else if (RWKV_PREP4) phase_rwkv_prep4(c, l); else phase_rwkv_prep3(c, l); }
    if constexpr (PH == PH_CHUNK) { if (!RWKV_NAIVE) phase_rwkv_chunk(c); }
    if constexpr (PH == PH_RWKV_OUT) { if (!RWKV_NAIVE) phase_rwkv_out(c, l); }
#ifndef MLA_NAIVE
#define MLA_NAIVE 0
#endif
    if constexpr (PH == PH_MLA_PREP) { if (MLA_NAIVE) phase_mla_prep(c, l); else {
        pg8::Gemm g{Zb + ZCQ, (const bf16*)(c.ws + WS_WSM + WSM_UQ) + (size_t)l * 768 * 256, M, 768, 256, ZP}; pg8::StaticOrder S; S.init(M, 768, c.nb, c.bid); pg8::EpiBf16P E{(bf16*)(c.R + R_QR), 768, 3, nullptr, 0.f};
        pg8::gemm_phase<pg8::EpiBf16P, pg8::StaticOrder, true, true>(c.lds, g, S, E); } }
    if constexpr (PH == PH_MLA_PREP2) { if (!MLA_NAIVE) {
        int k128 = 128; asm volatile("" : "+s"(k128));
        pg8::Gemm g{Zb + ZCKV, (const bf16*)(c.ws + WS_WSM + WSM_UKV) + (size_t)l * 768 * 128, M, 768, k128, ZP}; pg8::StaticOrder S; S.init(M, 768, c.nb, (c.bid + 192) % c.nb); pg8::EpiBf16P E{(bf16*)(c.R + R_KVR), 768, 3, nullptr, 0.f};
        pg8::gemm_phase<pg8::EpiBf16P, pg8::StaticOrder, true, true>(c.lds, g, S, E); } }
    #ifndef MLA_POST1_OLD
#define MLA_POST1_OLD 0
#endif
    if constexpr (PH == PH_MLA_POST1) { if (!MLA_NAIVE) { if (MLA_POST1_OLD) phase_mla_post1(c, l); else phase_mla_post1b(c, l); } }
#ifndef GMLP_NAIVE
#define GMLP_NAIVE 0
#endif
    if constexpr (PH == PH_GMLP) { if (GMLP_NAIVE) phase_gmlp(c, l); else phase_gmlp_mfma(c, l); }
    if constexpr (PH == PH_SCAN) { if (RWKV_NAIVE) phase_rwkv_scan_naive(c); else phase_rwkv_scan2(c); }
#ifndef ATTN_NAIVE
#define ATTN_NAIVE 0
#endif
#ifndef ATTN_ONE_TILE
#define ATTN_ONE_TILE 0
#endif
    if constexpr (PH == PH_ATTN) { if (ATTN_NAIVE) phase_attn_naive(c); else if (ATTN_ONE_TILE) phase_attn_mfma(c); else phase_attn_mfma2(c, l); }
    if constexpr (PH == PH_POST) { if (RWKV_NAIVE) phase_rwkv_post(c, l); phase_mla_post(c, l); }
    if constexpr (PH == PH_GEMM_OUT) { pg8::Gemm g{YC, (const bf16*)(c.ws + WS_WOUT) + (size_t)l * D * D, M, D, D, 0}; pg8::StaticOrder S; S.init(M, D, c.nb, c.bid); pg8::EpiResF32 E{l == 0 ? (const float*)c.in(I_X) : (const float*)c.out(), (float*)c.out(), D};
        pg8::gemm_phase<pg8::EpiResF32, pg8::StaticOrder, true, true>(c.lds, g, S, E); }
    if constexpr (PH == PH_NORM2) phase_rmsnorm<false>(c, c.out(), c.in(I_FFNG), XNg, nullptr);
    if constexpr (PH == PH_DGU) { pg8::Gemm g{(const bf16*)(c.R + R_XN2), (const bf16*)(c.ws + WS_WDGU), M, 2 * DFF, D, 0}; pg8::StaticOrder S; S.init(M, 2 * DFF, c.nb, c.bid); pg8::EpiSwiGLU E{(bf16*)(c.R + R_H), DFF, 2 * DFF / 256, (const float*)(c.R + R_SS0), 1.0f / D};
        pg8::gemm_phase<pg8::EpiSwiGLU, pg8::StaticOrder, true, true>(c.lds, g, S, E); }
    if constexpr (PH == PH_DDOWN) { pg8::Gemm g{(const bf16*)(c.R + R_H), (const bf16*)(c.ws + WS_WDD), M, D, DFF, 0}; pg8::StaticOrder S; S.init(M, D, c.nb, c.bid);
        pg8::EpiResF32N E{(const float*)c.out(), (float*)c.out(), D, XN, (const float*)(c.in(I_MIXG) + D), (float*)(c.R + R_SS1)};
        pg8::gemm_phase<pg8::EpiResF32N, pg8::StaticOrder, true, true>(c.lds, g, S, E); }
    if constexpr (PH == PH_GEMM_OUTN) { pg8::Gemm g{YC, (const bf16*)(c.ws + WS_WOUT), M, D, D, 0}; pg8::StaticOrder S; S.init(M, D, c.nb, c.bid);
        pg8::EpiResF32N E{(const float*)c.in(I_X), (float*)c.out(), D, (bf16*)(c.R + R_XN2), (const float*)c.in(I_FFNG), (float*)(c.R + R_SS0)};
        pg8::gemm_phase<pg8::EpiResF32N, pg8::StaticOrder, true, true>(c.lds, g, S, E); }
    if constexpr (PH == PH_NORM2R) { phase_rmsnorm<true>(c, c.out(), c.in(I_FFNG) + D, XNg, c.in(I_ROUTER)); __syncthreads(); phase_conv_experts(c); }
    if constexpr (PH == PH_COUNT) phase_moe_count(c);
    if constexpr (PH == PH_SCATTER) phase_moe_scatter(c);
    if constexpr (PH == PH_EGU || PH == PH_EDOWN || PH == PH_EDOWNX) {
        const int* tile = (const int*)(c.ws + WS_TOK + TOK_TILE); LAS int* te = (LAS int*)(c.lds + RING_BYTES + 8192);
        const int T = __builtin_amdgcn_readfirstlane(tile[16]);
        __syncthreads();
        if (c.tid < 2 * M / 256 + NE) te[c.tid] = tile[32 + c.tid];
        __syncthreads();
        const int nx = T - 2 * HMAIN, ndx = nx * (D / 256) < c.nb / 2 ? nx * (D / 256) : 0;
        if constexpr (PH == PH_EGU) {
            const int t0 = e ? HMAIN : 0, n1 = e ? 0 : nx;
            pg8::Gemm g{(const bf16*)(c.R + R_XNP), (const bf16*)(c.R + R_WMGU), M2MAX, NE * 2 * DFE, D, 0};
            pg8::MoeOrder<true> S{te, t0, HMAIN, 0, 2 * HMAIN, n1, HMAIN, 2 * DFE / 256, c.nb, c.bid, e ? ndx : 0, 4};
            pg8::EpiSwiGLU E{(bf16*)(c.R + R_HME), DFE, 2 * DFE / 256, nullptr, 0.f};
            pg8::gemm_phase<pg8::EpiSwiGLU, pg8::MoeOrder<true>, true, true>(c.lds, g, S, E);
        } else {
            const bool xtra = PH == PH_EDOWNX;
            if (!xtra || ndx > 0) {
            pg8::Gemm g{(const bf16*)(c.R + R_HME), (const bf16*)(c.R + R_WMD), HCAP * 256, NE * D, DFE, 0};
            pg8::MoeOrder<false> S{te, xtra ? 2 * HMAIN : (e ? HMAIN : 0), xtra ? nx : HMAIN, xtra ? HMAIN : 0, 2 * HMAIN, (!xtra && !e && ndx == 0) ? nx : 0, HMAIN, D / 256, c.nb, c.bid, 0, 0};
            pg8::EpiBf16P E{(bf16*)(c.R + R_YP), D, D / 256, nullptr, 0.f};
            pg8::gemm_phase<pg8::EpiBf16P, pg8::MoeOrder<false>, true, true>(c.lds, g, S, E); }
        }
    }
    if constexpr (PH == PH_COMBINE) phase_moe_combine(c);
}


__device__ __forceinline__ void make_ctx(Ctx& c, LAS unsigned char* lds, int wave_s) {
    (void)wave_s; int tid = threadIdx.x; asm volatile("" : "+v"(tid));
    int bid = blockIdx.x, nb = gridDim.x; asm volatile("" : "+s"(bid)); asm volatile("" : "+s"(nb));
    c.lds = lds; c.tid = tid; c.lane = tid & 63; c.wave = __builtin_amdgcn_readfirstlane(tid >> 6); c.bid = bid; c.nb = nb;
    c.gw = c.bid * NWAVES + c.wave; c.ngw = c.nb * NWAVES; c.ws = (GAS unsigned char*)c.ptr_(40); c.R = c.ws + WS_R;
}
__device__ __forceinline__ void kernel_prologue(const Args& args, LAS unsigned char* lds) {
    for (int u = threadIdx.x; u < (LDS_BYTES - RING_BYTES) / 4; u += NTHR) ((LAS unsigned*)(lds + RING_BYTES))[u] = 0u;
    __syncthreads();
    if (threadIdx.x < 82) ((LAS unsigned*)(lds + ARGS_OFF))[threadIdx.x] = ((const unsigned*)&args)[threadIdx.x];
    __syncthreads();
}
template <int PH> __device__ __forceinline__ void run_phase(LAS unsigned char* lds, int l, int e, int wave_s) {
    asm volatile("" : "+s"(l)); asm volatile("" : "+s"(e)); asm volatile("" : "+s"(wave_s));
    Ctx c; make_ctx(c, lds, wave_s);
    do_phase<PH>(c, l, e);
}
#if !MK_ONE_LAUNCH
template <int PH> __global__ void __launch_bounds__(NTHR, 2) k_ph(Args args, int l, int e) {
    extern __shared__ __attribute__((aligned(16))) unsigned char lds_raw[];
    kernel_prologue(args, (LAS unsigned char*)lds_raw);
    run_phase<PH>((LAS unsigned char*)lds_raw, l, e, __builtin_amdgcn_readfirstlane(threadIdx.x >> 6));
}
#else
__global__ void __launch_bounds__(NTHR, 2) k_mega(Args args) {
    extern __shared__ __attribute__((aligned(16))) unsigned char lds_raw[];
    LAS unsigned char* lds = (LAS unsigned char*)lds_raw;
    kernel_prologue(args, lds);
    volatile LAS unsigned* MISC = (volatile LAS unsigned*)(lds + MISC_OFF);
    (void)xcd_barrier_post((unsigned*)(args.ws + WS_CTL) + CW_BAR, MISC + 8);
    int wave_s = __builtin_amdgcn_readfirstlane(threadIdx.x >> 6);
#define GRIDBAR() do { Ctx cb_; cb_.lds = lds; XcdBarrier b_; b_.bar = (unsigned*)((unsigned char*)cb_.ptr_(40) + WS_CTL) + CW_BAR; b_.x = xb_xcc_id(); b_.st = (volatile LAS unsigned*)(lds + MISC_OFF) + 8; xcd_barrier(b_); } while (0)
#define PHASE(PH, l, e) do { run_phase<PH>(lds, l, e, wave_s); GRIDBAR(); } while (0)
#define MIXER_CORE(l) do { run_phase<PH_GEMM_IN>(lds, l, 0, wave_s); if ((l) == 0) run_phase<PH_CONVB>(lds, 0, 0, wave_s); GRIDBAR(); \
        run_phase<PH_RWKV_PREP>(lds, l, 0, wave_s); run_phase<PH_MLA_PREP>(lds, l, 0, wave_s); run_phase<PH_MLA_PREP2>(lds, l, 0, wave_s); PHASE(PH_GMLP, l, 0); \
        run_phase<PH_MLA_POST1>(lds, l, 0, wave_s); PHASE(PH_CHUNK, l, 0); \
        run_phase<PH_SCAN>(lds, l, 0, wave_s); PHASE(PH_ATTN, l, 0); \
        run_phase<PH_RWKV_OUT>(lds, l, 0, wave_s); PHASE(PH_POST, l, 0); } while (0)
    run_phase<PH_CONV>(lds, 0, 0, wave_s); PHASE(PH_NORM1, 0, 0);
    MIXER_CORE(0);
    PHASE(PH_GEMM_OUTN, 0, 0);
    PHASE(PH_DGU, 0, 0); PHASE(PH_DDOWN, 0, 0);
    MIXER_CORE(1);
    PHASE(PH_GEMM_OUT, 1, 0);
    PHASE(PH_NORM2R, 1, 0); PHASE(PH_SCATTER, 1, 0);
    PHASE(PH_EGU, 1, 0); PHASE(PH_EDOWN, 1, 0); run_phase<PH_EDOWNX>(lds, 1, 0, wave_s); PHASE(PH_EGU, 1, 1); PHASE(PH_EDOWN, 1, 1);
    run_phase<PH_COMBINE>(lds, 1, 0, wave_s);
#undef MIXER_CORE
#undef PHASE
#undef GRIDBAR
}
#endif

#if !MK_ONE_LAUNCH
template <int PH> static void launch_ph(const Args& a, int l, int e, int grid, hipStream_t stream) {
    static bool attr = false;
    if (!attr) { (void)hipFuncSetAttribute((const void*)k_ph<PH>, hipFuncAttributeMaxDynamicSharedMemorySize, LDS_BYTES); attr = true; }
    hipLaunchKernelGGL(k_ph<PH>, dim3(grid), dim3(NTHR), LDS_BYTES, stream, a, l, e);
}
#endif
extern "C" void kernel_launch(void* const* d_in, const int* in_sizes, int n_in, void* d_out, int out_size, void* d_ws, size_t ws_size, hipStream_t stream) {
    static int grid = 0;
    if (grid == 0) {
        if (n_in != 39 || out_size != M * D || ws_size < WS_END) { fprintf(stderr, "kernel_launch: unexpected shapes (n_in %d, out %d, ws %zu < %zu)\n", n_in, out_size, ws_size, (size_t)WS_END); grid = -1; return; }
        int dev = 0, cus = 0;
        if (hipGetDevice(&dev) != hipSuccess || hipDeviceGetAttribute(&cus, hipDeviceAttributeMultiprocessorCount, dev) != hipSuccess) { grid = -1; return; }
        grid = cus;
    }
    if (grid < 0) return;
    Args a{};
    for (int i = 0; i < 39; ++i) a.in[i] = (const float*)d_in[i];
    a.out = (float*)d_out; a.ws = (unsigned char*)d_ws; a.ph_lo = 0; a.ph_hi = 0;
#if MK_ONE_LAUNCH
    {
        static bool attr = false;
        if (!attr) { (void)hipFuncSetAttribute((const void*)k_mega, hipFuncAttributeMaxDynamicSharedMemorySize, LDS_BYTES); attr = true; }
        (void)hipMemsetAsync((char*)d_ws + WS_CTL, 0, CTL_ZERO_BYTES, stream);
        hipLaunchKernelGGL(k_mega, dim3(grid), dim3(NTHR), LDS_BYTES, stream, a);
        return;
    }
#else
    (void)hipMemsetAsync((char*)d_ws + WS_CTL, 0, CTL_ZERO_BYTES, stream);
    launch_ph<PH_CONV>(a, 0, 0, grid, stream); launch_ph<PH_NORM1>(a, 0, 0, grid, stream);
    for (int l = 0; l < 2; ++l) {
        launch_ph<PH_GEMM_IN>(a, l, 0, grid, stream); if (l == 0) launch_ph<PH_CONVB>(a, 0, 0, grid, stream);
        launch_ph<PH_RWKV_PREP>(a, l, 0, grid, stream); launch_ph<PH_MLA_PREP>(a, l, 0, grid, stream); launch_ph<PH_MLA_PREP2>(a, l, 0, grid, stream); launch_ph<PH_GMLP>(a, l, 0, grid, stream);
        launch_ph<PH_MLA_POST1>(a, l, 0, grid, stream); launch_ph<PH_CHUNK>(a, l, 0, grid, stream);
        launch_ph<PH_SCAN>(a, l, 0, grid, stream); launch_ph<PH_ATTN>(a, l, 0, grid, stream);
        launch_ph<PH_RWKV_OUT>(a, l, 0, grid, stream); launch_ph<PH_POST>(a, l, 0, grid, stream);
        if (l == 0) { launch_ph<PH_GEMM_OUTN>(a, 0, 0, grid, stream); launch_ph<PH_DGU>(a, 0, 0, grid, stream); launch_ph<PH_DDOWN>(a, 0, 0, grid, stream); }
        else { launch_ph<PH_GEMM_OUT>(a, 1, 0, grid, stream);
            launch_ph<PH_NORM2R>(a, 1, 0, grid, stream); launch_ph<PH_SCATTER>(a, 1, 0, grid, stream);
            launch_ph<PH_EGU>(a, 1, 0, grid, stream); launch_ph<PH_EDOWN>(a, 1, 0, grid, stream); launch_ph<PH_EDOWNX>(a, 1, 0, grid, stream);
            launch_ph<PH_EGU>(a, 1, 1, grid, stream); launch_ph<PH_EDOWN>(a, 1, 1, grid, stream);
            launch_ph<PH_COMBINE>(a, 1, 0, grid, stream); }
    }
#endif
}
```

```cpp
#include <hip/hip_runtime.h>
#include <cstdio>
#include <cstdint>
#include <cmath>
namespace pg8 {
#define PG8_LAS __attribute__((address_space(3)))
typedef unsigned short bf16_t;
typedef short bf16x8 __attribute__((ext_vector_type(8)));
typedef float f32x4 __attribute__((ext_vector_type(4)));
typedef unsigned u32x4 __attribute__((ext_vector_type(4)));
constexpr int BM = 256, BK = 64, HALF = 128, HTB = HALF * BK * 2  , STAGE_BYTES = 8 * HTB, NXCD = 8, WGM = 8;

__host__ __device__ __forceinline__ int lds_byte(int r, int c) { const int st = (r >> 4) * 2 + (c >> 5), rr = r & 15, cc = c & 31, ob = rr * 64 + cc * 2; return st * 1024 + (ob ^ (((ob >> 9) & 1) << 5)); }
__host__ __device__ __forceinline__ void stage_rc(int b, int& R, int& C) { const int st = b / 1024, sb = b % 1024, swz = sb ^ (((sb >> 9) & 1) << 5); R = (st >> 1) * 16 + swz / 64; C = (st & 1) * 32 + (swz % 64) / 2; }
__host__ __device__ __forceinline__ int perm32(int rho) { const int n = rho >> 4, i = rho & 15; return 8 * (i >> 2) + 4 * n + (i & 3); }

struct Unit { int pm, pn, po; };
struct Gemm { const bf16_t* A; const bf16_t* Bt; int M, N, K, lda; };

struct StaticOrder {
    int nM, nN, nwg, G, c;
    __host__ __device__ void init(int M, int N, int G_, int c_) { nM = M / BM; nN = N / BM; nwg = nM * nN; G = G_; c = c_; }
    __host__ __device__ bool next(int i, Unit& u) const {
        const long L = (long)i * G + c; if (L >= nwg) return false;
        int wgid = (int)L; { const int q = nwg / NXCD, r = nwg % NXCD, xcd = wgid % NXCD, off = wgid / NXCD; wgid = (xcd < r ? xcd * (q + 1) : r * (q + 1) + (xcd - r) * q) + off; }
        const int nig = WGM * nN, gid = wgid / nig, fm = gid * WGM, gsz = (nM - fm) < WGM ? (nM - fm) : WGM;
        u.pm = fm + ((wgid % nig) % gsz); u.pn = (wgid % nig) / gsz; u.po = u.pm; return true;
    }
    __device__ __forceinline__ void a_ready(const Unit&) const {}
    __device__ __forceinline__ void done(const Unit&) const {}
};

__device__ __forceinline__ unsigned cvt_pk_bf16(float lo, float hi) { unsigned r; asm volatile("v_cvt_pk_bf16_f32 %0, %1, %2" : "=v"(r) : "v"(lo), "v"(hi)); return r; }
typedef float f32x2 __attribute__((ext_vector_type(2)));
__device__ __forceinline__ f32x2 gelu_pk(f32x2 v) {
    const f32x2 av = __builtin_elementwise_abs(v), d = av * 0.2316418882f + 1.0f;
    f32x2 t; t.x = __builtin_amdgcn_rcpf(d.x); t.y = __builtin_amdgcn_rcpf(d.y);
    f32x2 q = t * 0.5307027145f + (-0.7265760135f); q = q * t + 0.7107068705f; q = q * t + (-0.142248368f); q = q * t + 0.127414796f; q = q * t;
    const f32x2 s = (v * v) * (-0.72134752044f);
    f32x2 e; e.x = __builtin_amdgcn_exp2f(s.x); e.y = __builtin_amdgcn_exp2f(s.y);
    const f32x2 m = v * (q * e), r = v - m;
    f32x2 o; o.x = v.x < 0.f ? m.x : r.x; o.y = v.y < 0.f ? m.y : r.y; return o;
}

template <int ACT  > struct EpiBf16 {
    static constexpr bool PERM = true, AFTER_DRAIN = false; static_assert(ACT == 0 || ACT == 1, "EpiBf16: ACT is 0 (none) or 1 (gelu_pk)");
    bf16_t* O; int ldc; const float* bias; int split_cols; size_t split_stride; float scale0;
    __device__ __forceinline__ void operator()(const f32x4 (&acc)[2][2][4][2], const Unit& u, int wr, int wc, int fr, int fq) const {
        const int row0 = u.po * BM + wr * 64 + fr; int colt = u.pn * BM; bf16_t* base = O;
        float sc = 1.f; if (split_cols) { const int t = colt / split_cols; base += (size_t)t * split_stride; colt -= t * split_cols; if (t == 0) sc = scale0; }
        const int col0 = colt + wc * 32 + 8 * fq, bcol0 = u.pn * BM + wc * 32 + 8 * fq;
        f32x4 bv[2][2];
#pragma unroll
        for (int bj = 0; bj < 2; ++bj)
#pragma unroll
            for (int n = 0; n < 2; ++n) bv[bj][n] = bias ? *(const f32x4*)(bias + bcol0 + bj * HALF + 4 * n) : (f32x4){0.f, 0.f, 0.f, 0.f};
#pragma unroll
        for (int ai = 0; ai < 2; ++ai)
#pragma unroll
            for (int m = 0; m < 4; ++m) { bf16_t* rowp = base + (size_t)(row0 + ai * HALF + m * 16) * ldc + col0;
#pragma unroll
                for (int bj = 0; bj < 2; ++bj) { f32x4 v0 = acc[ai][bj][m][0] + bv[bj][0], v1 = acc[ai][bj][m][1] + bv[bj][1];
                    if (ACT == 1) { f32x2 a = gelu_pk((f32x2){v0[0], v0[1]}), b = gelu_pk((f32x2){v0[2], v0[3]}), c = gelu_pk((f32x2){v1[0], v1[1]}), d = gelu_pk((f32x2){v1[2], v1[3]});
                        v0 = (f32x4){a.x, a.y, b.x, b.y}; v1 = (f32x4){c.x, c.y, d.x, d.y}; }
                    v0 = v0 * sc; v1 = v1 * sc; u32x4 w; w.x = cvt_pk_bf16(v0[0], v0[1]); w.y = cvt_pk_bf16(v0[2], v0[3]); w.z = cvt_pk_bf16(v1[0], v1[1]); w.w = cvt_pk_bf16(v1[2], v1[3]);
                    *(u32x4*)(rowp + bj * HALF) = w; } }
    }
};

typedef unsigned u32x2v __attribute__((ext_vector_type(2)));
template <bool BB> __device__ __forceinline__ f32x4 res_load(const void* base, size_t idx) {
    if constexpr (BB) { const u32x2v w = *(const u32x2v*)((const bf16_t*)base + idx); return (f32x4){__builtin_bit_cast(float, w.x << 16), __builtin_bit_cast(float, w.x & 0xffff0000u), __builtin_bit_cast(float, w.y << 16), __builtin_bit_cast(float, w.y & 0xffff0000u)}; }
    else return *(const f32x4*)((const float*)base + idx); }
template <bool OB> __device__ __forceinline__ void res_store(void* out, size_t idx, const f32x4 v) {
    if constexpr (OB) *(u32x2v*)((bf16_t*)out + idx) = (u32x2v){cvt_pk_bf16(v[0], v[1]), cvt_pk_bf16(v[2], v[3])};
    else *(f32x4*)((float*)out + idx) = v; }
template <bool BB, bool OB> struct EpiResT {
    static constexpr bool PERM = false, AFTER_DRAIN = false;
    const void* base; void* out; int ldc;
    __device__ __forceinline__ void operator()(const f32x4 (&acc)[2][2][4][2], const Unit& u, int wr, int wc, int fr, int fq) const {
        const int row0 = u.po * BM + wr * 64 + fr, col0 = u.pn * BM + wc * 32 + 4 * fq;
#pragma unroll
        for (int ai = 0; ai < 2; ++ai)
#pragma unroll
            for (int m = 0; m < 4; ++m) { const size_t off = (size_t)(row0 + ai * HALF + m * 16) * ldc + col0;
#pragma unroll
                for (int bj = 0; bj < 2; ++bj)
#pragma unroll
                    for (int n = 0; n < 2; ++n) { const f32x4 b = res_load<BB>(base, off + bj * HALF + n * 16); res_store<OB>(out, off + bj * HALF + n * 16, b + acc[ai][bj][m][n]); } }
    }
};
typedef EpiResT<false, false> EpiResF32;
template <bool BB, bool OB> struct EpiResNT {
    static constexpr bool PERM = false, AFTER_DRAIN = false;
    const void* base; void* out; int ldc; bf16_t* xn; const float* gain; float* ss;
    __device__ __forceinline__ void operator()(const f32x4 (&acc)[2][2][4][2], const Unit& u, int wr, int wc, int fr, int fq) const {
        const int row0 = u.po * BM + wr * 64 + fr, col0 = u.pn * BM + wc * 32 + 4 * fq;
        f32x4 gv[2][2];
#pragma unroll
        for (int bj = 0; bj < 2; ++bj)
#pragma unroll
            for (int n = 0; n < 2; ++n) gv[bj][n] = *(const f32x4*)(gain + col0 + bj * HALF + n * 16);
#pragma unroll
        for (int ai = 0; ai < 2; ++ai)
#pragma unroll
            for (int m = 0; m < 4; ++m) { const int row = row0 + ai * HALF + m * 16; const size_t off = (size_t)row * ldc + col0; float s = 0.f;
#pragma unroll
                for (int bj = 0; bj < 2; ++bj)
#pragma unroll
                    for (int n = 0; n < 2; ++n) { const f32x4 b = res_load<BB>(base, off + bj * HALF + n * 16); const f32x4 v = b + acc[ai][bj][m][n]; res_store<OB>(out, off + bj * HALF + n * 16, v);
                        s += (v[0] * v[0] + v[1] * v[1]) + (v[2] * v[2] + v[3] * v[3]); const f32x4 w = v * gv[bj][n];
                        *(u32x2v*)(xn + off + bj * HALF + n * 16) = (u32x2v){cvt_pk_bf16(w[0], w[1]), cvt_pk_bf16(w[2], w[3])}; }
                s += __shfl_xor(s, 16); s += __shfl_xor(s, 32);
                if (fq == 0) ss[(size_t)row * 16 + u.pn * 4 + wc] = s; }
    }
};
typedef EpiResNT<false, false> EpiResF32N;
__device__ __forceinline__ float row_rstd(const float* ss, int row, float inv_n, float eps) { if (!ss) return 1.0f;
    const f32x4* p = (const f32x4*)(ss + (size_t)row * 16); const f32x4 a = p[0], b = p[1], c = p[2], d = p[3];
    const float t = ((a[0] + a[1]) + (a[2] + a[3])) + ((b[0] + b[1]) + (b[2] + b[3])) + (((c[0] + c[1]) + (c[2] + c[3])) + ((d[0] + d[1]) + (d[2] + d[3])));
    return __builtin_amdgcn_rsqf(t * inv_n + eps); }
struct EpiBf16P {
    static constexpr bool PERM = true, AFTER_DRAIN = false;
    bf16_t* O; int ldc; int ntn; const float* ss; float inv_n;
    __device__ __forceinline__ void operator()(const f32x4 (&acc)[2][2][4][2], const Unit& u, int wr, int wc, int fr, int fq) const {
        const int row0 = u.po * BM + wr * 64 + fr, col0 = (u.pn % ntn) * BM + wc * 32 + 8 * fq;
#pragma unroll
        for (int ai = 0; ai < 2; ++ai)
#pragma unroll
            for (int m = 0; m < 4; ++m) { bf16_t* rowp = O + (size_t)(row0 + ai * HALF + m * 16) * ldc + col0; const float rs = row_rstd(ss, row0 + ai * HALF + m * 16, inv_n, 1e-6f);
#pragma unroll
                for (int bj = 0; bj < 2; ++bj) { const f32x4 v0 = acc[ai][bj][m][0] * rs, v1 = acc[ai][bj][m][1] * rs;
                    u32x4 w; w.x = cvt_pk_bf16(v0[0], v0[1]); w.y = cvt_pk_bf16(v0[2], v0[3]); w.z = cvt_pk_bf16(v1[0], v1[1]); w.w = cvt_pk_bf16(v1[2], v1[3]);
                    *(u32x4*)(rowp + bj * HALF) = w; } }
    }
};
__device__ __forceinline__ float silu_f(float x) { return x / (1.0f + __expf(-x)); }
struct EpiSwiGLU {
    static constexpr bool PERM = true, AFTER_DRAIN = false;
    bf16_t* H; int ldh; int ntn; const float* ss; float inv_n;
    __device__ __forceinline__ void operator()(const f32x4 (&acc)[2][2][4][2], const Unit& u, int wr, int wc, int fr, int fq) const {
        const int row0 = u.po * BM + wr * 64 + fr, col0 = (u.pn % ntn) * HALF + wc * 32 + 8 * fq;
#pragma unroll
        for (int ai = 0; ai < 2; ++ai)
#pragma unroll
            for (int m = 0; m < 4; ++m) { bf16_t* rowp = H + (size_t)(row0 + ai * HALF + m * 16) * ldh + col0;
                const float rs = row_rstd(ss, row0 + ai * HALF + m * 16, inv_n, 1e-6f);
                const f32x4 g0 = acc[ai][0][m][0] * rs, g1 = acc[ai][0][m][1] * rs, u0 = acc[ai][1][m][0] * rs, u1 = acc[ai][1][m][1] * rs;
                u32x4 w;
                w.x = cvt_pk_bf16(silu_f(g0[0]) * u0[0], silu_f(g0[1]) * u0[1]); w.y = cvt_pk_bf16(silu_f(g0[2]) * u0[2], silu_f(g0[3]) * u0[3]);
                w.z = cvt_pk_bf16(silu_f(g1[0]) * u1[0], silu_f(g1[1]) * u1[1]); w.w = cvt_pk_bf16(silu_f(g1[2]) * u1[2], silu_f(g1[3]) * u1[3]);
                *(u32x4*)rowp = w; }
    }
};
struct RangeOrder {
    int pm0, nM, pn0, nN, G, c;
    __device__ __forceinline__ bool next(int i, Unit& u) const { const int L = i * G + c; if (L >= nM * nN) return false; const int q = L / nM; u.pn = pn0 + q; u.pm = pm0 + (L - q * nM); u.po = u.pm; return true; }
    __device__ __forceinline__ void a_ready(const Unit&) const {}
    __device__ __forceinline__ void done(const Unit&) const {}
};

template <bool AROW> struct MoeOrder {
    const PG8_LAS int* te; int t0, n0, s0, t1, n1, s1, nN, G, c, nq, q;
    __device__ __forceinline__ bool next(int i, Unit& u) const { const int U = (n0 + n1) * nN; int L;
        if (c < nq) { if (i >= q) return false; L = c * q + i; } else L = nq * q + (c - nq) + i * (G - nq);
        if (L >= U) return false; const int ti = L / nN, pn = L - ti * nN;
        const int tile = ti < n0 ? t0 + ti : t1 + (ti - n0), slot = ti < n0 ? s0 + ti : s1 + (ti - n0); const int e = te[tile];
        u.pn = e * nN + pn; u.pm = AROW ? tile : slot; u.po = AROW ? slot : tile; return true; }
    __device__ __forceinline__ void a_ready(const Unit&) const {}
    __device__ __forceinline__ void done(const Unit&) const {}
};
template <class Epi, class Sched, bool ALIGN_EPI = false, bool SP2 = false>
__device__ __forceinline__ void gemm_phase(PG8_LAS unsigned char* lds, const Gemm g, const Sched& S, const Epi& E) {
    int tid_ = threadIdx.x; asm volatile("" : "+v"(tid_));
    const int tid = tid_, wid = __builtin_amdgcn_readfirstlane(tid >> 6), lane = tid & 63, wr = wid >> 2, wc = wid & 3, fr = lane & 15, fq = lane >> 4;
    const int K = g.K, nt = K / BK, lda = g.lda ? g.lda : K;
    unsigned voffA[2], voffB[2];
#pragma unroll
    for (int i = 0; i < 2; ++i) { int R, C; stage_rc(tid * 16 + i * 8192, R, C); const int Rb = Epi::PERM ? ((R & ~31) + perm32(R & 31)) : R;
        voffA[i] = (unsigned)(R * lda + C) * 2u; voffB[i] = (unsigned)(Rb * K + C) * 2u; }
    const size_t kstep = (size_t)(BK * 2);
    const size_t hstep = (size_t)HALF * K * 2, hstepA = (size_t)HALF * lda * 2;
    const size_t tstep = 2 * hstep, tstepA = 2 * hstepA;
    const unsigned ldsw = (unsigned)wid * 1024u;
    const int aoff = lds_byte(wr * 64 + fr, fq * 8), boff = lds_byte(wc * 32 + fr, fq * 8);
#define PG8_SA(b, h) (((b) * 2 + (h)) * HTB)
#define PG8_SB(b, h) ((4 + (b) * 2 + (h)) * HTB)
#define PG8_STAGE(bufoff, gbase, voff) do { _Pragma("unroll") for (int _i = 0; _i < 2; ++_i) \
        __builtin_amdgcn_global_load_lds((const unsigned*)((const char*)(gbase) + (voff)[_i]), (PG8_LAS unsigned*)(lds + (bufoff) + ldsw + _i * 8192), 16, 0, 0); } while (0)
#define PG8_LDA(dst, b, h) do { _Pragma("unroll") for (int m = 0; m < 4; ++m) _Pragma("unroll") for (int k = 0; k < 2; ++k) dst[m][k] = *(const PG8_LAS bf16x8*)(lds + PG8_SA(b, h) + aoff + m * 2048 + k * 1024); } while (0)
#define PG8_LDB(dst, b, h) do { _Pragma("unroll") for (int n = 0; n < 2; ++n) _Pragma("unroll") for (int k = 0; k < 2; ++k) dst[n][k] = *(const PG8_LAS bf16x8*)(lds + PG8_SB(b, h) + boff + n * 2048 + k * 1024); } while (0)
#define PG8_MMA(ai, bj, At, Bt) do { __builtin_amdgcn_s_setprio(1); _Pragma("unroll") for (int m = 0; m < 4; ++m) _Pragma("unroll") for (int n = 0; n < 2; ++n) _Pragma("unroll") for (int k = 0; k < 2; ++k) \
        acc[ai][bj][m][n] = __builtin_amdgcn_mfma_f32_16x16x32_bf16(Bt[n][k], At[m][k], acc[ai][bj][m][n], 0, 0, 0); __builtin_amdgcn_s_setprio(0); } while (0)
#define PG8_WAIT_V(n) asm volatile("s_waitcnt vmcnt(" #n ")" ::: "memory")
#define PG8_WAIT_L(n) asm volatile("s_waitcnt lgkmcnt(" #n ")" ::: "memory")
#define PG8_BAR __builtin_amdgcn_s_barrier()
#define PG8_SCHED __builtin_amdgcn_sched_barrier(0)
    Unit cur, nxt; int ui = 0;
    if (!S.next(0, cur)) return;
    f32x4 acc[2][2][4][2];
#pragma unroll
    for (int a = 0; a < 2; ++a)
#pragma unroll
        for (int b = 0; b < 2; ++b)
#pragma unroll
            for (int m = 0; m < 4; ++m)
#pragma unroll
                for (int n = 0; n < 2; ++n) acc[a][b][m][n] = (f32x4){0.f, 0.f, 0.f, 0.f};
    bf16x8 At[4][2], B0[2][2], B1[2][2];
    const char* cA = (const char*)g.A + (size_t)cur.pm * tstepA; const char* cB = (const char*)g.Bt + (size_t)cur.pn * tstep;
    S.a_ready(cur);
    if constexpr (SP2) {
        PG8_STAGE(PG8_SB(0, 0), cB, voffB); PG8_STAGE(PG8_SB(0, 1), cB + hstep, voffB); PG8_STAGE(PG8_SA(0, 0), cA, voffA); PG8_STAGE(PG8_SA(0, 1), cA + hstepA, voffA);
        if (wr == 1) PG8_BAR;
        PG8_WAIT_V(2); PG8_BAR;
        PG8_STAGE(PG8_SB(1, 0), cB + kstep, voffB); PG8_STAGE(PG8_SA(1, 0), cA + kstep, voffA); PG8_STAGE(PG8_SB(1, 1), cB + hstep + kstep, voffB);
        PG8_WAIT_V(6); PG8_BAR;
    } else {
        PG8_STAGE(PG8_SB(0, 0), cB, voffB); PG8_STAGE(PG8_SA(0, 0), cA, voffA); PG8_STAGE(PG8_SB(0, 1), cB + hstep, voffB); PG8_STAGE(PG8_SA(0, 1), cA + hstepA, voffA);
        if (wr == 1) PG8_BAR;
        PG8_WAIT_V(4); PG8_BAR;
        PG8_STAGE(PG8_SB(1, 0), cB + kstep, voffB); PG8_STAGE(PG8_SA(1, 0), cA + kstep, voffA); PG8_STAGE(PG8_SB(1, 1), cB + hstep + kstep, voffB);
        PG8_WAIT_V(6); PG8_BAR;
    }
    for (;;) {
        const bool has_next = S.next(ui + 1, nxt);
        const char* nA = has_next ? (const char*)g.A + (size_t)nxt.pm * tstepA : cA; const char* nB = has_next ? (const char*)g.Bt + (size_t)nxt.pn * tstep : cB;
        for (int t = 0; t < nt; t += 2) {
            const bool last = (t == nt - 2);
            const char* a1 = cA + (size_t)(t + 1) * kstep;
            const char* a2 = last ? nA : cA + (size_t)(t + 2) * kstep; const char* b2 = last ? nB : cB + (size_t)(t + 2) * kstep;
            const char* a3 = a2 + kstep; const char* b3 = b2 + kstep;
            if (last && has_next) S.a_ready(nxt);
            if constexpr (SP2) {
            PG8_LDB(B0, 0, 0); PG8_LDB(B1, 0, 1); PG8_SCHED; PG8_LDA(At, 0, 0); PG8_STAGE(PG8_SA(1, 1), a1 + hstepA, voffA);
            PG8_WAIT_V(8); PG8_WAIT_L(0); PG8_BAR; PG8_MMA(0, 0, At, B0); PG8_MMA(0, 1, At, B1); PG8_BAR; PG8_SCHED;
            PG8_LDA(At, 0, 1); PG8_STAGE(PG8_SB(0, 0), b2, voffB); PG8_STAGE(PG8_SB(0, 1), b2 + hstep, voffB); PG8_STAGE(PG8_SA(0, 0), a2, voffA);
            PG8_WAIT_V(8); PG8_WAIT_L(0); PG8_BAR; PG8_MMA(1, 0, At, B0); PG8_MMA(1, 1, At, B1); PG8_BAR; PG8_SCHED;
            PG8_LDB(B0, 1, 0); PG8_LDB(B1, 1, 1); PG8_SCHED; PG8_LDA(At, 1, 0); PG8_STAGE(PG8_SA(0, 1), a2 + hstepA, voffA);
            PG8_WAIT_V(8); PG8_WAIT_L(0); PG8_BAR; PG8_MMA(0, 0, At, B0); PG8_MMA(0, 1, At, B1); PG8_BAR; PG8_SCHED;
            PG8_LDA(At, 1, 1); PG8_STAGE(PG8_SB(1, 0), b3, voffB); PG8_STAGE(PG8_SB(1, 1), b3 + hstep, voffB); PG8_STAGE(PG8_SA(1, 0), a3, voffA);
            PG8_WAIT_V(8); PG8_WAIT_L(0); PG8_BAR; PG8_MMA(1, 0, At, B0); PG8_MMA(1, 1, At, B1); PG8_BAR; PG8_SCHED;
            } else {
            PG8_LDB(B0, 0, 0); PG8_SCHED; PG8_LDA(At, 0, 0); PG8_STAGE(PG8_SA(1, 1), a1 + hstepA, voffA);
            PG8_WAIT_L(8); PG8_BAR; PG8_WAIT_L(0); PG8_MMA(0, 0, At, B0); PG8_BAR; PG8_SCHED;
            PG8_LDB(B1, 0, 1); PG8_STAGE(PG8_SB(0, 0), b2, voffB);
            PG8_BAR; PG8_WAIT_L(0); PG8_MMA(0, 1, At, B1); PG8_BAR;
            PG8_LDA(At, 0, 1); PG8_STAGE(PG8_SA(0, 0), a2, voffA);
            PG8_BAR; PG8_WAIT_L(0); PG8_MMA(1, 0, At, B0); PG8_BAR; PG8_SCHED;
            PG8_STAGE(PG8_SB(0, 1), b2 + hstep, voffB);
            PG8_WAIT_V(6); PG8_BAR; PG8_MMA(1, 1, At, B1); PG8_BAR;
            PG8_LDB(B0, 1, 0); PG8_SCHED; PG8_LDA(At, 1, 0); PG8_STAGE(PG8_SA(0, 1), a2 + hstepA, voffA);
            PG8_WAIT_L(8); PG8_BAR; PG8_WAIT_L(0); PG8_MMA(0, 0, At, B0); PG8_BAR; PG8_SCHED;
            PG8_LDB(B1, 1, 1); PG8_STAGE(PG8_SB(1, 0), b3, voffB);
            PG8_BAR; PG8_WAIT_L(0); PG8_MMA(0, 1, At, B1); PG8_BAR;
            PG8_LDA(At, 1, 1); PG8_STAGE(PG8_SA(1, 0), a3, voffA);
            PG8_BAR; PG8_WAIT_L(0); PG8_MMA(1, 0, At, B0); PG8_BAR; PG8_SCHED;
            PG8_STAGE(PG8_SB(1, 1), b3 + hstep, voffB);
            PG8_WAIT_V(6); PG8_BAR; PG8_MMA(1, 1, At, B1); PG8_BAR;
            }
        }
        if constexpr (ALIGN_EPI) { if (wr == 0) PG8_BAR; }
        if constexpr (!Epi::AFTER_DRAIN) { E(acc, cur, wr, wc, fr, fq); S.done(cur); }
        if (!has_next) break;
#pragma unroll
        for (int a = 0; a < 2; ++a)
#pragma unroll
            for (int b = 0; b < 2; ++b)
#pragma unroll
                for (int m = 0; m < 4; ++m)
#pragma unroll
                    for (int n = 0; n < 2; ++n) acc[a][b][m][n] = (f32x4){0.f, 0.f, 0.f, 0.f};
        cur = nxt; cA = nA; cB = nB; ++ui;
        if constexpr (ALIGN_EPI) { if (wr == 1) PG8_BAR; }
    }
    PG8_WAIT_V(0);
    if constexpr (!ALIGN_EPI) { if (wr == 0) PG8_BAR; }
    PG8_BAR;
    if constexpr (Epi::AFTER_DRAIN) { E.fused(acc, cur, wr, wc, fr, fq, lds, wid, lane); S.done(cur); }
#undef PG8_SA
#undef PG8_SB
#undef PG8_STAGE
#undef PG8_LDA
#undef PG8_LDB
#undef PG8_MMA
#undef PG8_WAIT_V
#undef PG8_WAIT_L
#undef PG8_BAR
#undef PG8_SCHED
}
}

#define PROBE_KS 4
#define PROBE_YL 1.f
#define PROBE_NO_VP 0
#ifndef PROBE_REP
#define PROBE_REP 1
#endif
#ifndef MK_ONE_LAUNCH
#define MK_ONE_LAUNCH 1
#endif
constexpr int NWAVES = 8, NTHR = 512;
constexpr int BATCH = 2, SEQ = 8192, M = BATCH * SEQ, D = 1024;
constexpr int AH = 6, AW = 384;
constexpr int ZP = 2304;
constexpr int ZR = 0, ZK = 384, ZV = 768, ZWD = 1152, ZAD = 1184, ZGD = 1216, ZU = 1280, ZCV = 1536, ZCQ = 1792, ZCKV = 2048, ZKR = 2176;
constexpr int DFF = 2816, DFE = 3584, NE = 8;
constexpr int QKD = 96, QP = 576;
constexpr float EPS = 1e-6f;
constexpr int M2MAX = 2 * M + NE * 256;

constexpr size_t MiB = 1u << 20;
constexpr size_t WS_CTL = 0, CTL_ZERO_BYTES = 1 * MiB;
constexpr size_t WS_WIN = 1 * MiB, WS_WOUT = 10 * MiB, WS_WDGU = 14 * MiB, WS_WDD = 25 * MiB;
constexpr size_t WS_WSM = 31 * MiB;
constexpr size_t WS_XN = 33 * MiB, WS_VF = 65 * MiB, WS_TOK = 77 * MiB, WS_R = 79 * MiB;
constexpr size_t WSM_UQ = 0, WSM_UKV = WSM_UQ + 2 * 768 * 256 * 2, WSM_GW = WSM_UKV + 2 * 768 * 128 * 2, WSM_LW = WSM_GW + 2 * 4 * 128 * 128 * 2, WSM_LA = WSM_LW + 2 * AW * 32 * 2, WSM_LG = WSM_LA + 2 * AW * 32 * 2, WSM_VD = WSM_LG + 2 * AW * 64 * 2, WSM_END = WSM_VD + 16 * AW * 2;
constexpr size_t R_Z = 0, R_NAT = 72 * MiB, R_TR = 120 * MiB, R_QR = 168 * MiB, R_KVR = 192 * MiB, R_VG = 216 * MiB, R_BON = 240 * MiB, R_WL = 240 * MiB + 512 * 1024, R_NT = 241 * MiB, R_YL = 265 * MiB;
constexpr size_t R_Q = 289 * MiB, R_K = 307 * MiB, R_V = 325 * MiB;
constexpr size_t R_CHM = 0, R_CHR = 12 * MiB, R_CHS = 24 * MiB, R_OATT = 36 * MiB;
constexpr size_t R_RW = R_NAT, R_LW = R_NT, R_YRAW = R_YL;
constexpr int NCHUNK = BATCH * AH * (SEQ / 64);
constexpr size_t BLK = 4096;
constexpr size_t R_H = 0;
constexpr size_t R_XB = 340 * MiB;
constexpr size_t R_XN2 = 100 * MiB;
constexpr size_t R_WMD = 0, R_WMGU = 72 * MiB;
constexpr size_t R_XNP = 184 * MiB, R_YP = R_XNP, R_HME = 252 * MiB;
constexpr int HMAIN = 64, HCAP = 71;
constexpr size_t WS_END = WS_R + 377 * MiB;
constexpr size_t RWSZ = (size_t)M * AW;
constexpr size_t TOK_E = 0, TOK_G = (size_t)M * 2 * 4, TOK_POS = (size_t)M * 4 * 4, TOK_SEG = (size_t)M * 6 * 4, TOK_TILE = TOK_SEG + 256 * 8 * 4;
constexpr int NSEG = 256, SEGT = M / NSEG;

constexpr int CW_BAR = 4096;
constexpr int CW_CQ = 40000;
constexpr size_t R_SS0 = 140 * MiB, R_SS1 = 120 * MiB;
constexpr int LDS_BYTES = 147456, RING_BYTES = 131072, MISC_OFF = RING_BYTES + 320;

#define GAS __attribute__((address_space(1)))
#define LAS __attribute__((address_space(3)))
typedef unsigned short bf16;
typedef unsigned v4u __attribute__((ext_vector_type(4)));
typedef unsigned v2u __attribute__((ext_vector_type(2)));
typedef float f32x4 __attribute__((ext_vector_type(4)));
typedef float f32x2 __attribute__((ext_vector_type(2)));
#define LDS_WAIT() asm volatile("s_waitcnt lgkmcnt(0)" ::: "memory")
#define VM_WAIT() asm volatile("s_waitcnt vmcnt(0)" ::: "memory")
typedef __bf16 bf16x2_hw __attribute__((ext_vector_type(2)));
__device__ __forceinline__ unsigned pk2(float lo, float hi) { const f32x2 v = {lo, hi}; return __builtin_bit_cast(unsigned, __builtin_convertvector(v, bf16x2_hw)); }
__device__ __forceinline__ unsigned f2bf(float f) { return pk2(f, 0.f) & 0xffffu; }
__device__ __forceinline__ float bf2f(bf16 b) { return __builtin_bit_cast(float, (unsigned)b << 16); }
__device__ __forceinline__ float bflo(unsigned w) { return __builtin_bit_cast(float, w << 16); }
__device__ __forceinline__ float bfhi(unsigned w) { return __builtin_bit_cast(float, w & 0xffff0000u); }
template <int CTRL> __device__ __forceinline__ float dpp_mov(float v) { return __builtin_bit_cast(float, __builtin_amdgcn_update_dpp(0, __builtin_bit_cast(int, v), CTRL, 0xf, 0xf, false)); }
__device__ __forceinline__ float wave_sum(float v) {
    v += dpp_mov<0xB1>(v);
    v += dpp_mov<0x4E>(v);
    v += dpp_mov<0x124>(v);
    v += dpp_mov<0x128>(v);
    const int vi = __builtin_bit_cast(int, v);
    const float r0 = __builtin_bit_cast(float, __builtin_amdgcn_readlane(vi, 0)), r1 = __builtin_bit_cast(float, __builtin_amdgcn_readlane(vi, 16));
    const float r2 = __builtin_bit_cast(float, __builtin_amdgcn_readlane(vi, 32)), r3 = __builtin_bit_cast(float, __builtin_amdgcn_readlane(vi, 48));
    return (r0 + r1) + (r2 + r3);
}
__device__ __forceinline__ float row16_sum(float v) {
    v += dpp_mov<0xB1>(v); v += dpp_mov<0x4E>(v); v += dpp_mov<0x124>(v); v += dpp_mov<0x128>(v); return v; }
__device__ __forceinline__ float sigmoid_f(float x) { return 1.0f / (1.0f + __expf(-x)); }
__device__ __forceinline__ float sigmoid_fast(float x) { return __builtin_amdgcn_rcpf(1.0f + __expf(-x)); }
__device__ __forceinline__ unsigned short f2bf_hw(float x) { typedef __bf16 bfx2 __attribute__((ext_vector_type(2))); const f32x2 v = {x, 0.f}; return (unsigned short)(__builtin_bit_cast(unsigned, __builtin_convertvector(v, bfx2)) & 0xffffu); }
__device__ __forceinline__ float gelu_erf(float x) { return 0.5f * x * (1.0f + erff(x * 0.70710678118654752f)); }

#define XB_TMO      128
#define XB_XCNT(j)  (256  + 64 * (j))
#define XB_XSUB(j)  (1280 + 64 * (j))
#define XB_XGEN(j)  (2304 + 64 * (j))
#define XB_TOP      3328
#define XB_TOPGEN   3392
#define XCD_BAR_WORDS 3456
#define XB_SPIN_CAP (1u << 18)

__device__ __forceinline__ unsigned xb_ld(unsigned* p)              { return __hip_atomic_load(p, __ATOMIC_RELAXED, __HIP_MEMORY_SCOPE_AGENT); }
__device__ __forceinline__ unsigned xb_add(unsigned* p, unsigned v) { return __hip_atomic_fetch_add(p, v, __ATOMIC_RELAXED, __HIP_MEMORY_SCOPE_AGENT); }
__device__ __forceinline__ unsigned xb_xcc_id() { return (unsigned)__builtin_amdgcn_s_getreg((3 << 11) | 20) & 0xFu; }
#define XB_SPIN(cond, bar) do { unsigned _sp = 0; while (cond) { __builtin_amdgcn_s_sleep(1); \
    if ((++_sp & 255u) == 0u) { if (xb_ld(&(bar)[XB_TMO])) break; if (_sp > XB_SPIN_CAP) { atomicAdd(&(bar)[XB_TMO], 1u); break; } } } } while (0)

struct XcdBarrier {
    unsigned* bar; unsigned x;
    volatile LAS unsigned* st;
};

__device__ __forceinline__ XcdBarrier xcd_barrier_post(unsigned* bar, volatile LAS unsigned* st) {
    XcdBarrier b; b.bar = bar; b.x = xb_xcc_id(); b.st = st;
    if (threadIdx.x == 0) (void)xb_add(&bar[XB_XCNT(b.x)], 1u);
    return b;
}
__device__ __forceinline__ void xcd_barrier_complete(unsigned* bar, unsigned x, unsigned& nloc, unsigned& nx) {
    const unsigned G = gridDim.x * gridDim.y * gridDim.z;
    unsigned sum, cnt, mine, sp = 0u;
    for (;;) {
        sum = 0u; cnt = 0u; mine = 0u;
#pragma unroll
        for (unsigned j = 0; j < 16; ++j) { const unsigned c = xb_ld(&bar[XB_XCNT(j)]); sum += c; cnt += (c > 0u) ? 1u : 0u; mine = (j == x) ? c : mine; }
        if (sum == G) break;
        __builtin_amdgcn_s_sleep(1);
        if ((++sp & 255u) == 0u) { if (xb_ld(&bar[XB_TMO])) break; if (sp > XB_SPIN_CAP) { atomicAdd(&bar[XB_TMO], 1u); break; } }
    }
    nloc = mine > 0u ? mine : 1u; nx = cnt > 0u ? cnt : 1u;
}

__device__ __forceinline__ void xcd_barrier(const XcdBarrier& b) {
    asm volatile("s_waitcnt vmcnt(0)" ::: "memory");
    __syncthreads();
    if (threadIdx.x == 0) {
        unsigned* bar = b.bar;
        __builtin_amdgcn_s_waitcnt(0);
        unsigned nloc = b.st[0], nx = b.st[1];
        if (nloc == 0u) { xcd_barrier_complete(bar, b.x, nloc, nx); b.st[0] = nloc; b.st[1] = nx; }
        const unsigned old = xb_add(&bar[XB_XSUB(b.x)], 1u);
        const unsigned gen = old / nloc;
        if (old + 1u == (gen + 1u) * nloc) {
            __builtin_amdgcn_fence(__ATOMIC_RELEASE, "agent");
            asm volatile("s_waitcnt vmcnt(0)" ::: "memory");
            const unsigned og = xb_add(&bar[XB_TOP], 1u);
            const unsigned tg = og / nx;
            if (og + 1u == (tg + 1u) * nx) xb_add(&bar[XB_TOPGEN], 1u);
            else XB_SPIN(xb_ld(&bar[XB_TOPGEN]) == tg, bar);
            __builtin_amdgcn_fence(__ATOMIC_ACQUIRE, "agent");
            xb_add(&bar[XB_XGEN(b.x)], 1u);
            asm volatile("s_waitcnt vmcnt(0)" ::: "memory");
        } else {
            XB_SPIN(xb_ld(&bar[XB_XGEN(b.x)]) == gen, bar);
            __builtin_amdgcn_fence(__ATOMIC_ACQUIRE, "agent");
            asm volatile("s_waitcnt vmcnt(0)" ::: "memory");
        }
    }
    __syncthreads();
}


struct Args { const float* in[39]; float* out; unsigned char* ws; int ph_lo, ph_hi; };
enum { I_X = 0, I_POS, I_MIXG, I_WIN, I_MU, I_W0, I_WUP, I_A0, I_AUP, I_GUP, I_KK, I_KA, I_RK, I_LNG, I_LNB, I_V0, I_VDN, I_VUP,
       I_QNG, I_WUQ, I_KVNG, I_WUKV, I_QHG, I_KHG, I_BOG, I_CLNG, I_CLNB, I_CWS, I_CBS, I_COG, I_WOUT, I_FFNG, I_DWG, I_DWU, I_DWD, I_ROUTER, I_MWG, I_MWU, I_MWD };

constexpr int ARGS_OFF = RING_BYTES + 4096;
struct Ctx {
    LAS unsigned char* lds; int tid, lane, wave, bid, nb, gw, ngw;
    GAS unsigned char* ws; GAS unsigned char* R;
    __device__ __forceinline__ unsigned long long ptr_(int k) const { unsigned off = ARGS_OFF + 8 * k; asm volatile("" : "+v"(off));
        const volatile LAS unsigned* p = (const volatile LAS unsigned*)(lds + off);
        const unsigned lo = __builtin_amdgcn_readfirstlane(p[0]), hi = __builtin_amdgcn_readfirstlane(p[1]); return ((unsigned long long)hi << 32) | lo; }
    __device__ __forceinline__ const GAS float* in(int k) const { return (const GAS float*)ptr_(k); }
    __device__ __forceinline__ GAS float* out() const { return (GAS float*)ptr_(39); }
};

__device__ __forceinline__ void conv_item(const GAS float* W, int K, int N, GAS bf16* WT, int n0, int drow0, int k0, LAS float* scr, int lane, const GAS float* gk = nullptr) {
#pragma unroll 8
    for (int i = 0; i < 32; ++i) { const int kk = 2 * i + (lane >> 5); scr[kk * 33 + (lane & 31)] = W[(size_t)(k0 + kk) * N + n0 + (lane & 31)] * (gk ? gk[k0 + kk] : 1.0f); }
    LDS_WAIT(); asm volatile("" ::: "memory");
    const int c = lane & 7;
#pragma unroll
    for (int j = 0; j < 4; ++j) { const int n = (lane >> 3) + 8 * j; const LAS float* s = scr + (8 * c) * 33 + n;
        v4u o; o.x = pk2(s[0 * 33], s[1 * 33]); o.y = pk2(s[2 * 33], s[3 * 33]); o.z = pk2(s[4 * 33], s[5 * 33]); o.w = pk2(s[6 * 33], s[7 * 33]);
        *(GAS v4u*)(WT + (size_t)(drow0 + n) * K + k0 + 8 * c) = o; }
    LDS_WAIT(); asm volatile("" ::: "memory");
}
template <int MAP> __device__ __forceinline__ int conv_row(int n0) {
    if (MAP == 1) return n0 < 1280 ? n0 : (n0 < 1696 ? n0 - 1280 + ZCQ : n0 - 1696 + ZU);
    if (MAP == 2) return (n0 >> 7) * 256 + (n0 & 127);
    if (MAP == 3) return (n0 >> 7) * 256 + 128 + (n0 & 127);
    if (MAP == 4) return (n0 / QKD) * 128 + (n0 % QKD);
    return n0;
}
struct CJ { const GAS float* W; GAS bf16* WT; const GAS float* gk; int K, N, n0, drow0, k0; };
__device__ __forceinline__ void conv_load(const CJ& j, float (&r)[32], int lane) {
#pragma unroll
    for (int i = 0; i < 32; ++i) r[i] = __builtin_nontemporal_load(j.W + (size_t)(j.k0 + 2 * i + (lane >> 5)) * j.N + j.n0 + (lane & 31));
}
__device__ __forceinline__ void conv_finish(const CJ& j, const float (&r)[32], LAS float* scr, int lane) {
#pragma unroll
    for (int i = 0; i < 32; ++i) { const int kk = 2 * i + (lane >> 5); scr[kk * 33 + (lane & 31)] = r[i] * (j.gk ? j.gk[j.k0 + kk] : 1.0f); }
    LDS_WAIT(); asm volatile("" ::: "memory");
    const int cq = lane & 7;
#pragma unroll
    for (int q = 0; q < 4; ++q) { const int n = (lane >> 3) + 8 * q; const LAS float* p = scr + (8 * cq) * 33 + n;
        v4u o; o.x = pk2(p[0 * 33], p[1 * 33]); o.y = pk2(p[2 * 33], p[3 * 33]); o.z = pk2(p[4 * 33], p[5 * 33]); o.w = pk2(p[6 * 33], p[7 * 33]);
        *(GAS v4u*)(j.WT + (size_t)(j.drow0 + n) * j.K + j.k0 + 8 * cq) = o; }
    LDS_WAIT(); asm volatile("" ::: "memory");
}
template <class JobFn> __device__ __forceinline__ void conv_run(const Ctx& c, int total, const JobFn& job, int gw, int ngw) {
    LAS float* scr = (LAS float*)(c.lds + c.wave * 8704);
    float ra[32], rb[32];
    int it = gw;
    if (it < total) conv_load(job(it), ra, c.lane);
    for (; it < total; it += 2 * ngw) {
        const int it2 = it + ngw, it3 = it2 + ngw;
        if (it2 < total) conv_load(job(it2), rb, c.lane);
        conv_finish(job(it), ra, scr, c.lane);
        if (it3 < total) conv_load(job(it3), ra, c.lane);
        if (it2 < total) conv_finish(job(it2), rb, scr, c.lane);
    }
}
__device__ __forceinline__ CJ conv_mk(const GAS float* W, GAS bf16* WT, const GAS float* gk, int K, int N, int r, int map) {
    const int nblk = N / 32, kb = r / nblk, nbk = r - kb * nblk, n0 = 32 * nbk; CJ j; j.W = W; j.WT = WT; j.gk = gk; j.K = K; j.N = N; j.n0 = n0; j.k0 = 64 * kb;
    j.drow0 = map == 1 ? conv_row<1>(n0) : map == 2 ? conv_row<2>(n0) : map == 3 ? conv_row<3>(n0) : map == 4 ? conv_row<4>(n0) : n0; return j;
}
struct StaticJobsA { const Ctx* c;
    static constexpr int N_WIN = 16 * 69, N_UQ = 4 * 18, N_UKV = 2 * 24, PER_L = N_WIN + N_UQ + N_UKV, TOTAL = 2 * PER_L;
    __device__ __forceinline__ CJ operator()(int it) const { const Ctx& cx = *c; const int l = it / PER_L; int r = it - l * PER_L;
        if (r < N_WIN) return conv_mk(cx.in(I_WIN) + (size_t)l * D * 2208, (GAS bf16*)(cx.ws + WS_WIN) + (size_t)l * ZP * D, nullptr, D, 2208, r, 1); r -= N_WIN;
        if (r < N_UQ) return conv_mk(cx.in(I_WUQ) + (size_t)l * 256 * QP, (GAS bf16*)(cx.ws + WS_WSM + WSM_UQ) + (size_t)l * 768 * 256, cx.in(I_QNG) + l * 256, 256, QP, r, 4); r -= N_UQ;
        return conv_mk(cx.in(I_WUKV) + (size_t)l * 128 * 768, (GAS bf16*)(cx.ws + WS_WSM + WSM_UKV) + (size_t)l * 768 * 128, cx.in(I_KVNG) + l * 128, 128, 768, r, 0); }
};
struct StaticJobsB { const Ctx* c;
    static constexpr int N_WOUT = 16 * 32, N_DG = 16 * 88, N_DD = 44 * 32, TOTAL = 2 * N_WOUT + 2 * N_DG + N_DD;
    __device__ __forceinline__ CJ operator()(int it) const { const Ctx& cx = *c; int r = it;
        if (r < 2 * N_WOUT) { const int l = r / N_WOUT; return conv_mk(cx.in(I_WOUT) + (size_t)l * D * D, (GAS bf16*)(cx.ws + WS_WOUT) + (size_t)l * D * D, nullptr, D, D, r - l * N_WOUT, 0); } r -= 2 * N_WOUT;
        if (r < N_DG) return conv_mk(cx.in(I_DWG), (GAS bf16*)(cx.ws + WS_WDGU), nullptr, D, DFF, r, 2); r -= N_DG;
        if (r < N_DG) return conv_mk(cx.in(I_DWU), (GAS bf16*)(cx.ws + WS_WDGU), nullptr, D, DFF, r, 3); r -= N_DG;
        return conv_mk(cx.in(I_DWD), (GAS bf16*)(cx.ws + WS_WDD), nullptr, DFF, D, r, 0); }
};
__device__ __forceinline__ void phase_conv_b(const Ctx& c) {
    const int nfull = (M / 256) * (ZP / 256) - 2 * c.nb;
    if (nfull <= 0 || nfull >= c.nb) { StaticJobsB J{&c}; conv_run(c, StaticJobsB::TOTAL, J, c.gw, c.ngw); return; }
    if (c.bid < nfull) return;
    StaticJobsB J{&c}; conv_run(c, StaticJobsB::TOTAL, J, (c.bid - nfull) * NWAVES + c.wave, (c.nb - nfull) * NWAVES);
}
struct ExpertGUJobs { const Ctx* c;
    static constexpr int PER = 16 * 112, TOTAL = NE * 2 * PER;
    __device__ __forceinline__ CJ operator()(int it) const { const Ctx& cx = *c; const int j = it / PER, r = it - j * PER, e = j >> 1, kind = j & 1;
        return conv_mk((kind ? cx.in(I_MWU) : cx.in(I_MWG)) + (size_t)e * D * DFE, (GAS bf16*)(cx.R + R_WMGU) + (size_t)e * 2 * DFE * D, nullptr, D, DFE, r, 2 + kind); }
};
struct ExpertDJobs { const Ctx* c;
    static constexpr int PER = 56 * 32, TOTAL = NE * PER;
    __device__ __forceinline__ CJ operator()(int it) const { const Ctx& cx = *c; const int e = it / PER, r = it - e * PER;
        return conv_mk(cx.in(I_MWD) + (size_t)e * DFE * D, (GAS bf16*)(cx.R + R_WMD) + (size_t)e * D * DFE, nullptr, DFE, D, r, 0); }
};
template <class JobFn> __device__ __forceinline__ void conv_pop(const Ctx& c, GAS unsigned* head, int total, const JobFn& job, GAS unsigned* stop_ctr, unsigned stop_at) {
    LAS float* scr = (LAS float*)(c.lds + c.wave * 8704); LAS int* pb = (LAS int*)(c.lds + RING_BYTES + 12288);
    for (;;) {
        __syncthreads();
        if (c.tid == 0) { const bool stop = stop_ctr && __hip_atomic_load(stop_ctr, __ATOMIC_RELAXED, __HIP_MEMORY_SCOPE_AGENT) >= stop_at;
            pb[0] = stop ? total : (int)__hip_atomic_fetch_add(head, 16u, __ATOMIC_RELAXED, __HIP_MEMORY_SCOPE_AGENT); }
        __syncthreads();
        const int base = pb[0]; if (base >= total) break;
        const int i0 = base + c.wave, i1 = base + 8 + c.wave;
        float ra[32], rb[32];
        if (i0 < total) conv_load(job(i0), ra, c.lane);
        if (i1 < total) conv_load(job(i1), rb, c.lane);
        if (i0 < total) conv_finish(job(i0), ra, scr, c.lane);
        if (i1 < total) conv_finish(job(i1), rb, scr, c.lane);
    }
}

__device__ __forceinline__ void phase_conv_static(const Ctx& c) {
    StaticJobsA J{&c}; conv_run(c, StaticJobsA::TOTAL, J, c.gw, c.ngw);
    for (int l = 0; l < 2; ++l) {
        GAS bf16* win = (GAS bf16*)(c.ws + WS_WIN) + (size_t)l * ZP * D;
        for (int i = c.bid * NTHR + c.tid; i < 96 * D / 8; i += c.nb * NTHR) ((GAS v4u*)(win + (size_t)2208 * D))[i] = (v4u){0u, 0u, 0u, 0u};
        GAS bf16* uq = (GAS bf16*)(c.ws + WS_WSM + WSM_UQ) + (size_t)l * 768 * 256;
        { GAS bf16* lw_ = (GAS bf16*)(c.ws + WS_WSM + WSM_LW) + (size_t)l * AW * 32; GAS bf16* la_ = (GAS bf16*)(c.ws + WS_WSM + WSM_LA) + (size_t)l * AW * 32; GAS bf16* lg_ = (GAS bf16*)(c.ws + WS_WSM + WSM_LG) + (size_t)l * AW * 64;
          const GAS float* sw = c.in(I_WUP) + (size_t)l * 32 * AW; const GAS float* sa = c.in(I_AUP) + (size_t)l * 32 * AW; const GAS float* sg = c.in(I_GUP) + (size_t)l * 64 * AW;
          for (int i = c.bid * NTHR + c.tid; i < AW * 32; i += c.nb * NTHR) { const int ch = i >> 5, kq = i & 31; lw_[i] = (bf16)f2bf(sw[kq * AW + ch]); la_[i] = (bf16)f2bf(sa[kq * AW + ch]); }
          for (int i = c.bid * NTHR + c.tid; i < AW * 64; i += c.nb * NTHR) { const int ch = i >> 6, kq = i & 63; lg_[i] = (bf16)f2bf(sg[kq * AW + ch]); }
          if (l == 1) { GAS bf16* vdt = (GAS bf16*)(c.ws + WS_WSM + WSM_VD); const GAS float* sv = c.in(I_VDN); for (int i = c.bid * NTHR + c.tid; i < 16 * AW; i += c.nb * NTHR) { const int j = i / AW, cx = i % AW; vdt[i] = (bf16)f2bf(sv[cx * 16 + j]); } } }
        { const GAS float* wsrc = c.in(I_CWS) + (size_t)l * 4 * 128 * 128; GAS bf16* wdst = (GAS bf16*)(c.ws + WS_WSM + WSM_GW) + (size_t)l * 4 * 128 * 128;
          for (int i = c.bid * NTHR + c.tid; i < 4 * 128 * 128 / 2; i += c.nb * NTHR) { const int e0 = 2 * i, tq = (e0 >> 7) & 127, sq = e0 & 127; const f32x2 w = *(const GAS f32x2*)(wsrc + e0);
              ((GAS unsigned*)wdst)[i] = pk2(sq <= tq ? w.x : 0.f, sq + 1 <= tq ? w.y : 0.f); } }
        for (int i = c.bid * NTHR + c.tid; i < AH * 32 * 256 / 8; i += c.nb * NTHR) { const int r = i / 32, cc8 = i % 32; ((GAS v4u*)(uq + (size_t)((r / 32) * 128 + 96 + (r % 32)) * 256))[cc8] = (v4u){0u, 0u, 0u, 0u}; }
    }
}
__device__ __forceinline__ void phase_conv_experts(const Ctx& c) {
    ExpertGUJobs JG{&c}; conv_pop(c, (GAS unsigned*)(c.ws + WS_CTL) + CW_CQ, ExpertGUJobs::TOTAL, JG, nullptr, 0u);
    __syncthreads();
    ExpertDJobs JD{&c}; conv_run(c, ExpertDJobs::TOTAL, JD, c.gw, c.ngw); }

template <bool ROUTER> __device__ __forceinline__ void phase_rmsnorm(const Ctx& c, const GAS float* x, const GAS float* g, GAS bf16* xn, const GAS float* router) {
    LAS float* rl = (LAS float*)c.lds;
    if (ROUTER) { for (int i = c.tid; i < D * NE / 4; i += NTHR) { const f32x4 r = ((const GAS f32x4*)router)[i]; const int d = i >> 1, e4 = (i & 1) * 4; rl[(e4 + 0) * D + d] = r.x; rl[(e4 + 1) * D + d] = r.y; rl[(e4 + 2) * D + d] = r.z; rl[(e4 + 3) * D + d] = r.w; } __syncthreads(); }
    const int i16 = c.lane & 15, g16 = c.lane >> 4;
    f32x4 gv[16];
#pragma unroll
    for (int k = 0; k < 16; ++k) gv[k] = *(const GAS f32x4*)(g + 64 * k + 4 * i16);
    LAS int* sel = (LAS int*)(c.lds + 32768);
    GAS int* segc = (GAS int*)(c.ws + WS_TOK + TOK_SEG);
    for (int sg = ROUTER ? c.bid : 0; sg < (ROUTER ? NSEG : 1); sg += ROUTER ? c.nb : 1) {
    const int m0 = ROUTER ? sg * SEGT + c.wave * 8 : c.gw * 4, mstep = ROUTER ? 4 : c.ngw * 4, mend = ROUTER ? m0 + 8 : M;
    for (int mb = m0; mb < mend; mb += mstep) {
        const int m = mb + g16;
        f32x4 v[16]; float ss = 0.f;
#pragma unroll
        for (int k = 0; k < 16; ++k) v[k] = *(const GAS f32x4*)(x + (size_t)m * D + 64 * k + 4 * i16);
#pragma unroll
        for (int k = 0; k < 16; ++k) ss += (v[k].x * v[k].x + v[k].y * v[k].y) + (v[k].z * v[k].z + v[k].w * v[k].w);
        const float rstd = __builtin_amdgcn_rsqf(row16_sum(ss) * (1.0f / D) + EPS);
#pragma unroll
        for (int k = 0; k < 16; ++k) { v[k] = v[k] * rstd * gv[k]; *(GAS v2u*)(xn + (size_t)m * D + 64 * k + 4 * i16) = (v2u){pk2(v[k].x, v[k].y), pk2(v[k].z, v[k].w)}; }
        if (ROUTER) {
            float lg[8];
#pragma unroll
            for (int e = 0; e < 8; ++e) lg[e] = 0.f;
#pragma unroll
            for (int k = 0; k < 16; ++k)
#pragma unroll
                for (int e = 0; e < 8; ++e) { const f32x4 r = *(const LAS f32x4*)(rl + e * D + 64 * k + 4 * i16); lg[e] += (v[k].x * r.x + v[k].y * r.y) + (v[k].z * r.z + v[k].w * r.w); }
#pragma unroll
            for (int e = 0; e < 8; ++e) lg[e] = row16_sum(lg[e]);
            if (i16 == 0) {
                int e0 = 0; float v0 = lg[0];
#pragma unroll
                for (int e = 1; e < 8; ++e) if (lg[e] > v0) { v0 = lg[e]; e0 = e; }
                int e1 = -1; float v1 = -INFINITY;
#pragma unroll
                for (int e = 0; e < 8; ++e) if (e != e0 && lg[e] > v1) { v1 = lg[e]; e1 = e; }
                const float p1 = 1.0f / (1.0f + __expf(v0 - v1)), p0 = 1.0f - p1;
                GAS int* te = (GAS int*)(c.ws + WS_TOK + TOK_E); GAS float* tg = (GAS float*)(c.ws + WS_TOK + TOK_G);
                te[2 * m] = e0; te[2 * m + 1] = e1; tg[2 * m] = p0; tg[2 * m + 1] = p1;
                sel[2 * (m - sg * SEGT)] = e0; sel[2 * (m - sg * SEGT) + 1] = e1;
            }
        }
    }
    if (ROUTER) {
        __syncthreads();
        if (c.wave == 0) { const int e0 = sel[2 * c.lane], e1 = sel[2 * c.lane + 1];
#pragma unroll
            for (int e = 0; e < NE; ++e) { const unsigned long long b0 = __ballot(e0 == e), b1 = __ballot(e1 == e); if (c.lane == 0) segc[sg * NE + e] = __popcll(b0) + __popcll(b1); } }
        __syncthreads();
    }
    }
}

__device__ __forceinline__ float zsh(const GAS bf16* Z, int m, int s, int col, float mu) {
    const float cur = bf2f(Z[(size_t)m * ZP + col]); const float prev = s > 0 ? bf2f(Z[(size_t)(m - 1) * ZP + col]) : 0.f; return cur + (prev - cur) * mu;
}
__device__ __forceinline__ void phase_rwkv_prep(const Ctx& c, int l) {
    const GAS bf16* Z = (const GAS bf16*)(c.R + R_Z);
    GAS bf16* RW = (GAS bf16*)(c.R + R_RW); GAS float* LW = (GAS float*)(c.R + R_LW); GAS bf16* VF = (GAS bf16*)(c.ws + WS_VF);
    const GAS float* mu = c.in(I_MU) + l * 1280; const GAS float* w0 = c.in(I_W0) + l * AW; const GAS float* wup = c.in(I_WUP) + (size_t)l * 32 * AW;
    const GAS float* a0 = c.in(I_A0) + l * AW; const GAS float* aup = c.in(I_AUP) + (size_t)l * 32 * AW; const GAS float* gup = c.in(I_GUP) + (size_t)l * 64 * AW;
    const GAS float* kkw = c.in(I_KK) + l * AW; const GAS float* kaw = c.in(I_KA) + l * AW;
    const GAS float* v0 = c.in(I_V0); const GAS float* vdn = c.in(I_VDN); const GAS float* vup = c.in(I_VUP);
    LAS float* sm = (LAS float*)c.lds;
    LAS float* vs = sm + 8 * 128;
    LAS float* vd = vs + 8 * 384;
    const int t = c.tid;
    for (int grp = c.bid; grp < M / 8; grp += c.nb) {
        const int m0 = grp * 8;
        float r[8], k[8], v[8];
        if (t < AW) {
            const float mr = mu[ZR + t], mk = mu[ZK + t], mv = mu[ZV + t];
#pragma unroll
            for (int q = 0; q < 8; ++q) { const int m = m0 + q, s = m % SEQ; r[q] = zsh(Z, m, s, ZR + t, mr); k[q] = zsh(Z, m, s, ZK + t, mk); v[q] = zsh(Z, m, s, ZV + t, mv); }
        } else {
            const int j = t - AW; const float mj = mu[ZWD + j];
#pragma unroll
            for (int q = 0; q < 8; ++q) { const int m = m0 + q, s = m % SEQ; float x = zsh(Z, m, s, ZWD + j, mj);
                if (j < 32) x = tanhf(x); else if (j >= 64) x = sigmoid_f(x);
                sm[q * 128 + j] = x; }
        }
        __syncthreads();
        float wa[8], aa[8], ga[8];
        if (t < AW) {
#pragma unroll
            for (int q = 0; q < 8; ++q) { wa[q] = 0.f; aa[q] = 0.f; ga[q] = 0.f; }
            for (int j = 0; j < 32; ++j) { const float ww = wup[j * AW + t], au = aup[j * AW + t];
#pragma unroll
                for (int q = 0; q < 8; ++q) { wa[q] += sm[q * 128 + j] * ww; aa[q] += sm[q * 128 + 32 + j] * au; } }
            for (int j = 0; j < 64; ++j) { const float gu = gup[j * AW + t];
#pragma unroll
                for (int q = 0; q < 8; ++q) ga[q] += sm[q * 128 + 64 + j] * gu; }
            if (l > 0) {
#pragma unroll
                for (int q = 0; q < 8; ++q) vs[q * AW + t] = v[q];
            }
        }
        __syncthreads();
        if (l > 0) {
            if (t < 128) { const int q = t >> 4, j = t & 15; float s = 0.f; for (int cc = 0; cc < AW; ++cc) s += vs[q * AW + cc] * vdn[cc * 16 + j]; vd[q * 16 + j] = s; }
            __syncthreads();
        }
        if (t < AW) {
            const float w0t = w0[t], a0t = a0[t], kkt = kkw[t], kat = kaw[t];
#pragma unroll
            for (int q = 0; q < 8; ++q) { const int m = m0 + q; const size_t o = (size_t)m * AW + t;
                const float xw = -(w0t + wa[q]);
                const float sp = xw > 20.f ? xw : log1pf(__expf(xw));
                const float lw = -__expf(-sp - 0.5f);
                const float av = sigmoid_f(a0t + aa[q]);
                float vv = v[q];
                if (l > 0) { float x = v0[t];
#pragma unroll
                    for (int j = 0; j < 16; ++j) x += vd[q * 16 + j] * vup[j * AW + t];
                    const float vf = bf2f(VF[o]); vv = vv + (vf - vv) * sigmoid_f(x); }
                else VF[o] = (bf16)f2bf(vv);
                float kk = k[q] * kkt; const float ss = wave_sum(kk * kk); kk = kk / fmaxf(sqrtf(ss), 1e-12f);
                const float k2 = k[q] * (1.0f + (av - 1.0f) * kat);
                RW[0 * RWSZ + o] = (bf16)f2bf(r[q]); RW[1 * RWSZ + o] = (bf16)f2bf(k2); RW[2 * RWSZ + o] = (bf16)f2bf(vv); RW[3 * RWSZ + o] = (bf16)f2bf(kk);
                RW[4 * RWSZ + o] = (bf16)f2bf(av); RW[5 * RWSZ + o] = (bf16)f2bf(ga[q]); LW[o] = lw; }
        }
        __syncthreads();
    }
}

__device__ __forceinline__ void phase_rwkv_scan_naive(const Ctx& c) {
    const GAS bf16* RW = (const GAS bf16*)(c.R + R_RW); const GAS float* LW = (const GAS float*)(c.R + R_LW); GAS float* YRAW = (GAS float*)(c.R + R_YRAW);
    constexpr int CH = 32;
    LAS float* sr = (LAS float*)c.lds;
    LAS float* sw = sr + CH * 64; LAS float* skk = sw + CH * 64; LAS float* sb = skk + CH * 64; LAS float* sk2 = sb + CH * 64; LAS float* sv = sk2 + CH * 64; LAS float* sy = sv + CH * 64;
    const int t = c.tid, vrow = t >> 3, kq = t & 7;
    for (int item = c.bid; item < BATCH * AH; item += c.nb) {
        const int b = item / AH, h = item % AH;
        float st[8];
#pragma unroll
        for (int i = 0; i < 8; ++i) st[i] = 0.f;
        for (int s0 = 0; s0 < SEQ; s0 += CH) {
            __syncthreads();
#pragma unroll
            for (int q = 0; q < 4; ++q) { const int e = t + q * NTHR, ts = e >> 6, ch = e & 63; const size_t o = (size_t)(b * SEQ + s0 + ts) * AW + h * 64 + ch;
                const float kk = bf2f(RW[3 * RWSZ + o]), av = bf2f(RW[4 * RWSZ + o]);
                sr[e] = bf2f(RW[0 * RWSZ + o]); sw[e] = __expf(LW[o]); skk[e] = kk; sb[e] = kk * av; sk2[e] = bf2f(RW[1 * RWSZ + o]); sv[e] = bf2f(RW[2 * RWSZ + o]); }
            __syncthreads();
            for (int ts = 0; ts < CH; ++ts) {
                const int o = ts * 64 + kq * 8; float p = 0.f;
#pragma unroll
                for (int i = 0; i < 8; ++i) p += st[i] * skk[o + i];
                p += __shfl_xor(p, 1); p += __shfl_xor(p, 2); p += __shfl_xor(p, 4);
                const float sa = -p, vv = sv[ts * 64 + vrow]; float y = 0.f;
#pragma unroll
                for (int i = 0; i < 8; ++i) { st[i] = st[i] * sw[o + i] + sa * sb[o + i] + vv * sk2[o + i]; y += st[i] * sr[o + i]; }
                y += __shfl_xor(y, 1); y += __shfl_xor(y, 2); y += __shfl_xor(y, 4);
                if (kq == 0) sy[ts * 64 + vrow] = y;
            }
            __syncthreads();
#pragma unroll
            for (int q = 0; q < 4; ++q) { const int e = t + q * NTHR, ts = e >> 6, ch = e & 63; YRAW[(size_t)(b * SEQ + s0 + ts) * AW + h * 64 + ch] = sy[e]; }
        }
        __syncthreads();
    }
}

__device__ __forceinline__ void phase_rwkv_post(const Ctx& c, int l) {
    const GAS bf16* RW = (const GAS bf16*)(c.R + R_RW); const GAS float* YRAW = (const GAS float*)(c.R + R_YRAW); GAS bf16* YC = (GAS bf16*)(c.ws + WS_XN);
    const GAS float* lng = c.in(I_LNG) + l * AW; const GAS float* lnb = c.in(I_LNB) + l * AW; const GAS float* rk = c.in(I_RK) + l * AW;
    for (int it = c.gw; it < M * AH; it += c.ngw) {
        const int m = it / AH, h = it % AH, ch = h * 64 + c.lane; const size_t o = (size_t)m * AW + ch;
        const float y = YRAW[o]; const float mean = wave_sum(y) * (1.0f / 64.0f); const float d = y - mean; const float var = wave_sum(d * d) * (1.0f / 64.0f);
        const float yn = d * (__builtin_amdgcn_rsqf(var + 64e-5f)) * lng[ch] + lnb[ch];
        const float r = bf2f(RW[0 * RWSZ + o]), k2 = bf2f(RW[1 * RWSZ + o]), v = bf2f(RW[2 * RWSZ + o]), g = bf2f(RW[5 * RWSZ + o]);
        const float bonus = wave_sum(r * k2 * rk[ch]);
        YC[(size_t)m * D + ch] = (bf16)f2bf((yn + bonus * v) * g);
    }
}

__device__ __forceinline__ int vt_pos(int kap) { return 8 * ((kap >> 2) & 1) + 4 * (kap >> 3) + (kap & 3); }

typedef short bf16x8 __attribute__((ext_vector_type(8)));
typedef float f32x16 __attribute__((ext_vector_type(16)));
typedef __bf16 bf16x2_t __attribute__((ext_vector_type(2)));
__device__ __forceinline__ unsigned cvtpk(float lo, float hi) { const f32x2 v = {lo, hi}; const bf16x2_t b = __builtin_convertvector(v, bf16x2_t); return __builtin_bit_cast(unsigned, b); }
__device__ __forceinline__ bf16x8 pack8(const f32x16& a, int s8) {
    v4u t; t.x = cvtpk(a[s8], a[s8 + 1]); t.y = cvtpk(a[s8 + 2], a[s8 + 3]); t.z = cvtpk(a[s8 + 4], a[s8 + 5]); t.w = cvtpk(a[s8 + 6], a[s8 + 7]); return __builtin_bit_cast(bf16x8, t);
}
#define MFMA32(a, b, c) __builtin_amdgcn_mfma_f32_32x32x16_bf16(a, b, c, 0, 0, 0)
__device__ __forceinline__ float keep_neg(float x, int d) { return __builtin_bit_cast(float, __builtin_bit_cast(unsigned, x) & (unsigned)(d >> 31)); }
__device__ __forceinline__ float keep_zero(float x, int d) { return __builtin_bit_cast(float, __builtin_bit_cast(unsigned, x) & ~(unsigned)((d | -d) >> 31)); }
__device__ __forceinline__ f32x16 zero16() { f32x16 z;
#pragma unroll
    for (int r = 0; r < 16; ++r) z[r] = 0.f;
    return z; }

__device__ __forceinline__ void phase_rwkv_prep2(const Ctx& c, int l) {
    const GAS bf16* Z = (const GAS bf16*)(c.R + R_Z);
    GAS bf16* NAT = (GAS bf16*)(c.R + R_NAT); GAS bf16* TR = (GAS bf16*)(c.R + R_TR); GAS bf16* VN = (GAS bf16*)(c.R + R_VG); GAS bf16* GN = VN + (size_t)M * AW; GAS float* BON = (GAS float*)(c.R + R_BON); GAS float* WL = (GAS float*)(c.R + R_WL); GAS bf16* VF = (GAS bf16*)(c.ws + WS_VF);
    const GAS float* mu = c.in(I_MU) + l * 1280; const GAS float* w0 = c.in(I_W0) + l * AW; const GAS float* wup = c.in(I_WUP) + (size_t)l * 32 * AW;
    const GAS float* a0 = c.in(I_A0) + l * AW; const GAS float* aup = c.in(I_AUP) + (size_t)l * 32 * AW; const GAS float* gup = c.in(I_GUP) + (size_t)l * 64 * AW;
    const GAS float* kkw = c.in(I_KK) + l * AW; const GAS float* kaw = c.in(I_KA) + l * AW; const GAS float* rkw = c.in(I_RK) + l * AW;
    const GAS float* v0 = c.in(I_V0); const GAS float* vdn = c.in(I_VDN); const GAS float* vup = c.in(I_VUP);
    LAS float* sm = (LAS float*)c.lds;
    LAS float* vs = sm + 8 * 128;
    LAS float* vd = vs + 8 * 384;
    const int t = c.tid;
    constexpr size_t ASZ = (size_t)NCHUNK * BLK;
    for (int item = c.bid; item < M / 64; item += c.nb) {
        const int b = item / (SEQ / 64), cc = item % (SEQ / 64);
        const int hh = t >> 6, c64 = t & 63; const size_t cbo = ((size_t)((b * AH + hh) * (SEQ / 64) + cc)) * BLK;
        float cum = 0.f;
        for (int grp = 0; grp < 8; ++grp) {
            const int m0 = item * 64 + grp * 8;
            float r[8], k[8], v[8];
            if (t < AW) {
                const float mr = mu[ZR + t], mk = mu[ZK + t], mv = mu[ZV + t];
#pragma unroll
                for (int q = 0; q < 8; ++q) { const int m = m0 + q, s = m % SEQ; r[q] = zsh(Z, m, s, ZR + t, mr); k[q] = zsh(Z, m, s, ZK + t, mk); v[q] = zsh(Z, m, s, ZV + t, mv); }
            } else {
                const int j = t - AW; const float mj = mu[ZWD + j];
#pragma unroll
                for (int q = 0; q < 8; ++q) { const int m = m0 + q, s = m % SEQ; float x = zsh(Z, m, s, ZWD + j, mj);
                    if (j < 32) x = tanhf(x); else if (j >= 64) x = sigmoid_f(x);
                    sm[q * 128 + j] = x; }
            }
            __syncthreads();
            float wa[8], aa[8], ga[8];
            if (t < AW) {
#pragma unroll
                for (int q = 0; q < 8; ++q) { wa[q] = 0.f; aa[q] = 0.f; ga[q] = 0.f; }
                for (int j = 0; j < 32; ++j) { const float ww = wup[j * AW + t], au = aup[j * AW + t];
#pragma unroll
                    for (int q = 0; q < 8; ++q) { wa[q] += sm[q * 128 + j] * ww; aa[q] += sm[q * 128 + 32 + j] * au; } }
                for (int j = 0; j < 64; ++j) { const float gu = gup[j * AW + t];
#pragma unroll
                    for (int q = 0; q < 8; ++q) ga[q] += sm[q * 128 + 64 + j] * gu; }
                if (l > 0) {
#pragma unroll
                    for (int q = 0; q < 8; ++q) vs[q * AW + t] = v[q];
                }
            }
            __syncthreads();
            if (l > 0) {
                if (t < 128) { const int q = t >> 4, j = t & 15; float s = 0.f; for (int cx = 0; cx < AW; ++cx) s += vs[q * AW + cx] * vdn[cx * 16 + j]; vd[q * 16 + j] = s; }
                __syncthreads();
            }
            if (t < AW) {
                const float w0t = w0[t], a0t = a0[t], kkt = kkw[t], kat = kaw[t], rkt = rkw[t];
                unsigned short ta[8], tv[8], tb[8], tk[8];
#pragma unroll
                for (int q = 0; q < 8; ++q) { const int m = m0 + q; const size_t o = (size_t)m * AW + t;
                    const float xw = -(w0t + wa[q]);
                    const float sp = xw > 20.f ? xw : log1pf(__expf(xw));
                    const float lw = -__expf(-sp - 0.5f);
                    const float av = sigmoid_f(a0t + aa[q]);
                    float vv = v[q];
                    if (l > 0) { float x = v0[t];
#pragma unroll
                        for (int j = 0; j < 16; ++j) x += vd[q * 16 + j] * vup[j * AW + t];
                        const float vf = bf2f(VF[o]); vv = vv + (vf - vv) * sigmoid_f(x); }
                    else VF[o] = (bf16)f2bf(vv);
                    float kk = k[q] * kkt; const float ss = wave_sum(kk * kk); kk = kk / fmaxf(sqrtf(ss), 1e-12f);
                    const float k2 = k[q] * (1.0f + (av - 1.0f) * kat);
                    const float rq = bf2f((bf16)f2bf(r[q])), k2q = bf2f((bf16)f2bf(k2));
                    const float bon = wave_sum(rq * k2q * rkt);
                    if (c64 == 0) BON[(size_t)m * AH + hh] = bon;
                    VN[o] = (bf16)f2bf(vv); GN[o] = (bf16)f2bf(ga[q]);
                    const float cprev = cum; cum += lw;
                    const float ep = __expf(cum), en = __expf(-cum), epv = __expf(cprev);
                    const int tt = grp * 8 + q; const size_t no = cbo + (size_t)tt * 64 + c64;
                    const unsigned short xa = (unsigned short)f2bf(-kk * epv), xb = (unsigned short)f2bf(kk * av * en), xk = (unsigned short)f2bf(k2 * en);
                    NAT[0 * ASZ + no] = xa; NAT[1 * ASZ + no] = (bf16)f2bf(r[q] * ep); NAT[2 * ASZ + no] = xb; NAT[3 * ASZ + no] = xk;
                    ta[q] = xa; tv[q] = (unsigned short)f2bf(vv); tb[q] = xb; tk[q] = xk; }
                const int p1 = 16 * (grp >> 1) + 4 * (grp & 1); const size_t to = cbo + (size_t)c64 * 64 + p1;
                *(GAS v2u*)(TR + 0 * ASZ + to) = (v2u){(unsigned)ta[0] | ((unsigned)ta[1] << 16), (unsigned)ta[2] | ((unsigned)ta[3] << 16)}; *(GAS v2u*)(TR + 0 * ASZ + to + 8) = (v2u){(unsigned)ta[4] | ((unsigned)ta[5] << 16), (unsigned)ta[6] | ((unsigned)ta[7] << 16)};
                *(GAS v2u*)(TR + 1 * ASZ + to) = (v2u){(unsigned)tv[0] | ((unsigned)tv[1] << 16), (unsigned)tv[2] | ((unsigned)tv[3] << 16)}; *(GAS v2u*)(TR + 1 * ASZ + to + 8) = (v2u){(unsigned)tv[4] | ((unsigned)tv[5] << 16), (unsigned)tv[6] | ((unsigned)tv[7] << 16)};
                *(GAS v2u*)(TR + 2 * ASZ + to) = (v2u){(unsigned)tb[0] | ((unsigned)tb[1] << 16), (unsigned)tb[2] | ((unsigned)tb[3] << 16)}; *(GAS v2u*)(TR + 2 * ASZ + to + 8) = (v2u){(unsigned)tb[4] | ((unsigned)tb[5] << 16), (unsigned)tb[6] | ((unsigned)tb[7] << 16)};
                *(GAS v2u*)(TR + 3 * ASZ + to) = (v2u){(unsigned)tk[0] | ((unsigned)tk[1] << 16), (unsigned)tk[2] | ((unsigned)tk[3] << 16)}; *(GAS v2u*)(TR + 3 * ASZ + to + 8) = (v2u){(unsigned)tk[4] | ((unsigned)tk[5] << 16), (unsigned)tk[6] | ((unsigned)tk[7] << 16)};
            }
            __syncthreads();
        }
        if (t < AW) WL[(cbo >> 12) * 64 + c64] = __expf(cum);
    }
}


typedef float f32x4v __attribute__((ext_vector_type(4)));
__device__ __forceinline__ void phase_rwkv_prep3(const Ctx& c, int l) {
    const GAS bf16* Z = (const GAS bf16*)(c.R + R_Z);
    GAS bf16* NAT = (GAS bf16*)(c.R + R_NAT); GAS bf16* TR = (GAS bf16*)(c.R + R_TR); GAS bf16* VN = (GAS bf16*)(c.R + R_VG); GAS bf16* GN = VN + (size_t)M * AW; GAS float* BON = (GAS float*)(c.R + R_BON); GAS float* WL = (GAS float*)(c.R + R_WL); GAS bf16* VF = (GAS bf16*)(c.ws + WS_VF);
    const GAS float* mu = c.in(I_MU) + l * 1280; const GAS float* w0 = c.in(I_W0) + l * AW; const GAS float* a0 = c.in(I_A0) + l * AW;
    const GAS float* kkw = c.in(I_KK) + l * AW; const GAS float* kaw = c.in(I_KA) + l * AW; const GAS float* rkw = c.in(I_RK) + l * AW;
    const GAS float* v0 = c.in(I_V0); const GAS float* vdn = c.in(I_VDN); const GAS float* vup = c.in(I_VUP);
    const GAS bf16* LWt = (const GAS bf16*)(c.ws + WS_WSM + WSM_LW) + (size_t)l * AW * 32; const GAS bf16* LAt = (const GAS bf16*)(c.ws + WS_WSM + WSM_LA) + (size_t)l * AW * 32; const GAS bf16* LGt = (const GAS bf16*)(c.ws + WS_WSM + WSM_LG) + (size_t)l * AW * 64;
    constexpr int SP = 136;
    LAS unsigned short* sm = (LAS unsigned short*)c.lds;
    LAS float* lora = (LAS float*)(c.lds + 8192);
    LAS unsigned short* vs = (LAS unsigned short*)(lora + 3 * 16 * AW);
    LAS float* vd = (LAS float*)(vs + 16 * 392);
    const GAS bf16* VDt = (const GAS bf16*)(c.ws + WS_WSM + WSM_VD);
    const int t = c.tid, lane = c.lane;
    constexpr size_t ASZ = (size_t)NCHUNK * BLK;
    for (int item = c.bid; item < M / 64; item += c.nb) {
        const int b = item / (SEQ / 64), cc = item % (SEQ / 64);
        const int hh = c.wave < 6 ? c.wave : c.wave - 2, c64 = lane, tc = hh * 64 + lane, qlo = c.wave >= 6 ? 8 : 0, qhi = (c.wave == 4 || c.wave == 5) ? 8 : 16;
        const size_t cbo = ((size_t)((b * AH + hh) * (SEQ / 64) + cc)) * BLK;
        float cum = 0.f;
        for (int grp = 0; grp < 4; ++grp) {
            const int m0 = item * 64 + grp * 16;
            if (t < AW) {
                if (l > 0) { const float mv = mu[ZV + t];
#pragma unroll 4
                    for (int q = 0; q < 16; ++q) { const int m = m0 + q, s = m % SEQ; vs[q * 392 + t] = (unsigned short)f2bf(zsh(Z, m, s, ZV + t, mv)); } }
            } else {
                const int j = t - AW; const float mj = mu[ZWD + j];
                float zt[17]; const int s0_ = m0 % SEQ;
#pragma unroll
                for (int q = 0; q < 17; ++q) zt[q] = bf2f(Z[(size_t)(m0 + q - 1 + ((q == 0 && s0_ == 0) ? 1 : 0)) * ZP + ZWD + j]);
                if (s0_ == 0) zt[0] = 0.f;
#pragma unroll
                for (int q = 0; q < 16; ++q) { float x = zt[q + 1] + (zt[q] - zt[q + 1]) * mj;
                    const float ex = __expf(j < 32 ? 2.0f * x : -x), rc = 1.0f / (1.0f + ex);
                    x = j < 32 ? 1.0f - 2.0f * rc : (j >= 64 ? rc : x);
                    sm[q * SP + j] = (unsigned short)f2bf(x); }
            }
            __syncthreads();
            {
                const int row = lane & 15, kq = lane >> 4;
                const bf16x8 aw = *(const LAS bf16x8*)(sm + row * SP + 8 * kq), aa = *(const LAS bf16x8*)(sm + row * SP + 32 + 8 * kq), ag0 = *(const LAS bf16x8*)(sm + row * SP + 64 + 8 * kq), ag1 = *(const LAS bf16x8*)(sm + row * SP + 96 + 8 * kq);
#pragma unroll
                for (int i = 0; i < 3; ++i) { const int ch = 16 * (3 * c.wave + i) + row;
                    f32x4v dw = {0.f, 0.f, 0.f, 0.f}, da = dw, dg = dw;
                    dw = __builtin_amdgcn_mfma_f32_16x16x32_bf16(aw, *(const GAS bf16x8*)(LWt + ch * 32 + 8 * kq), dw, 0, 0, 0);
                    da = __builtin_amdgcn_mfma_f32_16x16x32_bf16(aa, *(const GAS bf16x8*)(LAt + ch * 32 + 8 * kq), da, 0, 0, 0);
                    dg = __builtin_amdgcn_mfma_f32_16x16x32_bf16(ag0, *(const GAS bf16x8*)(LGt + ch * 64 + 8 * kq), dg, 0, 0, 0);
                    dg = __builtin_amdgcn_mfma_f32_16x16x32_bf16(ag1, *(const GAS bf16x8*)(LGt + ch * 64 + 32 + 8 * kq), dg, 0, 0, 0);
#pragma unroll
                    for (int rr = 0; rr < 4; ++rr) { const int tq = 4 * kq + rr; lora[(0 * 16 + tq) * AW + ch] = dw[rr]; lora[(1 * 16 + tq) * AW + ch] = da[rr]; lora[(2 * 16 + tq) * AW + ch] = dg[rr]; } }
                if (l > 0 && c.wave == 7) {
                    f32x4v dv = {0.f, 0.f, 0.f, 0.f}; bf16x8 vbf[12];
#pragma unroll
                    for (int ks = 0; ks < 12; ++ks) vbf[ks] = *(const GAS bf16x8*)(VDt + row * AW + 32 * ks + 8 * kq);
#pragma unroll
                    for (int ks = 0; ks < 12; ++ks) dv = __builtin_amdgcn_mfma_f32_16x16x32_bf16(*(const LAS bf16x8*)(vs + row * 392 + 32 * ks + 8 * kq), vbf[ks], dv, 0, 0, 0);
#pragma unroll
                    for (int rr = 0; rr < 4; ++rr) vd[(4 * kq + rr) * 16 + row] = dv[rr]; }
            }
            __syncthreads();

            {
                const float w0t = w0[tc], a0t = a0[tc], kkt = kkw[tc], kat = kaw[tc], rkt = rkw[tc], mr = mu[ZR + tc], mk = mu[ZK + tc], mv = mu[ZV + tc];
                unsigned short ta[16], tv[16], tb[16], tk[16];
                float vupr[16], vfin[16]; float v0t = 0.f;
#pragma unroll
                for (int j = 0; j < 16; ++j) { vupr[j] = 0.f; vfin[j] = 0.f; }
                if (l > 0) { v0t = v0[tc];
                    unsigned short vfr[16];
#pragma unroll
                    for (int j = 0; j < 16; ++j) { vupr[j] = vup[j * AW + tc]; vfr[j] = VF[(size_t)(m0 + j) * AW + tc]; }
#pragma unroll
                    for (int j = 0; j < 16; ++j) vfin[j] = bf2f(vfr[j]); }
                float rin[16], kin[16], vin[16];
                { float zr_[17], zk_[17], zv_[17]; const int s0_ = m0 % SEQ;
#pragma unroll
                  for (int q = 0; q < 17; ++q) { const size_t zo = (size_t)(m0 + q - 1 + ((q == 0 && s0_ == 0) ? 1 : 0)) * ZP;
                      zr_[q] = bf2f(Z[zo + ZR + tc]); zk_[q] = bf2f(Z[zo + ZK + tc]); zv_[q] = bf2f(Z[zo + ZV + tc]); }
                  if (s0_ == 0) { zr_[0] = 0.f; zk_[0] = 0.f; zv_[0] = 0.f; }
#pragma unroll
                  for (int q = 0; q < 16; ++q) { rin[q] = zr_[q + 1] + (zr_[q] - zr_[q + 1]) * mr; kin[q] = zk_[q + 1] + (zk_[q] - zk_[q + 1]) * mk; vin[q] = zv_[q + 1] + (zv_[q] - zv_[q + 1]) * mv;
                  } }
#pragma unroll
                for (int q = 0; q < 16; ++q) { const int m = m0 + q; const size_t o = (size_t)m * AW + tc;
                    const float rv = rin[q], kv = kin[q], vv0 = vin[q];
                    const float xw = -(w0t + lora[(0 * 16 + q) * AW + tc]);
                    const float sp = xw > 20.f ? xw : __logf(1.0f + __expf(xw));
                    const float lw = -__expf(-sp - 0.5f);
                    const float cprev = cum; cum += lw;
                    if (q >= qlo && q < qhi) {
                    const float av = sigmoid_fast(a0t + lora[(1 * 16 + q) * AW + tc]);
                    float vv = vv0;
                    if (l > 0) { float x = v0t;
#pragma unroll
                        for (int j = 0; j < 16; ++j) x += vd[q * 16 + j] * vupr[j];
                        const float vf = vfin[q]; vv = vv + (vf - vv) * sigmoid_fast(x); }
                    else VF[o] = f2bf_hw(vv);
                    float kk = kv * kkt; const float ss = wave_sum(kk * kk); kk = kk * __builtin_amdgcn_rsqf(fmaxf(ss, 1e-24f));
                    const float k2 = kv * (1.0f + (av - 1.0f) * kat);
                    const float rq = bf2f(f2bf_hw(rv)), k2q = bf2f(f2bf_hw(k2));
                    const float bon = wave_sum(rq * k2q * rkt);
                    if (c64 == 0) BON[(size_t)m * AH + hh] = bon;
                    VN[o] = f2bf_hw(vv); GN[o] = f2bf_hw(lora[(2 * 16 + q) * AW + tc]);
                    const float ep = __expf(cum), en = __expf(-cum), epv = __expf(cprev);
                    const int tt = grp * 16 + q; const size_t no = cbo + (size_t)tt * 64 + c64;
                    const unsigned short xa = f2bf_hw(-kk * epv), xb = f2bf_hw(kk * av * en), xk = f2bf_hw(k2 * en);
                    NAT[0 * ASZ + no] = xa; NAT[1 * ASZ + no] = f2bf_hw(rv * ep); NAT[2 * ASZ + no] = xb; NAT[3 * ASZ + no] = xk;
                    ta[q] = xa; tv[q] = f2bf_hw(vv); tb[q] = xb; tk[q] = xk; } }
                const size_t to = cbo + (size_t)c64 * 64 + 16 * grp;
#define PK2(a, i, j) ((unsigned)a[i] | ((unsigned)a[j] << 16))
#define TRST(x, a) do { if (qlo == 0) { *(GAS v2u*)(TR + (x) * ASZ + to) = (v2u){PK2(a, 0, 1), PK2(a, 2, 3)}; *(GAS v2u*)(TR + (x) * ASZ + to + 8) = (v2u){PK2(a, 4, 5), PK2(a, 6, 7)}; } \
                        if (qhi == 16) { *(GAS v2u*)(TR + (x) * ASZ + to + 4) = (v2u){PK2(a, 8, 9), PK2(a, 10, 11)}; *(GAS v2u*)(TR + (x) * ASZ + to + 12) = (v2u){PK2(a, 12, 13), PK2(a, 14, 15)}; } } while (0)
                TRST(0, ta); TRST(1, tv); TRST(2, tb); TRST(3, tk);
#undef TRST
#undef PK2
            }
            __syncthreads();
        }
        if (c.wave < 6) WL[(cbo >> 12) * 64 + c64] = __expf(cum);
    }
}

__device__ __forceinline__ void phase_rwkv_prep4(const Ctx& c, int l) {
    const GAS bf16* Z = (const GAS bf16*)(c.R + R_Z);
    GAS bf16* NAT = (GAS bf16*)(c.R + R_NAT); GAS bf16* TR = (GAS bf16*)(c.R + R_TR); GAS bf16* VN = (GAS bf16*)(c.R + R_VG); GAS bf16* GN = VN + (size_t)M * AW; GAS float* BON = (GAS float*)(c.R + R_BON); GAS float* WL = (GAS float*)(c.R + R_WL); GAS bf16* VF = (GAS bf16*)(c.ws + WS_VF);
    const GAS float* mu = c.in(I_MU) + l * 1280; const GAS float* w0 = c.in(I_W0) + l * AW; const GAS float* a0 = c.in(I_A0) + l * AW;
    const GAS float* kkw = c.in(I_KK) + l * AW; const GAS float* kaw = c.in(I_KA) + l * AW; const GAS float* rkw = c.in(I_RK) + l * AW;
    const GAS float* v0 = c.in(I_V0); const GAS float* vdn = c.in(I_VDN); const GAS float* vup = c.in(I_VUP);
    const GAS bf16* LWt = (const GAS bf16*)(c.ws + WS_WSM + WSM_LW) + (size_t)l * AW * 32; const GAS bf16* LAt = (const GAS bf16*)(c.ws + WS_WSM + WSM_LA) + (size_t)l * AW * 32; const GAS bf16* LGt = (const GAS bf16*)(c.ws + WS_WSM + WSM_LG) + (size_t)l * AW * 64;
    constexpr int SP = 136;
    LAS unsigned short* sm = (LAS unsigned short*)c.lds;
    LAS float* lora = (LAS float*)(c.lds + 8192);
    LAS unsigned short* vs = (LAS unsigned short*)(lora + 3 * 16 * AW);
    LAS float* vd = (LAS float*)(vs + 16 * 392);
    const GAS bf16* VDt = (const GAS bf16*)(c.ws + WS_WSM + WSM_VD);
    const int t = c.tid, lane = c.lane;
    constexpr size_t ASZ = (size_t)NCHUNK * BLK;
    for (int item = c.bid; item < M / 64; item += c.nb) {
        const int b = item / (SEQ / 64), cc = item % (SEQ / 64);
        const int p3 = c.wave % 3, hf = c.wave / 3, hh = 2 * p3 + (lane >> 5), c2 = 2 * (lane & 31), tc = hh * 64 + c2;
        const unsigned cbo = (unsigned)(((b * AH + hh) * (SEQ / 64) + cc) * BLK);
        f32x2 cum = {0.f, 0.f};
        for (int grp = 0; grp < 4; ++grp) {
            const int m0 = item * 64 + grp * 16;
            if (t < AW) {
                if (l > 0) { const float mv = mu[ZV + t];
#pragma unroll 4
                    for (int q = 0; q < 16; ++q) { const int m = m0 + q, s = m % SEQ; vs[q * 392 + t] = (unsigned short)f2bf(zsh(Z, m, s, ZV + t, mv)); } }
            } else {
                const int j = t - AW; const float mj = mu[ZWD + j];
                float zt[17]; const int s0_ = m0 % SEQ;
#pragma unroll
                for (int q = 0; q < 17; ++q) zt[q] = bf2f(Z[(size_t)(m0 + q - 1 + ((q == 0 && s0_ == 0) ? 1 : 0)) * ZP + ZWD + j]);
                if (s0_ == 0) zt[0] = 0.f;
#pragma unroll
                for (int q = 0; q < 16; ++q) { float x = zt[q + 1] + (zt[q] - zt[q + 1]) * mj;
                    const float ex = __expf(j < 32 ? 2.0f * x : -x), rc = 1.0f / (1.0f + ex);
                    x = j < 32 ? 1.0f - 2.0f * rc : (j >= 64 ? rc : x);
                    sm[q * SP + j] = (unsigned short)f2bf(x); }
            }
            __syncthreads();
            {
                const int row = lane & 15, kq = lane >> 4;
                const bf16x8 aw = *(const LAS bf16x8*)(sm + row * SP + 8 * kq), aa = *(const LAS bf16x8*)(sm + row * SP + 32 + 8 * kq), ag0 = *(const LAS bf16x8*)(sm + row * SP + 64 + 8 * kq), ag1 = *(const LAS bf16x8*)(sm + row * SP + 96 + 8 * kq);
#pragma unroll
                for (int i = 0; i < 3; ++i) { const int ch = 16 * (3 * c.wave + i) + row;
                    f32x4v dw = {0.f, 0.f, 0.f, 0.f}, da = dw, dg = dw;
                    dw = __builtin_amdgcn_mfma_f32_16x16x32_bf16(aw, *(const GAS bf16x8*)(LWt + ch * 32 + 8 * kq), dw, 0, 0, 0);
                    da = __builtin_amdgcn_mfma_f32_16x16x32_bf16(aa, *(const GAS bf16x8*)(LAt + ch * 32 + 8 * kq), da, 0, 0, 0);
                    dg = __builtin_amdgcn_mfma_f32_16x16x32_bf16(ag0, *(const GAS bf16x8*)(LGt + ch * 64 + 8 * kq), dg, 0, 0, 0);
                    dg = __builtin_amdgcn_mfma_f32_16x16x32_bf16(ag1, *(const GAS bf16x8*)(LGt + ch * 64 + 32 + 8 * kq), dg, 0, 0, 0);
#pragma unroll
                    for (int rr = 0; rr < 4; ++rr) { const int tq = 4 * kq + rr; lora[(0 * 16 + tq) * AW + ch] = dw[rr]; lora[(1 * 16 + tq) * AW + ch] = da[rr]; lora[(2 * 16 + tq) * AW + ch] = dg[rr]; } }
                if (l > 0 && c.wave == 7) {
                    f32x4v dv = {0.f, 0.f, 0.f, 0.f}; bf16x8 vbf[12];
#pragma unroll
                    for (int ks = 0; ks < 12; ++ks) vbf[ks] = *(const GAS bf16x8*)(VDt + row * AW + 32 * ks + 8 * kq);
#pragma unroll
                    for (int ks = 0; ks < 12; ++ks) dv = __builtin_amdgcn_mfma_f32_16x16x32_bf16(*(const LAS bf16x8*)(vs + row * 392 + 32 * ks + 8 * kq), vbf[ks], dv, 0, 0, 0);
#pragma unroll
                    for (int rr = 0; rr < 4; ++rr) vd[(4 * kq + rr) * 16 + row] = dv[rr]; }
            }
            __syncthreads();

            if (c.wave < 6) {
#define LD2(p) (*(const GAS f32x2*)(p))
                const f32x2 w0t = LD2(w0 + tc), a0t = LD2(a0 + tc), kkt = LD2(kkw + tc), kat = LD2(kaw + tc), rkt = LD2(rkw + tc), mr = LD2(mu + ZR + tc), mk = LD2(mu + ZK + tc), mv = LD2(mu + ZV + tc);
                const int Q0 = 8 * hf, s0_ = (m0 + Q0) % SEQ; const bool pz = s0_ == 0;
                unsigned zr_[9], zk_[9], zv_[9], vfr[8];
#pragma unroll
                for (int q = 0; q < 9; ++q) { const size_t zo = (size_t)(m0 + Q0 + q - 1 + ((q == 0 && pz) ? 1 : 0)) * ZP + tc;
                    zr_[q] = *(const GAS unsigned*)(Z + zo + ZR); zk_[q] = *(const GAS unsigned*)(Z + zo + ZK); zv_[q] = *(const GAS unsigned*)(Z + zo + ZV); }
#pragma unroll
                for (int j = 0; j < 8; ++j) vfr[j] = 0u;
                f32x2 sgv[8];
#pragma unroll
                for (int j = 0; j < 8; ++j) sgv[j] = (f32x2){0.f, 0.f};
                if (l > 0) {
                    f32x2 vupr[16]; const f32x2 v0t = LD2(v0 + tc);
#pragma unroll
                    for (int j = 0; j < 16; ++j) vupr[j] = LD2(vup + j * AW + tc);
#pragma unroll
                    for (int j = 0; j < 8; ++j) vfr[j] = *(const GAS unsigned*)(VF + (size_t)(m0 + Q0 + j) * AW + tc);
#pragma unroll
                    for (int q8 = 0; q8 < 8; ++q8) { f32x2 x = v0t; const LAS f32x4* vq4 = (const LAS f32x4*)(vd + (Q0 + q8) * 16);
#pragma unroll
                        for (int j4 = 0; j4 < 4; ++j4) { const f32x4 d4 = vq4[j4]; x += vupr[4 * j4] * d4.x; x += vupr[4 * j4 + 1] * d4.y; x += vupr[4 * j4 + 2] * d4.z; x += vupr[4 * j4 + 3] * d4.w; }
                        sgv[q8] = (f32x2){sigmoid_fast(x.x), sigmoid_fast(x.y)}; } }
#undef LD2
                if (pz) { zr_[0] = 0u; zk_[0] = 0u; zv_[0] = 0u; }
                f32x2 cumv[9];
#pragma unroll
                for (int q = 0; q < 16; ++q) { const f32x2 lo2 = *(const LAS f32x2*)(lora + (0 * 16 + q) * AW + tc); f32x2 lw;
#pragma unroll
                    for (int e = 0; e < 2; ++e) { const float xw = -(w0t[e] + lo2[e]); const float sp = xw > 20.f ? xw : __logf(1.0f + __expf(xw)); lw[e] = -__expf(-sp - 0.5f); }
                    if (q >= Q0 && q < Q0 + 8) cumv[q & 7] = cum;
                    cum += lw;
                    if (q == Q0 + 7) cumv[8] = cum; }
                const unsigned to = cbo + (unsigned)c2 * 64 + 16 * grp;
#define LO2(a, i, j) (((a)[i] & 0xffffu) | ((a)[j] << 16))
#define HI2(a, i, j) (((a)[i] >> 16) | ((a)[j] & 0xffff0000u))
#pragma unroll
                for (int h4 = 0; h4 < 2; ++h4) {
                    unsigned xa_[4], xv_[4], xb_[4], xk_[4];
#pragma unroll
                    for (int u = 0; u < 4; ++u) { const int q8 = 4 * h4 + u, q = Q0 + q8; const unsigned mo = (unsigned)(m0 + q) * AW + tc;
                        const f32x2 pr = {bflo(zr_[q8]), bfhi(zr_[q8])}, cr = {bflo(zr_[q8 + 1]), bfhi(zr_[q8 + 1])}, pk = {bflo(zk_[q8]), bfhi(zk_[q8])}, ck = {bflo(zk_[q8 + 1]), bfhi(zk_[q8 + 1])};
                        const f32x2 pv = {bflo(zv_[q8]), bfhi(zv_[q8])}, cv = {bflo(zv_[q8 + 1]), bfhi(zv_[q8 + 1])};
                        const f32x2 rv = cr + (pr - cr) * mr, kv = ck + (pk - ck) * mk, vv0 = cv + (pv - cv) * mv;
                        const f32x2 la2 = *(const LAS f32x2*)(lora + (1 * 16 + q) * AW + tc), lg2 = *(const LAS f32x2*)(lora + (2 * 16 + q) * AW + tc);
                        const f32x2 av = {sigmoid_fast(a0t.x + la2.x), sigmoid_fast(a0t.y + la2.y)};
                        f32x2 vv = vv0;
                        if (l > 0) { const f32x2 vf = {bflo(vfr[q8]), bfhi(vfr[q8])}; vv = vv + (vf - vv) * sgv[q8]; }
                        else *(GAS unsigned*)(VF + mo) = pk2(vv.x, vv.y);
                        f32x2 kk = kv * kkt; float ss = row16_sum(kk.x * kk.x + kk.y * kk.y);
                        ss += __builtin_bit_cast(float, __builtin_amdgcn_ds_swizzle(__builtin_bit_cast(int, ss), 0x401F));
                        kk = kk * __builtin_amdgcn_rsqf(fmaxf(ss, 1e-24f));
                        const f32x2 k2 = kv * (1.0f + (av - 1.0f) * kat);
                        const unsigned rqb = pk2(rv.x, rv.y), k2b = pk2(k2.x, k2.y);
                        float bon = row16_sum(bflo(rqb) * bflo(k2b) * rkt.x + bfhi(rqb) * bfhi(k2b) * rkt.y);
                        bon += __builtin_bit_cast(float, __builtin_amdgcn_ds_swizzle(__builtin_bit_cast(int, bon), 0x401F));
                        if ((lane & 31) == 0) BON[(size_t)(m0 + q) * AH + hh] = bon;
                        const unsigned vvb = pk2(vv.x, vv.y);
                        *(GAS unsigned*)(VN + mo) = vvb; *(GAS unsigned*)(GN + mo) = pk2(lg2.x, lg2.y);
                        const f32x2 cu = cumv[q8 + 1], cp = cumv[q8];
                        const f32x2 ep = {__expf(cu.x), __expf(cu.y)}, en = {__expf(-cu.x), __expf(-cu.y)}, epv = {__expf(cp.x), __expf(cp.y)};
                        const f32x2 ta2 = -(kk * epv), tr2 = rv * ep, tb2 = kk * av * en, tk2 = k2 * en;
                        const unsigned xa = pk2(ta2.x, ta2.y), xr = pk2(tr2.x, tr2.y), xb = pk2(tb2.x, tb2.y), xk = pk2(tk2.x, tk2.y);
                        const unsigned no = cbo + (unsigned)(grp * 16 + q) * 64 + c2;
                        *(GAS unsigned*)(NAT + 0 * ASZ + no) = xa; *(GAS unsigned*)(NAT + 1 * ASZ + no) = xr; *(GAS unsigned*)(NAT + 2 * ASZ + no) = xb; *(GAS unsigned*)(NAT + 3 * ASZ + no) = xk;
                        xa_[u] = xa; xv_[u] = vvb; xb_[u] = xb; xk_[u] = xk; }
                    const unsigned pp = hf ? (h4 ? 12 : 4) : (h4 ? 8 : 0);
#define TRST(x, a) do { *(GAS v2u*)(TR + (x) * ASZ + to + pp) = (v2u){LO2(a, 0, 1), LO2(a, 2, 3)}; *(GAS v2u*)(TR + (x) * ASZ + to + 64 + pp) = (v2u){HI2(a, 0, 1), HI2(a, 2, 3)}; } while (0)
                    TRST(0, xa_); TRST(1, xv_); TRST(2, xb_); TRST(3, xk_);
#undef TRST
                }
#undef LO2
#undef HI2
            }
            __syncthreads();
        }
        if (c.wave < 3) *(GAS f32x2*)(WL + (cbo >> 12) * 64 + c2) = (f32x2){__expf(cum.x), __expf(cum.y)};
    }
}

__host__ __device__ constexpr int tri_start(int t) { const int a = t >> 2, b = t & 3; return 8 * a * a + 4 * a + (b >= 1 ? 4 * a : 0) + (b >= 2 ? 4 * a + 4 : 0) + (b == 3 ? 4 * a + 4 : 0); }
static_assert(tri_start(1) == 0 && tri_start(2) == 4 && tri_start(5) == 16 && tri_start(64) == 2112, "tri_start");
__device__ __forceinline__ void phase_rwkv_chunk(const Ctx& c) {
    const GAS bf16* NAT = (const GAS bf16*)(c.R + R_NAT); const GAS bf16* TR = (const GAS bf16*)(c.R + R_TR); const GAS float* WLp = (const GAS float*)(c.R + R_WL);
    GAS v4u* CHM = (GAS v4u*)(c.R + R_CHM); GAS v4u* CHR = (GAS v4u*)(c.R + R_CHR); GAS v4u* NB = (GAS v4u*)(c.R + R_NT); GAS float* YL = (GAS float*)(c.R + R_YL);
    constexpr size_t ASZ = (size_t)NCHUNK * BLK;
    const int lane = c.lane, l31 = lane & 31, hi = lane >> 5;
    const int fo = l31 * 64 + 8 * hi;
    const int tpos = (lane & ~15) + vt_pos(lane & 15);
    const bool six = c.nb * 6 == NCHUNK;
    for (int cb = six ? (c.wave < 6 ? c.bid * 6 + c.wave : NCHUNK) : c.gw; cb < NCHUNK; cb += six ? NCHUNK : c.ngw) {
        unsigned lbase = (unsigned)c.wave * 16384u; asm volatile("" : "+v"(lbase));
        LAS float* la = (LAS float*)(c.lds + lbase);
        LAS unsigned short* lt = (LAS unsigned short*)(c.lds + lbase);
        const GAS bf16* At = NAT + 0 * ASZ + (size_t)cb * BLK; const GAS bf16* Rt = NAT + 1 * ASZ + (size_t)cb * BLK; const GAS bf16* Bh = NAT + 2 * ASZ + (size_t)cb * BLK; const GAS bf16* Kh = NAT + 3 * ASZ + (size_t)cb * BLK;
        const GAS bf16* AtT = TR + 0 * ASZ + (size_t)cb * BLK; const GAS bf16* VT = TR + 1 * ASZ + (size_t)cb * BLK; const GAS bf16* BhT = TR + 2 * ASZ + (size_t)cb * BLK; const GAS bf16* KhT = TR + 3 * ASZ + (size_t)cb * BLK;
        const GAS float* wl = WLp + (size_t)cb * 64;
#define LDF(P, blk, ks) (*(const GAS bf16x8*)((P) + (blk) * 2048 + (ks) * 16 + fo))
#define LDT(blk, ks) (*(const LAS bf16x8*)(lt + ((blk) * 32 + l31) * 72 + (ks) * 16 + 8 * hi))
        f32x16 acc[2][2];
#pragma unroll
        for (int rb = 0; rb < 2; ++rb)
#pragma unroll
            for (int cbk = 0; cbk < 2; ++cbk) { if (rb == 1 && cbk == 0) continue;
                acc[rb][cbk] = zero16();
#pragma unroll
                for (int ks = 0; ks < 4; ++ks) acc[rb][cbk] = MFMA32(LDF(Bh, rb, ks), LDF(At, cbk, ks), acc[rb][cbk]); }
#pragma unroll
        for (int rb = 0; rb < 2; ++rb)
#pragma unroll
            for (int cbk = 0; cbk < 2; ++cbk)
#pragma unroll
                for (int r = 0; r < 16; ++r) { if (rb == 1 && cbk == 0) continue; const int j = 32 * rb + 8 * (r >> 2) + 4 * hi + (r & 3), tq = 32 * cbk + l31; if (rb != cbk || j < tq) la[tri_start(tq) + j] = acc[rb][cbk][r]; }
        __builtin_amdgcn_sched_barrier(0);
        bf16x8 fAtT[2][4], fBhT[2][4];
#pragma unroll
        for (int bk = 0; bk < 2; ++bk)
#pragma unroll
            for (int ks = 0; ks < 4; ++ks) { fAtT[bk][ks] = LDF(AtT, bk, ks); fBhT[bk][ks] = LDF(BhT, bk, ks); }
        f32x2 Tc2[32];
#define TCV(j) Tc2[(j) >> 1][(j) & 1]
#pragma unroll
        for (int tq = 0; tq < 64; ++tq) { int ln_ = lane; asm volatile("" : "+v"(ln_));
            f32x2 sv = {ln_ == tq ? 1.f : 0.f, 0.f};
#pragma unroll
            for (int j = 0; j + 4 <= tq; j += 4) { const f32x4 a4 = *(const LAS f32x4*)(la + tri_start(tq) + j); sv += (f32x2){a4.x, a4.y} * Tc2[j >> 1]; sv += (f32x2){a4.z, a4.w} * Tc2[(j >> 1) + 1]; }
            if (tq & 3) { const int j0 = tq & ~3; const f32x4 a4 = *(const LAS f32x4*)(la + tri_start(tq) + j0);
                sv.x += a4.x * TCV(j0); if ((tq & 3) > 1) sv.y += a4.y * TCV(j0 + 1); if ((tq & 3) > 2) sv.x += a4.z * TCV(j0 + 2); }
            TCV(tq) = sv.x + sv.y; }
#pragma unroll
        for (int tq = 0; tq < 64; ++tq) lt[tq * 72 + tpos] = (unsigned short)f2bf(TCV(tq));
#undef TCV
        __builtin_amdgcn_sched_barrier(0);
        bf16x8 fBhN[2][4], fRtN[2][4];
#pragma unroll
        for (int bk = 0; bk < 2; ++bk)
#pragma unroll
            for (int ks = 0; ks < 4; ++ks) { fBhN[bk][ks] = LDF(Bh, bk, ks); fRtN[bk][ks] = LDF(Rt, bk, ks); }
        bf16x8 Ap[2][2][2];
#pragma unroll
        for (int rb = 0; rb < 2; ++rb)
#pragma unroll
            for (int cbk = 0; cbk < 2; ++cbk) { f32x16 a = zero16();
#pragma unroll
                for (int ks = 0; ks < 4; ++ks) a = MFMA32(LDT(rb, ks), fAtT[cbk][ks], a);
                Ap[rb][cbk][0] = pack8(a, 0); Ap[rb][cbk][1] = pack8(a, 8); }
        __builtin_amdgcn_sched_barrier(0);
        { const float wl0 = wl[l31], wl1 = wl[32 + l31];
#pragma unroll
          for (int rbp = 0; rbp < 2; ++rbp)
#pragma unroll
            for (int cbk = 0; cbk < 2; ++cbk) { f32x16 a = zero16();
#pragma unroll
                for (int rbt = 0; rbt < 2; ++rbt)
#pragma unroll
                    for (int s = 0; s < 2; ++s) a = MFMA32(Ap[rbt][rbp][s], fBhT[cbk][2 * rbt + s], a);
                const float wk = cbk ? wl1 : wl0;
#pragma unroll
                for (int r = 0; r < 16; ++r) { const int kp = 32 * rbp + 8 * (r >> 2) + 4 * hi + (r & 3), kq = 32 * cbk + l31; a[r] = a[r] * wk + keep_zero(wk, kp - kq); }
                CHM[((size_t)cb * 8 + cbk * 4 + 2 * rbp + 0) * 64 + lane] = __builtin_bit_cast(v4u, pack8(a, 0)); CHM[((size_t)cb * 8 + cbk * 4 + 2 * rbp + 1) * 64 + lane] = __builtin_bit_cast(v4u, pack8(a, 8)); } }
        __builtin_amdgcn_sched_barrier(0);
        bf16x8 Pb[2][2][2];
        {
#pragma unroll
          for (int rb = 0; rb < 2; ++rb)
#pragma unroll
            for (int cbk = 0; cbk < 2; ++cbk) { if (rb == 1 && cbk == 0) continue;
                f32x16 a = zero16();
#pragma unroll
                for (int ks = 0; ks < 4; ++ks) a = MFMA32(fBhN[rb][ks], fRtN[cbk][ks], a);
                if (rb == cbk) {
#pragma unroll
                for (int r = 0; r < 16; ++r) { const int j = 32 * rb + 8 * (r >> 2) + 4 * hi + (r & 3), tq = 32 * cbk + l31; a[r] = keep_neg(a[r], j - tq - 1); } }
                Pb[rb][cbk][0] = pack8(a, 0); Pb[rb][cbk][1] = pack8(a, 8); }
#pragma unroll
          for (int rbk = 0; rbk < 2; ++rbk)
#pragma unroll
            for (int cbt = 0; cbt < 2; ++cbt) { f32x16 a;
#pragma unroll
                for (int g = 0; g < 4; ++g) { const v2u w = *(const GAS v2u*)(Rt + (32 * cbt + l31) * 64 + 32 * rbk + 8 * g + 4 * hi); a[4 * g] = bflo(w.x); a[4 * g + 1] = bfhi(w.x); a[4 * g + 2] = bflo(w.y); a[4 * g + 3] = bfhi(w.y); }
#pragma unroll
                for (int rbj = 0; rbj < 2; ++rbj)
#pragma unroll
                    for (int s = 0; s < 2; ++s) { if (rbj == 1 && cbt == 0) continue; a = MFMA32(Ap[rbj][rbk][s], Pb[rbj][cbt][s], a); }
                CHR[((size_t)cb * 8 + cbt * 4 + 2 * rbk + 0) * 64 + lane] = __builtin_bit_cast(v4u, pack8(a, 0)); CHR[((size_t)cb * 8 + cbt * 4 + 2 * rbk + 1) * 64 + lane] = __builtin_bit_cast(v4u, pack8(a, 8)); } }
        __builtin_amdgcn_sched_barrier(0);
        f32x4 wlr[2][4];
#pragma unroll
        for (int rbk = 0; rbk < 2; ++rbk)
#pragma unroll
            for (int g = 0; g < 4; ++g) wlr[rbk][g] = *(const GAS f32x4*)(wl + 32 * rbk + 8 * g + 4 * hi);
        bf16x8 Vp[2][2][2];
        { bf16x8 Pk[2][2][2];
#pragma unroll
          for (int rb = 0; rb < 2; ++rb)
#pragma unroll
            for (int cbk = 0; cbk < 2; ++cbk) { if (rb == 1 && cbk == 0) continue;
                f32x16 a = zero16();
#pragma unroll
                for (int ks = 0; ks < 4; ++ks) a = MFMA32(LDF(Kh, rb, ks), LDF(At, cbk, ks), a);
                if (rb == cbk) {
#pragma unroll
                for (int r = 0; r < 16; ++r) { const int j = 32 * rb + 8 * (r >> 2) + 4 * hi + (r & 3), tq = 32 * cbk + l31; a[r] = keep_neg(a[r], j - tq); } }
                Pk[rb][cbk][0] = pack8(a, 0); Pk[rb][cbk][1] = pack8(a, 8); }
          bf16x8 X2b[2][2][2];
#pragma unroll
          for (int rbt = 0; rbt < 2; ++rbt)
#pragma unroll
            for (int cbv = 0; cbv < 2; ++cbv) { f32x16 a = zero16();
#pragma unroll
                for (int rbj = 0; rbj < 2; ++rbj)
#pragma unroll
                    for (int s = 0; s < 2; ++s) { if (rbj == 1 && rbt == 0) continue; a = MFMA32(Pk[rbj][rbt][s], LDF(VT, cbv, 2 * rbj + s), a); }
                X2b[rbt][cbv][0] = pack8(a, 0); X2b[rbt][cbv][1] = pack8(a, 8); }
#pragma unroll
          for (int rb = 0; rb < 2; ++rb)
#pragma unroll
            for (int cbv = 0; cbv < 2; ++cbv) { f32x16 a = zero16();
#pragma unroll
                for (int ks = 0; ks < 4; ++ks) a = MFMA32(LDT(rb, ks), X2b[ks >> 1][cbv][ks & 1], a);
                Vp[rb][cbv][0] = pack8(a, 0); Vp[rb][cbv][1] = pack8(a, 8); } }
        __builtin_amdgcn_sched_barrier(0);
#pragma unroll
        for (int rbk = 0; rbk < 2; ++rbk)
#pragma unroll
            for (int cbv = 0; cbv < 2; ++cbv) { f32x16 a = zero16();
#pragma unroll
                for (int ks = 0; ks < 4; ++ks) { a = MFMA32(LDF(BhT, rbk, ks), Vp[ks >> 1][cbv][ks & 1], a); a = MFMA32(LDF(KhT, rbk, ks), LDF(VT, cbv, ks), a); }
#pragma unroll
                for (int g = 0; g < 4; ++g) { const f32x4 w4 = wlr[rbk][g]; a[4 * g] *= w4.x; a[4 * g + 1] *= w4.y; a[4 * g + 2] *= w4.z; a[4 * g + 3] *= w4.w; }
                NB[(((size_t)cb * 2 + cbv) * 4 + 2 * rbk + 0) * 64 + lane] = __builtin_bit_cast(v4u, pack8(a, 0)); NB[(((size_t)cb * 2 + cbv) * 4 + 2 * rbk + 1) * 64 + lane] = __builtin_bit_cast(v4u, pack8(a, 8)); }
        __builtin_amdgcn_sched_barrier(0);
        f32x16 yl[2][2];
        {
#pragma unroll
          for (int rbv = 0; rbv < 2; ++rbv)
#pragma unroll
            for (int cbt = 0; cbt < 2; ++cbt) { f32x16 a = zero16();
#pragma unroll
                for (int rbj = 0; rbj < 2; ++rbj)
#pragma unroll
                    for (int s = 0; s < 2; ++s) { if (rbj == 1 && cbt == 0) continue; a = MFMA32(Vp[rbj][rbv][s], Pb[rbj][cbt][s], a); }
                yl[rbv][cbt] = PROBE_NO_VP ? zero16() : a; } }
        __builtin_amdgcn_sched_barrier(0);
        { bf16x8 Pk2[2][2][2];
#pragma unroll
          for (int rb = 0; rb < 2; ++rb)
#pragma unroll
            for (int cbk = 0; cbk < 2; ++cbk) { if (rb == 1 && cbk == 0) continue;
                f32x16 a = zero16();
#pragma unroll
                for (int ks = 0; ks < 4; ++ks) a = MFMA32(LDF(Kh, rb, ks), LDF(Rt, cbk, ks), a);
                if (rb == cbk) {
#pragma unroll
                for (int r = 0; r < 16; ++r) { const int j = 32 * rb + 8 * (r >> 2) + 4 * hi + (r & 3), tq = 32 * cbk + l31; a[r] = keep_neg(a[r], j - tq - 1); } }
                Pk2[rb][cbk][0] = pack8(a, 0); Pk2[rb][cbk][1] = pack8(a, 8); }
#pragma unroll
          for (int rbv = 0; rbv < 2; ++rbv)
#pragma unroll
            for (int cbt = 0; cbt < 2; ++cbt) { f32x16 a = yl[rbv][cbt];
#pragma unroll
                for (int rbj = 0; rbj < 2; ++rbj)
#pragma unroll
                    for (int s = 0; s < 2; ++s) { if (rbj == 1 && cbt == 0) continue; a = MFMA32(LDF(VT, rbv, 2 * rbj + s), Pk2[rbj][cbt][s], a); }
#pragma unroll
                for (int g = 0; g < 4; ++g) {
#ifdef PROBE_COPY
                    const v2u w = *(const GAS v2u*)(Kh + (32 * cbt + l31) * 64 + 32 * rbv + 8 * g + 4 * hi); const v2u w2 = *(const GAS v2u*)(VT + (32 * cbt + l31) * 64 + 32 * rbv + 8 * g + 4 * hi);
                    a[4 * g] = bflo(w.x) + bflo(w2.x); a[4 * g + 1] = bfhi(w.x) + bfhi(w2.x); a[4 * g + 2] = bflo(w.y) + bflo(w2.y); a[4 * g + 3] = bfhi(w.y) + bfhi(w2.y);
#endif
                    *(GAS f32x4*)(YL + (size_t)cb * BLK + (32 * cbt + l31) * 64 + 32 * rbv + 8 * g + 4 * hi) = (f32x4){a[4 * g], a[4 * g + 1], a[4 * g + 2], a[4 * g + 3]}; } } }
#undef LDF
#undef LDT
    }
}

constexpr int SCAN_WGS = 6;
__device__ __forceinline__ void phase_rwkv_scan2(const Ctx& c) {
    const GAS v4u* CHM = (const GAS v4u*)(c.R + R_CHM); GAS v4u* CHS = (GAS v4u*)(c.R + R_CHS); const GAS v4u* NB = (const GAS v4u*)(c.R + R_NT);
    const int lane = c.lane;
    if (c.nb < 2 * SCAN_WGS || c.bid < c.nb - SCAN_WGS) return;
    const int wg = c.bid - (c.nb - SCAN_WGS), bhl = c.wave >> 2, rbk = (c.wave >> 1) & 1, cbv = c.wave & 1, bh = wg * 2 + bhl; const size_t cb0 = (size_t)bh * (SEQ / 64);
    LAS v4u* xs = (LAS v4u*)c.lds;
    const int myslot = c.wave * 128 + lane, peer = (c.wave ^ 2) * 128 + lane;
    bf16x8 own[2], oth[2];
#pragma unroll
    for (int i = 0; i < 2; ++i) { own[i] = (bf16x8){0, 0, 0, 0, 0, 0, 0, 0}; oth[i] = own[i]; }
    constexpr int NBUF = 6;
    v4u mq[NBUF][4], nq[NBUF][2];
#define SCAN_LOAD(buf, cc) do { _Pragma("unroll") for (int i_ = 0; i_ < 4; ++i_) mq[buf][i_] = CHM[((cb0 + (cc)) * 8 + rbk * 4 + i_) * 64 + lane]; \
                                _Pragma("unroll") for (int i_ = 0; i_ < 2; ++i_) nq[buf][i_] = NB[(((cb0 + (cc)) * 2 + cbv) * 4 + 2 * rbk + i_) * 64 + lane]; } while (0)
    SCAN_LOAD(0, 0); SCAN_LOAD(1, 1); SCAN_LOAD(2, 2); SCAN_LOAD(3, 3); SCAN_LOAD(4, 4);
    __syncthreads();
    for (int cc0 = 0; cc0 < SEQ / 64; cc0 += NBUF) {
#pragma unroll
        for (int u = 0; u < NBUF; ++u) { const int cc = cc0 + u;
            if (cc < SEQ / 64) {
                if (cc + 5 < SEQ / 64) SCAN_LOAD((u + 5) % NBUF, cc + 5);
#pragma unroll
                for (int i = 0; i < 2; ++i) CHS[((cb0 + cc) * 8 + cbv * 4 + 2 * rbk + i) * 64 + lane] = __builtin_bit_cast(v4u, own[i]);
                f32x16 a;
#pragma unroll
                for (int hf = 0; hf < 2; ++hf) { const v4u w = nq[u][hf];
                    a[8 * hf + 0] = bflo(w.x); a[8 * hf + 1] = bfhi(w.x); a[8 * hf + 2] = bflo(w.y); a[8 * hf + 3] = bfhi(w.y);
                    a[8 * hf + 4] = bflo(w.z); a[8 * hf + 5] = bfhi(w.z); a[8 * hf + 6] = bflo(w.w); a[8 * hf + 7] = bfhi(w.w); }
#pragma unroll
                for (int ks = 0; ks < 4; ++ks) a = MFMA32(__builtin_bit_cast(bf16x8, mq[u][ks]), (ks >> 1) == rbk ? own[ks & 1] : oth[ks & 1], a);
                own[0] = pack8(a, 0); own[1] = pack8(a, 8);
                LAS v4u* slot = xs + (cc & 1) * 1024;
                slot[myslot] = __builtin_bit_cast(v4u, own[0]); slot[myslot + 64] = __builtin_bit_cast(v4u, own[1]);
                __syncthreads();
                oth[0] = __builtin_bit_cast(bf16x8, slot[peer]); oth[1] = __builtin_bit_cast(bf16x8, slot[peer + 64]);
            }
        }
    }
#undef SCAN_LOAD
    __syncthreads();
}

__device__ __forceinline__ void phase_rwkv_out(const Ctx& c, int l) {
    const GAS v4u* CHR = (const GAS v4u*)(c.R + R_CHR); const GAS v4u* CHS = (const GAS v4u*)(c.R + R_CHS); const GAS float* YL = (const GAS float*)(c.R + R_YL);
    const GAS bf16* VN = (const GAS bf16*)(c.R + R_VG); const GAS bf16* GN = VN + (size_t)M * AW; const GAS float* BON = (const GAS float*)(c.R + R_BON); GAS bf16* YC = (GAS bf16*)(c.ws + WS_XN);
    const GAS float* lng = c.in(I_LNG) + l * AW; const GAS float* lnb = c.in(I_LNB) + l * AW;
    const int lane = c.lane, l31 = lane & 31, hi = lane >> 5;
    const bool six = c.nb * 6 == NCHUNK;
    for (int cb = six ? (c.wave < 6 ? c.bid * 6 + c.wave : NCHUNK) : c.gw; cb < NCHUNK; cb += six ? NCHUNK : c.ngw) {
        const int bh = cb / (SEQ / 64), cc = cb % (SEQ / 64), b = bh / AH, h = bh % AH;
#pragma unroll
        for (int cbt = 0; cbt < 2; ++cbt) {
            f32x16 y[2];
#pragma unroll
            for (int rbv = 0; rbv < 2; ++rbv) {
#pragma unroll
                for (int g = 0; g < 4; ++g) { const f32x4 q4 = *(const GAS f32x4*)(YL + (size_t)cb * BLK + (32 * cbt + l31) * 64 + 32 * rbv + 8 * g + 4 * hi); y[rbv][4 * g] = q4.x * PROBE_YL; y[rbv][4 * g + 1] = q4.y * PROBE_YL; y[rbv][4 * g + 2] = q4.z * PROBE_YL; y[rbv][4 * g + 3] = q4.w * PROBE_YL; }
#pragma unroll
                for (int ks = 0; ks < PROBE_KS; ++ks) y[rbv] = MFMA32(__builtin_bit_cast(bf16x8, CHS[((size_t)cb * 8 + rbv * 4 + ks) * 64 + lane]), __builtin_bit_cast(bf16x8, CHR[((size_t)cb * 8 + cbt * 4 + ks) * 64 + lane]), y[rbv]);
            }
            float s = 0.f;
#pragma unroll
            for (int r = 0; r < 16; ++r) s += y[0][r] + y[1][r];
            s += __shfl_xor(s, 32);
            const float mean = s * (1.0f / 64.0f); float q = 0.f;
#pragma unroll
            for (int r = 0; r < 16; ++r) { y[0][r] -= mean; y[1][r] -= mean; q += y[0][r] * y[0][r] + y[1][r] * y[1][r]; }
            q += __shfl_xor(q, 32);
            const float rstd = __builtin_amdgcn_rsqf(q * (1.0f / 64.0f) + 64e-5f);
            const size_t m = (size_t)b * SEQ + cc * 64 + 32 * cbt + l31; const float bon = BON[m * AH + h];
#pragma unroll
            for (int rbv = 0; rbv < 2; ++rbv)
#pragma unroll
                for (int g = 0; g < 4; ++g) { const int ch = h * 64 + 32 * rbv + 8 * g + 4 * hi;
                    const f32x4 g4 = *(const GAS f32x4*)(lng + ch), b4 = *(const GAS f32x4*)(lnb + ch); const v2u vv = *(const GAS v2u*)(VN + m * AW + ch), gg = *(const GAS v2u*)(GN + m * AW + ch);
                    const float o0 = (y[rbv][4 * g] * rstd * g4.x + b4.x + bon * bflo(vv.x)) * bflo(gg.x), o1 = (y[rbv][4 * g + 1] * rstd * g4.y + b4.y + bon * bfhi(vv.x)) * bfhi(gg.x);
                    const float o2 = (y[rbv][4 * g + 2] * rstd * g4.z + b4.z + bon * bflo(vv.y)) * bflo(gg.y), o3 = (y[rbv][4 * g + 3] * rstd * g4.w + b4.w + bon * bfhi(vv.y)) * bfhi(gg.y);
#ifdef RWKV_SANITIZE
                    { GAS float* oo[4] = {nullptr, nullptr, nullptr, nullptr}; (void)oo; }
#define SAN(x) ((x) == (x) && fabsf(x) < 1e30f ? (x) : 0.f)
                    *(GAS v2u*)(YC + m * D + ch) = (v2u){pk2(SAN(o0), SAN(o1)), pk2(SAN(o2), SAN(o3))}; }
#else
                    *(GAS v2u*)(YC + m * D + ch) = (v2u){pk2(o0, o1), pk2(o2, o3)}; }
#endif
        }
    }
}
__device__ __forceinline__ void phase_mla_prep(const Ctx& c, int l) {
    const GAS bf16* Z = (const GAS bf16*)(c.R + R_Z);
    GAS bf16* Q = (GAS bf16*)(c.R + R_Q); GAS bf16* K = (GAS bf16*)(c.R + R_K); GAS bf16* V = (GAS bf16*)(c.R + R_V);
    const GAS float* qng = c.in(I_QNG) + l * 256; const GAS float* wuq = c.in(I_WUQ) + (size_t)l * 256 * QP; const GAS float* kvng = c.in(I_KVNG) + l * 128; const GAS float* wukv = c.in(I_WUKV) + (size_t)l * 128 * 768;
    const GAS float* qhg = c.in(I_QHG) + l * QKD; const GAS float* khg = c.in(I_KHG) + l * QKD; const GAS int* pos = (const GAS int*)c.in(I_POS);
    LAS float* cqn = (LAS float*)c.lds;
    LAS float* ckn = cqn + 16 * 256;
    LAS float* krs = ckn + 16 * 128;
    LAS float* qb = krs + 16 * 32;
    LAS float* kvb = qb + 16 * QP;
    const float qscale = 1.4426950408889634f / sqrtf((float)QKD);
    for (int grp = c.bid; grp < M / 16; grp += c.nb) {
        const int m0 = grp * 16;
        __syncthreads();
#pragma unroll
        for (int q = 0; q < 2; ++q) { const int tk = 2 * c.wave + q; const GAS bf16* zr = Z + (size_t)(m0 + tk) * ZP;
            float x[4]; float ss = 0.f;
#pragma unroll
            for (int i = 0; i < 4; ++i) { x[i] = bf2f(zr[ZCQ + c.lane + 64 * i]); ss += x[i] * x[i]; }
            float rstd = __builtin_amdgcn_rsqf(wave_sum(ss) * (1.0f / 256.0f) + EPS);
#pragma unroll
            for (int i = 0; i < 4; ++i) cqn[tk * 256 + c.lane + 64 * i] = x[i] * rstd * qng[c.lane + 64 * i];
            float y[2]; ss = 0.f;
#pragma unroll
            for (int i = 0; i < 2; ++i) { y[i] = bf2f(zr[ZCKV + c.lane + 64 * i]); ss += y[i] * y[i]; }
            rstd = __builtin_amdgcn_rsqf(wave_sum(ss) * (1.0f / 128.0f) + EPS);
#pragma unroll
            for (int i = 0; i < 2; ++i) ckn[tk * 128 + c.lane + 64 * i] = y[i] * rstd * kvng[c.lane + 64 * i];
            if (c.lane < 32) krs[tk * 32 + c.lane] = bf2f(zr[ZKR + c.lane]);
        }
        __syncthreads();
        for (int col = c.tid; col < QP; col += NTHR) {
            float acc[16];
#pragma unroll
            for (int q = 0; q < 16; ++q) acc[q] = 0.f;
            for (int kx = 0; kx < 256; ++kx) { const float w = wuq[(size_t)kx * QP + col];
#pragma unroll
                for (int q = 0; q < 16; ++q) acc[q] += cqn[q * 256 + kx] * w; }
#pragma unroll
            for (int q = 0; q < 16; ++q) qb[q * QP + col] = acc[q];
        }
        for (int col = c.tid; col < 768; col += NTHR) {
            float acc[16];
#pragma unroll
            for (int q = 0; q < 16; ++q) acc[q] = 0.f;
            for (int kx = 0; kx < 128; ++kx) { const float w = wukv[(size_t)kx * 768 + col];
#pragma unroll
                for (int q = 0; q < 16; ++q) acc[q] += ckn[q * 128 + kx] * w; }
#pragma unroll
            for (int q = 0; q < 16; ++q) kvb[q * 768 + col] = acc[q];
        }
        __syncthreads();
        for (int pr = c.wave; pr < 16 * AH; pr += NWAVES) {
            const int tk = pr / AH, h = pr % AH, m = m0 + tk; const int ln = c.lane, l32 = ln & 31, fi = ln & 15;
            const float ang = (float)pos[m] * exp2f(-(float)(2 * fi) * (13.287712379549449f / 32.0f));
            const float cs = cosf(ang), sn = sinf(ang);
            { const float x0 = qb[tk * QP + h * QKD + ln], x1 = ln < 32 ? qb[tk * QP + h * QKD + 64 + l32] : 0.f;
              const float rstd = __builtin_amdgcn_rsqf(wave_sum(x0 * x0 + x1 * x1) * (1.0f / QKD) + EPS);
              const float n0 = x0 * rstd * qhg[ln], n1 = x1 * rstd * qhg[64 + l32];
              const float pn = __shfl_xor(n1, 16);
              const float ro = (ln & 16) ? (pn * sn + n1 * cs) : (n1 * cs - pn * sn);
              Q[(size_t)m * QP + h * QKD + ln] = (bf16)f2bf(n0 * qscale);
              if (ln < 32) Q[(size_t)m * QP + h * QKD + 64 + ln] = (bf16)f2bf(ro * qscale); }
            { const float x0 = kvb[tk * 768 + h * 128 + ln], x1 = ln < 32 ? krs[tk * 32 + l32] : 0.f;
              const float rstd = __builtin_amdgcn_rsqf(wave_sum(x0 * x0 + x1 * x1) * (1.0f / QKD) + EPS);
              const float n0 = x0 * rstd * khg[ln], n1 = x1 * rstd * khg[64 + l32];
              const float pn = __shfl_xor(n1, 16);
              const float ro = (ln & 16) ? (pn * sn + n1 * cs) : (n1 * cs - pn * sn);
              K[(size_t)m * QP + h * QKD + ln] = (bf16)f2bf(n0);
              if (ln < 32) K[(size_t)m * QP + h * QKD + 64 + ln] = (bf16)f2bf(ro); }
            { const int sq = m % SEQ, bb = m / SEQ; V[((size_t)((bb * AH + h) * 64 + ln)) * SEQ + (sq & ~15) + vt_pos(sq & 15)] = (bf16)f2bf(kvb[tk * 768 + h * 128 + 64 + ln]); }
        }
    }
    __syncthreads();
}


__device__ __forceinline__ void phase_mla_post1(const Ctx& c, int l) {
    const GAS bf16* Z = (const GAS bf16*)(c.R + R_Z); const GAS bf16* QR = (const GAS bf16*)(c.R + R_QR); const GAS bf16* KVR = (const GAS bf16*)(c.R + R_KVR);
    GAS bf16* Q = (GAS bf16*)(c.R + R_Q); GAS bf16* K = (GAS bf16*)(c.R + R_K); GAS bf16* Vt = (GAS bf16*)(c.R + R_V);
    const GAS float* qhg = c.in(I_QHG) + l * QKD; const GAS float* khg = c.in(I_KHG) + l * QKD; const GAS int* pos = (const GAS int*)c.in(I_POS);
    LAS unsigned short* vt = (LAS unsigned short*)c.lds;
    const float qscale = 1.4426950408889634f / sqrtf((float)QKD);
    const int ln = c.lane, l32 = ln & 31, fi = ln & 15;
    const float g0q = qhg[ln], g1q = qhg[64 + l32], g0k = khg[ln], g1k = khg[64 + l32];
    const float ifr = exp2f(-(float)(2 * fi) * (13.287712379549449f / 32.0f));
    for (int item = c.bid; item < M / 64; item += c.nb) {
        __syncthreads();
        float zq[4], zk2[2], xq0[AH], xq1[AH], xk0[AH], xv0[AH], krv; int pq;
#define P1_LOAD(tok) do { const GAS bf16* zr_ = Z + (size_t)(tok) * ZP; \
            _Pragma("unroll") for (int i = 0; i < 4; ++i) nzq[i] = bf2f(zr_[ZCQ + ln + 64 * i]); \
            _Pragma("unroll") for (int i = 0; i < 2; ++i) nzk[i] = bf2f(zr_[ZCKV + ln + 64 * i]); \
            nkr = ln < 32 ? bf2f(zr_[ZKR + l32]) : 0.f; npq = pos[tok]; \
            _Pragma("unroll") for (int h = 0; h < AH; ++h) { nq0[h] = bf2f(QR[(size_t)(tok) * 768 + h * 128 + ln]); nq1[h] = ln < 32 ? bf2f(QR[(size_t)(tok) * 768 + h * 128 + 64 + l32]) : 0.f; \
                nk0[h] = bf2f(KVR[(size_t)(tok) * 768 + h * 128 + ln]); nv0[h] = bf2f(KVR[(size_t)(tok) * 768 + h * 128 + 64 + ln]); } } while (0)
        float nzq[4], nzk[2], nq0[AH], nq1[AH], nk0[AH], nv0[AH], nkr; int npq;
        P1_LOAD(item * 64 + c.wave * 8);
        for (int q = 0; q < 8; ++q) {
            const int tl = c.wave * 8 + q, m = item * 64 + tl;
#pragma unroll
            for (int i = 0; i < 4; ++i) zq[i] = nzq[i];
            zk2[0] = nzk[0]; zk2[1] = nzk[1]; krv = nkr; pq = npq;
#pragma unroll
            for (int h = 0; h < AH; ++h) { xq0[h] = nq0[h]; xq1[h] = nq1[h]; xk0[h] = nk0[h]; xv0[h] = nv0[h]; }
            if (q + 1 < 8) P1_LOAD(m + 1);
            const float ang = (float)pq * ifr;
            const float rq = __builtin_amdgcn_rsqf(wave_sum((zq[0] * zq[0] + zq[1] * zq[1]) + (zq[2] * zq[2] + zq[3] * zq[3])) * (1.0f / 256.0f) + EPS);
            const float rkv = __builtin_amdgcn_rsqf(wave_sum(zk2[0] * zk2[0] + zk2[1] * zk2[1]) * (1.0f / 128.0f) + EPS);
            float rev = ang * 0.15915494309189535f; rev -= floorf(rev);
            const float cs = __builtin_amdgcn_cosf(rev), sn = __builtin_amdgcn_sinf(rev);
            const int tp = (tl & ~15) + vt_pos(tl & 15);
#pragma unroll
            for (int h = 0; h < AH; ++h) {
                { const float x0 = xq0[h] * rq, x1 = xq1[h] * rq;
                  const float rstd = __builtin_amdgcn_rsqf(wave_sum(x0 * x0 + x1 * x1) * (1.0f / QKD) + EPS);
                  const float n0 = x0 * rstd * g0q, n1 = x1 * rstd * g1q; const float pn = __shfl_xor(n1, 16);
                  const float ro = (ln & 16) ? (pn * sn + n1 * cs) : (n1 * cs - pn * sn);
                  Q[(size_t)m * QP + h * QKD + ln] = (bf16)f2bf(n0 * qscale); if (ln < 32) Q[(size_t)m * QP + h * QKD + 64 + ln] = (bf16)f2bf(ro * qscale); }
                { const float x0 = xk0[h] * rkv, x1 = krv;
                  const float rstd = __builtin_amdgcn_rsqf(wave_sum(x0 * x0 + x1 * x1) * (1.0f / QKD) + EPS);
                  const float n0 = x0 * rstd * g0k, n1 = x1 * rstd * g1k; const float pn = __shfl_xor(n1, 16);
                  const float ro = (ln & 16) ? (pn * sn + n1 * cs) : (n1 * cs - pn * sn);
                  K[(size_t)m * QP + h * QKD + ln] = (bf16)f2bf(n0); if (ln < 32) K[(size_t)m * QP + h * QKD + 64 + ln] = (bf16)f2bf(ro); }
                vt[(h * 64 + ln) * 72 + tp] = (unsigned short)f2bf(xv0[h] * rkv);
            }
        }
#undef P1_LOAD
        __syncthreads();
        const int b = (item * 64) / SEQ, s0 = (item * 64) % SEQ;
        for (int p = c.tid; p < AW * 8; p += NTHR) { const int row = p >> 3, pc = p & 7; const int h = row >> 6, d = row & 63;
            *(GAS v4u*)(Vt + ((size_t)((b * AH + h) * 64 + d)) * SEQ + s0 + 8 * pc) = *(const LAS v4u*)(vt + row * 72 + 8 * pc); }
    }
    __syncthreads();
}
__device__ __forceinline__ float oct_sum(float v) { v += dpp_mov<0xB1>(v); v += dpp_mov<0x4E>(v); v += dpp_mov<0x141>(v); return v; }
__device__ __forceinline__ float sq8(const v4u w) { const float a = bflo(w.x), b = bfhi(w.x), c_ = bflo(w.y), d = bfhi(w.y), e = bflo(w.z), f = bfhi(w.z), g = bflo(w.w), h = bfhi(w.w);
    return ((a * a + b * b) + (c_ * c_ + d * d)) + ((e * e + f * f) + (g * g + h * h)); }
__device__ __forceinline__ v4u p1_head(const v4u w, float sc, const float (&g)[8], const f32x4 c0, const f32x4 c1, const f32x4 s0, const f32x4 s1, bool act, bool rope, float sgn, float oscale) {
    float x[8]; x[0] = bflo(w.x) * sc; x[1] = bfhi(w.x) * sc; x[2] = bflo(w.y) * sc; x[3] = bfhi(w.y) * sc; x[4] = bflo(w.z) * sc; x[5] = bfhi(w.z) * sc; x[6] = bflo(w.w) * sc; x[7] = bfhi(w.w) * sc;
    float ss = ((x[0] * x[0] + x[1] * x[1]) + (x[2] * x[2] + x[3] * x[3])) + ((x[4] * x[4] + x[5] * x[5]) + (x[6] * x[6] + x[7] * x[7]));
    ss = row16_sum(act ? ss : 0.f);
    const float rstd = __builtin_amdgcn_rsqf(ss * (1.0f / QKD) + EPS);
    float o[8];
#pragma unroll
    for (int j = 0; j < 8; ++j) { const float n = x[j] * rstd * g[j]; const float pn = dpp_mov<0x4E>(n); const float cs = j < 4 ? c0[j & 3] : c1[j & 3], sn = j < 4 ? s0[j & 3] : s1[j & 3];
        const float ro = n * cs + sgn * (pn * sn); o[j] = (rope ? ro : n) * oscale; }
    return (v4u){pk2(o[0], o[1]), pk2(o[2], o[3]), pk2(o[4], o[5]), pk2(o[6], o[7])};
}
__device__ __forceinline__ void phase_mla_post1b(const Ctx& c, int l) {
    const GAS bf16* Z = (const GAS bf16*)(c.R + R_Z); const GAS bf16* QR = (const GAS bf16*)(c.R + R_QR); const GAS bf16* KVR = (const GAS bf16*)(c.R + R_KVR);
    GAS bf16* Q = (GAS bf16*)(c.R + R_Q); GAS bf16* K = (GAS bf16*)(c.R + R_K); GAS bf16* Vt = (GAS bf16*)(c.R + R_V);
    const GAS float* qhg = c.in(I_QHG) + l * QKD; const GAS float* khg = c.in(I_KHG) + l * QKD; const GAS int* pos = (const GAS int*)c.in(I_POS);
    constexpr int VTP = 68, TKP = 40;
    LAS unsigned short* vt = (LAS unsigned short*)c.lds;
    LAS float* tk = (LAS float*)(c.lds + 384 * VTP * 2);
    const float qscale = 1.4426950408889634f / sqrtf((float)QKD);
    const int ln = c.lane, i16 = ln & 15, g16 = ln >> 4, ic = i16 < 12 ? i16 : 11, s8 = ln & 7, t8 = ln >> 3;
    float gq[8], gk[8];
#pragma unroll
    for (int j = 0; j < 8; ++j) { gq[j] = qhg[8 * ic + j]; gk[j] = khg[8 * ic + j]; }
    const float ifa = exp2f(-(float)(2 * s8) * (13.287712379549449f / 32.0f)), ifb = exp2f(-(float)(2 * (s8 + 8)) * (13.287712379549449f / 32.0f));
    const bool act = i16 < 12, rope = i16 >= 8, nope = i16 < 8; const float sgn = (i16 & 2) ? 1.f : -1.f;
    for (int item = c.bid; item < M / 64; item += c.nb) {
        __syncthreads();
        {
            const int tok = item * 64 + c.wave * 8 + t8; const GAS bf16* zr = Z + (size_t)tok * ZP;
            v4u a[4], b2[2];
#pragma unroll
            for (int i = 0; i < 4; ++i) a[i] = *(const GAS v4u*)(zr + ZCQ + 32 * s8 + 8 * i);
#pragma unroll
            for (int i = 0; i < 2; ++i) b2[i] = *(const GAS v4u*)(zr + ZCKV + 16 * s8 + 8 * i);
            const int pq = pos[tok];
            const float ssq = oct_sum((sq8(a[0]) + sq8(a[1])) + (sq8(a[2]) + sq8(a[3]))), ssk = oct_sum(sq8(b2[0]) + sq8(b2[1]));
            const float rq = __builtin_amdgcn_rsqf(ssq * (1.0f / 256.0f) + EPS), rkv = __builtin_amdgcn_rsqf(ssk * (1.0f / 128.0f) + EPS);
            float ra = ((float)pq * ifa) * 0.15915494309189535f; ra -= floorf(ra); float rb = ((float)pq * ifb) * 0.15915494309189535f; rb -= floorf(rb);
            LAS float* tp_ = tk + (c.wave * 8 + t8) * TKP;
            tp_[4 + s8] = __builtin_amdgcn_cosf(ra); tp_[12 + s8] = __builtin_amdgcn_cosf(rb); tp_[20 + s8] = __builtin_amdgcn_sinf(ra); tp_[28 + s8] = __builtin_amdgcn_sinf(rb);
            if (s8 == 0) { tp_[0] = rq; tp_[1] = rkv; }
        }
        LDS_WAIT();
#pragma unroll 2
        for (int q = 0; q < 8; ++q) { const int tl = c.wave * 8 + q, m = item * 64 + tl; const float rkv = tk[tl * TKP + 1]; const int tp = (tl & ~15) + vt_pos(tl & 15);
            float xv[AH];
#pragma unroll
            for (int h = 0; h < AH; ++h) xv[h] = bf2f(KVR[(size_t)m * 768 + h * 128 + 64 + ln]);
#pragma unroll
            for (int h = 0; h < AH; ++h) vt[(h * 64 + ln) * VTP + tp] = (unsigned short)f2bf(xv[h] * rkv); }
        for (int pb = 0; pb < 12; pb += 4) {
            v4u wq[4], wk[4], wr[4];
#pragma unroll
            for (int u = 0; u < 4; ++u) { const int idx = (pb + u) * 4 + g16, t = idx & 7, h = idx >> 3; const size_t m = (size_t)(item * 64 + c.wave * 8 + t);
                wq[u] = *(const GAS v4u*)(QR + m * 768 + h * 128 + 8 * ic); wk[u] = *(const GAS v4u*)(KVR + m * 768 + h * 128 + 8 * (i16 & 7)); wr[u] = *(const GAS v4u*)(Z + m * ZP + ZKR + 8 * (ic & 3)); }
#pragma unroll
            for (int u = 0; u < 4; ++u) { const int idx = (pb + u) * 4 + g16, t = idx & 7, h = idx >> 3; const size_t m = (size_t)(item * 64 + c.wave * 8 + t);
                const LAS float* tp_ = tk + (c.wave * 8 + t) * TKP; const float rq = tp_[0], rkv = tp_[1];
                const LAS f32x4* cp = (const LAS f32x4*)(tp_ + 4 + 8 * (i16 & 1)); const LAS f32x4* sp = (const LAS f32x4*)(tp_ + 20 + 8 * (i16 & 1));
                const f32x4 c0 = cp[0], c1 = cp[1], s0 = sp[0], s1 = sp[1];
                const v4u oq = p1_head(wq[u], rq, gq, c0, c1, s0, s1, act, rope, sgn, qscale);
                v4u kw; kw.x = nope ? wk[u].x : wr[u].x; kw.y = nope ? wk[u].y : wr[u].y; kw.z = nope ? wk[u].z : wr[u].z; kw.w = nope ? wk[u].w : wr[u].w;
                const v4u ok = p1_head(kw, nope ? rkv : 1.0f, gk, c0, c1, s0, s1, act, rope, sgn, 1.0f);
                if (act) { *(GAS v4u*)(Q + m * QP + h * QKD + 8 * i16) = oq; *(GAS v4u*)(K + m * QP + h * QKD + 8 * i16) = ok; } }
        }
        __syncthreads();
        const int b = (item * 64) / SEQ, s0_ = (item * 64) % SEQ;
        for (int p = c.tid; p < AW * 8; p += NTHR) { const int row = p >> 3, pc = p & 7; const int h = row >> 6, d = row & 63;
            const LAS v2u* src = (const LAS v2u*)(vt + row * VTP + 8 * pc); const v2u lo = src[0], hi2 = src[1];
            *(GAS v4u*)(Vt + ((size_t)((b * AH + h) * 64 + d)) * SEQ + s0_ + 8 * pc) = (v4u){lo.x, lo.y, hi2.x, hi2.y}; }
    }
    __syncthreads();
}
__device__ __forceinline__ void phase_attn_naive(const Ctx& c) {
    const GAS bf16* Q = (const GAS bf16*)(c.R + R_Q); const GAS bf16* K = (const GAS bf16*)(c.R + R_K); const GAS bf16* V = (const GAS bf16*)(c.R + R_V); GAS float* O = (GAS float*)(c.R + R_OATT);
    LAS float* ks = (LAS float*)c.lds;
    LAS float* vs = ks + 64 * QKD;
    const int row = c.tid >> 1, hf = c.tid & 1;
    for (int item = c.bid; item < BATCH * AH * 32 * 2; item += c.nb) {
        const int qg = 31 - item / (BATCH * AH * 2), rem = item % (BATCH * AH * 2), vh = rem & 1, bh = rem >> 1, b = bh / AH, h = bh % AH;
        const size_t qrow = (size_t)b * SEQ + qg * 256 + row;
        float q[48];
#pragma unroll
        for (int i = 0; i < 24; ++i) { const unsigned w = *(const GAS unsigned*)(Q + qrow * QP + h * QKD + hf * 48 + 2 * i); q[2 * i] = bflo(w); q[2 * i + 1] = bfhi(w); }
        float acc[16];
#pragma unroll
        for (int i = 0; i < 16; ++i) acc[i] = 0.f;
        float mrun = -INFINITY, lrun = 0.f;
        const int myc = qg * 4 + (c.wave >> 1), ntile = qg * 4 + 4;
        for (int j = 0; j < ntile; ++j) {
            __syncthreads();
            const size_t kr0 = (size_t)b * SEQ + j * 64;
            for (int e = c.tid; e < 64 * QKD / 2; e += NTHR) { const int kr = e / (QKD / 2), dd = e % (QKD / 2); const unsigned w = *(const GAS unsigned*)(K + (kr0 + kr) * QP + h * QKD + 2 * dd); ks[kr * QKD + 2 * dd] = bflo(w); ks[kr * QKD + 2 * dd + 1] = bfhi(w); }
            for (int e = c.tid; e < 64 * 32; e += NTHR) { const int kr = e & 63, dd = e >> 6; vs[kr * 32 + dd] = bf2f(V[((size_t)(bh * 64 + vh * 32 + dd)) * SEQ + j * 64 + (kr & ~15) + vt_pos(kr & 15)]); }
            __syncthreads();
            if (j <= myc) {
#pragma unroll 1
                for (int k4 = 0; k4 < 64; k4 += 4) {
                    float s[4];
#pragma unroll
                    for (int u = 0; u < 4; ++u) { const LAS f32x4* kp = (const LAS f32x4*)(ks + (k4 + u) * QKD + hf * 48); float d0 = 0.f, d1 = 0.f;
#pragma unroll
                        for (int i = 0; i < 12; ++i) { const f32x4 kv = kp[i]; d0 += q[4 * i] * kv.x + q[4 * i + 2] * kv.z; d1 += q[4 * i + 1] * kv.y + q[4 * i + 3] * kv.w; }
                        s[u] = d0 + d1; }
#pragma unroll
                    for (int u = 0; u < 4; ++u) s[u] += __shfl_xor(s[u], 1);
                    const float mx = fmaxf(fmaxf(s[0], s[1]), fmaxf(s[2], s[3])), mnew = fmaxf(mrun, mx), corr = exp2f(mrun - mnew);
                    mrun = mnew; lrun *= corr;
#pragma unroll
                    for (int i = 0; i < 16; ++i) acc[i] *= corr;
#pragma unroll
                    for (int u = 0; u < 4; ++u) { const float p = exp2f(s[u] - mnew); lrun += p; const LAS f32x4* vp = (const LAS f32x4*)(vs + (k4 + u) * 32 + hf * 16);
#pragma unroll
                        for (int i = 0; i < 4; ++i) { const f32x4 vv = vp[i]; acc[4 * i] += p * vv.x; acc[4 * i + 1] += p * vv.y; acc[4 * i + 2] += p * vv.z; acc[4 * i + 3] += p * vv.w; } }
                }
            }
        }
        const float inv = 1.0f / lrun;
        GAS float* op = O + qrow * AW + h * 64 + vh * 32 + hf * 16;
#pragma unroll
        for (int i = 0; i < 4; ++i) *(GAS f32x4*)(op + 4 * i) = (f32x4){acc[4 * i] * inv, acc[4 * i + 1] * inv, acc[4 * i + 2] * inv, acc[4 * i + 3] * inv};
    }
    __syncthreads();
}
__device__ __forceinline__ void phase_attn_mfma(const Ctx& c) {
    const GAS bf16* Q = (const GAS bf16*)(c.R + R_Q); const GAS bf16* K = (const GAS bf16*)(c.R + R_K); const GAS bf16* Vt = (const GAS bf16*)(c.R + R_V); GAS float* O = (GAS float*)(c.R + R_OATT);
    constexpr int KP = 104, VP = 72, KBUF = 64 * KP * 2, VBUF = 64 * VP * 2, BUF = KBUF + VBUF;
    const int l31 = c.lane & 31, hi = c.lane >> 5, w = c.wave;
    const int nitem = BATCH * AH * 32;
    for (int rnd = 0;; ++rnd) {
        int item;
        const int na = c.nb >= 2 * SCAN_WGS ? c.nb - SCAN_WGS : c.nb;
        if (c.bid >= na) break;
        if (2 * na >= nitem) { if (rnd >= 2) break; item = rnd == 0 ? c.bid : 2 * na - 1 - c.bid; if (item >= nitem) continue; }
        else { item = c.bid + rnd * na; if (item >= nitem) break; }
        const int qb = 31 - item / (BATCH * AH), bh = item % (BATCH * AH), b = bh / AH, h = bh % AH;
        const size_t q0 = (size_t)b * SEQ + qb * 256 + 32 * w;
        bf16x8 qf[6];
#pragma unroll
        for (int ds = 0; ds < 6; ++ds) qf[ds] = *(const GAS bf16x8*)(Q + (q0 + l31) * QP + h * QKD + 16 * ds + 8 * hi);
        f32x16 o0, o1;
#pragma unroll
        for (int r = 0; r < 16; ++r) { o0[r] = 0.f; o1[r] = 0.f; }
        float mrun = -INFINITY, lrun = 0.f;
        const int NT = 4 * qb + 4, myc = 4 * qb + (w >> 1);
        const int kr0 = c.tid / 12, kc0 = c.tid % 12, kr1 = (c.tid + 512) / 12, kc1 = (c.tid + 512) % 12, vr = c.tid >> 3, vc = c.tid & 7;
        const GAS bf16* kg0 = K + ((size_t)b * SEQ + kr0) * QP + h * QKD + 8 * kc0; const GAS bf16* kg1 = K + ((size_t)b * SEQ + kr1) * QP + h * QKD + 8 * kc1;
        const GAS bf16* vg = Vt + ((size_t)(bh * 64 + vr)) * SEQ + 8 * vc;
        const int kl0 = (kr0 * KP + 8 * kc0) * 2, kl1 = (kr1 * KP + 8 * kc1) * 2, vl = KBUF + (vr * VP + 8 * vc) * 2;
        const bool two = c.tid < 256;
        v4u kx0 = *(const GAS v4u*)kg0, kx1 = two ? *(const GAS v4u*)kg1 : (v4u){0u, 0u, 0u, 0u}, vx = *(const GAS v4u*)vg;
        __syncthreads();
        *(LAS v4u*)(c.lds + kl0) = kx0; if (two) *(LAS v4u*)(c.lds + kl1) = kx1; *(LAS v4u*)(c.lds + vl) = vx;
        __syncthreads();
        for (int j = 0; j < NT; ++j) {
            const bool more = j + 1 < NT;
            if (more) { kx0 = *(const GAS v4u*)(kg0 + (size_t)(j + 1) * 64 * QP); if (two) kx1 = *(const GAS v4u*)(kg1 + (size_t)(j + 1) * 64 * QP); vx = *(const GAS v4u*)(vg + (j + 1) * 64); }
            if (j <= myc) {
                const LAS unsigned char* kb = c.lds + (j & 1) * BUF; const LAS unsigned char* vb = kb + KBUF;
                f32x16 p0, p1;
#pragma unroll
                for (int r = 0; r < 16; ++r) { p0[r] = 0.f; p1[r] = 0.f; }
#pragma unroll
                for (int ds = 0; ds < 6; ++ds) {
                    const bf16x8 kf0 = *(const LAS bf16x8*)(kb + (l31 * KP + 16 * ds + 8 * hi) * 2), kf1 = *(const LAS bf16x8*)(kb + ((l31 + 32) * KP + 16 * ds + 8 * hi) * 2);
                    p0 = __builtin_amdgcn_mfma_f32_32x32x16_bf16(kf0, qf[ds], p0, 0, 0, 0); p1 = __builtin_amdgcn_mfma_f32_32x32x16_bf16(kf1, qf[ds], p1, 0, 0, 0);
                }
                float mx = fmaxf(p0[0], p1[0]);
#pragma unroll
                for (int r = 1; r < 16; ++r) mx = fmaxf(mx, fmaxf(p0[r], p1[r]));
                mx = fmaxf(mx, __shfl_xor(mx, 32));
                const float mnew = fmaxf(mrun, mx), corr = __builtin_amdgcn_exp2f(mrun - mnew); mrun = mnew;
                float ls = 0.f;
#pragma unroll
                for (int r = 0; r < 16; ++r) { p0[r] = __builtin_amdgcn_exp2f(p0[r] - mnew); p1[r] = __builtin_amdgcn_exp2f(p1[r] - mnew); ls += p0[r] + p1[r]; }
                lrun = lrun * corr + ls;
#pragma unroll
                for (int r = 0; r < 16; ++r) { o0[r] *= corr; o1[r] *= corr; }
                bf16x8 pb[4];
                { v4u t;
                  t.x = cvtpk(p0[0], p0[1]); t.y = cvtpk(p0[2], p0[3]); t.z = cvtpk(p0[4], p0[5]); t.w = cvtpk(p0[6], p0[7]); pb[0] = __builtin_bit_cast(bf16x8, t);
                  t.x = cvtpk(p0[8], p0[9]); t.y = cvtpk(p0[10], p0[11]); t.z = cvtpk(p0[12], p0[13]); t.w = cvtpk(p0[14], p0[15]); pb[1] = __builtin_bit_cast(bf16x8, t);
                  t.x = cvtpk(p1[0], p1[1]); t.y = cvtpk(p1[2], p1[3]); t.z = cvtpk(p1[4], p1[5]); t.w = cvtpk(p1[6], p1[7]); pb[2] = __builtin_bit_cast(bf16x8, t);
                  t.x = cvtpk(p1[8], p1[9]); t.y = cvtpk(p1[10], p1[11]); t.z = cvtpk(p1[12], p1[13]); t.w = cvtpk(p1[14], p1[15]); pb[3] = __builtin_bit_cast(bf16x8, t); }
#pragma unroll
                for (int sx = 0; sx < 4; ++sx) {
                    const bf16x8 vf0 = *(const LAS bf16x8*)(vb + (l31 * VP + 16 * sx + 8 * hi) * 2), vf1 = *(const LAS bf16x8*)(vb + ((l31 + 32) * VP + 16 * sx + 8 * hi) * 2);
                    o0 = __builtin_amdgcn_mfma_f32_32x32x16_bf16(vf0, pb[sx], o0, 0, 0, 0); o1 = __builtin_amdgcn_mfma_f32_32x32x16_bf16(vf1, pb[sx], o1, 0, 0, 0);
                }
            }
            if (more) { LAS unsigned char* nb_ = c.lds + ((j + 1) & 1) * BUF; *(LAS v4u*)(nb_ + kl0) = kx0; if (two) *(LAS v4u*)(nb_ + kl1) = kx1; *(LAS v4u*)(nb_ + vl) = vx; }
            __syncthreads();
        }
        const float lt = lrun + __shfl_xor(lrun, 32), inv = 1.0f / lt;
        GAS float* op = O + (q0 + l31) * AW + h * 64 + 4 * hi;
#pragma unroll
        for (int g = 0; g < 4; ++g) {
            *(GAS f32x4*)(op + 8 * g) = (f32x4){o0[4 * g] * inv, o0[4 * g + 1] * inv, o0[4 * g + 2] * inv, o0[4 * g + 3] * inv};
            *(GAS f32x4*)(op + 32 + 8 * g) = (f32x4){o1[4 * g] * inv, o1[4 * g + 1] * inv, o1[4 * g + 2] * inv, o1[4 * g + 3] * inv};
        }
    }
    __syncthreads();
}
__device__ __forceinline__ void phase_attn_mfma2(const Ctx& c, int l) {
    const GAS bf16* Q = (const GAS bf16*)(c.R + R_Q); const GAS bf16* K = (const GAS bf16*)(c.R + R_K); const GAS bf16* Vt = (const GAS bf16*)(c.R + R_V); GAS float* O = (GAS float*)(c.R + R_OATT);
    constexpr int KP = 104, VP = 72, KBUF = 128 * KP * 2, VBUF = 64 * VP * 2, BUF = KBUF + 2 * VBUF;
    const int l31 = c.lane & 31, hi = c.lane >> 5, w = c.wave;
    const int nitem = BATCH * AH * 32;
    for (int rnd = 0;; ++rnd) {
        int item;
        const int na = c.nb >= 2 * SCAN_WGS ? c.nb - SCAN_WGS : c.nb;
        if (c.bid >= na) break;
        if (2 * na >= nitem) { if (rnd >= 2) break; item = rnd == 0 ? c.bid : 2 * na - 1 - c.bid; if (item >= nitem) continue; }
        else { item = c.bid + rnd * na; if (item >= nitem) break; }
        const int qb = 31 - item / (BATCH * AH), bh = item % (BATCH * AH), b = bh / AH, h = bh % AH;
        const size_t q0 = (size_t)b * SEQ + qb * 256 + 32 * w;
        bf16x8 qf[6];
#pragma unroll
        for (int ds = 0; ds < 6; ++ds) qf[ds] = *(const GAS bf16x8*)(Q + (q0 + l31) * QP + h * QKD + 16 * ds + 8 * hi);
        f32x16 o0 = zero16(), o1 = zero16();
        float mrun = -INFINITY, lrun = 0.f;
        const int NS = 2 * qb + 2, myc = 4 * qb + (w >> 1);
        int kl[3]; const GAS bf16* kg[3];
#pragma unroll
        for (int i = 0; i < 3; ++i) { const int p = c.tid + 512 * i, kr = p / 12, kc = p % 12; kl[i] = (kr * KP + 8 * kc) * 2; kg[i] = K + ((size_t)b * SEQ + kr) * QP + h * QKD + 8 * kc; }
        int vl[2]; const GAS bf16* vg[2];
#pragma unroll
        for (int i = 0; i < 2; ++i) { const int p = c.tid + 512 * i, half = p >> 9, vr = (p >> 3) & 63, vc = p & 7; vl[i] = KBUF + half * VBUF + (vr * VP + 8 * vc) * 2; vg[i] = Vt + ((size_t)(bh * 64 + vr)) * SEQ + 64 * half + 8 * vc; }
        v4u kx[3], vx[2];
#pragma unroll
        for (int i = 0; i < 3; ++i) kx[i] = *(const GAS v4u*)kg[i];
#pragma unroll
        for (int i = 0; i < 2; ++i) vx[i] = *(const GAS v4u*)vg[i];
        __syncthreads();
#pragma unroll
        for (int i = 0; i < 3; ++i) *(LAS v4u*)(c.lds + kl[i]) = kx[i];
#pragma unroll
        for (int i = 0; i < 2; ++i) *(LAS v4u*)(c.lds + vl[i]) = vx[i];
        __syncthreads();
        for (int j = 0; j < NS; ++j) {
            const bool more = j + 1 < NS;
            if (more) {
#pragma unroll
                for (int i = 0; i < 3; ++i) kx[i] = *(const GAS v4u*)(kg[i] + (size_t)(j + 1) * 128 * QP);
#pragma unroll
                for (int i = 0; i < 2; ++i) vx[i] = *(const GAS v4u*)(vg[i] + (j + 1) * 128); }
            const int nvis = myc - 2 * j + 1;
            if (nvis > 0) {
                const LAS unsigned char* kb = c.lds + (j & 1) * BUF; const LAS unsigned char* vb = kb + KBUF;
                const bool first = mrun == -INFINITY;
                const float cin = first ? 0.f : -mrun;
                f32x16 p0, p1, p2, p3;
#pragma unroll
                for (int r = 0; r < 16; ++r) { p0[r] = cin; p1[r] = cin; p2[r] = cin; p3[r] = cin; }
#define KFR(blk, ds) (*(const LAS bf16x8*)(kb + ((l31 + 32 * (blk)) * KP + 16 * (ds) + 8 * hi) * 2))
                bf16x8 ka[8], kc[8];
#pragma unroll
                for (int ds = 0; ds < 2; ++ds) { ka[4 * ds] = KFR(0, ds); ka[4 * ds + 1] = KFR(1, ds); ka[4 * ds + 2] = KFR(2, ds); ka[4 * ds + 3] = KFR(3, ds); }
#pragma unroll
                for (int ds = 0; ds < 2; ++ds) { kc[4 * ds] = KFR(0, ds + 2); kc[4 * ds + 1] = KFR(1, ds + 2); kc[4 * ds + 2] = KFR(2, ds + 2); kc[4 * ds + 3] = KFR(3, ds + 2); }
#pragma unroll
                for (int ds = 0; ds < 2; ++ds) { p0 = MFMA32(ka[4 * ds], qf[ds], p0); p1 = MFMA32(ka[4 * ds + 1], qf[ds], p1); p2 = MFMA32(ka[4 * ds + 2], qf[ds], p2); p3 = MFMA32(ka[4 * ds + 3], qf[ds], p3); }
#pragma unroll
                for (int ds = 0; ds < 2; ++ds) { ka[4 * ds] = KFR(0, ds + 4); ka[4 * ds + 1] = KFR(1, ds + 4); ka[4 * ds + 2] = KFR(2, ds + 4); ka[4 * ds + 3] = KFR(3, ds + 4); }
#pragma unroll
                for (int ds = 0; ds < 2; ++ds) { p0 = MFMA32(kc[4 * ds], qf[ds + 2], p0); p1 = MFMA32(kc[4 * ds + 1], qf[ds + 2], p1); p2 = MFMA32(kc[4 * ds + 2], qf[ds + 2], p2); p3 = MFMA32(kc[4 * ds + 3], qf[ds + 2], p3); }
#pragma unroll
                for (int ds = 0; ds < 2; ++ds) { p0 = MFMA32(ka[4 * ds], qf[ds + 4], p0); p1 = MFMA32(ka[4 * ds + 1], qf[ds + 4], p1); p2 = MFMA32(ka[4 * ds + 2], qf[ds + 4], p2); p3 = MFMA32(ka[4 * ds + 3], qf[ds + 4], p3); }
#undef KFR
                bf16x8 vfa[8];
#pragma unroll
                for (int sx = 0; sx < 8; ++sx) { const LAS unsigned char* vq = vb + (sx >> 2) * VBUF; vfa[sx] = *(const LAS bf16x8*)(vq + (l31 * VP + 16 * (sx & 3) + 8 * hi) * 2); }
                if (__builtin_amdgcn_readfirstlane(nvis) < 2) {
#pragma unroll
                    for (int r = 0; r < 16; ++r) { p2[r] = -INFINITY; p3[r] = -INFINITY; } }
                float mx = fmaxf(fmaxf(p0[0], p1[0]), fmaxf(p2[0], p3[0]));
#pragma unroll
                for (int r = 1; r < 16; ++r) mx = fmaxf(mx, fmaxf(fmaxf(p0[r], p1[r]), fmaxf(p2[r], p3[r])));
                mx = fmaxf(mx, __shfl_xor(mx, 32));
                const float dl = first ? mx : fmaxf(mx, 0.f);
                if (__any(first || dl != 0.f)) {
                    const float corr = first ? 0.f : __builtin_amdgcn_exp2f(-dl);
#pragma unroll
                    for (int r = 0; r < 16; ++r) { p0[r] -= dl; p1[r] -= dl; p2[r] -= dl; p3[r] -= dl; o0[r] *= corr; o1[r] *= corr; }
                    lrun *= corr; mrun = first ? mx : mrun + dl; }
                float ls = 0.f;
#pragma unroll
                for (int r = 0; r < 16; ++r) { p0[r] = __builtin_amdgcn_exp2f(p0[r]); p1[r] = __builtin_amdgcn_exp2f(p1[r]); p2[r] = __builtin_amdgcn_exp2f(p2[r]); p3[r] = __builtin_amdgcn_exp2f(p3[r]);
                    ls += (p0[r] + p1[r]) + (p2[r] + p3[r]); }
                lrun += ls;
#pragma unroll
                for (int sx = 0; sx < 8; ++sx) {
                    const bf16x8 pb = sx < 2 ? pack8(p0, 8 * (sx & 1)) : sx < 4 ? pack8(p1, 8 * (sx & 1)) : sx < 6 ? pack8(p2, 8 * (sx & 1)) : pack8(p3, 8 * (sx & 1));
                    const LAS unsigned char* vq = vb + (sx >> 2) * VBUF;
                    o0 = MFMA32(vfa[sx], pb, o0); o1 = MFMA32(*(const LAS bf16x8*)(vq + ((l31 + 32) * VP + 16 * (sx & 3) + 8 * hi) * 2), pb, o1);
                }
            }
            if (more) { LAS unsigned char* nb_ = c.lds + ((j + 1) & 1) * BUF;
#pragma unroll
                for (int i = 0; i < 3; ++i) *(LAS v4u*)(nb_ + kl[i]) = kx[i];
#pragma unroll
                for (int i = 0; i < 2; ++i) *(LAS v4u*)(nb_ + vl[i]) = vx[i]; }
            __syncthreads();
        }
        const float lt = lrun + __shfl_xor(lrun, 32), inv = 1.0f / lt;
        GAS float* op = O + (q0 + l31) * AW + h * 64 + 4 * hi;
#pragma unroll
        for (int g = 0; g < 4; ++g) {
            *(GAS f32x4*)(op + 8 * g) = (f32x4){o0[4 * g] * inv, o0[4 * g + 1] * inv, o0[4 * g + 2] * inv, o0[4 * g + 3] * inv};
            *(GAS f32x4*)(op + 32 + 8 * g) = (f32x4){o1[4 * g] * inv, o1[4 * g + 1] * inv, o1[4 * g + 2] * inv, o1[4 * g + 3] * inv};
        }
    }
    __syncthreads();
    if (l == 1) {
        const int na_ = c.nb >= 2 * SCAN_WGS ? c.nb - SCAN_WGS : c.nb;
        if (c.bid < na_) { GAS unsigned* cq = (GAS unsigned*)(c.ws + WS_CTL) + CW_CQ;
            if (c.tid == 0) (void)__hip_atomic_fetch_add(cq + 64, 1u, __ATOMIC_RELAXED, __HIP_MEMORY_SCOPE_AGENT);
            ExpertGUJobs JG{&c}; conv_pop(c, cq, ExpertGUJobs::TOTAL, JG, cq + 64, (unsigned)na_); }
    }
}
__device__ __forceinline__ void phase_mla_post(const Ctx& c, int l) {
    const GAS float* O = (const GAS float*)(c.R + R_OATT); GAS bf16* YC = (GAS bf16*)(c.ws + WS_XN); const GAS float* og = c.in(I_BOG) + l * AW;
    const int i16 = c.lane & 15, g16 = c.lane >> 4;
    f32x4 gv[6];
#pragma unroll
    for (int k = 0; k < 6; ++k) gv[k] = *(const GAS f32x4*)(og + 64 * k + 4 * i16);
    for (int m0 = c.gw * 4; m0 < M; m0 += c.ngw * 8) {
        const int mA = m0 + g16, mB = mA + c.ngw * 4; const bool hasB = m0 + c.ngw * 4 < M;
        f32x4 xa[6], xb[6];
#pragma unroll
        for (int k = 0; k < 6; ++k) xa[k] = *(const GAS f32x4*)(O + (size_t)mA * AW + 64 * k + 4 * i16);
        if (hasB) {
#pragma unroll
            for (int k = 0; k < 6; ++k) xb[k] = *(const GAS f32x4*)(O + (size_t)mB * AW + 64 * k + 4 * i16); }
        { float ss = 0.f;
#pragma unroll
          for (int k = 0; k < 6; ++k) ss += (xa[k].x * xa[k].x + xa[k].y * xa[k].y) + (xa[k].z * xa[k].z + xa[k].w * xa[k].w);
          const float rstd = __builtin_amdgcn_rsqf(row16_sum(ss) * (1.0f / AW) + EPS);
#pragma unroll
          for (int k = 0; k < 6; ++k) { const f32x4 v = xa[k] * rstd * gv[k]; *(GAS v2u*)(YC + (size_t)mA * D + AW + 64 * k + 4 * i16) = (v2u){pk2(v.x, v.y), pk2(v.z, v.w)}; } }
        if (hasB) { float ss = 0.f;
#pragma unroll
          for (int k = 0; k < 6; ++k) ss += (xb[k].x * xb[k].x + xb[k].y * xb[k].y) + (xb[k].z * xb[k].z + xb[k].w * xb[k].w);
          const float rstd = __builtin_amdgcn_rsqf(row16_sum(ss) * (1.0f / AW) + EPS);
#pragma unroll
          for (int k = 0; k < 6; ++k) { const f32x4 v = xb[k] * rstd * gv[k]; *(GAS v2u*)(YC + (size_t)mB * D + AW + 64 * k + 4 * i16) = (v2u){pk2(v.x, v.y), pk2(v.z, v.w)}; } }
    }
}

__device__ __forceinline__ void phase_gmlp(const Ctx& c, int l) {
    const GAS bf16* Z = (const GAS bf16*)(c.R + R_Z); GAS bf16* YC = (GAS bf16*)(c.ws + WS_XN);
    const GAS float* lng = c.in(I_CLNG) + l * 256; const GAS float* lnb = c.in(I_CLNB) + l * 256; const GAS float* ws = c.in(I_CWS) + (size_t)l * 4 * 128 * 128; const GAS float* bs = c.in(I_CBS) + l * 4 * 128; const GAS float* og = c.in(I_COG) + l * 256;
    LAS float* vln = (LAS float*)c.lds;
    LAS float* ssq2 = (LAS float*)(c.lds + MISC_OFF + 256);
    for (int item = c.bid; item < M / 128; item += c.nb) {
        const int m0 = item * 128;
        __syncthreads();
        for (int q = 0; q < 16; ++q) { const int t = c.wave * 16 + q; const GAS bf16* zr = Z + (size_t)(m0 + t) * ZP + ZCV;
            float x[4]; float s = 0.f;
#pragma unroll
            for (int i = 0; i < 4; ++i) { x[i] = gelu_erf(bf2f(zr[c.lane + 64 * i])); s += x[i]; }
            const float mean = wave_sum(s) * (1.0f / 256.0f); float s2 = 0.f;
#pragma unroll
            for (int i = 0; i < 4; ++i) { x[i] -= mean; s2 += x[i] * x[i]; }
            const float rstd = __builtin_amdgcn_rsqf(wave_sum(s2) * (1.0f / 256.0f) + EPS);
#pragma unroll
            for (int i = 0; i < 4; ++i) vln[t * 256 + c.lane + 64 * i] = x[i] * rstd * lng[c.lane + 64 * i] + lnb[c.lane + 64 * i];
        }
        __syncthreads();
        const int g = c.wave & 3, half = c.wave >> 2, ch = g * 64 + c.lane;
        for (int tt = 0; tt < 64; ++tt) { const int t = half * 64 + tt; const GAS float* wr = ws + ((size_t)g * 128 + t) * 128; float acc = 0.f;
            for (int s = 0; s <= t; ++s) acc += wr[s] * vln[s * 256 + ch];
            const float sv = acc + bs[g * 128 + t]; const float u = gelu_erf(bf2f(Z[(size_t)(m0 + t) * ZP + ZU + ch])); const float y = u * sv;
            const float p = wave_sum(y * y); if (c.lane == 0) ssq2[t * 4 + g] = p;
            YC[(size_t)(m0 + t) * D + 768 + ch] = (bf16)f2bf(y); }
        __syncthreads();
        for (int tt = 0; tt < 64; ++tt) { const int t = half * 64 + tt; const float tot = (ssq2[t * 4 + 0] + ssq2[t * 4 + 1]) + (ssq2[t * 4 + 2] + ssq2[t * 4 + 3]);
            const float rstd = __builtin_amdgcn_rsqf(tot * (1.0f / 256.0f) + EPS); GAS bf16* p = YC + (size_t)(m0 + t) * D + 768 + ch; *p = (bf16)f2bf(bf2f(*p) * rstd * og[ch]); }
    }
    __syncthreads();
}


__device__ __forceinline__ void phase_gmlp_mfma(const Ctx& c, int l) {
    const GAS bf16* Z = (const GAS bf16*)(c.R + R_Z); GAS bf16* YC = (GAS bf16*)(c.ws + WS_XN);
    const GAS float* lng = c.in(I_CLNG) + l * 256; const GAS float* lnb = c.in(I_CLNB) + l * 256; const GAS float* bs = c.in(I_CBS) + l * 4 * 128; const GAS float* og = c.in(I_COG) + l * 256;
    const GAS bf16* W = (const GAS bf16*)(c.ws + WS_WSM + WSM_GW) + (size_t)l * 4 * 128 * 128;
    constexpr int VP = 136;
    LAS unsigned short* vT = (LAS unsigned short*)c.lds;
    LAS float* sq = (LAS float*)(c.lds + 256 * VP * 2);
    const int lane = c.lane, l31 = lane & 31, hi = lane >> 5;
    float lg4[4], lb4[4];
#pragma unroll
    for (int i = 0; i < 4; ++i) { lg4[i] = lng[lane + 64 * i]; lb4[i] = lnb[lane + 64 * i]; }
    for (int it_ = c.bid; it_ < M / 64; it_ += c.nb) {
        const int item = c.nb == 256 ? (it_ < 64 ? 2 * it_ + 1 : it_ < 192 ? 2 * (it_ - 64) : 2 * (it_ - 128) + 1) : it_;
        const int th = item & 1, m0 = (item >> 1) * 128, nq = 8 * (th + 1);
        __syncthreads();
        for (int q0 = 0; q0 < nq; q0 += 4) {
            float zx[4][4];
#pragma unroll
            for (int u = 0; u < 4; ++u) { const GAS bf16* zr = Z + (size_t)(m0 + c.wave * nq + q0 + u) * ZP + ZCV;
#pragma unroll
                for (int i = 0; i < 4; ++i) zx[u][i] = bf2f(zr[lane + 64 * i]); }
            float x[4][4], s1[4], s2[4];
#pragma unroll
            for (int u = 0; u < 4; ++u) { s1[u] = 0.f; s2[u] = 0.f;
#pragma unroll
                for (int i = 0; i < 4; i += 2) { const pg8::f32x2 gv = pg8::gelu_pk((pg8::f32x2){zx[u][i], zx[u][i + 1]}); x[u][i] = gv.x; x[u][i + 1] = gv.y; s1[u] += gv.x + gv.y; s2[u] += gv.x * gv.x + gv.y * gv.y; } }
#pragma unroll
            for (int u = 0; u < 4; ++u) { s1[u] = wave_sum(s1[u]); s2[u] = wave_sum(s2[u]); }
            float mean[4], rstd[4];
#pragma unroll
            for (int u = 0; u < 4; ++u) { mean[u] = s1[u] * (1.0f / 256.0f); rstd[u] = __builtin_amdgcn_rsqf(fmaxf(s2[u] * (1.0f / 256.0f) - mean[u] * mean[u], 0.f) + EPS); }
            const int t0 = c.wave * nq + q0;
#pragma unroll
            for (int i = 0; i < 4; ++i) { float y[4];
#pragma unroll
                for (int u = 0; u < 4; ++u) y[u] = (x[u][i] - mean[u]) * rstd[u] * lg4[i] + lb4[i];
                *(LAS v2u*)(vT + (lane + 64 * i) * VP + t0) = (v2u){pk2(y[0], y[1]), pk2(y[2], y[3])}; }
        }
        __syncthreads();
        const int tb = 2 * th + (c.wave & 1), g = c.wave >> 1; const int t = 32 * tb + l31, tl = 32 * (c.wave & 1) + l31; const size_t m = (size_t)m0 + t;
        float ss = 0.f; const float bias = bs[g * 128 + t];
        const GAS bf16* wr = W + ((size_t)g * 128 + t) * 128 + 8 * hi;
#pragma unroll 1
        for (int i = 0; i < 2; ++i) { const int cblk = 2 * g + i; f32x16 a = zero16();
            for (int ks = 0; ks < 2 * tb + 2; ++ks) a = MFMA32(*(const LAS bf16x8*)(vT + (32 * cblk + l31) * VP + 16 * ks + 8 * hi), *(const GAS bf16x8*)(wr + 16 * ks), a);
#pragma unroll
            for (int gq = 0; gq < 4; ++gq) { const int ch = 32 * cblk + 8 * gq + 4 * hi; const v2u zu = *(const GAS v2u*)(Z + m * ZP + ZU + ch);
                const pg8::f32x2 u01 = pg8::gelu_pk((pg8::f32x2){bflo(zu.x), bfhi(zu.x)}), u23 = pg8::gelu_pk((pg8::f32x2){bflo(zu.y), bfhi(zu.y)});
                const float y0 = u01.x * (a[4 * gq] + bias), y1 = u01.y * (a[4 * gq + 1] + bias), y2 = u23.x * (a[4 * gq + 2] + bias), y3 = u23.y * (a[4 * gq + 3] + bias);
                ss += (y0 * y0 + y1 * y1) + (y2 * y2 + y3 * y3);
                *(GAS v2u*)(YC + m * D + 768 + ch) = (v2u){pk2(y0, y1), pk2(y2, y3)}; } }
        ss += __shfl_xor(ss, 32);
        if (hi == 0) sq[g * 64 + tl] = ss;
        __syncthreads();
        const float rstd = __builtin_amdgcn_rsqf(((sq[tl] + sq[64 + tl]) + (sq[128 + tl] + sq[192 + tl])) * (1.0f / 256.0f) + EPS);
#pragma unroll 1
        for (int i = 0; i < 2; ++i) { const int cblk = 2 * g + i;
#pragma unroll
            for (int gq = 0; gq < 4; ++gq) { const int ch = 32 * cblk + 8 * gq + 4 * hi; const f32x4 o4 = *(const GAS f32x4*)(og + ch); GAS v2u* p = (GAS v2u*)(YC + m * D + 768 + ch); const v2u w = *p;
                *p = (v2u){pk2(bflo(w.x) * rstd * o4.x, bfhi(w.x) * rstd * o4.y), pk2(bflo(w.y) * rstd * o4.z, bfhi(w.y) * rstd * o4.w)}; } }
    }
    __syncthreads();
}

__device__ __forceinline__ void phase_moe_count(const Ctx& c) {
    const GAS int* te = (const GAS int*)(c.ws + WS_TOK + TOK_E); GAS int* seg = (GAS int*)(c.ws + WS_TOK + TOK_SEG);
    for (int sgi = c.gw; sgi < NSEG; sgi += c.ngw) {
        const int m = sgi * SEGT + c.lane; const int e0 = te[2 * m], e1 = te[2 * m + 1];
#pragma unroll
        for (int e = 0; e < NE; ++e) { const unsigned long long b0 = __ballot(e0 == e), b1 = __ballot(e1 == e); if (c.lane == 0) seg[sgi * NE + e] = __popcll(b0) + __popcll(b1); }
    }
}
__device__ __forceinline__ void phase_moe_scatter(const Ctx& c) {
    const GAS int* te = (const GAS int*)(c.ws + WS_TOK + TOK_E); const GAS int* seg = (const GAS int*)(c.ws + WS_TOK + TOK_SEG); GAS int* tpos = (GAS int*)(c.ws + WS_TOK + TOK_POS); GAS int* tile = (GAS int*)(c.ws + WS_TOK + TOK_TILE);
    const GAS bf16* XN = (const GAS bf16*)(c.ws + WS_XN); GAS bf16* XNP = (GAS bf16*)(c.R + R_XNP);
    LAS int* pre = (LAS int*)c.lds;
    LAS int* tot = pre + NSEG * NE;
    LAS int* base = tot + NE;
    __syncthreads();
    if (c.tid < NE) { int s = 0; for (int sgi = 0; sgi < NSEG; ++sgi) { pre[sgi * NE + c.tid] = s; s += seg[sgi * NE + c.tid]; } tot[c.tid] = s; }
    __syncthreads();
    if (c.tid == 0) { int s = 0; for (int e = 0; e < NE; ++e) { base[e] = s; s += (tot[e] + 255) & ~255; }
        if (c.bid == 0) { int T = 0; for (int e = 0; e < NE; ++e) { const int n = ((tot[e] + 255) & ~255) / 256; tile[e] = base[e] / 256; tile[8 + e] = n; for (int i = 0; i < n; ++i) tile[32 + T + i] = e; T += n; } tile[16] = T; } }
    __syncthreads();
    for (int sgi = c.bid; sgi < NSEG; sgi += c.nb) {
        const int m = sgi * SEGT + c.lane; const int e0 = te[2 * m], e1 = te[2 * m + 1]; int p0 = 0, p1 = 0;
        const unsigned long long below = (1ull << c.lane) - 1ull;
#pragma unroll
        for (int e = 0; e < NE; ++e) { const unsigned long long b0 = __ballot(e0 == e), b1 = __ballot(e1 == e);
            const int r = __popcll(b0 & below) + __popcll(b1 & below); const int st = base[e] + pre[sgi * NE + e];
            if (e0 == e) p0 = st + r; if (e1 == e) p1 = st + r + ((e0 == e) ? 1 : 0); }
        if (c.wave == 0) { tpos[2 * m] = p0; tpos[2 * m + 1] = p1; }
        v4u x0[8], x1[8];
#pragma unroll
        for (int u = 0; u < 8; ++u) { const GAS v4u* src = (const GAS v4u*)(XN + (size_t)(sgi * SEGT + 8 * c.wave + u) * D) + c.lane; x0[u] = src[0]; x1[u] = src[64]; }
#pragma unroll
        for (int u = 0; u < 8; ++u) { const int d0 = __shfl(p0, 8 * c.wave + u), d1 = __shfl(p1, 8 * c.wave + u); GAS v4u* o0 = (GAS v4u*)(XNP + (size_t)d0 * D) + c.lane; GAS v4u* o1 = (GAS v4u*)(XNP + (size_t)d1 * D) + c.lane;
            o0[0] = x0[u]; o0[64] = x1[u]; o1[0] = x0[u]; o1[64] = x1[u]; }
    }
    for (int e = 0; e < NE; ++e) { const int r0 = base[e] + tot[e], r1 = base[e] + ((tot[e] + 255) & ~255);
        for (int r = r0 + c.gw; r < r1; r += c.ngw) { GAS v4u* o = (GAS v4u*)(XNP + (size_t)r * D) + c.lane; o[0] = (v4u){0u, 0u, 0u, 0u}; o[64] = (v4u){0u, 0u, 0u, 0u}; } }
    __syncthreads();
}
__device__ __forceinline__ void phase_moe_combine(const Ctx& c) {
    const GAS float* tg = (const GAS float*)(c.ws + WS_TOK + TOK_G); const GAS int* tpos = (const GAS int*)(c.ws + WS_TOK + TOK_POS); const GAS bf16* YP = (const GAS bf16*)(c.R + R_YP); GAS float* out = c.out();
    v2u a0n[4], a1n[4]; f32x4 xn_[4]; float g0n = 0.f, g1n = 0.f;
#define CB_LOAD(tok) do { g0n = tg[2 * (tok)]; g1n = tg[2 * (tok) + 1]; const int p0_ = tpos[2 * (tok)], p1_ = tpos[2 * (tok) + 1]; \
        const GAS v2u* y0_ = (const GAS v2u*)(YP + (size_t)p0_ * D) + c.lane; const GAS v2u* y1_ = (const GAS v2u*)(YP + (size_t)p1_ * D) + c.lane; const GAS f32x4* o_ = (const GAS f32x4*)(out + (size_t)(tok) * D) + c.lane; \
        _Pragma("unroll") for (int j = 0; j < 4; ++j) { a0n[j] = y0_[64 * j]; a1n[j] = y1_[64 * j]; xn_[j] = o_[64 * j]; } } while (0)
    if (c.gw < M) CB_LOAD(c.gw);
    for (int m = c.gw; m < M; m += c.ngw) {
        v2u a0[4], a1[4]; f32x4 x[4]; const float g0 = g0n, g1 = g1n;
#pragma unroll
        for (int j = 0; j < 4; ++j) { a0[j] = a0n[j]; a1[j] = a1n[j]; x[j] = xn_[j]; }
        if (m + c.ngw < M) CB_LOAD(m + c.ngw);
        GAS f32x4* o = (GAS f32x4*)(out + (size_t)m * D) + c.lane;
#pragma unroll
        for (int j = 0; j < 4; ++j) { f32x4 y = x[j];
            y.x += g0 * bflo(a0[j].x) + g1 * bflo(a1[j].x); y.y += g0 * bfhi(a0[j].x) + g1 * bfhi(a1[j].x); y.z += g0 * bflo(a0[j].y) + g1 * bflo(a1[j].y); y.w += g0 * bfhi(a0[j].y) + g1 * bfhi(a1[j].y); o[64 * j] = y; }
    }
#undef CB_LOAD
}

enum { PH_CONV = 0, PH_NORM1, PH_GEMM_IN, PH_RWKV_PREP, PH_MLA_PREP, PH_GMLP, PH_SCAN, PH_ATTN, PH_POST, PH_GEMM_OUT, PH_NORM2, PH_DGU, PH_DDOWN, PH_NORM2R, PH_COUNT, PH_SCATTER, PH_CONVE, PH_EGU, PH_EDOWN, PH_COMBINE, PH_CHUNK, PH_RWKV_OUT, PH_MLA_POST1, PH_MLA_PREP2, PH_EDOWNX, PH_GEMM_OUTN, PH_CONVB };
#ifndef PHASE_INLINE
#define PHASE_INLINE __forceinline__
#endif
template <int PH> __device__ PHASE_INLINE void do_phase(const Ctx& c, int l, int e) {
    bf16* XN = (bf16*)(c.ws + WS_XN); bf16* Zb = (bf16*)(c.R + R_Z); bf16* YC = (bf16*)(c.ws + WS_XN);
    GAS bf16* XNg = (GAS bf16*)(c.ws + WS_XN);
    if constexpr (PH == PH_CONV) phase_conv_static(c);
    if constexpr (PH == PH_CONVB) phase_conv_b(c);
    if constexpr (PH == PH_NORM1) phase_rmsnorm<false>(c, l == 0 ? c.in(I_X) : (const GAS float*)c.out(), c.in(I_MIXG) + l * D, XNg, nullptr);
    if constexpr (PH == PH_GEMM_IN) { pg8::Gemm g{XN, (const bf16*)(c.ws + WS_WIN) + (size_t)l * ZP * D, M, ZP, D, 0}; pg8::StaticOrder S; S.init(M, ZP, c.nb, c.bid); pg8::EpiBf16P E{Zb, ZP, ZP / 256, l == 1 ? (const float*)(c.R + R_SS1) : nullptr, 1.0f / D};
        pg8::gemm_phase<pg8::EpiBf16P, pg8::StaticOrder, true, true>(c.lds, g, S, E); }
#ifndef RWKV_NAIVE
#define RWKV_NAIVE 0
#endif
#ifndef RWKV_PREP_VALU
#define RWKV_PREP_VALU 0
#endif
#ifndef RWKV_PREP4
#define RWKV_PREP4 0
#endif
    if constexpr (PH == PH_RWKV_PREP) { if (RWKV_NAIVE) phase_rwkv_prep(c, l); else if (RWKV_PREP_VALU) phase_rwkv_prep2(c, l); else if (RWKV_PREP4) phase_rwkv_prep4(c, l); else phase_rwkv_prep3(c, l); }
    if constexpr (PH == PH_CHUNK) { if (!RWKV_NAIVE) phase_rwkv_chunk(c); }
    if constexpr (PH == PH_RWKV_OUT) { if (!RWKV_NAIVE) phase_rwkv_out(c, l); }
#ifndef MLA_NAIVE
#define MLA_NAIVE 0
#endif
    if constexpr (PH == PH_MLA_PREP) { if (MLA_NAIVE) phase_mla_prep(c, l); else {
        pg8::Gemm g{Zb + ZCQ, (const bf16*)(c.ws + WS_WSM + WSM_UQ) + (size_t)l * 768 * 256, M, 768, 256, ZP}; pg8::StaticOrder S; S.init(M, 768, c.nb, c.bid); pg8::EpiBf16P E{(bf16*)(c.R + R_QR), 768, 3, nullptr, 0.f};
        pg8::gemm_phase<pg8::EpiBf16P, pg8::StaticOrder, true, true>(c.lds, g, S, E); } }
    if constexpr (PH == PH_MLA_PREP2) { if (!MLA_NAIVE) {
        int k128 = 128; asm volatile("" : "+s"(k128));
        pg8::Gemm g{Zb + ZCKV, (const bf16*)(c.ws + WS_WSM + WSM_UKV) + (size_t)l * 768 * 128, M, 768, k128, ZP}; pg8::StaticOrder S; S.init(M, 768, c.nb, (c.bid + 192) % c.nb); pg8::EpiBf16P E{(bf16*)(c.R + R_KVR), 768, 3, nullptr, 0.f};
        pg8::gemm_phase<pg8::EpiBf16P, pg8::StaticOrder, true, true>(c.lds, g, S, E); } }
    #ifndef MLA_POST1_OLD
#define MLA_POST1_OLD 0
#endif
    if constexpr (PH == PH_MLA_POST1) { if (!MLA_NAIVE) { if (MLA_POST1_OLD) phase_mla_post1(c, l); else phase_mla_post1b(c, l); } }
#ifndef GMLP_NAIVE
#define GMLP_NAIVE 0
#endif
    if constexpr (PH == PH_GMLP) { if (GMLP_NAIVE) phase_gmlp(c, l); else phase_gmlp_mfma(c, l); }
    if constexpr (PH == PH_SCAN) { if (RWKV_NAIVE) phase_rwkv_scan_naive(c); else phase_rwkv_scan2(c); }
#ifndef ATTN_NAIVE
#define ATTN_NAIVE 0
#endif
#ifndef ATTN_ONE_TILE
#define ATTN_ONE_TILE 0
#endif
    if constexpr (PH == PH_ATTN) { if (ATTN_NAIVE) phase_attn_naive(c); else if (ATTN_ONE_TILE) phase_attn_mfma(c); else phase_attn_mfma2(c, l); }
    if constexpr (PH == PH_POST) { if (RWKV_NAIVE) phase_rwkv_post(c, l); phase_mla_post(c, l); }
    if constexpr (PH == PH_GEMM_OUT) { pg8::Gemm g{YC, (const bf16*)(c.ws + WS_WOUT) + (size_t)l * D * D, M, D, D, 0}; pg8::StaticOrder S; S.init(M, D, c.nb, c.bid);
        pg8::EpiResT<true, false> E{(const void*)(c.R + R_XB), (void*)c.out(), D};
        pg8::gemm_phase<pg8::EpiResT<true, false>, pg8::StaticOrder, true, true>(c.lds, g, S, E); }
    if constexpr (PH == PH_NORM2) phase_rmsnorm<false>(c, c.out(), c.in(I_FFNG), XNg, nullptr);
    if constexpr (PH == PH_DGU) { pg8::Gemm g{(const bf16*)(c.R + R_XN2), (const bf16*)(c.ws + WS_WDGU), M, 2 * DFF, D, 0}; pg8::StaticOrder S; S.init(M, 2 * DFF, c.nb, c.bid); pg8::EpiSwiGLU E{(bf16*)(c.R + R_H), DFF, 2 * DFF / 256, (const float*)(c.R + R_SS0), 1.0f / D};
        pg8::gemm_phase<pg8::EpiSwiGLU, pg8::StaticOrder, true, true>(c.lds, g, S, E); }
    if constexpr (PH == PH_DDOWN) { pg8::Gemm g{(const bf16*)(c.R + R_H), (const bf16*)(c.ws + WS_WDD), M, D, DFF, 0}; pg8::StaticOrder S; S.init(M, D, c.nb, c.bid);
        pg8::EpiResNT<true, true> E{(const void*)(c.R + R_XB), (void*)(c.R + R_XB), D, XN, (const float*)(c.in(I_MIXG) + D), (float*)(c.R + R_SS1)};
        pg8::gemm_phase<pg8::EpiResNT<true, true>, pg8::StaticOrder, true, true>(c.lds, g, S, E); }
    if constexpr (PH == PH_GEMM_OUTN) { pg8::Gemm g{YC, (const bf16*)(c.ws + WS_WOUT), M, D, D, 0}; pg8::StaticOrder S; S.init(M, D, c.nb, c.bid);
        pg8::EpiResNT<false, true> E{(const void*)c.in(I_X), (void*)(c.R + R_XB), D, (bf16*)(c.R + R_XN2), (const float*)c.in(I_FFNG), (float*)(c.R + R_SS0)};
        pg8::gemm_phase<pg8::EpiResNT<false, true>, pg8::StaticOrder, true, true>(c.lds, g, S, E); }
    if constexpr (PH == PH_NORM2R) { phase_rmsnorm<true>(c, c.out(), c.in(I_FFNG) + D, XNg, c.in(I_ROUTER)); __syncthreads(); phase_conv_experts(c); }
    if constexpr (PH == PH_COUNT) phase_moe_count(c);
    if constexpr (PH == PH_SCATTER) phase_moe_scatter(c);
    if constexpr (PH == PH_EGU || PH == PH_EDOWN || PH == PH_EDOWNX) {
        const int* tile = (const int*)(c.ws + WS_TOK + TOK_TILE); LAS int* te = (LAS int*)(c.lds + RING_BYTES + 8192);
        const int T = __builtin_amdgcn_readfirstlane(tile[16]);
        __syncthreads();
        if (c.tid < 2 * M / 256 + NE) te[c.tid] = tile[32 + c.tid];
        __syncthreads();
        const int nx = T - 2 * HMAIN, ndx = nx * (D / 256) < c.nb / 2 ? nx * (D / 256) : 0;
        if constexpr (PH == PH_EGU) {
            const int t0 = e ? HMAIN : 0, n1 = e ? 0 : nx;
            pg8::Gemm g{(const bf16*)(c.R + R_XNP), (const bf16*)(c.R + R_WMGU), M2MAX, NE * 2 * DFE, D, 0};
            pg8::MoeOrder<true> S{te, t0, HMAIN, 0, 2 * HMAIN, n1, HMAIN, 2 * DFE / 256, c.nb, c.bid, e ? ndx : 0, 4};
            pg8::EpiSwiGLU E{(bf16*)(c.R + R_HME), DFE, 2 * DFE / 256, nullptr, 0.f};
            pg8::gemm_phase<pg8::EpiSwiGLU, pg8::MoeOrder<true>, true, true>(c.lds, g, S, E);
        } else {
            const bool xtra = PH == PH_EDOWNX;
            if (!xtra || ndx > 0) {
            pg8::Gemm g{(const bf16*)(c.R + R_HME), (const bf16*)(c.R + R_WMD), HCAP * 256, NE * D, DFE, 0};
            pg8::MoeOrder<false> S{te, xtra ? 2 * HMAIN : (e ? HMAIN : 0), xtra ? nx : HMAIN, xtra ? HMAIN : 0, 2 * HMAIN, (!xtra && !e && ndx == 0) ? nx : 0, HMAIN, D / 256, c.nb, c.bid, 0, 0};
            pg8::EpiBf16P E{(bf16*)(c.R + R_YP), D, D / 256, nullptr, 0.f};
            pg8::gemm_phase<pg8::EpiBf16P, pg8::MoeOrder<false>, true, true>(c.lds, g, S, E); }
        }
    }
    if constexpr (PH == PH_COMBINE) phase_moe_combine(c);
}


__device__ __forceinline__ void make_ctx(Ctx& c, LAS unsigned char* lds, int wave_s) {
    (void)wave_s; int tid = threadIdx.x; asm volatile("" : "+v"(tid));
    int bid = blockIdx.x, nb = gridDim.x; asm volatile("" : "+s"(bid)); asm volatile("" : "+s"(nb));
    c.lds = lds; c.tid = tid; c.lane = tid & 63; c.wave = __builtin_amdgcn_readfirstlane(tid >> 6); c.bid = bid; c.nb = nb;
    c.gw = c.bid * NWAVES + c.wave; c.ngw = c.nb * NWAVES; c.ws = (GAS unsigned char*)c.ptr_(40); c.R = c.ws + WS_R;
}
__device__ __forceinline__ void kernel_prologue(const Args& args, LAS unsigned char* lds) {
    for (int u = threadIdx.x; u < (LDS_BYTES - RING_BYTES) / 4; u += NTHR) ((LAS unsigned*)(lds + RING_BYTES))[u] = 0u;
    __syncthreads();
    if (threadIdx.x < 82) ((LAS unsigned*)(lds + ARGS_OFF))[threadIdx.x] = ((const unsigned*)&args)[threadIdx.x];
    __syncthreads();
}
template <int PH> __device__ __forceinline__ void run_phase(LAS unsigned char* lds, int l, int e, int wave_s) {
    asm volatile("" : "+s"(l)); asm volatile("" : "+s"(e)); asm volatile("" : "+s"(wave_s));
    Ctx c; make_ctx(c, lds, wave_s);
    do_phase<PH>(c, l, e);
}
#if !MK_ONE_LAUNCH
template <int PH> __global__ void __launch_bounds__(NTHR, 2) k_ph(Args args, int l, int e) {
    extern __shared__ __attribute__((aligned(16))) unsigned char lds_raw[];
    kernel_prologue(args, (LAS unsigned char*)lds_raw);
    run_phase<PH>((LAS unsigned char*)lds_raw, l, e, __builtin_amdgcn_readfirstlane(threadIdx.x >> 6));
}
#else
__global__ void __launch_bounds__(NTHR, 2) k_mega(Args args) {
    extern __shared__ __attribute__((aligned(16))) unsigned char lds_raw[];
    LAS unsigned char* lds = (LAS unsigned char*)lds_raw;
    kernel_prologue(args, lds);
    volatile LAS unsigned* MISC = (volatile LAS unsigned*)(lds + MISC_OFF);
    (void)xcd_barrier_post((unsigned*)(args.ws + WS_CTL) + CW_BAR, MISC + 8);
    int wave_s = __builtin_amdgcn_readfirstlane(threadIdx.x >> 6);
#define GRIDBAR() do { Ctx cb_; cb_.lds = lds; XcdBarrier b_; b_.bar = (unsigned*)((unsigned char*)cb_.ptr_(40) + WS_CTL) + CW_BAR; b_.x = xb_xcc_id(); b_.st = (volatile LAS unsigned*)(lds + MISC_OFF) + 8; xcd_barrier(b_); } while (0)
#define PHASE(PH, l, e) do { run_phase<PH>(lds, l, e, wave_s); GRIDBAR(); } while (0)
#define MIXER_CORE(l) do { run_phase<PH_GEMM_IN>(lds, l, 0, wave_s); if ((l) == 0) run_phase<PH_CONVB>(lds, 0, 0, wave_s); GRIDBAR(); \
        run_phase<PH_RWKV_PREP>(lds, l, 0, wave_s); run_phase<PH_MLA_PREP>(lds, l, 0, wave_s); run_phase<PH_MLA_PREP2>(lds, l, 0, wave_s); PHASE(PH_GMLP, l, 0); \
        run_phase<PH_MLA_POST1>(lds, l, 0, wave_s); PHASE(PH_CHUNK, l, 0); \
        run_phase<PH_SCAN>(lds, l, 0, wave_s); PHASE(PH_ATTN, l, 0); \
        run_phase<PH_RWKV_OUT>(lds, l, 0, wave_s); PHASE(PH_POST, l, 0); } while (0)
    run_phase<PH_CONV>(lds, 0, 0, wave_s); PHASE(PH_NORM1, 0, 0);
    MIXER_CORE(0);
    PHASE(PH_GEMM_OUTN, 0, 0);
    PHASE(PH_DGU, 0, 0); PHASE(PH_DDOWN, 0, 0);
    MIXER_CORE(1);
    PHASE(PH_GEMM_OUT, 1, 0);
    PHASE(PH_NORM2R, 1, 0); PHASE(PH_SCATTER, 1, 0);
    PHASE(PH_EGU, 1, 0); PHASE(PH_EDOWN, 1, 0); run_phase<PH_EDOWNX>(lds, 1, 0, wave_s); PHASE(PH_EGU, 1, 1); PHASE(PH_EDOWN, 1, 1);
    run_phase<PH_COMBINE>(lds, 1, 0, wave_s);
#undef MIXER_CORE
#undef PHASE
#undef GRIDBAR
}
#endif

#if !MK_ONE_LAUNCH
template <int PH> static void launch_ph(const Args& a, int l, int e, int grid, hipStream_t stream) {
    static bool attr = false;
    if (!attr) { (void)hipFuncSetAttribute((const void*)k_ph<PH>, hipFuncAttributeMaxDynamicSharedMemorySize, LDS_BYTES); attr = true; }
    hipLaunchKernelGGL(k_ph<PH>, dim3(grid), dim3(NTHR), LDS_BYTES, stream, a, l, e);
}
#endif
extern "C" void kernel_launch(void* const* d_in, const int* in_sizes, int n_in, void* d_out, int out_size, void* d_ws, size_t ws_size, hipStream_t stream) {
    static int grid = 0;
    if (grid == 0) {
        if (n_in != 39 || out_size != M * D || ws_size < WS_END) { fprintf(stderr, "kernel_launch: unexpected shapes (n_in %d, out %d, ws %zu < %zu)\n", n_in, out_size, ws_size, (size_t)WS_END); grid = -1; return; }
        int dev = 0, cus = 0;
        if (hipGetDevice(&dev) != hipSuccess || hipDeviceGetAttribute(&cus, hipDeviceAttributeMultiprocessorCount, dev) != hipSuccess) { grid = -1; return; }
        grid = cus;
    }
    if (grid < 0) return;
    Args a{};
    for (int i = 0; i < 39; ++i) a.in[i] = (const float*)d_in[i];
    a.out = (float*)d_out; a.ws = (unsigned char*)d_ws; a.ph_lo = 0; a.ph_hi = 0;
#if MK_ONE_LAUNCH
    {
        static bool attr = false;
        if (!attr) { (void)hipFuncSetAttribute((const void*)k_mega, hipFuncAttributeMaxDynamicSharedMemorySize, LDS_BYTES); attr = true; }
        (void)hipMemsetAsync((char*)d_ws + WS_CTL, 0, CTL_ZERO_BYTES, stream);
        hipLaunchKernelGGL(k_mega, dim3(grid), dim3(NTHR), LDS_BYTES, stream, a);
        return;
    }
#else
    (void)hipMemsetAsync((char*)d_ws + WS_CTL, 0, CTL_ZERO_BYTES, stream);
    launch_ph<PH_CONV>(a, 0, 0, grid, stream); launch_ph<PH_NORM1>(a, 0, 0, grid, stream);
    for (int l = 0; l < 2; ++l) {
        launch_ph<PH_GEMM_IN>(a, l, 0, grid, stream); if (l == 0) launch_ph<PH_CONVB>(a, 0, 0, grid, stream);
        launch_ph<PH_RWKV_PREP>(a, l, 0, grid, stream); launch_ph<PH_MLA_PREP>(a, l, 0, grid, stream); launch_ph<PH_MLA_PREP2>(a, l, 0, grid, stream); launch_ph<PH_GMLP>(a, l, 0, grid, stream);
        launch_ph<PH_MLA_POST1>(a, l, 0, grid, stream); launch_ph<PH_CHUNK>(a, l, 0, grid, stream);
        launch_ph<PH_SCAN>(a, l, 0, grid, stream); launch_ph<PH_ATTN>(a, l, 0, grid, stream);
        launch_ph<PH_RWKV_OUT>(a, l, 0, grid, stream); launch_ph<PH_POST>(a, l, 0, grid, stream);
        if (l == 0) { launch_ph<PH_GEMM_OUTN>(a, 0, 0, grid, stream); launch_ph<PH_DGU>(a, 0, 0, grid, stream); launch_ph<PH_DDOWN>(a, 0, 0, grid, stream); }
        else { launch_ph<PH_GEMM_OUT>(a, 1, 0, grid, stream);
            launch_ph<PH_NORM2R>(a, 1, 0, grid, stream); launch_ph<PH_SCATTER>(a, 1, 0, grid, stream);
            launch_ph<PH_EGU>(a, 1, 0, grid, stream); launch_ph<PH_EDOWN>(a, 1, 0, grid, stream); launch_ph<PH_EDOWNX>(a, 1, 0, grid, stream);
            launch_ph<PH_EGU>(a, 1, 1, grid, stream); launch_ph<PH_EDOWN>(a, 1, 1, grid, stream);
            launch_ph<PH_COMBINE>(a, 1, 0, grid, stream); }
    }
#endif
}
```

```cpp
#include <hip/hip_runtime.h>
#include <cstdio>
#include <cstdint>
#include <cmath>
namespace pg8 {
#define PG8_LAS __attribute__((address_space(3)))
typedef unsigned short bf16_t;
typedef short bf16x8 __attribute__((ext_vector_type(8)));
typedef float f32x4 __attribute__((ext_vector_type(4)));
typedef unsigned u32x4 __attribute__((ext_vector_type(4)));
constexpr int BM = 256, BK = 64, HALF = 128, HTB = HALF * BK * 2  , STAGE_BYTES = 8 * HTB, NXCD = 8, WGM = 8;

__host__ __device__ __forceinline__ int lds_byte(int r, int c) { const int st = (r >> 4) * 2 + (c >> 5), rr = r & 15, cc = c & 31, ob = rr * 64 + cc * 2; return st * 1024 + (ob ^ (((ob >> 9) & 1) << 5)); }
__host__ __device__ __forceinline__ void stage_rc(int b, int& R, int& C) { const int st = b / 1024, sb = b % 1024, swz = sb ^ (((sb >> 9) & 1) << 5); R = (st >> 1) * 16 + swz / 64; C = (st & 1) * 32 + (swz % 64) / 2; }
__host__ __device__ __forceinline__ int perm32(int rho) { const int n = rho >> 4, i = rho & 15; return 8 * (i >> 2) + 4 * n + (i & 3); }

struct Unit { int pm, pn, po; };
struct Gemm { const bf16_t* A; const bf16_t* Bt; int M, N, K, lda; };

struct StaticOrder {
    int nM, nN, nwg, G, c;
    __host__ __device__ void init(int M, int N, int G_, int c_) { nM = M / BM; nN = N / BM; nwg = nM * nN; G = G_; c = c_; }
    __host__ __device__ bool next(int i, Unit& u) const {
        const long L = (long)i * G + c; if (L >= nwg) return false;
        int wgid = (int)L; { const int q = nwg / NXCD, r = nwg % NXCD, xcd = wgid % NXCD, off = wgid / NXCD; wgid = (xcd < r ? xcd * (q + 1) : r * (q + 1) + (xcd - r) * q) + off; }
        const int nig = WGM * nN, gid = wgid / nig, fm = gid * WGM, gsz = (nM - fm) < WGM ? (nM - fm) : WGM;
        u.pm = fm + ((wgid % nig) % gsz); u.pn = (wgid % nig) / gsz; u.po = u.pm; return true;
    }
    __device__ __forceinline__ void a_ready(const Unit&) const {}
    __device__ __forceinline__ void done(const Unit&) const {}
};

__device__ __forceinline__ unsigned cvt_pk_bf16(float lo, float hi) { unsigned r; asm volatile("v_cvt_pk_bf16_f32 %0, %1, %2" : "=v"(r) : "v"(lo), "v"(hi)); return r; }
typedef float f32x2 __attribute__((ext_vector_type(2)));
__device__ __forceinline__ f32x2 gelu_pk(f32x2 v) {
    const f32x2 av = __builtin_elementwise_abs(v), d = av * 0.2316418882f + 1.0f;
    f32x2 t; t.x = __builtin_amdgcn_rcpf(d.x); t.y = __builtin_amdgcn_rcpf(d.y);
    f32x2 q = t * 0.5307027145f + (-0.7265760135f); q = q * t + 0.7107068705f; q = q * t + (-0.142248368f); q = q * t + 0.127414796f; q = q * t;
    const f32x2 s = (v * v) * (-0.72134752044f);
    f32x2 e; e.x = __builtin_amdgcn_exp2f(s.x); e.y = __builtin_amdgcn_exp2f(s.y);
    const f32x2 m = v * (q * e), r = v - m;
    f32x2 o; o.x = v.x < 0.f ? m.x : r.x; o.y = v.y < 0.f ? m.y : r.y; return o;
}

template <int ACT  > struct EpiBf16 {
    static constexpr bool PERM = true, AFTER_DRAIN = false; static_assert(ACT == 0 || ACT == 1, "EpiBf16: ACT is 0 (none) or 1 (gelu_pk)");
    bf16_t* O; int ldc; const float* bias; int split_cols; size_t split_stride; float scale0;
    __device__ __forceinline__ void operator()(const f32x4 (&acc)[2][2][4][2], const Unit& u, int wr, int wc, int fr, int fq) const {
        const int row0 = u.po * BM + wr * 64 + fr; int colt = u.pn * BM; bf16_t* base = O;
        float sc = 1.f; if (split_cols) { const int t = colt / split_cols; base += (size_t)t * split_stride; colt -= t * split_cols; if (t == 0) sc = scale0; }
        const int col0 = colt + wc * 32 + 8 * fq, bcol0 = u.pn * BM + wc * 32 + 8 * fq;
        f32x4 bv[2][2];
#pragma unroll
        for (int bj = 0; bj < 2; ++bj)
#pragma unroll
            for (int n = 0; n < 2; ++n) bv[bj][n] = bias ? *(const f32x4*)(bias + bcol0 + bj * HALF + 4 * n) : (f32x4){0.f, 0.f, 0.f, 0.f};
#pragma unroll
        for (int ai = 0; ai < 2; ++ai)
#pragma unroll
            for (int m = 0; m < 4; ++m) { bf16_t* rowp = base + (size_t)(row0 + ai * HALF + m * 16) * ldc + col0;
#pragma unroll
                for (int bj = 0; bj < 2; ++bj) { f32x4 v0 = acc[ai][bj][m][0] + bv[bj][0], v1 = acc[ai][bj][m][1] + bv[bj][1];
                    if (ACT == 1) { f32x2 a = gelu_pk((f32x2){v0[0], v0[1]}), b = gelu_pk((f32x2){v0[2], v0[3]}), c = gelu_pk((f32x2){v1[0], v1[1]}), d = gelu_pk((f32x2){v1[2], v1[3]});
                        v0 = (f32x4){a.x, a.y, b.x, b.y}; v1 = (f32x4){c.x, c.y, d.x, d.y}; }
                    v0 = v0 * sc; v1 = v1 * sc; u32x4 w; w.x = cvt_pk_bf16(v0[0], v0[1]); w.y = cvt_pk_bf16(v0[2], v0[3]); w.z = cvt_pk_bf16(v1[0], v1[1]); w.w = cvt_pk_bf16(v1[2], v1[3]);
                    *(u32x4*)(rowp + bj * HALF) = w; } }
    }
};

typedef unsigned u32x2v __attribute__((ext_vector_type(2)));
template <bool BB> __device__ __forceinline__ f32x4 res_load(const void* base, size_t idx) {
    if constexpr (BB) { const u32x2v w = *(const u32x2v*)((const bf16_t*)base + idx); return (f32x4){__builtin_bit_cast(float, w.x << 16), __builtin_bit_cast(float, w.x & 0xffff0000u), __builtin_bit_cast(float, w.y << 16), __builtin_bit_cast(float, w.y & 0xffff0000u)}; }
    else return *(const f32x4*)((const float*)base + idx); }
template <bool OB> __device__ __forceinline__ void res_store(void* out, size_t idx, const f32x4 v) {
    if constexpr (OB) *(u32x2v*)((bf16_t*)out + idx) = (u32x2v){cvt_pk_bf16(v[0], v[1]), cvt_pk_bf16(v[2], v[3])};
    else *(f32x4*)((float*)out + idx) = v; }
template <bool BB, bool OB> struct EpiResT {
    static constexpr bool PERM = false, AFTER_DRAIN = false;
    const void* base; void* out_; int ldc; long hi_adj;
    __device__ __forceinline__ void operator()(const f32x4 (&acc)[2][2][4][2], const Unit& u, int wr, int wc, int fr, int fq) const {
        void* out = (void*)((char*)out_ + (u.po >= 32 ? hi_adj : 0));
        const int row0 = u.po * BM + wr * 64 + fr, col0 = u.pn * BM + wc * 32 + 4 * fq;
#pragma unroll
        for (int ai = 0; ai < 2; ++ai)
#pragma unroll
            for (int m = 0; m < 4; ++m) { const size_t off = (size_t)(row0 + ai * HALF + m * 16) * ldc + col0;
#pragma unroll
                for (int bj = 0; bj < 2; ++bj)
#pragma unroll
                    for (int n = 0; n < 2; ++n) { const f32x4 b = res_load<BB>(base, off + bj * HALF + n * 16); res_store<OB>(out, off + bj * HALF + n * 16, b + acc[ai][bj][m][n]); } }
    }
};
typedef EpiResT<false, false> EpiResF32;
template <bool BB, bool OB> struct EpiResNT {
    static constexpr bool PERM = false, AFTER_DRAIN = false;
    const void* base; void* out; int ldc; bf16_t* xn; const float* gain; float* ss;
    __device__ __forceinline__ void operator()(const f32x4 (&acc)[2][2][4][2], const Unit& u, int wr, int wc, int fr, int fq) const {
        const int row0 = u.po * BM + wr * 64 + fr, col0 = u.pn * BM + wc * 32 + 4 * fq;
        f32x4 gv[2][2];
#pragma unroll
        for (int bj = 0; bj < 2; ++bj)
#pragma unroll
            for (int n = 0; n < 2; ++n) gv[bj][n] = *(const f32x4*)(gain + col0 + bj * HALF + n * 16);
#pragma unroll
        for (int ai = 0; ai < 2; ++ai)
#pragma unroll
            for (int m = 0; m < 4; ++m) { const int row = row0 + ai * HALF + m * 16; const size_t off = (size_t)row * ldc + col0; float s = 0.f;
#pragma unroll
                for (int bj = 0; bj < 2; ++bj)
#pragma unroll
                    for (int n = 0; n < 2; ++n) { const f32x4 b = res_load<BB>(base, off + bj * HALF + n * 16); const f32x4 v = b + acc[ai][bj][m][n]; res_store<OB>(out, off + bj * HALF + n * 16, v);
                        s += (v[0] * v[0] + v[1] * v[1]) + (v[2] * v[2] + v[3] * v[3]); const f32x4 w = v * gv[bj][n];
                        *(u32x2v*)(xn + off + bj * HALF + n * 16) = (u32x2v){cvt_pk_bf16(w[0], w[1]), cvt_pk_bf16(w[2], w[3])}; }
                s += __shfl_xor(s, 16); s += __shfl_xor(s, 32);
                if (fq == 0) ss[(size_t)row * 16 + u.pn * 4 + wc] = s; }
    }
};
typedef EpiResNT<false, false> EpiResF32N;
__device__ __forceinline__ float row_rstd(const float* ss, int row, float inv_n, float eps) { if (!ss) return 1.0f;
    const f32x4* p = (const f32x4*)(ss + (size_t)row * 16); const f32x4 a = p[0], b = p[1], c = p[2], d = p[3];
    const float t = ((a[0] + a[1]) + (a[2] + a[3])) + ((b[0] + b[1]) + (b[2] + b[3])) + (((c[0] + c[1]) + (c[2] + c[3])) + ((d[0] + d[1]) + (d[2] + d[3])));
    return __builtin_amdgcn_rsqf(t * inv_n + eps); }
struct EpiBf16P {
    static constexpr bool PERM = true, AFTER_DRAIN = false;
    bf16_t* O; int ldc; int ntn; const float* ss; float inv_n;
    __device__ __forceinline__ void operator()(const f32x4 (&acc)[2][2][4][2], const Unit& u, int wr, int wc, int fr, int fq) const {
        const int row0 = u.po * BM + wr * 64 + fr, col0 = (u.pn % ntn) * BM + wc * 32 + 8 * fq;
#pragma unroll
        for (int ai = 0; ai < 2; ++ai)
#pragma unroll
            for (int m = 0; m < 4; ++m) { bf16_t* rowp = O + (size_t)(row0 + ai * HALF + m * 16) * ldc + col0; const float rs = row_rstd(ss, row0 + ai * HALF + m * 16, inv_n, 1e-6f);
#pragma unroll
                for (int bj = 0; bj < 2; ++bj) { const f32x4 v0 = acc[ai][bj][m][0] * rs, v1 = acc[ai][bj][m][1] * rs;
                    u32x4 w; w.x = cvt_pk_bf16(v0[0], v0[1]); w.y = cvt_pk_bf16(v0[2], v0[3]); w.z = cvt_pk_bf16(v1[0], v1[1]); w.w = cvt_pk_bf16(v1[2], v1[3]);
                    *(u32x4*)(rowp + bj * HALF) = w; } }
    }
};
__device__ __forceinline__ float silu_f(float x) { return x / (1.0f + __expf(-x)); }
struct EpiSwiGLU {
    static constexpr bool PERM = true, AFTER_DRAIN = false;
    bf16_t* H; int ldh; int ntn; const float* ss; float inv_n;
    __device__ __forceinline__ void operator()(const f32x4 (&acc)[2][2][4][2], const Unit& u, int wr, int wc, int fr, int fq) const {
        const int row0 = u.po * BM + wr * 64 + fr, col0 = (u.pn % ntn) * HALF + wc * 32 + 8 * fq;
#pragma unroll
        for (int ai = 0; ai < 2; ++ai)
#pragma unroll
            for (int m = 0; m < 4; ++m) { bf16_t* rowp = H + (size_t)(row0 + ai * HALF + m * 16) * ldh + col0;
                const float rs = row_rstd(ss, row0 + ai * HALF + m * 16, inv_n, 1e-6f);
                const f32x4 g0 = acc[ai][0][m][0] * rs, g1 = acc[ai][0][m][1] * rs, u0 = acc[ai][1][m][0] * rs, u1 = acc[ai][1][m][1] * rs;
                u32x4 w;
                w.x = cvt_pk_bf16(silu_f(g0[0]) * u0[0], silu_f(g0[1]) * u0[1]); w.y = cvt_pk_bf16(silu_f(g0[2]) * u0[2], silu_f(g0[3]) * u0[3]);
                w.z = cvt_pk_bf16(silu_f(g1[0]) * u1[0], silu_f(g1[1]) * u1[1]); w.w = cvt_pk_bf16(silu_f(g1[2]) * u1[2], silu_f(g1[3]) * u1[3]);
                *(u32x4*)rowp = w; }
    }
};
struct RangeOrder {
    int pm0, nM, pn0, nN, G, c;
    __device__ __forceinline__ bool next(int i, Unit& u) const { const int L = i * G + c; if (L >= nM * nN) return false; const int q = L / nM; u.pn = pn0 + q; u.pm = pm0 + (L - q * nM); u.po = u.pm; return true; }
    __device__ __forceinline__ void a_ready(const Unit&) const {}
    __device__ __forceinline__ void done(const Unit&) const {}
};

template <bool AROW> struct MoeOrder {
    const PG8_LAS int* te; int t0, n0, s0, t1, n1, s1, nN, G, c, nq, q;
    __device__ __forceinline__ bool next(int i, Unit& u) const { const int U = (n0 + n1) * nN; int L;
        if (c < nq) { if (i >= q) return false; L = c * q + i; } else L = nq * q + (c - nq) + i * (G - nq);
        if (L >= U) return false; const int ti = L / nN, pn = L - ti * nN;
        const int tile = ti < n0 ? t0 + ti : t1 + (ti - n0), slot = ti < n0 ? s0 + ti : s1 + (ti - n0); const int e = te[tile];
        u.pn = e * nN + pn; u.pm = AROW ? tile : slot; u.po = AROW ? slot : tile; return true; }
    __device__ __forceinline__ void a_ready(const Unit&) const {}
    __device__ __forceinline__ void done(const Unit&) const {}
};
template <class Epi, class Sched, bool ALIGN_EPI = false, bool SP2 = false>
__device__ __forceinline__ void gemm_phase(PG8_LAS unsigned char* lds, const Gemm g, const Sched& S, const Epi& E) {
    int tid_ = threadIdx.x; asm volatile("" : "+v"(tid_));
    const int tid = tid_, wid = __builtin_amdgcn_readfirstlane(tid >> 6), lane = tid & 63, wr = wid >> 2, wc = wid & 3, fr = lane & 15, fq = lane >> 4;
    const int K = g.K, nt = K / BK, lda = g.lda ? g.lda : K;
    unsigned voffA[2], voffB[2];
#pragma unroll
    for (int i = 0; i < 2; ++i) { int R, C; stage_rc(tid * 16 + i * 8192, R, C); const int Rb = Epi::PERM ? ((R & ~31) + perm32(R & 31)) : R;
        voffA[i] = (unsigned)(R * lda + C) * 2u; voffB[i] = (unsigned)(Rb * K + C) * 2u; }
    const size_t kstep = (size_t)(BK * 2);
    const size_t hstep = (size_t)HALF * K * 2, hstepA = (size_t)HALF * lda * 2;
    const size_t tstep = 2 * hstep, tstepA = 2 * hstepA;
    const unsigned ldsw = (unsigned)wid * 1024u;
    const int aoff = lds_byte(wr * 64 + fr, fq * 8), boff = lds_byte(wc * 32 + fr, fq * 8);
#define PG8_SA(b, h) (((b) * 2 + (h)) * HTB)
#define PG8_SB(b, h) ((4 + (b) * 2 + (h)) * HTB)
#define PG8_STAGE(bufoff, gbase, voff) do { _Pragma("unroll") for (int _i = 0; _i < 2; ++_i) \
        __builtin_amdgcn_global_load_lds((const unsigned*)((const char*)(gbase) + (voff)[_i]), (PG8_LAS unsigned*)(lds + (bufoff) + ldsw + _i * 8192), 16, 0, 0); } while (0)
#define PG8_LDA(dst, b, h) do { _Pragma("unroll") for (int m = 0; m < 4; ++m) _Pragma("unroll") for (int k = 0; k < 2; ++k) dst[m][k] = *(const PG8_LAS bf16x8*)(lds + PG8_SA(b, h) + aoff + m * 2048 + k * 1024); } while (0)
#define PG8_LDB(dst, b, h) do { _Pragma("unroll") for (int n = 0; n < 2; ++n) _Pragma("unroll") for (int k = 0; k < 2; ++k) dst[n][k] = *(const PG8_LAS bf16x8*)(lds + PG8_SB(b, h) + boff + n * 2048 + k * 1024); } while (0)
#define PG8_MMA(ai, bj, At, Bt) do { __builtin_amdgcn_s_setprio(1); _Pragma("unroll") for (int m = 0; m < 4; ++m) _Pragma("unroll") for (int n = 0; n < 2; ++n) _Pragma("unroll") for (int k = 0; k < 2; ++k) \
        acc[ai][bj][m][n] = __builtin_amdgcn_mfma_f32_16x16x32_bf16(Bt[n][k], At[m][k], acc[ai][bj][m][n], 0, 0, 0); __builtin_amdgcn_s_setprio(0); } while (0)
#define PG8_WAIT_V(n) asm volatile("s_waitcnt vmcnt(" #n ")" ::: "memory")
#define PG8_WAIT_L(n) asm volatile("s_waitcnt lgkmcnt(" #n ")" ::: "memory")
#define PG8_BAR __builtin_amdgcn_s_barrier()
#define PG8_SCHED __builtin_amdgcn_sched_barrier(0)
    Unit cur, nxt; int ui = 0;
    if (!S.next(0, cur)) return;
    f32x4 acc[2][2][4][2];
#pragma unroll
    for (int a = 0; a < 2; ++a)
#pragma unroll
        for (int b = 0; b < 2; ++b)
#pragma unroll
            for (int m = 0; m < 4; ++m)
#pragma unroll
                for (int n = 0; n < 2; ++n) acc[a][b][m][n] = (f32x4){0.f, 0.f, 0.f, 0.f};
    bf16x8 At[4][2], B0[2][2], B1[2][2];
    const char* cA = (const char*)g.A + (size_t)cur.pm * tstepA; const char* cB = (const char*)g.Bt + (size_t)cur.pn * tstep;
    S.a_ready(cur);
    if constexpr (SP2) {
        PG8_STAGE(PG8_SB(0, 0), cB, voffB); PG8_STAGE(PG8_SB(0, 1), cB + hstep, voffB); PG8_STAGE(PG8_SA(0, 0), cA, voffA); PG8_STAGE(PG8_SA(0, 1), cA + hstepA, voffA);
        if (wr == 1) PG8_BAR;
        PG8_WAIT_V(2); PG8_BAR;
        PG8_STAGE(PG8_SB(1, 0), cB + kstep, voffB); PG8_STAGE(PG8_SA(1, 0), cA + kstep, voffA); PG8_STAGE(PG8_SB(1, 1), cB + hstep + kstep, voffB);
        PG8_WAIT_V(6); PG8_BAR;
    } else {
        PG8_STAGE(PG8_SB(0, 0), cB, voffB); PG8_STAGE(PG8_SA(0, 0), cA, voffA); PG8_STAGE(PG8_SB(0, 1), cB + hstep, voffB); PG8_STAGE(PG8_SA(0, 1), cA + hstepA, voffA);
        if (wr == 1) PG8_BAR;
        PG8_WAIT_V(4); PG8_BAR;
        PG8_STAGE(PG8_SB(1, 0), cB + kstep, voffB); PG8_STAGE(PG8_SA(1, 0), cA + kstep, voffA); PG8_STAGE(PG8_SB(1, 1), cB + hstep + kstep, voffB);
        PG8_WAIT_V(6); PG8_BAR;
    }
    for (;;) {
        const bool has_next = S.next(ui + 1, nxt);
        const char* nA = has_next ? (const char*)g.A + (size_t)nxt.pm * tstepA : cA; const char* nB = has_next ? (const char*)g.Bt + (size_t)nxt.pn * tstep : cB;
        for (int t = 0; t < nt; t += 2) {
            const bool last = (t == nt - 2);
            const char* a1 = cA + (size_t)(t + 1) * kstep;
            const char* a2 = last ? nA : cA + (size_t)(t + 2) * kstep; const char* b2 = last ? nB : cB + (size_t)(t + 2) * kstep;
            const char* a3 = a2 + kstep; const char* b3 = b2 + kstep;
            if (last && has_next) S.a_ready(nxt);
            if constexpr (SP2) {
            PG8_LDB(B0, 0, 0); PG8_LDB(B1, 0, 1); PG8_SCHED; PG8_LDA(At, 0, 0); PG8_STAGE(PG8_SA(1, 1), a1 + hstepA, voffA);
            PG8_WAIT_V(8); PG8_WAIT_L(0); PG8_BAR; PG8_MMA(0, 0, At, B0); PG8_MMA(0, 1, At, B1); PG8_BAR; PG8_SCHED;
            PG8_LDA(At, 0, 1); PG8_STAGE(PG8_SB(0, 0), b2, voffB); PG8_STAGE(PG8_SB(0, 1), b2 + hstep, voffB); PG8_STAGE(PG8_SA(0, 0), a2, voffA);
            PG8_WAIT_V(8); PG8_WAIT_L(0); PG8_BAR; PG8_MMA(1, 0, At, B0); PG8_MMA(1, 1, At, B1); PG8_BAR; PG8_SCHED;
            PG8_LDB(B0, 1, 0); PG8_LDB(B1, 1, 1); PG8_SCHED; PG8_LDA(At, 1, 0); PG8_STAGE(PG8_SA(0, 1), a2 + hstepA, voffA);
            PG8_WAIT_V(8); PG8_WAIT_L(0); PG8_BAR; PG8_MMA(0, 0, At, B0); PG8_MMA(0, 1, At, B1); PG8_BAR; PG8_SCHED;
            PG8_LDA(At, 1, 1); PG8_STAGE(PG8_SB(1, 0), b3, voffB); PG8_STAGE(PG8_SB(1, 1), b3 + hstep, voffB); PG8_STAGE(PG8_SA(1, 0), a3, voffA);
            PG8_WAIT_V(8); PG8_WAIT_L(0); PG8_BAR; PG8_MMA(1, 0, At, B0); PG8_MMA(1, 1, At, B1); PG8_BAR; PG8_SCHED;
            } else {
            PG8_LDB(B0, 0, 0); PG8_SCHED; PG8_LDA(At, 0, 0); PG8_STAGE(PG8_SA(1, 1), a1 + hstepA, voffA);
            PG8_WAIT_L(8); PG8_BAR; PG8_WAIT_L(0); PG8_MMA(0, 0, At, B0); PG8_BAR; PG8_SCHED;
            PG8_LDB(B1, 0, 1); PG8_STAGE(PG8_SB(0, 0), b2, voffB);
            PG8_BAR; PG8_WAIT_L(0); PG8_MMA(0, 1, At, B1); PG8_BAR;
            PG8_LDA(At, 0, 1); PG8_STAGE(PG8_SA(0, 0), a2, voffA);
            PG8_BAR; PG8_WAIT_L(0); PG8_MMA(1, 0, At, B0); PG8_BAR; PG8_SCHED;
            PG8_STAGE(PG8_SB(0, 1), b2 + hstep, voffB);
            PG8_WAIT_V(6); PG8_BAR; PG8_MMA(1, 1, At, B1); PG8_BAR;
            PG8_LDB(B0, 1, 0); PG8_SCHED; PG8_LDA(At, 1, 0); PG8_STAGE(PG8_SA(0, 1), a2 + hstepA, voffA);
            PG8_WAIT_L(8); PG8_BAR; PG8_WAIT_L(0); PG8_MMA(0, 0, At, B0); PG8_BAR; PG8_SCHED;
            PG8_LDB(B1, 1, 1); PG8_STAGE(PG8_SB(1, 0), b3, voffB);
            PG8_BAR; PG8_WAIT_L(0); PG8_MMA(0, 1, At, B1); PG8_BAR;
            PG8_LDA(At, 1, 1); PG8_STAGE(PG8_SA(1, 0), a3, voffA);
            PG8_BAR; PG8_WAIT_L(0); PG8_MMA(1, 0, At, B0); PG8_BAR; PG8_SCHED;
            PG8_STAGE(PG8_SB(1, 1), b3 + hstep, voffB);
            PG8_WAIT_V(6); PG8_BAR; PG8_MMA(1, 1, At, B1); PG8_BAR;
            }
        }
        if constexpr (ALIGN_EPI) { if (wr == 0) PG8_BAR; }
        if constexpr (!Epi::AFTER_DRAIN) { E(acc, cur, wr, wc, fr, fq); S.done(cur); }
        if (!has_next) break;
#pragma unroll
        for (int a = 0; a < 2; ++a)
#pragma unroll
            for (int b = 0; b < 2; ++b)
#pragma unroll
                for (int m = 0; m < 4; ++m)
#pragma unroll
                    for (int n = 0; n < 2; ++n) acc[a][b][m][n] = (f32x4){0.f, 0.f, 0.f, 0.f};
        cur = nxt; cA = nA; cB = nB; ++ui;
        if constexpr (ALIGN_EPI) { if (wr == 1) PG8_BAR; }
    }
    PG8_WAIT_V(0);
    if constexpr (!ALIGN_EPI) { if (wr == 0) PG8_BAR; }
    PG8_BAR;
    if constexpr (Epi::AFTER_DRAIN) { E.fused(acc, cur, wr, wc, fr, fq, lds, wid, lane); S.done(cur); }
#undef PG8_SA
#undef PG8_SB
#undef PG8_STAGE
#undef PG8_LDA
#undef PG8_LDB
#undef PG8_MMA
#undef PG8_WAIT_V
#undef PG8_WAIT_L
#undef PG8_BAR
#undef PG8_SCHED
}
}

#define PROBE_KS 4
#define PROBE_YL 1.f
#define PROBE_NO_VP 0
#ifndef PROBE_REP
#define PROBE_REP 1
#endif
#ifndef MK_ONE_LAUNCH
#define MK_ONE_LAUNCH 1
#endif
constexpr int NWAVES = 8, NTHR = 512;
constexpr int BATCH = 2, SEQ = 8192, M = BATCH * SEQ, D = 1024;
constexpr int AH = 6, AW = 384;
constexpr int ZP = 2304;
constexpr int ZR = 0, ZK = 384, ZV = 768, ZWD = 1152, ZAD = 1184, ZGD = 1216, ZU = 1280, ZCV = 1536, ZCQ = 1792, ZCKV = 2048, ZKR = 2176;
constexpr int DFF = 2816, DFE = 3584, NE = 8;
constexpr int QKD = 96, QP = 576;
constexpr float EPS = 1e-6f;
constexpr int M2MAX = 2 * M + NE * 256;

constexpr size_t MiB = 1u << 20;
constexpr size_t WS_CTL = 0, CTL_ZERO_BYTES = 1 * MiB;
constexpr size_t WS_WIN = 1 * MiB, WS_WOUT = 10 * MiB, WS_WDGU = 14 * MiB, WS_WDD = 25 * MiB;
constexpr size_t WS_WSM = 31 * MiB;
constexpr size_t WS_XN = 33 * MiB, WS_VF = 65 * MiB, WS_TOK = 77 * MiB, WS_R = 79 * MiB;
constexpr size_t WSM_UQ = 0, WSM_UKV = WSM_UQ + 2 * 768 * 256 * 2, WSM_GW = WSM_UKV + 2 * 768 * 128 * 2, WSM_LW = WSM_GW + 2 * 4 * 128 * 128 * 2, WSM_LA = WSM_LW + 2 * AW * 32 * 2, WSM_LG = WSM_LA + 2 * AW * 32 * 2, WSM_VD = WSM_LG + 2 * AW * 64 * 2, WSM_END = WSM_VD + 16 * AW * 2;
constexpr size_t R_Z = 0, R_NAT = 72 * MiB, R_TR = 120 * MiB, R_QR = 168 * MiB, R_KVR = 192 * MiB, R_VG = 216 * MiB, R_BON = 240 * MiB, R_WL = 240 * MiB + 512 * 1024, R_NT = 241 * MiB, R_YL = 265 * MiB;
constexpr size_t R_Q = 289 * MiB, R_K = 307 * MiB, R_V = 325 * MiB;
constexpr size_t R_CHM = 0, R_CHR = 12 * MiB, R_CHS = 24 * MiB, R_OATT = 36 * MiB;
constexpr size_t R_RW = R_NAT, R_LW = R_NT, R_YRAW = R_YL;
constexpr int NCHUNK = BATCH * AH * (SEQ / 64);
constexpr size_t BLK = 4096;
constexpr size_t R_H = 0;
constexpr size_t WS_XB2LO = 14 * MiB, R_XB2HI = 56 * MiB;
constexpr size_t R_XB = 340 * MiB;
constexpr size_t R_XN2 = 100 * MiB;
constexpr size_t R_WMD = 0, R_WMGU = 72 * MiB;
constexpr size_t R_XNP = 184 * MiB, R_YP = R_XNP, R_HME = 252 * MiB;
constexpr int HMAIN = 64, HCAP = 71;
constexpr size_t WS_END = WS_R + 377 * MiB;
constexpr size_t RWSZ = (size_t)M * AW;
constexpr size_t TOK_E = 0, TOK_G = (size_t)M * 2 * 4, TOK_POS = (size_t)M * 4 * 4, TOK_SEG = (size_t)M * 6 * 4, TOK_TILE = TOK_SEG + 256 * 8 * 4;
constexpr int NSEG = 256, SEGT = M / NSEG;

constexpr int CW_BAR = 4096;
constexpr int CW_CQ = 40000;
constexpr size_t R_SS0 = 140 * MiB, R_SS1 = 120 * MiB;
constexpr int LDS_BYTES = 147456, RING_BYTES = 131072, MISC_OFF = RING_BYTES + 320;

#define GAS __attribute__((address_space(1)))
#define LAS __attribute__((address_space(3)))
typedef unsigned short bf16;
typedef unsigned v4u __attribute__((ext_vector_type(4)));
typedef unsigned v2u __attribute__((ext_vector_type(2)));
typedef float f32x4 __attribute__((ext_vector_type(4)));
typedef float f32x2 __attribute__((ext_vector_type(2)));
#define LDS_WAIT() asm volatile("s_waitcnt lgkmcnt(0)" ::: "memory")
#define VM_WAIT() asm volatile("s_waitcnt vmcnt(0)" ::: "memory")
typedef __bf16 bf16x2_hw __attribute__((ext_vector_type(2)));
__device__ __forceinline__ unsigned pk2(float lo, float hi) { const f32x2 v = {lo, hi}; return __builtin_bit_cast(unsigned, __builtin_convertvector(v, bf16x2_hw)); }
__device__ __forceinline__ unsigned f2bf(float f) { return pk2(f, 0.f) & 0xffffu; }
__device__ __forceinline__ float bf2f(bf16 b) { return __builtin_bit_cast(float, (unsigned)b << 16); }
__device__ __forceinline__ float bflo(unsigned w) { return __builtin_bit_cast(float, w << 16); }
__device__ __forceinline__ float bfhi(unsigned w) { return __builtin_bit_cast(float, w & 0xffff0000u); }
template <int CTRL> __device__ __forceinline__ float dpp_mov(float v) { return __builtin_bit_cast(float, __builtin_amdgcn_update_dpp(0, __builtin_bit_cast(int, v), CTRL, 0xf, 0xf, false)); }
__device__ __forceinline__ float wave_sum(float v) {
    v += dpp_mov<0xB1>(v);
    v += dpp_mov<0x4E>(v);
    v += dpp_mov<0x124>(v);
    v += dpp_mov<0x128>(v);
    const int vi = __builtin_bit_cast(int, v);
    const float r0 = __builtin_bit_cast(float, __builtin_amdgcn_readlane(vi, 0)), r1 = __builtin_bit_cast(float, __builtin_amdgcn_readlane(vi, 16));
    const float r2 = __builtin_bit_cast(float, __builtin_amdgcn_readlane(vi, 32)), r3 = __builtin_bit_cast(float, __builtin_amdgcn_readlane(vi, 48));
    return (r0 + r1) + (r2 + r3);
}
__device__ __forceinline__ float row16_sum(float v) {
    v += dpp_mov<0xB1>(v); v += dpp_mov<0x4E>(v); v += dpp_mov<0x124>(v); v += dpp_mov<0x128>(v); return v; }
__device__ __forceinline__ float sigmoid_f(float x) { return 1.0f / (1.0f + __expf(-x)); }
__device__ __forceinline__ float sigmoid_fast(float x) { return __builtin_amdgcn_rcpf(1.0f + __expf(-x)); }
__device__ __forceinline__ unsigned short f2bf_hw(float x) { typedef __bf16 bfx2 __attribute__((ext_vector_type(2))); const f32x2 v = {x, 0.f}; return (unsigned short)(__builtin_bit_cast(unsigned, __builtin_convertvector(v, bfx2)) & 0xffffu); }
__device__ __forceinline__ float gelu_erf(float x) { return 0.5f * x * (1.0f + erff(x * 0.70710678118654752f)); }

#define XB_TMO      128
#define XB_XCNT(j)  (256  + 64 * (j))
#define XB_XSUB(j)  (1280 + 64 * (j))
#define XB_XGEN(j)  (2304 + 64 * (j))
#define XB_TOP      3328
#define XB_TOPGEN   3392
#define XCD_BAR_WORDS 3456
#define XB_SPIN_CAP (1u << 18)

__device__ __forceinline__ unsigned xb_ld(unsigned* p)              { return __hip_atomic_load(p, __ATOMIC_RELAXED, __HIP_MEMORY_SCOPE_AGENT); }
__device__ __forceinline__ unsigned xb_add(unsigned* p, unsigned v) { return __hip_atomic_fetch_add(p, v, __ATOMIC_RELAXED, __HIP_MEMORY_SCOPE_AGENT); }
__device__ __forceinline__ unsigned xb_xcc_id() { return (unsigned)__builtin_amdgcn_s_getreg((3 << 11) | 20) & 0xFu; }
#define XB_SPIN(cond, bar) do { unsigned _sp = 0; while (cond) { __builtin_amdgcn_s_sleep(1); \
    if ((++_sp & 255u) == 0u) { if (xb_ld(&(bar)[XB_TMO])) break; if (_sp > XB_SPIN_CAP) { atomicAdd(&(bar)[XB_TMO], 1u); break; } } } } while (0)

struct XcdBarrier {
    unsigned* bar; unsigned x;
    volatile LAS unsigned* st;
};

__device__ __forceinline__ XcdBarrier xcd_barrier_post(unsigned* bar, volatile LAS unsigned* st) {
    XcdBarrier b; b.bar = bar; b.x = xb_xcc_id(); b.st = st;
    if (threadIdx.x == 0) (void)xb_add(&bar[XB_XCNT(b.x)], 1u);
    return b;
}
__device__ __forceinline__ void xcd_barrier_complete(unsigned* bar, unsigned x, unsigned& nloc, unsigned& nx) {
    const unsigned G = gridDim.x * gridDim.y * gridDim.z;
    unsigned sum, cnt, mine, sp = 0u;
    for (;;) {
        sum = 0u; cnt = 0u; mine = 0u;
#pragma unroll
        for (unsigned j = 0; j < 16; ++j) { const unsigned c = xb_ld(&bar[XB_XCNT(j)]); sum += c; cnt += (c > 0u) ? 1u : 0u; mine = (j == x) ? c : mine; }
        if (sum == G) break;
        __builtin_amdgcn_s_sleep(1);
        if ((++sp & 255u) == 0u) { if (xb_ld(&bar[XB_TMO])) break; if (sp > XB_SPIN_CAP) { atomicAdd(&bar[XB_TMO], 1u); break; } }
    }
    nloc = mine > 0u ? mine : 1u; nx = cnt > 0u ? cnt : 1u;
}

__device__ __forceinline__ void xcd_barrier(const XcdBarrier& b) {
    asm volatile("s_waitcnt vmcnt(0)" ::: "memory");
    __syncthreads();
    if (threadIdx.x == 0) {
        unsigned* bar = b.bar;
        __builtin_amdgcn_s_waitcnt(0);
        unsigned nloc = b.st[0], nx = b.st[1];
        if (nloc == 0u) { xcd_barrier_complete(bar, b.x, nloc, nx); b.st[0] = nloc; b.st[1] = nx; }
        const unsigned old = xb_add(&bar[XB_XSUB(b.x)], 1u);
        const unsigned gen = old / nloc;
        if (old + 1u == (gen + 1u) * nloc) {
            __builtin_amdgcn_fence(__ATOMIC_RELEASE, "agent");
            asm volatile("s_waitcnt vmcnt(0)" ::: "memory");
            const unsigned og = xb_add(&bar[XB_TOP], 1u);
            const unsigned tg = og / nx;
            if (og + 1u == (tg + 1u) * nx) xb_add(&bar[XB_TOPGEN], 1u);
            else XB_SPIN(xb_ld(&bar[XB_TOPGEN]) == tg, bar);
            __builtin_amdgcn_fence(__ATOMIC_ACQUIRE, "agent");
            xb_add(&bar[XB_XGEN(b.x)], 1u);
            asm volatile("s_waitcnt vmcnt(0)" ::: "memory");
        } else {
            XB_SPIN(xb_ld(&bar[XB_XGEN(b.x)]) == gen, bar);
            __builtin_amdgcn_fence(__ATOMIC_ACQUIRE, "agent");
            asm volatile("s_waitcnt vmcnt(0)" ::: "memory");
        }
    }
    __syncthreads();
}


struct Args { const float* in[39]; float* out; unsigned char* ws; int ph_lo, ph_hi; };
enum { I_X = 0, I_POS, I_MIXG, I_WIN, I_MU, I_W0, I_WUP, I_A0, I_AUP, I_GUP, I_KK, I_KA, I_RK, I_LNG, I_LNB, I_V0, I_VDN, I_VUP,
       I_QNG, I_WUQ, I_KVNG, I_WUKV, I_QHG, I_KHG, I_BOG, I_CLNG, I_CLNB, I_CWS, I_CBS, I_COG, I_WOUT, I_FFNG, I_DWG, I_DWU, I_DWD, I_ROUTER, I_MWG, I_MWU, I_MWD };

constexpr int ARGS_OFF = RING_BYTES + 4096;
struct Ctx {
    LAS unsigned char* lds; int tid, lane, wave, bid, nb, gw, ngw;
    GAS unsigned char* ws; GAS unsigned char* R;
    __device__ __forceinline__ unsigned long long ptr_(int k) const { unsigned off = ARGS_OFF + 8 * k; asm volatile("" : "+v"(off));
        const volatile LAS unsigned* p = (const volatile LAS unsigned*)(lds + off);
        const unsigned lo = __builtin_amdgcn_readfirstlane(p[0]), hi = __builtin_amdgcn_readfirstlane(p[1]); return ((unsigned long long)hi << 32) | lo; }
    __device__ __forceinline__ const GAS float* in(int k) const { return (const GAS float*)ptr_(k); }
    __device__ __forceinline__ GAS float* out() const { return (GAS float*)ptr_(39); }
};

__device__ __forceinline__ void conv_item(const GAS float* W, int K, int N, GAS bf16* WT, int n0, int drow0, int k0, LAS float* scr, int lane, const GAS float* gk = nullptr) {
#pragma unroll 8
    for (int i = 0; i < 32; ++i) { const int kk = 2 * i + (lane >> 5); scr[kk * 33 + (lane & 31)] = W[(size_t)(k0 + kk) * N + n0 + (lane & 31)] * (gk ? gk[k0 + kk] : 1.0f); }
    LDS_WAIT(); asm volatile("" ::: "memory");
    const int c = lane & 7;
#pragma unroll
    for (int j = 0; j < 4; ++j) { const int n = (lane >> 3) + 8 * j; const LAS float* s = scr + (8 * c) * 33 + n;
        v4u o; o.x = pk2(s[0 * 33], s[1 * 33]); o.y = pk2(s[2 * 33], s[3 * 33]); o.z = pk2(s[4 * 33], s[5 * 33]); o.w = pk2(s[6 * 33], s[7 * 33]);
        *(GAS v4u*)(WT + (size_t)(drow0 + n) * K + k0 + 8 * c) = o; }
    LDS_WAIT(); asm volatile("" ::: "memory");
}
template <int MAP> __device__ __forceinline__ int conv_row(int n0) {
    if (MAP == 1) return n0 < 1280 ? n0 : (n0 < 1696 ? n0 - 1280 + ZCQ : n0 - 1696 + ZU);
    if (MAP == 2) return (n0 >> 7) * 256 + (n0 & 127);
    if (MAP == 3) return (n0 >> 7) * 256 + 128 + (n0 & 127);
    if (MAP == 4) return (n0 / QKD) * 128 + (n0 % QKD);
    return n0;
}
struct CJ { const GAS float* W; GAS bf16* WT; const GAS float* gk; int K, N, n0, drow0, k0; };
__device__ __forceinline__ void conv_load(const CJ& j, float (&r)[32], int lane) {
#pragma unroll
    for (int i = 0; i < 32; ++i) r[i] = __builtin_nontemporal_load(j.W + (size_t)(j.k0 + 2 * i + (lane >> 5)) * j.N + j.n0 + (lane & 31));
}
__device__ __forceinline__ void conv_finish(const CJ& j, const float (&r)[32], LAS float* scr, int lane) {
#pragma unroll
    for (int i = 0; i < 32; ++i) { const int kk = 2 * i + (lane >> 5); scr[kk * 33 + (lane & 31)] = r[i] * (j.gk ? j.gk[j.k0 + kk] : 1.0f); }
    LDS_WAIT(); asm volatile("" ::: "memory");
    const int cq = lane & 7;
#pragma unroll
    for (int q = 0; q < 4; ++q) { const int n = (lane >> 3) + 8 * q; const LAS float* p = scr + (8 * cq) * 33 + n;
        v4u o; o.x = pk2(p[0 * 33], p[1 * 33]); o.y = pk2(p[2 * 33], p[3 * 33]); o.z = pk2(p[4 * 33], p[5 * 33]); o.w = pk2(p[6 * 33], p[7 * 33]);
        *(GAS v4u*)(j.WT + (size_t)(j.drow0 + n) * j.K + j.k0 + 8 * cq) = o; }
    LDS_WAIT(); asm volatile("" ::: "memory");
}
template <class JobFn> __device__ __forceinline__ void conv_run(const Ctx& c, int total, const JobFn& job, int gw, int ngw) {
    LAS float* scr = (LAS float*)(c.lds + c.wave * 8704);
    float ra[32], rb[32];
    int it = gw;
    if (it < total) conv_load(job(it), ra, c.lane);
    for (; it < total; it += 2 * ngw) {
        const int it2 = it + ngw, it3 = it2 + ngw;
        if (it2 < total) conv_load(job(it2), rb, c.lane);
        conv_finish(job(it), ra, scr, c.lane);
        if (it3 < total) conv_load(job(it3), ra, c.lane);
        if (it2 < total) conv_finish(job(it2), rb, scr, c.lane);
    }
}
__device__ __forceinline__ CJ conv_mk(const GAS float* W, GAS bf16* WT, const GAS float* gk, int K, int N, int r, int map) {
    const int nblk = N / 32, kb = r / nblk, nbk = r - kb * nblk, n0 = 32 * nbk; CJ j; j.W = W; j.WT = WT; j.gk = gk; j.K = K; j.N = N; j.n0 = n0; j.k0 = 64 * kb;
    j.drow0 = map == 1 ? conv_row<1>(n0) : map == 2 ? conv_row<2>(n0) : map == 3 ? conv_row<3>(n0) : map == 4 ? conv_row<4>(n0) : n0; return j;
}
struct StaticJobsA { const Ctx* c;
    static constexpr int N_WIN = 16 * 69, N_UQ = 4 * 18, N_UKV = 2 * 24, PER_L = N_WIN + N_UQ + N_UKV, TOTAL = 2 * PER_L;
    __device__ __forceinline__ CJ operator()(int it) const { const Ctx& cx = *c; const int l = it / PER_L; int r = it - l * PER_L;
        if (r < N_WIN) return conv_mk(cx.in(I_WIN) + (size_t)l * D * 2208, (GAS bf16*)(cx.ws + WS_WIN) + (size_t)l * ZP * D, nullptr, D, 2208, r, 1); r -= N_WIN;
        if (r < N_UQ) return conv_mk(cx.in(I_WUQ) + (size_t)l * 256 * QP, (GAS bf16*)(cx.ws + WS_WSM + WSM_UQ) + (size_t)l * 768 * 256, cx.in(I_QNG) + l * 256, 256, QP, r, 4); r -= N_UQ;
        return conv_mk(cx.in(I_WUKV) + (size_t)l * 128 * 768, (GAS bf16*)(cx.ws + WS_WSM + WSM_UKV) + (size_t)l * 768 * 128, cx.in(I_KVNG) + l * 128, 128, 768, r, 0); }
};
struct StaticJobsB { const Ctx* c;
    static constexpr int N_WOUT = 16 * 32, N_DG = 16 * 88, N_DD = 44 * 32, TOTAL = 2 * N_WOUT + 2 * N_DG + N_DD;
    __device__ __forceinline__ CJ operator()(int it) const { const Ctx& cx = *c; int r = it;
        if (r < 2 * N_WOUT) { const int l = r / N_WOUT; return conv_mk(cx.in(I_WOUT) + (size_t)l * D * D, (GAS bf16*)(cx.ws + WS_WOUT) + (size_t)l * D * D, nullptr, D, D, r - l * N_WOUT, 0); } r -= 2 * N_WOUT;
        if (r < N_DG) return conv_mk(cx.in(I_DWG), (GAS bf16*)(cx.ws + WS_WDGU), nullptr, D, DFF, r, 2); r -= N_DG;
        if (r < N_DG) return conv_mk(cx.in(I_DWU), (GAS bf16*)(cx.ws + WS_WDGU), nullptr, D, DFF, r, 3); r -= N_DG;
        return conv_mk(cx.in(I_DWD), (GAS bf16*)(cx.ws + WS_WDD), nullptr, DFF, D, r, 0); }
};
__device__ __forceinline__ void phase_conv_b(const Ctx& c) {
    const int nfull = (M / 256) * (ZP / 256) - 2 * c.nb;
    if (nfull <= 0 || nfull >= c.nb) { StaticJobsB J{&c}; conv_run(c, StaticJobsB::TOTAL, J, c.gw, c.ngw); return; }
    if (c.bid < nfull) return;
    StaticJobsB J{&c}; conv_run(c, StaticJobsB::TOTAL, J, (c.bid - nfull) * NWAVES + c.wave, (c.nb - nfull) * NWAVES);
}
struct ExpertGUJobs { const Ctx* c;
    static constexpr int PER = 16 * 112, TOTAL = NE * 2 * PER;
    __device__ __forceinline__ CJ operator()(int it) const { const Ctx& cx = *c; const int j = it / PER, r = it - j * PER, e = j >> 1, kind = j & 1;
        return conv_mk((kind ? cx.in(I_MWU) : cx.in(I_MWG)) + (size_t)e * D * DFE, (GAS bf16*)(cx.R + R_WMGU) + (size_t)e * 2 * DFE * D, nullptr, D, DFE, r, 2 + kind); }
};
struct ExpertDJobs { const Ctx* c;
    static constexpr int PER = 56 * 32, TOTAL = NE * PER;
    __device__ __forceinline__ CJ operator()(int it) const { const Ctx& cx = *c; const int e = it / PER, r = it - e * PER;
        return conv_mk(cx.in(I_MWD) + (size_t)e * DFE * D, (GAS bf16*)(cx.R + R_WMD) + (size_t)e * D * DFE, nullptr, DFE, D, r, 0); }
};
template <class JobFn> __device__ __forceinline__ void conv_pop(const Ctx& c, GAS unsigned* head, int total, const JobFn& job, GAS unsigned* stop_ctr, unsigned stop_at) {
    LAS float* scr = (LAS float*)(c.lds + c.wave * 8704); LAS int* pb = (LAS int*)(c.lds + RING_BYTES + 12288);
    for (;;) {
        __syncthreads();
        if (c.tid == 0) { const bool stop = stop_ctr && __hip_atomic_load(stop_ctr, __ATOMIC_RELAXED, __HIP_MEMORY_SCOPE_AGENT) >= stop_at;
            pb[0] = stop ? total : (int)__hip_atomic_fetch_add(head, 16u, __ATOMIC_RELAXED, __HIP_MEMORY_SCOPE_AGENT); }
        __syncthreads();
        const int base = pb[0]; if (base >= total) break;
        const int i0 = base + c.wave, i1 = base + 8 + c.wave;
        float ra[32], rb[32];
        if (i0 < total) conv_load(job(i0), ra, c.lane);
        if (i1 < total) conv_load(job(i1), rb, c.lane);
        if (i0 < total) conv_finish(job(i0), ra, scr, c.lane);
        if (i1 < total) conv_finish(job(i1), rb, scr, c.lane);
    }
}

__device__ __forceinline__ void phase_conv_static(const Ctx& c) {
    StaticJobsA J{&c}; conv_run(c, StaticJobsA::TOTAL, J, c.gw, c.ngw);
    for (int l = 0; l < 2; ++l) {
        GAS bf16* win = (GAS bf16*)(c.ws + WS_WIN) + (size_t)l * ZP * D;
        for (int i = c.bid * NTHR + c.tid; i < 96 * D / 8; i += c.nb * NTHR) ((GAS v4u*)(win + (size_t)2208 * D))[i] = (v4u){0u, 0u, 0u, 0u};
        GAS bf16* uq = (GAS bf16*)(c.ws + WS_WSM + WSM_UQ) + (size_t)l * 768 * 256;
        { GAS bf16* lw_ = (GAS bf16*)(c.ws + WS_WSM + WSM_LW) + (size_t)l * AW * 32; GAS bf16* la_ = (GAS bf16*)(c.ws + WS_WSM + WSM_LA) + (size_t)l * AW * 32; GAS bf16* lg_ = (GAS bf16*)(c.ws + WS_WSM + WSM_LG) + (size_t)l * AW * 64;
          const GAS float* sw = c.in(I_WUP) + (size_t)l * 32 * AW; const GAS float* sa = c.in(I_AUP) + (size_t)l * 32 * AW; const GAS float* sg = c.in(I_GUP) + (size_t)l * 64 * AW;
          for (int i = c.bid * NTHR + c.tid; i < AW * 32; i += c.nb * NTHR) { const int ch = i >> 5, kq = i & 31; lw_[i] = (bf16)f2bf(sw[kq * AW + ch]); la_[i] = (bf16)f2bf(sa[kq * AW + ch]); }
          for (int i = c.bid * NTHR + c.tid; i < AW * 64; i += c.nb * NTHR) { const int ch = i >> 6, kq = i & 63; lg_[i] = (bf16)f2bf(sg[kq * AW + ch]); }
          if (l == 1) { GAS bf16* vdt = (GAS bf16*)(c.ws + WS_WSM + WSM_VD); const GAS float* sv = c.in(I_VDN); for (int i = c.bid * NTHR + c.tid; i < 16 * AW; i += c.nb * NTHR) { const int j = i / AW, cx = i % AW; vdt[i] = (bf16)f2bf(sv[cx * 16 + j]); } } }
        { const GAS float* wsrc = c.in(I_CWS) + (size_t)l * 4 * 128 * 128; GAS bf16* wdst = (GAS bf16*)(c.ws + WS_WSM + WSM_GW) + (size_t)l * 4 * 128 * 128;
          for (int i = c.bid * NTHR + c.tid; i < 4 * 128 * 128 / 2; i += c.nb * NTHR) { const int e0 = 2 * i, tq = (e0 >> 7) & 127, sq = e0 & 127; const f32x2 w = *(const GAS f32x2*)(wsrc + e0);
              ((GAS unsigned*)wdst)[i] = pk2(sq <= tq ? w.x : 0.f, sq + 1 <= tq ? w.y : 0.f); } }
        for (int i = c.bid * NTHR + c.tid; i < AH * 32 * 256 / 8; i += c.nb * NTHR) { const int r = i / 32, cc8 = i % 32; ((GAS v4u*)(uq + (size_t)((r / 32) * 128 + 96 + (r % 32)) * 256))[cc8] = (v4u){0u, 0u, 0u, 0u}; }
    }
}
__device__ __forceinline__ void phase_conv_experts(const Ctx& c) {
    ExpertGUJobs JG{&c}; conv_pop(c, (GAS unsigned*)(c.ws + WS_CTL) + CW_CQ, ExpertGUJobs::TOTAL, JG, nullptr, 0u);
    __syncthreads();
    ExpertDJobs JD{&c}; conv_run(c, ExpertDJobs::TOTAL, JD, c.gw, c.ngw); }

template <bool ROUTER> __device__ __forceinline__ void phase_rmsnorm(const Ctx& c, const GAS float* x, const GAS float* g, GAS bf16* xn, const GAS float* router) {
    LAS float* rl = (LAS float*)c.lds;
    if (ROUTER) { for (int i = c.tid; i < D * NE / 4; i += NTHR) { const f32x4 r = ((const GAS f32x4*)router)[i]; const int d = i >> 1, e4 = (i & 1) * 4; rl[(e4 + 0) * D + d] = r.x; rl[(e4 + 1) * D + d] = r.y; rl[(e4 + 2) * D + d] = r.z; rl[(e4 + 3) * D + d] = r.w; } __syncthreads(); }
    const int i16 = c.lane & 15, g16 = c.lane >> 4;
    f32x4 gv[16];
#pragma unroll
    for (int k = 0; k < 16; ++k) gv[k] = *(const GAS f32x4*)(g + 64 * k + 4 * i16);
    LAS int* sel = (LAS int*)(c.lds + 32768);
    GAS int* segc = (GAS int*)(c.ws + WS_TOK + TOK_SEG);
    for (int sg = ROUTER ? c.bid : 0; sg < (ROUTER ? NSEG : 1); sg += ROUTER ? c.nb : 1) {
    const int m0 = ROUTER ? sg * SEGT + c.wave * 8 : c.gw * 4, mstep = ROUTER ? 4 : c.ngw * 4, mend = ROUTER ? m0 + 8 : M;
    for (int mb = m0; mb < mend; mb += mstep) {
        const int m = mb + g16;
        f32x4 v[16]; float ss = 0.f;
        if (ROUTER) {
            const GAS bf16* xb = m < M / 2 ? (const GAS bf16*)(c.ws + WS_XB2LO) + (size_t)m * D : (const GAS bf16*)(c.R + R_XB2HI) + (size_t)(m - M / 2) * D;
#pragma unroll
            for (int k = 0; k < 16; ++k) { const v2u w = *(const GAS v2u*)(xb + 64 * k + 4 * i16); v[k] = (f32x4){bflo(w.x), bfhi(w.x), bflo(w.y), bfhi(w.y)}; }
        } else {
#pragma unroll
        for (int k = 0; k < 16; ++k) v[k] = *(const GAS f32x4*)(x + (size_t)m * D + 64 * k + 4 * i16);
        }
#pragma unroll
        for (int k = 0; k < 16; ++k) ss += (v[k].x * v[k].x + v[k].y * v[k].y) + (v[k].z * v[k].z + v[k].w * v[k].w);
        const float rstd = __builtin_amdgcn_rsqf(row16_sum(ss) * (1.0f / D) + EPS);
#pragma unroll
        for (int k = 0; k < 16; ++k) { v[k] = v[k] * rstd * gv[k]; *(GAS v2u*)(xn + (size_t)m * D + 64 * k + 4 * i16) = (v2u){pk2(v[k].x, v[k].y), pk2(v[k].z, v[k].w)}; }
        if (ROUTER) {
            float lg[8];
#pragma unroll
            for (int e = 0; e < 8; ++e) lg[e] = 0.f;
#pragma unroll
            for (int k = 0; k < 16; ++k)
#pragma unroll
                for (int e = 0; e < 8; ++e) { const f32x4 r = *(const LAS f32x4*)(rl + e * D + 64 * k + 4 * i16); lg[e] += (v[k].x * r.x + v[k].y * r.y) + (v[k].z * r.z + v[k].w * r.w); }
#pragma unroll
            for (int e = 0; e < 8; ++e) lg[e] = row16_sum(lg[e]);
            if (i16 == 0) {
                int e0 = 0; float v0 = lg[0];
#pragma unroll
                for (int e = 1; e < 8; ++e) if (lg[e] > v0) { v0 = lg[e]; e0 = e; }
                int e1 = -1; float v1 = -INFINITY;
#pragma unroll
                for (int e = 0; e < 8; ++e) if (e != e0 && lg[e] > v1) { v1 = lg[e]; e1 = e; }
                const float p1 = 1.0f / (1.0f + __expf(v0 - v1)), p0 = 1.0f - p1;
                GAS int* te = (GAS int*)(c.ws + WS_TOK + TOK_E); GAS float* tg = (GAS float*)(c.ws + WS_TOK + TOK_G);
                te[2 * m] = e0; te[2 * m + 1] = e1; tg[2 * m] = p0; tg[2 * m + 1] = p1;
                sel[2 * (m - sg * SEGT)] = e0; sel[2 * (m - sg * SEGT) + 1] = e1;
            }
        }
    }
    if (ROUTER) {
        __syncthreads();
        if (c.wave == 0) { const int e0 = sel[2 * c.lane], e1 = sel[2 * c.lane + 1];
#pragma unroll
            for (int e = 0; e < NE; ++e) { const unsigned long long b0 = __ballot(e0 == e), b1 = __ballot(e1 == e); if (c.lane == 0) segc[sg * NE + e] = __popcll(b0) + __popcll(b1); } }
        __syncthreads();
    }
    }
}

__device__ __forceinline__ float zsh(const GAS bf16* Z, int m, int s, int col, float mu) {
    const float cur = bf2f(Z[(size_t)m * ZP + col]); const float prev = s > 0 ? bf2f(Z[(size_t)(m - 1) * ZP + col]) : 0.f; return cur + (prev - cur) * mu;
}
__device__ __forceinline__ void phase_rwkv_prep(const Ctx& c, int l) {
    const GAS bf16* Z = (const GAS bf16*)(c.R + R_Z);
    GAS bf16* RW = (GAS bf16*)(c.R + R_RW); GAS float* LW = (GAS float*)(c.R + R_LW); GAS bf16* VF = (GAS bf16*)(c.ws + WS_VF);
    const GAS float* mu = c.in(I_MU) + l * 1280; const GAS float* w0 = c.in(I_W0) + l * AW; const GAS float* wup = c.in(I_WUP) + (size_t)l * 32 * AW;
    const GAS float* a0 = c.in(I_A0) + l * AW; const GAS float* aup = c.in(I_AUP) + (size_t)l * 32 * AW; const GAS float* gup = c.in(I_GUP) + (size_t)l * 64 * AW;
    const GAS float* kkw = c.in(I_KK) + l * AW; const GAS float* kaw = c.in(I_KA) + l * AW;
    const GAS float* v0 = c.in(I_V0); const GAS float* vdn = c.in(I_VDN); const GAS float* vup = c.in(I_VUP);
    LAS float* sm = (LAS float*)c.lds;
    LAS float* vs = sm + 8 * 128;
    LAS float* vd = vs + 8 * 384;
    const int t = c.tid;
    for (int grp = c.bid; grp < M / 8; grp += c.nb) {
        const int m0 = grp * 8;
        float r[8], k[8], v[8];
        if (t < AW) {
            const float mr = mu[ZR + t], mk = mu[ZK + t], mv = mu[ZV + t];
#pragma unroll
            for (int q = 0; q < 8; ++q) { const int m = m0 + q, s = m % SEQ; r[q] = zsh(Z, m, s, ZR + t, mr); k[q] = zsh(Z, m, s, ZK + t, mk); v[q] = zsh(Z, m, s, ZV + t, mv); }
        } else {
            const int j = t - AW; const float mj = mu[ZWD + j];
#pragma unroll
            for (int q = 0; q < 8; ++q) { const int m = m0 + q, s = m % SEQ; float x = zsh(Z, m, s, ZWD + j, mj);
                if (j < 32) x = tanhf(x); else if (j >= 64) x = sigmoid_f(x);
                sm[q * 128 + j] = x; }
        }
        __syncthreads();
        float wa[8], aa[8], ga[8];
        if (t < AW) {
#pragma unroll
            for (int q = 0; q < 8; ++q) { wa[q] = 0.f; aa[q] = 0.f; ga[q] = 0.f; }
            for (int j = 0; j < 32; ++j) { const float ww = wup[j * AW + t], au = aup[j * AW + t];
#pragma unroll
                for (int q = 0; q < 8; ++q) { wa[q] += sm[q * 128 + j] * ww; aa[q] += sm[q * 128 + 32 + j] * au; } }
            for (int j = 0; j < 64; ++j) { const float gu = gup[j * AW + t];
#pragma unroll
                for (int q = 0; q < 8; ++q) ga[q] += sm[q * 128 + 64 + j] * gu; }
            if (l > 0) {
#pragma unroll
                for (int q = 0; q < 8; ++q) vs[q * AW + t] = v[q];
            }
        }
        __syncthreads();
        if (l > 0) {
            if (t < 128) { const int q = t >> 4, j = t & 15; float s = 0.f; for (int cc = 0; cc < AW; ++cc) s += vs[q * AW + cc] * vdn[cc * 16 + j]; vd[q * 16 + j] = s; }
            __syncthreads();
        }
        if (t < AW) {
            const float w0t = w0[t], a0t = a0[t], kkt = kkw[t], kat = kaw[t];
#pragma unroll
            for (int q = 0; q < 8; ++q) { const int m = m0 + q; const size_t o = (size_t)m * AW + t;
                const float xw = -(w0t + wa[q]);
                const float sp = xw > 20.f ? xw : log1pf(__expf(xw));
                const float lw = -__expf(-sp - 0.5f);
                const float av = sigmoid_f(a0t + aa[q]);
                float vv = v[q];
                if (l > 0) { float x = v0[t];
#pragma unroll
                    for (int j = 0; j < 16; ++j) x += vd[q * 16 + j] * vup[j * AW + t];
                    const float vf = bf2f(VF[o]); vv = vv + (vf - vv) * sigmoid_f(x); }
                else VF[o] = (bf16)f2bf(vv);
                float kk = k[q] * kkt; const float ss = wave_sum(kk * kk); kk = kk / fmaxf(sqrtf(ss), 1e-12f);
                const float k2 = k[q] * (1.0f + (av - 1.0f) * kat);
                RW[0 * RWSZ + o] = (bf16)f2bf(r[q]); RW[1 * RWSZ + o] = (bf16)f2bf(k2); RW[2 * RWSZ + o] = (bf16)f2bf(vv); RW[3 * RWSZ + o] = (bf16)f2bf(kk);
                RW[4 * RWSZ + o] = (bf16)f2bf(av); RW[5 * RWSZ + o] = (bf16)f2bf(ga[q]); LW[o] = lw; }
        }
        __syncthreads();
    }
}

__device__ __forceinline__ void phase_rwkv_scan_naive(const Ctx& c) {
    const GAS bf16* RW = (const GAS bf16*)(c.R + R_RW); const GAS float* LW = (const GAS float*)(c.R + R_LW); GAS float* YRAW = (GAS float*)(c.R + R_YRAW);
    constexpr int CH = 32;
    LAS float* sr = (LAS float*)c.lds;
    LAS float* sw = sr + CH * 64; LAS float* skk = sw + CH * 64; LAS float* sb = skk + CH * 64; LAS float* sk2 = sb + CH * 64; LAS float* sv = sk2 + CH * 64; LAS float* sy = sv + CH * 64;
    const int t = c.tid, vrow = t >> 3, kq = t & 7;
    for (int item = c.bid; item < BATCH * AH; item += c.nb) {
        const int b = item / AH, h = item % AH;
        float st[8];
#pragma unroll
        for (int i = 0; i < 8; ++i) st[i] = 0.f;
        for (int s0 = 0; s0 < SEQ; s0 += CH) {
            __syncthreads();
#pragma unroll
            for (int q = 0; q < 4; ++q) { const int e = t + q * NTHR, ts = e >> 6, ch = e & 63; const size_t o = (size_t)(b * SEQ + s0 + ts) * AW + h * 64 + ch;
                const float kk = bf2f(RW[3 * RWSZ + o]), av = bf2f(RW[4 * RWSZ + o]);
                sr[e] = bf2f(RW[0 * RWSZ + o]); sw[e] = __expf(LW[o]); skk[e] = kk; sb[e] = kk * av; sk2[e] = bf2f(RW[1 * RWSZ + o]); sv[e] = bf2f(RW[2 * RWSZ + o]); }
            __syncthreads();
            for (int ts = 0; ts < CH; ++ts) {
                const int o = ts * 64 + kq * 8; float p = 0.f;
#pragma unroll
                for (int i = 0; i < 8; ++i) p += st[i] * skk[o + i];
                p += __shfl_xor(p, 1); p += __shfl_xor(p, 2); p += __shfl_xor(p, 4);
                const float sa = -p, vv = sv[ts * 64 + vrow]; float y = 0.f;
#pragma unroll
                for (int i = 0; i < 8; ++i) { st[i] = st[i] * sw[o + i] + sa * sb[o + i] + vv * sk2[o + i]; y += st[i] * sr[o + i]; }
                y += __shfl_xor(y, 1); y += __shfl_xor(y, 2); y += __shfl_xor(y, 4);
                if (kq == 0) sy[ts * 64 + vrow] = y;
            }
            __syncthreads();
#pragma unroll
            for (int q = 0; q < 4; ++q) { const int e = t + q * NTHR, ts = e >> 6, ch = e & 63; YRAW[(size_t)(b * SEQ + s0 + ts) * AW + h * 64 + ch] = sy[e]; }
        }
        __syncthreads();
    }
}

__device__ __forceinline__ void phase_rwkv_post(const Ctx& c, int l) {
    const GAS bf16* RW = (const GAS bf16*)(c.R + R_RW); const GAS float* YRAW = (const GAS float*)(c.R + R_YRAW); GAS bf16* YC = (GAS bf16*)(c.ws + WS_XN);
    const GAS float* lng = c.in(I_LNG) + l * AW; const GAS float* lnb = c.in(I_LNB) + l * AW; const GAS float* rk = c.in(I_RK) + l * AW;
    for (int it = c.gw; it < M * AH; it += c.ngw) {
        const int m = it / AH, h = it % AH, ch = h * 64 + c.lane; const size_t o = (size_t)m * AW + ch;
        const float y = YRAW[o]; const float mean = wave_sum(y) * (1.0f / 64.0f); const float d = y - mean; const float var = wave_sum(d * d) * (1.0f / 64.0f);
        const float yn = d * (__builtin_amdgcn_rsqf(var + 64e-5f)) * lng[ch] + lnb[ch];
        const float r = bf2f(RW[0 * RWSZ + o]), k2 = bf2f(RW[1 * RWSZ + o]), v = bf2f(RW[2 * RWSZ + o]), g = bf2f(RW[5 * RWSZ + o]);
        const float bonus = wave_sum(r * k2 * rk[ch]);
        YC[(size_t)m * D + ch] = (bf16)f2bf((yn + bonus * v) * g);
    }
}

__device__ __forceinline__ int vt_pos(int kap) { return 8 * ((kap >> 2) & 1) + 4 * (kap >> 3) + (kap & 3); }

typedef short bf16x8 __attribute__((ext_vector_type(8)));
typedef float f32x16 __attribute__((ext_vector_type(16)));
typedef __bf16 bf16x2_t __attribute__((ext_vector_type(2)));
__device__ __forceinline__ unsigned cvtpk(float lo, float hi) { const f32x2 v = {lo, hi}; const bf16x2_t b = __builtin_convertvector(v, bf16x2_t); return __builtin_bit_cast(unsigned, b); }
__device__ __forceinline__ bf16x8 pack8(const f32x16& a, int s8) {
    v4u t; t.x = cvtpk(a[s8], a[s8 + 1]); t.y = cvtpk(a[s8 + 2], a[s8 + 3]); t.z = cvtpk(a[s8 + 4], a[s8 + 5]); t.w = cvtpk(a[s8 + 6], a[s8 + 7]); return __builtin_bit_cast(bf16x8, t);
}
#define MFMA32(a, b, c) __builtin_amdgcn_mfma_f32_32x32x16_bf16(a, b, c, 0, 0, 0)
__device__ __forceinline__ float keep_neg(float x, int d) { return __builtin_bit_cast(float, __builtin_bit_cast(unsigned, x) & (unsigned)(d >> 31)); }
__device__ __forceinline__ float keep_zero(float x, int d) { return __builtin_bit_cast(float, __builtin_bit_cast(unsigned, x) & ~(unsigned)((d | -d) >> 31)); }
__device__ __forceinline__ f32x16 zero16() { f32x16 z;
#pragma unroll
    for (int r = 0; r < 16; ++r) z[r] = 0.f;
    return z; }

__device__ __forceinline__ void phase_rwkv_prep2(const Ctx& c, int l) {
    const GAS bf16* Z = (const GAS bf16*)(c.R + R_Z);
    GAS bf16* NAT = (GAS bf16*)(c.R + R_NAT); GAS bf16* TR = (GAS bf16*)(c.R + R_TR); GAS bf16* VN = (GAS bf16*)(c.R + R_VG); GAS bf16* GN = VN + (size_t)M * AW; GAS float* BON = (GAS float*)(c.R + R_BON); GAS float* WL = (GAS float*)(c.R + R_WL); GAS bf16* VF = (GAS bf16*)(c.ws + WS_VF);
    const GAS float* mu = c.in(I_MU) + l * 1280; const GAS float* w0 = c.in(I_W0) + l * AW; const GAS float* wup = c.in(I_WUP) + (size_t)l * 32 * AW;
    const GAS float* a0 = c.in(I_A0) + l * AW; const GAS float* aup = c.in(I_AUP) + (size_t)l * 32 * AW; const GAS float* gup = c.in(I_GUP) + (size_t)l * 64 * AW;
    const GAS float* kkw = c.in(I_KK) + l * AW; const GAS float* kaw = c.in(I_KA) + l * AW; const GAS float* rkw = c.in(I_RK) + l * AW;
    const GAS float* v0 = c.in(I_V0); const GAS float* vdn = c.in(I_VDN); const GAS float* vup = c.in(I_VUP);
    LAS float* sm = (LAS float*)c.lds;
    LAS float* vs = sm + 8 * 128;
    LAS float* vd = vs + 8 * 384;
    const int t = c.tid;
    constexpr size_t ASZ = (size_t)NCHUNK * BLK;
    for (int item = c.bid; item < M / 64; item += c.nb) {
        const int b = item / (SEQ / 64), cc = item % (SEQ / 64);
        const int hh = t >> 6, c64 = t & 63; const size_t cbo = ((size_t)((b * AH + hh) * (SEQ / 64) + cc)) * BLK;
        float cum = 0.f;
        for (int grp = 0; grp < 8; ++grp) {
            const int m0 = item * 64 + grp * 8;
            float r[8], k[8], v[8];
            if (t < AW) {
                const float mr = mu[ZR + t], mk = mu[ZK + t], mv = mu[ZV + t];
#pragma unroll
                for (int q = 0; q < 8; ++q) { const int m = m0 + q, s = m % SEQ; r[q] = zsh(Z, m, s, ZR + t, mr); k[q] = zsh(Z, m, s, ZK + t, mk); v[q] = zsh(Z, m, s, ZV + t, mv); }
            } else {
                const int j = t - AW; const float mj = mu[ZWD + j];
#pragma unroll
                for (int q = 0; q < 8; ++q) { const int m = m0 + q, s = m % SEQ; float x = zsh(Z, m, s, ZWD + j, mj);
                    if (j < 32) x = tanhf(x); else if (j >= 64) x = sigmoid_f(x);
                    sm[q * 128 + j] = x; }
            }
            __syncthreads();
            float wa[8], aa[8], ga[8];
            if (t < AW) {
#pragma unroll
                for (int q = 0; q < 8; ++q) { wa[q] = 0.f; aa[q] = 0.f; ga[q] = 0.f; }
                for (int j = 0; j < 32; ++j) { const float ww = wup[j * AW + t], au = aup[j * AW + t];
#pragma unroll
                    for (int q = 0; q < 8; ++q) { wa[q] += sm[q * 128 + j] * ww; aa[q] += sm[q * 128 + 32 + j] * au; } }
                for (int j = 0; j < 64; ++j) { const float gu = gup[j * AW + t];
#pragma unroll
                    for (int q = 0; q < 8; ++q) ga[q] += sm[q * 128 + 64 + j] * gu; }
                if (l > 0) {
#pragma unroll
                    for (int q = 0; q < 8; ++q) vs[q * AW + t] = v[q];
                }
            }
            __syncthreads();
            if (l > 0) {
                if (t < 128) { const int q = t >> 4, j = t & 15; float s = 0.f; for (int cx = 0; cx < AW; ++cx) s += vs[q * AW + cx] * vdn[cx * 16 + j]; vd[q * 16 + j] = s; }
                __syncthreads();
            }
            if (t < AW) {
                const float w0t = w0[t], a0t = a0[t], kkt = kkw[t], kat = kaw[t], rkt = rkw[t];
                unsigned short ta[8], tv[8], tb[8], tk[8];
#pragma unroll
                for (int q = 0; q < 8; ++q) { const int m = m0 + q; const size_t o = (size_t)m * AW + t;
                    const float xw = -(w0t + wa[q]);
                    const float sp = xw > 20.f ? xw : log1pf(__expf(xw));
                    const float lw = -__expf(-sp - 0.5f);
                    const float av = sigmoid_f(a0t + aa[q]);
                    float vv = v[q];
                    if (l > 0) { float x = v0[t];
#pragma unroll
                        for (int j = 0; j < 16; ++j) x += vd[q * 16 + j] * vup[j * AW + t];
                        const float vf = bf2f(VF[o]); vv = vv + (vf - vv) * sigmoid_f(x); }
                    else VF[o] = (bf16)f2bf(vv);
                    float kk = k[q] * kkt; const float ss = wave_sum(kk * kk); kk = kk / fmaxf(sqrtf(ss), 1e-12f);
                    const float k2 = k[q] * (1.0f + (av - 1.0f) * kat);
                    const float rq = bf2f((bf16)f2bf(r[q])), k2q = bf2f((bf16)f2bf(k2));
                    const float bon = wave_sum(rq * k2q * rkt);
                    if (c64 == 0) BON[(size_t)m * AH + hh] = bon;
                    VN[o] = (bf16)f2bf(vv); GN[o] = (bf16)f2bf(ga[q]);
                    const float cprev = cum; cum += lw;
                    const float ep = __expf(cum), en = __expf(-cum), epv = __expf(cprev);
                    const int tt = grp * 8 + q; const size_t no = cbo + (size_t)tt * 64 + c64;
                    const unsigned short xa = (unsigned short)f2bf(-kk * epv), xb = (unsigned short)f2bf(kk * av * en), xk = (unsigned short)f2bf(k2 * en);
                    NAT[0 * ASZ + no] = xa; NAT[1 * ASZ + no] = (bf16)f2bf(r[q] * ep); NAT[2 * ASZ + no] = xb; NAT[3 * ASZ + no] = xk;
                    ta[q] = xa; tv[q] = (unsigned short)f2bf(vv); tb[q] = xb; tk[q] = xk; }
                const int p1 = 16 * (grp >> 1) + 4 * (grp & 1); const size_t to = cbo + (size_t)c64 * 64 + p1;
                *(GAS v2u*)(TR + 0 * ASZ + to) = (v2u){(unsigned)ta[0] | ((unsigned)ta[1] << 16), (unsigned)ta[2] | ((unsigned)ta[3] << 16)}; *(GAS v2u*)(TR + 0 * ASZ + to + 8) = (v2u){(unsigned)ta[4] | ((unsigned)ta[5] << 16), (unsigned)ta[6] | ((unsigned)ta[7] << 16)};
                *(GAS v2u*)(TR + 1 * ASZ + to) = (v2u){(unsigned)tv[0] | ((unsigned)tv[1] << 16), (unsigned)tv[2] | ((unsigned)tv[3] << 16)}; *(GAS v2u*)(TR + 1 * ASZ + to + 8) = (v2u){(unsigned)tv[4] | ((unsigned)tv[5] << 16), (unsigned)tv[6] | ((unsigned)tv[7] << 16)};
                *(GAS v2u*)(TR + 2 * ASZ + to) = (v2u){(unsigned)tb[0] | ((unsigned)tb[1] << 16), (unsigned)tb[2] | ((unsigned)tb[3] << 16)}; *(GAS v2u*)(TR + 2 * ASZ + to + 8) = (v2u){(unsigned)tb[4] | ((unsigned)tb[5] << 16), (unsigned)tb[6] | ((unsigned)tb[7] << 16)};
                *(GAS v2u*)(TR + 3 * ASZ + to) = (v2u){(unsigned)tk[0] | ((unsigned)tk[1] << 16), (unsigned)tk[2] | ((unsigned)tk[3] << 16)}; *(GAS v2u*)(TR + 3 * ASZ + to + 8) = (v2u){(unsigned)tk[4] | ((unsigned)tk[5] << 16), (unsigned)tk[6] | ((unsigned)tk[7] << 16)};
            }
            __syncthreads();
        }
        if (t < AW) WL[(cbo >> 12) * 64 + c64] = __expf(cum);
    }
}


typedef float f32x4v __attribute__((ext_vector_type(4)));
__device__ __forceinline__ void phase_rwkv_prep3(const Ctx& c, int l) {
    const GAS bf16* Z = (const GAS bf16*)(c.R + R_Z);
    GAS bf16* NAT = (GAS bf16*)(c.R + R_NAT); GAS bf16* TR = (GAS bf16*)(c.R + R_TR); GAS bf16* VN = (GAS bf16*)(c.R + R_VG); GAS bf16* GN = VN + (size_t)M * AW; GAS float* BON = (GAS float*)(c.R + R_BON); GAS float* WL = (GAS float*)(c.R + R_WL); GAS bf16* VF = (GAS bf16*)(c.ws + WS_VF);
    const GAS float* mu = c.in(I_MU) + l * 1280; const GAS float* w0 = c.in(I_W0) + l * AW; const GAS float* a0 = c.in(I_A0) + l * AW;
    const GAS float* kkw = c.in(I_KK) + l * AW; const GAS float* kaw = c.in(I_KA) + l * AW; const GAS float* rkw = c.in(I_RK) + l * AW;
    const GAS float* v0 = c.in(I_V0); const GAS float* vdn = c.in(I_VDN); const GAS float* vup = c.in(I_VUP);
    const GAS bf16* LWt = (const GAS bf16*)(c.ws + WS_WSM + WSM_LW) + (size_t)l * AW * 32; const GAS bf16* LAt = (const GAS bf16*)(c.ws + WS_WSM + WSM_LA) + (size_t)l * AW * 32; const GAS bf16* LGt = (const GAS bf16*)(c.ws + WS_WSM + WSM_LG) + (size_t)l * AW * 64;
    constexpr int SP = 136;
    LAS unsigned short* sm = (LAS unsigned short*)c.lds;
    LAS float* lora = (LAS float*)(c.lds + 8192);
    LAS unsigned short* vs = (LAS unsigned short*)(lora + 3 * 16 * AW);
    LAS float* vd = (LAS float*)(vs + 16 * 392);
    const GAS bf16* VDt = (const GAS bf16*)(c.ws + WS_WSM + WSM_VD);
    const int t = c.tid, lane = c.lane;
    constexpr size_t ASZ = (size_t)NCHUNK * BLK;
    for (int item = c.bid; item < M / 64; item += c.nb) {
        const int b = item / (SEQ / 64), cc = item % (SEQ / 64);
        const int hh = c.wave < 6 ? c.wave : c.wave - 2, c64 = lane, tc = hh * 64 + lane, qlo = c.wave >= 6 ? 8 : 0, qhi = (c.wave == 4 || c.wave == 5) ? 8 : 16;
        const size_t cbo = ((size_t)((b * AH + hh) * (SEQ / 64) + cc)) * BLK;
        float cum = 0.f;
        for (int grp = 0; grp < 4; ++grp) {
            const int m0 = item * 64 + grp * 16;
            if (t < AW) {
                if (l > 0) { const float mv = mu[ZV + t];
#pragma unroll 4
                    for (int q = 0; q < 16; ++q) { const int m = m0 + q, s = m % SEQ; vs[q * 392 + t] = (unsigned short)f2bf(zsh(Z, m, s, ZV + t, mv)); } }
            } else {
                const int j = t - AW; const float mj = mu[ZWD + j];
                float zt[17]; const int s0_ = m0 % SEQ;
#pragma unroll
                for (int q = 0; q < 17; ++q) zt[q] = bf2f(Z[(size_t)(m0 + q - 1 + ((q == 0 && s0_ == 0) ? 1 : 0)) * ZP + ZWD + j]);
                if (s0_ == 0) zt[0] = 0.f;
#pragma unroll
                for (int q = 0; q < 16; ++q) { float x = zt[q + 1] + (zt[q] - zt[q + 1]) * mj;
                    const float ex = __expf(j < 32 ? 2.0f * x : -x), rc = 1.0f / (1.0f + ex);
                    x = j < 32 ? 1.0f - 2.0f * rc : (j >= 64 ? rc : x);
                    sm[q * SP + j] = (unsigned short)f2bf(x); }
            }
            __syncthreads();
            {
                const int row = lane & 15, kq = lane >> 4;
                const bf16x8 aw = *(const LAS bf16x8*)(sm + row * SP + 8 * kq), aa = *(const LAS bf16x8*)(sm + row * SP + 32 + 8 * kq), ag0 = *(const LAS bf16x8*)(sm + row * SP + 64 + 8 * kq), ag1 = *(const LAS bf16x8*)(sm + row * SP + 96 + 8 * kq);
#pragma unroll
                for (int i = 0; i < 3; ++i) { const int ch = 16 * (3 * c.wave + i) + row;
                    f32x4v dw = {0.f, 0.f, 0.f, 0.f}, da = dw, dg = dw;
                    dw = __builtin_amdgcn_mfma_f32_16x16x32_bf16(aw, *(const GAS bf16x8*)(LWt + ch * 32 + 8 * kq), dw, 0, 0, 0);
                    da = __builtin_amdgcn_mfma_f32_16x16x32_bf16(aa, *(const GAS bf16x8*)(LAt + ch * 32 + 8 * kq), da, 0, 0, 0);
                    dg = __builtin_amdgcn_mfma_f32_16x16x32_bf16(ag0, *(const GAS bf16x8*)(LGt + ch * 64 + 8 * kq), dg, 0, 0, 0);
                    dg = __builtin_amdgcn_mfma_f32_16x16x32_bf16(ag1, *(const GAS bf16x8*)(LGt + ch * 64 + 32 + 8 * kq), dg, 0, 0, 0);
#pragma unroll
                    for (int rr = 0; rr < 4; ++rr) { const int tq = 4 * kq + rr; lora[(0 * 16 + tq) * AW + ch] = dw[rr]; lora[(1 * 16 + tq) * AW + ch] = da[rr]; lora[(2 * 16 + tq) * AW + ch] = dg[rr]; } }
                if (l > 0 && c.wave == 7) {
                    f32x4v dv = {0.f, 0.f, 0.f, 0.f}; bf16x8 vbf[12];
#pragma unroll
                    for (int ks = 0; ks < 12; ++ks) vbf[ks] = *(const GAS bf16x8*)(VDt + row * AW + 32 * ks + 8 * kq);
#pragma unroll
                    for (int ks = 0; ks < 12; ++ks) dv = __builtin_amdgcn_mfma_f32_16x16x32_bf16(*(const LAS bf16x8*)(vs + row * 392 + 32 * ks + 8 * kq), vbf[ks], dv, 0, 0, 0);
#pragma unroll
                    for (int rr = 0; rr < 4; ++rr) vd[(4 * kq + rr) * 16 + row] = dv[rr]; }
            }
            __syncthreads();

            {
                const float w0t = w0[tc], a0t = a0[tc], kkt = kkw[tc], kat = kaw[tc], rkt = rkw[tc], mr = mu[ZR + tc], mk = mu[ZK + tc], mv = mu[ZV + tc];
                unsigned short ta[16], tv[16], tb[16], tk[16];
                float vupr[16], vfin[16]; float v0t = 0.f;
#pragma unroll
                for (int j = 0; j < 16; ++j) { vupr[j] = 0.f; vfin[j] = 0.f; }
                if (l > 0) { v0t = v0[tc];
                    unsigned short vfr[16];
#pragma unroll
                    for (int j = 0; j < 16; ++j) { vupr[j] = vup[j * AW + tc]; vfr[j] = VF[(size_t)(m0 + j) * AW + tc]; }
#pragma unroll
                    for (int j = 0; j < 16; ++j) vfin[j] = bf2f(vfr[j]); }
                float rin[16], kin[16], vin[16];
                { float zr_[17], zk_[17], zv_[17]; const int s0_ = m0 % SEQ;
#pragma unroll
                  for (int q = 0; q < 17; ++q) { const size_t zo = (size_t)(m0 + q - 1 + ((q == 0 && s0_ == 0) ? 1 : 0)) * ZP;
                      zr_[q] = bf2f(Z[zo + ZR + tc]); zk_[q] = bf2f(Z[zo + ZK + tc]); zv_[q] = bf2f(Z[zo + ZV + tc]); }
                  if (s0_ == 0) { zr_[0] = 0.f; zk_[0] = 0.f; zv_[0] = 0.f; }
#pragma unroll
                  for (int q = 0; q < 16; ++q) { rin[q] = zr_[q + 1] + (zr_[q] - zr_[q + 1]) * mr; kin[q] = zk_[q + 1] + (zk_[q] - zk_[q + 1]) * mk; vin[q] = zv_[q + 1] + (zv_[q] - zv_[q + 1]) * mv;
                  } }
#pragma unroll
                for (int q = 0; q < 16; ++q) { const int m = m0 + q; const size_t o = (size_t)m * AW + tc;
                    const float rv = rin[q], kv = kin[q], vv0 = vin[q];
                    const float xw = -(w0t + lora[(0 * 16 + q) * AW + tc]);
                    const float sp = xw > 20.f ? xw : __logf(1.0f + __expf(xw));
                    const float lw = -__expf(-sp - 0.5f);
                    const float cprev = cum; cum += lw;
                    if (q >= qlo && q < qhi) {
                    const float av = sigmoid_fast(a0t + lora[(1 * 16 + q) * AW + tc]);
                    float vv = vv0;
                    if (l > 0) { float x = v0t;
#pragma unroll
                        for (int j = 0; j < 16; ++j) x += vd[q * 16 + j] * vupr[j];
                        const float vf = vfin[q]; vv = vv + (vf - vv) * sigmoid_fast(x); }
                    else VF[o] = f2bf_hw(vv);
                    float kk = kv * kkt; const float ss = wave_sum(kk * kk); kk = kk * __builtin_amdgcn_rsqf(fmaxf(ss, 1e-24f));
                    const float k2 = kv * (1.0f + (av - 1.0f) * kat);
                    const float rq = bf2f(f2bf_hw(rv)), k2q = bf2f(f2bf_hw(k2));
                    const float bon = wave_sum(rq * k2q * rkt);
                    if (c64 == 0) BON[(size_t)m * AH + hh] = bon;
                    VN[o] = f2bf_hw(vv); GN[o] = f2bf_hw(lora[(2 * 16 + q) * AW + tc]);
                    const float ep = __expf(cum), en = __expf(-cum), epv = __expf(cprev);
                    const int tt = grp * 16 + q; const size_t no = cbo + (size_t)tt * 64 + c64;
                    const unsigned short xa = f2bf_hw(-kk * epv), xb = f2bf_hw(kk * av * en), xk = f2bf_hw(k2 * en);
                    NAT[0 * ASZ + no] = xa; NAT[1 * ASZ + no] = f2bf_hw(rv * ep); NAT[2 * ASZ + no] = xb; NAT[3 * ASZ + no] = xk;
                    ta[q] = xa; tv[q] = f2bf_hw(vv); tb[q] = xb; tk[q] = xk; } }
                const size_t to = cbo + (size_t)c64 * 64 + 16 * grp;
#define PK2(a, i, j) ((unsigned)a[i] | ((unsigned)a[j] << 16))
#define TRST(x, a) do { if (qlo == 0) { *(GAS v2u*)(TR + (x) * ASZ + to) = (v2u){PK2(a, 0, 1), PK2(a, 2, 3)}; *(GAS v2u*)(TR + (x) * ASZ + to + 8) = (v2u){PK2(a, 4, 5), PK2(a, 6, 7)}; } \
                        if (qhi == 16) { *(GAS v2u*)(TR + (x) * ASZ + to + 4) = (v2u){PK2(a, 8, 9), PK2(a, 10, 11)}; *(GAS v2u*)(TR + (x) * ASZ + to + 12) = (v2u){PK2(a, 12, 13), PK2(a, 14, 15)}; } } while (0)
                TRST(0, ta); TRST(1, tv); TRST(2, tb); TRST(3, tk);
#undef TRST
#undef PK2
            }
            __syncthreads();
        }
        if (c.wave < 6) WL[(cbo >> 12) * 64 + c64] = __expf(cum);
    }
}

__device__ __forceinline__ void phase_rwkv_prep4(const Ctx& c, int l) {
    const GAS bf16* Z = (const GAS bf16*)(c.R + R_Z);
    GAS bf16* NAT = (GAS bf16*)(c.R + R_NAT); GAS bf16* TR = (GAS bf16*)(c.R + R_TR); GAS bf16* VN = (GAS bf16*)(c.R + R_VG); GAS bf16* GN = VN + (size_t)M * AW; GAS float* BON = (GAS float*)(c.R + R_BON); GAS float* WL = (GAS float*)(c.R + R_WL); GAS bf16* VF = (GAS bf16*)(c.ws + WS_VF);
    const GAS float* mu = c.in(I_MU) + l * 1280; const GAS float* w0 = c.in(I_W0) + l * AW; const GAS float* a0 = c.in(I_A0) + l * AW;
    const GAS float* kkw = c.in(I_KK) + l * AW; const GAS float* kaw = c.in(I_KA) + l * AW; const GAS float* rkw = c.in(I_RK) + l * AW;
    const GAS float* v0 = c.in(I_V0); const GAS float* vdn = c.in(I_VDN); const GAS float* vup = c.in(I_VUP);
    const GAS bf16* LWt = (const GAS bf16*)(c.ws + WS_WSM + WSM_LW) + (size_t)l * AW * 32; const GAS bf16* LAt = (const GAS bf16*)(c.ws + WS_WSM + WSM_LA) + (size_t)l * AW * 32; const GAS bf16* LGt = (const GAS bf16*)(c.ws + WS_WSM + WSM_LG) + (size_t)l * AW * 64;
    constexpr int SP = 136;
    LAS unsigned short* sm = (LAS unsigned short*)c.lds;
    LAS float* lora = (LAS float*)(c.lds + 8192);
    LAS unsigned short* vs = (LAS unsigned short*)(lora + 3 * 16 * AW);
    LAS float* vd = (LAS float*)(vs + 16 * 392);
    const GAS bf16* VDt = (const GAS bf16*)(c.ws + WS_WSM + WSM_VD);
    const int t = c.tid, lane = c.lane;
    constexpr size_t ASZ = (size_t)NCHUNK * BLK;
    for (int item = c.bid; item < M / 64; item += c.nb) {
        const int b = item / (SEQ / 64), cc = item % (SEQ / 64);
        const int p3 = c.wave % 3, hf = c.wave / 3, hh = 2 * p3 + (lane >> 5), c2 = 2 * (lane & 31), tc = hh * 64 + c2;
        const unsigned cbo = (unsigned)(((b * AH + hh) * (SEQ / 64) + cc) * BLK);
        f32x2 cum = {0.f, 0.f};
        for (int grp = 0; grp < 4; ++grp) {
            const int m0 = item * 64 + grp * 16;
            if (t < AW) {
                if (l > 0) { const float mv = mu[ZV + t];
#pragma unroll 4
                    for (int q = 0; q < 16; ++q) { const int m = m0 + q, s = m % SEQ; vs[q * 392 + t] = (unsigned short)f2bf(zsh(Z, m, s, ZV + t, mv)); } }
            } else {
                const int j = t - AW; const float mj = mu[ZWD + j];
                float zt[17]; const int s0_ = m0 % SEQ;
#pragma unroll
                for (int q = 0; q < 17; ++q) zt[q] = bf2f(Z[(size_t)(m0 + q - 1 + ((q == 0 && s0_ == 0) ? 1 : 0)) * ZP + ZWD + j]);
                if (s0_ == 0) zt[0] = 0.f;
#pragma unroll
                for (int q = 0; q < 16; ++q) { float x = zt[q + 1] + (zt[q] - zt[q + 1]) * mj;
                    const float ex = __expf(j < 32 ? 2.0f * x : -x), rc = 1.0f / (1.0f + ex);
                    x = j < 32 ? 1.0f - 2.0f * rc : (j >= 64 ? rc : x);
                    sm[q * SP + j] = (unsigned short)f2bf(x); }
            }
            __syncthreads();
            {
                const int row = lane & 15, kq = lane >> 4;
                const bf16x8 aw = *(const LAS bf16x8*)(sm + row * SP + 8 * kq), aa = *(const LAS bf16x8*)(sm + row * SP + 32 + 8 * kq), ag0 = *(const LAS bf16x8*)(sm + row * SP + 64 + 8 * kq), ag1 = *(const LAS bf16x8*)(sm + row * SP + 96 + 8 * kq);
#pragma unroll
                for (int i = 0; i < 3; ++i) { const int ch = 16 * (3 * c.wave + i) + row;
                    f32x4v dw = {0.f, 0.f, 0.f, 0.f}, da = dw, dg = dw;
                    dw = __builtin_amdgcn_mfma_f32_16x16x32_bf16(aw, *(const GAS bf16x8*)(LWt + ch * 32 + 8 * kq), dw, 0, 0, 0);
                    da = __builtin_amdgcn_mfma_f32_16x16x32_bf16(aa, *(const GAS bf16x8*)(LAt + ch * 32 + 8 * kq), da, 0, 0, 0);
                    dg = __builtin_amdgcn_mfma_f32_16x16x32_bf16(ag0, *(const GAS bf16x8*)(LGt + ch * 64 + 8 * kq), dg, 0, 0, 0);
                    dg = __builtin_amdgcn_mfma_f32_16x16x32_bf16(ag1, *(const GAS bf16x8*)(LGt + ch * 64 + 32 + 8 * kq), dg, 0, 0, 0);
#pragma unroll
                    for (int rr = 0; rr < 4; ++rr) { const int tq = 4 * kq + rr; lora[(0 * 16 + tq) * AW + ch] = dw[rr]; lora[(1 * 16 + tq) * AW + ch] = da[rr]; lora[(2 * 16 + tq) * AW + ch] = dg[rr]; } }
                if (l > 0 && c.wave == 7) {
                    f32x4v dv = {0.f, 0.f, 0.f, 0.f}; bf16x8 vbf[12];
#pragma unroll
                    for (int ks = 0; ks < 12; ++ks) vbf[ks] = *(const GAS bf16x8*)(VDt + row * AW + 32 * ks + 8 * kq);
#pragma unroll
                    for (int ks = 0; ks < 12; ++ks) dv = __builtin_amdgcn_mfma_f32_16x16x32_bf16(*(const LAS bf16x8*)(vs + row * 392 + 32 * ks + 8 * kq), vbf[ks], dv, 0, 0, 0);
#pragma unroll
                    for (int rr = 0; rr < 4; ++rr) vd[(4 * kq + rr) * 16 + row] = dv[rr]; }
            }
            __syncthreads();

            if (c.wave < 6) {
#define LD2(p) (*(const GAS f32x2*)(p))
                const f32x2 w0t = LD2(w0 + tc), a0t = LD2(a0 + tc), kkt = LD2(kkw + tc), kat = LD2(kaw + tc), rkt = LD2(rkw + tc), mr = LD2(mu + ZR + tc), mk = LD2(mu + ZK + tc), mv = LD2(mu + ZV + tc);
                const int Q0 = 8 * hf, s0_ = (m0 + Q0) % SEQ; const bool pz = s0_ == 0;
                unsigned zr_[9], zk_[9], zv_[9], vfr[8];
#pragma unroll
                for (int q = 0; q < 9; ++q) { const size_t zo = (size_t)(m0 + Q0 + q - 1 + ((q == 0 && pz) ? 1 : 0)) * ZP + tc;
                    zr_[q] = *(const GAS unsigned*)(Z + zo + ZR); zk_[q] = *(const GAS unsigned*)(Z + zo + ZK); zv_[q] = *(const GAS unsigned*)(Z + zo + ZV); }
#pragma unroll
                for (int j = 0; j < 8; ++j) vfr[j] = 0u;
                f32x2 sgv[8];
#pragma unroll
                for (int j = 0; j < 8; ++j) sgv[j] = (f32x2){0.f, 0.f};
                if (l > 0) {
                    f32x2 vupr[16]; const f32x2 v0t = LD2(v0 + tc);
#pragma unroll
                    for (int j = 0; j < 16; ++j) vupr[j] = LD2(vup + j * AW + tc);
#pragma unroll
                    for (int j = 0; j < 8; ++j) vfr[j] = *(const GAS unsigned*)(VF + (size_t)(m0 + Q0 + j) * AW + tc);
#pragma unroll
                    for (int q8 = 0; q8 < 8; ++q8) { f32x2 x = v0t; const LAS f32x4* vq4 = (const LAS f32x4*)(vd + (Q0 + q8) * 16);
#pragma unroll
                        for (int j4 = 0; j4 < 4; ++j4) { const f32x4 d4 = vq4[j4]; x += vupr[4 * j4] * d4.x; x += vupr[4 * j4 + 1] * d4.y; x += vupr[4 * j4 + 2] * d4.z; x += vupr[4 * j4 + 3] * d4.w; }
                        sgv[q8] = (f32x2){sigmoid_fast(x.x), sigmoid_fast(x.y)}; } }
#undef LD2
                if (pz) { zr_[0] = 0u; zk_[0] = 0u; zv_[0] = 0u; }
                f32x2 cumv[9];
#pragma unroll
                for (int q = 0; q < 16; ++q) { const f32x2 lo2 = *(const LAS f32x2*)(lora + (0 * 16 + q) * AW + tc); f32x2 lw;
#pragma unroll
                    for (int e = 0; e < 2; ++e) { const float xw = -(w0t[e] + lo2[e]); const float sp = xw > 20.f ? xw : __logf(1.0f + __expf(xw)); lw[e] = -__expf(-sp - 0.5f); }
                    if (q >= Q0 && q < Q0 + 8) cumv[q & 7] = cum;
                    cum += lw;
                    if (q == Q0 + 7) cumv[8] = cum; }
                const unsigned to = cbo + (unsigned)c2 * 64 + 16 * grp;
#define LO2(a, i, j) (((a)[i] & 0xffffu) | ((a)[j] << 16))
#define HI2(a, i, j) (((a)[i] >> 16) | ((a)[j] & 0xffff0000u))
#pragma unroll
                for (int h4 = 0; h4 < 2; ++h4) {
                    unsigned xa_[4], xv_[4], xb_[4], xk_[4];
#pragma unroll
                    for (int u = 0; u < 4; ++u) { const int q8 = 4 * h4 + u, q = Q0 + q8; const unsigned mo = (unsigned)(m0 + q) * AW + tc;
                        const f32x2 pr = {bflo(zr_[q8]), bfhi(zr_[q8])}, cr = {bflo(zr_[q8 + 1]), bfhi(zr_[q8 + 1])}, pk = {bflo(zk_[q8]), bfhi(zk_[q8])}, ck = {bflo(zk_[q8 + 1]), bfhi(zk_[q8 + 1])};
                        const f32x2 pv = {bflo(zv_[q8]), bfhi(zv_[q8])}, cv = {bflo(zv_[q8 + 1]), bfhi(zv_[q8 + 1])};
                        const f32x2 rv = cr + (pr - cr) * mr, kv = ck + (pk - ck) * mk, vv0 = cv + (pv - cv) * mv;
                        const f32x2 la2 = *(const LAS f32x2*)(lora + (1 * 16 + q) * AW + tc), lg2 = *(const LAS f32x2*)(lora + (2 * 16 + q) * AW + tc);
                        const f32x2 av = {sigmoid_fast(a0t.x + la2.x), sigmoid_fast(a0t.y + la2.y)};
                        f32x2 vv = vv0;
                        if (l > 0) { const f32x2 vf = {bflo(vfr[q8]), bfhi(vfr[q8])}; vv = vv + (vf - vv) * sgv[q8]; }
                        else *(GAS unsigned*)(VF + mo) = pk2(vv.x, vv.y);
                        f32x2 kk = kv * kkt; float ss = row16_sum(kk.x * kk.x + kk.y * kk.y);
                        ss += __builtin_bit_cast(float, __builtin_amdgcn_ds_swizzle(__builtin_bit_cast(int, ss), 0x401F));
                        kk = kk * __builtin_amdgcn_rsqf(fmaxf(ss, 1e-24f));
                        const f32x2 k2 = kv * (1.0f + (av - 1.0f) * kat);
                        const unsigned rqb = pk2(rv.x, rv.y), k2b = pk2(k2.x, k2.y);
                        float bon = row16_sum(bflo(rqb) * bflo(k2b) * rkt.x + bfhi(rqb) * bfhi(k2b) * rkt.y);
                        bon += __builtin_bit_cast(float, __builtin_amdgcn_ds_swizzle(__builtin_bit_cast(int, bon), 0x401F));
                        if ((lane & 31) == 0) BON[(size_t)(m0 + q) * AH + hh] = bon;
                        const unsigned vvb = pk2(vv.x, vv.y);
                        *(GAS unsigned*)(VN + mo) = vvb; *(GAS unsigned*)(GN + mo) = pk2(lg2.x, lg2.y);
                        const f32x2 cu = cumv[q8 + 1], cp = cumv[q8];
                        const f32x2 ep = {__expf(cu.x), __expf(cu.y)}, en = {__expf(-cu.x), __expf(-cu.y)}, epv = {__expf(cp.x), __expf(cp.y)};
                        const f32x2 ta2 = -(kk * epv), tr2 = rv * ep, tb2 = kk * av * en, tk2 = k2 * en;
                        const unsigned xa = pk2(ta2.x, ta2.y), xr = pk2(tr2.x, tr2.y), xb = pk2(tb2.x, tb2.y), xk = pk2(tk2.x, tk2.y);
                        const unsigned no = cbo + (unsigned)(grp * 16 + q) * 64 + c2;
                        *(GAS unsigned*)(NAT + 0 * ASZ + no) = xa; *(GAS unsigned*)(NAT + 1 * ASZ + no) = xr; *(GAS unsigned*)(NAT + 2 * ASZ + no) = xb; *(GAS unsigned*)(NAT + 3 * ASZ + no) = xk;
                        xa_[u] = xa; xv_[u] = vvb; xb_[u] = xb; xk_[u] = xk; }
                    const unsigned pp = hf ? (h4 ? 12 : 4) : (h4 ? 8 : 0);
#define TRST(x, a) do { *(GAS v2u*)(TR + (x) * ASZ + to + pp) = (v2u){LO2(a, 0, 1), LO2(a, 2, 3)}; *(GAS v2u*)(TR + (x) * ASZ + to + 64 + pp) = (v2u){HI2(a, 0, 1), HI2(a, 2, 3)}; } while (0)
                    TRST(0, xa_); TRST(1, xv_); TRST(2, xb_); TRST(3, xk_);
#undef TRST
                }
#undef LO2
#undef HI2
            }
            __syncthreads();
        }
        if (c.wave < 3) *(GAS f32x2*)(WL + (cbo >> 12) * 64 + c2) = (f32x2){__expf(cum.x), __expf(cum.y)};
    }
}

__host__ __device__ constexpr int tri_start(int t) { const int a = t >> 2, b = t & 3; return 8 * a * a + 4 * a + (b >= 1 ? 4 * a : 0) + (b >= 2 ? 4 * a + 4 : 0) + (b == 3 ? 4 * a + 4 : 0); }
static_assert(tri_start(1) == 0 && tri_start(2) == 4 && tri_start(5) == 16 && tri_start(64) == 2112, "tri_start");
__device__ __forceinline__ void phase_rwkv_chunk(const Ctx& c) {
    const GAS bf16* NAT = (const GAS bf16*)(c.R + R_NAT); const GAS bf16* TR = (const GAS bf16*)(c.R + R_TR); const GAS float* WLp = (const GAS float*)(c.R + R_WL);
    GAS v4u* CHM = (GAS v4u*)(c.R + R_CHM); GAS v4u* CHR = (GAS v4u*)(c.R + R_CHR); GAS v4u* NB = (GAS v4u*)(c.R + R_NT); GAS float* YL = (GAS float*)(c.R + R_YL);
    constexpr size_t ASZ = (size_t)NCHUNK * BLK;
    const int lane = c.lane, l31 = lane & 31, hi = lane >> 5;
    const int fo = l31 * 64 + 8 * hi;
    const int tpos = (lane & ~15) + vt_pos(lane & 15);
    const bool six = c.nb * 6 == NCHUNK;
    for (int cb = six ? (c.wave < 6 ? c.bid * 6 + c.wave : NCHUNK) : c.gw; cb < NCHUNK; cb += six ? NCHUNK : c.ngw) {
        unsigned lbase = (unsigned)c.wave * 16384u; asm volatile("" : "+v"(lbase));
        LAS float* la = (LAS float*)(c.lds + lbase);
        LAS unsigned short* lt = (LAS unsigned short*)(c.lds + lbase);
        const GAS bf16* At = NAT + 0 * ASZ + (size_t)cb * BLK; const GAS bf16* Rt = NAT + 1 * ASZ + (size_t)cb * BLK; const GAS bf16* Bh = NAT + 2 * ASZ + (size_t)cb * BLK; const GAS bf16* Kh = NAT + 3 * ASZ + (size_t)cb * BLK;
        const GAS bf16* AtT = TR + 0 * ASZ + (size_t)cb * BLK; const GAS bf16* VT = TR + 1 * ASZ + (size_t)cb * BLK; const GAS bf16* BhT = TR + 2 * ASZ + (size_t)cb * BLK; const GAS bf16* KhT = TR + 3 * ASZ + (size_t)cb * BLK;
        const GAS float* wl = WLp + (size_t)cb * 64;
#define LDF(P, blk, ks) (*(const GAS bf16x8*)((P) + (blk) * 2048 + (ks) * 16 + fo))
#define LDT(blk, ks) (*(const LAS bf16x8*)(lt + ((blk) * 32 + l31) * 72 + (ks) * 16 + 8 * hi))
        f32x16 acc[2][2];
#pragma unroll
        for (int rb = 0; rb < 2; ++rb)
#pragma unroll
            for (int cbk = 0; cbk < 2; ++cbk) { if (rb == 1 && cbk == 0) continue;
                acc[rb][cbk] = zero16();
#pragma unroll
                for (int ks = 0; ks < 4; ++ks) acc[rb][cbk] = MFMA32(LDF(Bh, rb, ks), LDF(At, cbk, ks), acc[rb][cbk]); }
#pragma unroll
        for (int rb = 0; rb < 2; ++rb)
#pragma unroll
            for (int cbk = 0; cbk < 2; ++cbk)
#pragma unroll
                for (int r = 0; r < 16; ++r) { if (rb == 1 && cbk == 0) continue; const int j = 32 * rb + 8 * (r >> 2) + 4 * hi + (r & 3), tq = 32 * cbk + l31; if (rb != cbk || j < tq) la[tri_start(tq) + j] = acc[rb][cbk][r]; }
        __builtin_amdgcn_sched_barrier(0);
        bf16x8 fAtT[2][4], fBhT[2][4];
#pragma unroll
        for (int bk = 0; bk < 2; ++bk)
#pragma unroll
            for (int ks = 0; ks < 4; ++ks) { fAtT[bk][ks] = LDF(AtT, bk, ks); fBhT[bk][ks] = LDF(BhT, bk, ks); }
        f32x2 Tc2[32];
#define TCV(j) Tc2[(j) >> 1][(j) & 1]
#pragma unroll
        for (int tq = 0; tq < 64; ++tq) { int ln_ = lane; asm volatile("" : "+v"(ln_));
            f32x2 sv = {ln_ == tq ? 1.f : 0.f, 0.f};
#pragma unroll
            for (int j = 0; j + 4 <= tq; j += 4) { const f32x4 a4 = *(const LAS f32x4*)(la + tri_start(tq) + j); sv += (f32x2){a4.x, a4.y} * Tc2[j >> 1]; sv += (f32x2){a4.z, a4.w} * Tc2[(j >> 1) + 1]; }
            if (tq & 3) { const int j0 = tq & ~3; const f32x4 a4 = *(const LAS f32x4*)(la + tri_start(tq) + j0);
                sv.x += a4.x * TCV(j0); if ((tq & 3) > 1) sv.y += a4.y * TCV(j0 + 1); if ((tq & 3) > 2) sv.x += a4.z * TCV(j0 + 2); }
            TCV(tq) = sv.x + sv.y; }
#pragma unroll
        for (int tq = 0; tq < 64; ++tq) lt[tq * 72 + tpos] = (unsigned short)f2bf(TCV(tq));
#undef TCV
        __builtin_amdgcn_sched_barrier(0);
        bf16x8 fBhN[2][4], fRtN[2][4];
#pragma unroll
        for (int bk = 0; bk < 2; ++bk)
#pragma unroll
            for (int ks = 0; ks < 4; ++ks) { fBhN[bk][ks] = LDF(Bh, bk, ks); fRtN[bk][ks] = LDF(Rt, bk, ks); }
        bf16x8 Ap[2][2][2];
#pragma unroll
        for (int rb = 0; rb < 2; ++rb)
#pragma unroll
            for (int cbk = 0; cbk < 2; ++cbk) { f32x16 a = zero16();
#pragma unroll
                for (int ks = 0; ks < 4; ++ks) a = MFMA32(LDT(rb, ks), fAtT[cbk][ks], a);
                Ap[rb][cbk][0] = pack8(a, 0); Ap[rb][cbk][1] = pack8(a, 8); }
        __builtin_amdgcn_sched_barrier(0);
        { const float wl0 = wl[l31], wl1 = wl[32 + l31];
#pragma unroll
          for (int rbp = 0; rbp < 2; ++rbp)
#pragma unroll
            for (int cbk = 0; cbk < 2; ++cbk) { f32x16 a = zero16();
#pragma unroll
                for (int rbt = 0; rbt < 2; ++rbt)
#pragma unroll
                    for (int s = 0; s < 2; ++s) a = MFMA32(Ap[rbt][rbp][s], fBhT[cbk][2 * rbt + s], a);
                const float wk = cbk ? wl1 : wl0;
#pragma unroll
                for (int r = 0; r < 16; ++r) { const int kp = 32 * rbp + 8 * (r >> 2) + 4 * hi + (r & 3), kq = 32 * cbk + l31; a[r] = a[r] * wk + keep_zero(wk, kp - kq); }
                CHM[((size_t)cb * 8 + cbk * 4 + 2 * rbp + 0) * 64 + lane] = __builtin_bit_cast(v4u, pack8(a, 0)); CHM[((size_t)cb * 8 + cbk * 4 + 2 * rbp + 1) * 64 + lane] = __builtin_bit_cast(v4u, pack8(a, 8)); } }
        __builtin_amdgcn_sched_barrier(0);
        bf16x8 Pb[2][2][2];
        {
#pragma unroll
          for (int rb = 0; rb < 2; ++rb)
#pragma unroll
            for (int cbk = 0; cbk < 2; ++cbk) { if (rb == 1 && cbk == 0) continue;
                f32x16 a = zero16();
#pragma unroll
                for (int ks = 0; ks < 4; ++ks) a = MFMA32(fBhN[rb][ks], fRtN[cbk][ks], a);
                if (rb == cbk) {
#pragma unroll
                for (int r = 0; r < 16; ++r) { const int j = 32 * rb + 8 * (r >> 2) + 4 * hi + (r & 3), tq = 32 * cbk + l31; a[r] = keep_neg(a[r], j - tq - 1); } }
                Pb[rb][cbk][0] = pack8(a, 0); Pb[rb][cbk][1] = pack8(a, 8); }
#pragma unroll
          for (int rbk = 0; rbk < 2; ++rbk)
#pragma unroll
            for (int cbt = 0; cbt < 2; ++cbt) { f32x16 a;
#pragma unroll
                for (int g = 0; g < 4; ++g) { const v2u w = *(const GAS v2u*)(Rt + (32 * cbt + l31) * 64 + 32 * rbk + 8 * g + 4 * hi); a[4 * g] = bflo(w.x); a[4 * g + 1] = bfhi(w.x); a[4 * g + 2] = bflo(w.y); a[4 * g + 3] = bfhi(w.y); }
#pragma unroll
                for (int rbj = 0; rbj < 2; ++rbj)
#pragma unroll
                    for (int s = 0; s < 2; ++s) { if (rbj == 1 && cbt == 0) continue; a = MFMA32(Ap[rbj][rbk][s], Pb[rbj][cbt][s], a); }
                CHR[((size_t)cb * 8 + cbt * 4 + 2 * rbk + 0) * 64 + lane] = __builtin_bit_cast(v4u, pack8(a, 0)); CHR[((size_t)cb * 8 + cbt * 4 + 2 * rbk + 1) * 64 + lane] = __builtin_bit_cast(v4u, pack8(a, 8)); } }
        __builtin_amdgcn_sched_barrier(0);
        f32x4 wlr[2][4];
#pragma unroll
        for (int rbk = 0; rbk < 2; ++rbk)
#pragma unroll
            for (int g = 0; g < 4; ++g) wlr[rbk][g] = *(const GAS f32x4*)(wl + 32 * rbk + 8 * g + 4 * hi);
        bf16x8 Vp[2][2][2];
        { bf16x8 Pk[2][2][2];
#pragma unroll
          for (int rb = 0; rb < 2; ++rb)
#pragma unroll
            for (int cbk = 0; cbk < 2; ++cbk) { if (rb == 1 && cbk == 0) continue;
                f32x16 a = zero16();
#pragma unroll
                for (int ks = 0; ks < 4; ++ks) a = MFMA32(LDF(Kh, rb, ks), LDF(At, cbk, ks), a);
                if (rb == cbk) {
#pragma unroll
                for (int r = 0; r < 16; ++r) { const int j = 32 * rb + 8 * (r >> 2) + 4 * hi + (r & 3), tq = 32 * cbk + l31; a[r] = keep_neg(a[r], j - tq); } }
                Pk[rb][cbk][0] = pack8(a, 0); Pk[rb][cbk][1] = pack8(a, 8); }
          bf16x8 X2b[2][2][2];
#pragma unroll
          for (int rbt = 0; rbt < 2; ++rbt)
#pragma unroll
            for (int cbv = 0; cbv < 2; ++cbv) { f32x16 a = zero16();
#pragma unroll
                for (int rbj = 0; rbj < 2; ++rbj)
#pragma unroll
                    for (int s = 0; s < 2; ++s) { if (rbj == 1 && rbt == 0) continue; a = MFMA32(Pk[rbj][rbt][s], LDF(VT, cbv, 2 * rbj + s), a); }
                X2b[rbt][cbv][0] = pack8(a, 0); X2b[rbt][cbv][1] = pack8(a, 8); }
#pragma unroll
          for (int rb = 0; rb < 2; ++rb)
#pragma unroll
            for (int cbv = 0; cbv < 2; ++cbv) { f32x16 a = zero16();
#pragma unroll
                for (int ks = 0; ks < 4; ++ks) a = MFMA32(LDT(rb, ks), X2b[ks >> 1][cbv][ks & 1], a);
                Vp[rb][cbv][0] = pack8(a, 0); Vp[rb][cbv][1] = pack8(a, 8); } }
        __builtin_amdgcn_sched_barrier(0);
#pragma unroll
        for (int rbk = 0; rbk < 2; ++rbk)
#pragma unroll
            for (int cbv = 0; cbv < 2; ++cbv) { f32x16 a = zero16();
#pragma unroll
                for (int ks = 0; ks < 4; ++ks) { a = MFMA32(LDF(BhT, rbk, ks), Vp[ks >> 1][cbv][ks & 1], a); a = MFMA32(LDF(KhT, rbk, ks), LDF(VT, cbv, ks), a); }
#pragma unroll
                for (int g = 0; g < 4; ++g) { const f32x4 w4 = wlr[rbk][g]; a[4 * g] *= w4.x; a[4 * g + 1] *= w4.y; a[4 * g + 2] *= w4.z; a[4 * g + 3] *= w4.w; }
                NB[(((size_t)cb * 2 + cbv) * 4 + 2 * rbk + 0) * 64 + lane] = __builtin_bit_cast(v4u, pack8(a, 0)); NB[(((size_t)cb * 2 + cbv) * 4 + 2 * rbk + 1) * 64 + lane] = __builtin_bit_cast(v4u, pack8(a, 8)); }
        __builtin_amdgcn_sched_barrier(0);
        f32x16 yl[2][2];
        {
#pragma unroll
          for (int rbv = 0; rbv < 2; ++rbv)
#pragma unroll
            for (int cbt = 0; cbt < 2; ++cbt) { f32x16 a = zero16();
#pragma unroll
                for (int rbj = 0; rbj < 2; ++rbj)
#pragma unroll
                    for (int s = 0; s < 2; ++s) { if (rbj == 1 && cbt == 0) continue; a = MFMA32(Vp[rbj][rbv][s], Pb[rbj][cbt][s], a); }
                yl[rbv][cbt] = PROBE_NO_VP ? zero16() : a; } }
        __builtin_amdgcn_sched_barrier(0);
        { bf16x8 Pk2[2][2][2];
#pragma unroll
          for (int rb = 0; rb < 2; ++rb)
#pragma unroll
            for (int cbk = 0; cbk < 2; ++cbk) { if (rb == 1 && cbk == 0) continue;
                f32x16 a = zero16();
#pragma unroll
                for (int ks = 0; ks < 4; ++ks) a = MFMA32(LDF(Kh, rb, ks), LDF(Rt, cbk, ks), a);
                if (rb == cbk) {
#pragma unroll
                for (int r = 0; r < 16; ++r) { const int j = 32 * rb + 8 * (r >> 2) + 4 * hi + (r & 3), tq = 32 * cbk + l31; a[r] = keep_neg(a[r], j - tq - 1); } }
                Pk2[rb][cbk][0] = pack8(a, 0); Pk2[rb][cbk][1] = pack8(a, 8); }
#pragma unroll
          for (int rbv = 0; rbv < 2; ++rbv)
#pragma unroll
            for (int cbt = 0; cbt < 2; ++cbt) { f32x16 a = yl[rbv][cbt];
#pragma unroll
                for (int rbj = 0; rbj < 2; ++rbj)
#pragma unroll
                    for (int s = 0; s < 2; ++s) { if (rbj == 1 && cbt == 0) continue; a = MFMA32(LDF(VT, rbv, 2 * rbj + s), Pk2[rbj][cbt][s], a); }
#pragma unroll
                for (int g = 0; g < 4; ++g) {
#ifdef PROBE_COPY
                    const v2u w = *(const GAS v2u*)(Kh + (32 * cbt + l31) * 64 + 32 * rbv + 8 * g + 4 * hi); const v2u w2 = *(const GAS v2u*)(VT + (32 * cbt + l31) * 64 + 32 * rbv + 8 * g + 4 * hi);
                    a[4 * g] = bflo(w.x) + bflo(w2.x); a[4 * g + 1] = bfhi(w.x) + bfhi(w2.x); a[4 * g + 2] = bflo(w.y) + bflo(w2.y); a[4 * g + 3] = bfhi(w.y) + bfhi(w2.y);
#endif
                    *(GAS f32x4*)(YL + (size_t)cb * BLK + (32 * cbt + l31) * 64 + 32 * rbv + 8 * g + 4 * hi) = (f32x4){a[4 * g], a[4 * g + 1], a[4 * g + 2], a[4 * g + 3]}; } } }
#undef LDF
#undef LDT
    }
}

constexpr int SCAN_WGS = 6;
__device__ __forceinline__ void phase_rwkv_scan2(const Ctx& c) {
    const GAS v4u* CHM = (const GAS v4u*)(c.R + R_CHM); GAS v4u* CHS = (GAS v4u*)(c.R + R_CHS); const GAS v4u* NB = (const GAS v4u*)(c.R + R_NT);
    const int lane = c.lane;
    if (c.nb < 2 * SCAN_WGS || c.bid < c.nb - SCAN_WGS) return;
    const int wg = c.bid - (c.nb - SCAN_WGS), bhl = c.wave >> 2, rbk = (c.wave >> 1) & 1, cbv = c.wave & 1, bh = wg * 2 + bhl; const size_t cb0 = (size_t)bh * (SEQ / 64);
    LAS v4u* xs = (LAS v4u*)c.lds;
    const int myslot = c.wave * 128 + lane, peer = (c.wave ^ 2) * 128 + lane;
    bf16x8 own[2], oth[2];
#pragma unroll
    for (int i = 0; i < 2; ++i) { own[i] = (bf16x8){0, 0, 0, 0, 0, 0, 0, 0}; oth[i] = own[i]; }
    constexpr int NBUF = 6;
    v4u mq[NBUF][4], nq[NBUF][2];
#define SCAN_LOAD(buf, cc) do { _Pragma("unroll") for (int i_ = 0; i_ < 4; ++i_) mq[buf][i_] = CHM[((cb0 + (cc)) * 8 + rbk * 4 + i_) * 64 + lane]; \
                                _Pragma("unroll") for (int i_ = 0; i_ < 2; ++i_) nq[buf][i_] = NB[(((cb0 + (cc)) * 2 + cbv) * 4 + 2 * rbk + i_) * 64 + lane]; } while (0)
    SCAN_LOAD(0, 0); SCAN_LOAD(1, 1); SCAN_LOAD(2, 2); SCAN_LOAD(3, 3); SCAN_LOAD(4, 4);
    __syncthreads();
    for (int cc0 = 0; cc0 < SEQ / 64; cc0 += NBUF) {
#pragma unroll
        for (int u = 0; u < NBUF; ++u) { const int cc = cc0 + u;
            if (cc < SEQ / 64) {
                if (cc + 5 < SEQ / 64) SCAN_LOAD((u + 5) % NBUF, cc + 5);
#pragma unroll
                for (int i = 0; i < 2; ++i) CHS[((cb0 + cc) * 8 + cbv * 4 + 2 * rbk + i) * 64 + lane] = __builtin_bit_cast(v4u, own[i]);
                f32x16 a;
#pragma unroll
                for (int hf = 0; hf < 2; ++hf) { const v4u w = nq[u][hf];
                    a[8 * hf + 0] = bflo(w.x); a[8 * hf + 1] = bfhi(w.x); a[8 * hf + 2] = bflo(w.y); a[8 * hf + 3] = bfhi(w.y);
                    a[8 * hf + 4] = bflo(w.z); a[8 * hf + 5] = bfhi(w.z); a[8 * hf + 6] = bflo(w.w); a[8 * hf + 7] = bfhi(w.w); }
#pragma unroll
                for (int ks = 0; ks < 4; ++ks) a = MFMA32(__builtin_bit_cast(bf16x8, mq[u][ks]), (ks >> 1) == rbk ? own[ks & 1] : oth[ks & 1], a);
                own[0] = pack8(a, 0); own[1] = pack8(a, 8);
                LAS v4u* slot = xs + (cc & 1) * 1024;
                slot[myslot] = __builtin_bit_cast(v4u, own[0]); slot[myslot + 64] = __builtin_bit_cast(v4u, own[1]);
                __syncthreads();
                oth[0] = __builtin_bit_cast(bf16x8, slot[peer]); oth[1] = __builtin_bit_cast(bf16x8, slot[peer + 64]);
            }
        }
    }
#undef SCAN_LOAD
    __syncthreads();
}

__device__ __forceinline__ void phase_rwkv_out(const Ctx& c, int l) {
    const GAS v4u* CHR = (const GAS v4u*)(c.R + R_CHR); const GAS v4u* CHS = (const GAS v4u*)(c.R + R_CHS); const GAS float* YL = (const GAS float*)(c.R + R_YL);
    const GAS bf16* VN = (const GAS bf16*)(c.R + R_VG); const GAS bf16* GN = VN + (size_t)M * AW; const GAS float* BON = (const GAS float*)(c.R + R_BON); GAS bf16* YC = (GAS bf16*)(c.ws + WS_XN);
    const GAS float* lng = c.in(I_LNG) + l * AW; const GAS float* lnb = c.in(I_LNB) + l * AW;
    const int lane = c.lane, l31 = lane & 31, hi = lane >> 5;
    const bool six = c.nb * 6 == NCHUNK;
    for (int cb = six ? (c.wave < 6 ? c.bid * 6 + c.wave : NCHUNK) : c.gw; cb < NCHUNK; cb += six ? NCHUNK : c.ngw) {
        const int bh = cb / (SEQ / 64), cc = cb % (SEQ / 64), b = bh / AH, h = bh % AH;
#pragma unroll
        for (int cbt = 0; cbt < 2; ++cbt) {
            f32x16 y[2];
#pragma unroll
            for (int rbv = 0; rbv < 2; ++rbv) {
#pragma unroll
                for (int g = 0; g < 4; ++g) { const f32x4 q4 = *(const GAS f32x4*)(YL + (size_t)cb * BLK + (32 * cbt + l31) * 64 + 32 * rbv + 8 * g + 4 * hi); y[rbv][4 * g] = q4.x * PROBE_YL; y[rbv][4 * g + 1] = q4.y * PROBE_YL; y[rbv][4 * g + 2] = q4.z * PROBE_YL; y[rbv][4 * g + 3] = q4.w * PROBE_YL; }
#pragma unroll
                for (int ks = 0; ks < PROBE_KS; ++ks) y[rbv] = MFMA32(__builtin_bit_cast(bf16x8, CHS[((size_t)cb * 8 + rbv * 4 + ks) * 64 + lane]), __builtin_bit_cast(bf16x8, CHR[((size_t)cb * 8 + cbt * 4 + ks) * 64 + lane]), y[rbv]);
            }
            float s = 0.f;
#pragma unroll
            for (int r = 0; r < 16; ++r) s += y[0][r] + y[1][r];
            s += __shfl_xor(s, 32);
            const float mean = s * (1.0f / 64.0f); float q = 0.f;
#pragma unroll
            for (int r = 0; r < 16; ++r) { y[0][r] -= mean; y[1][r] -= mean; q += y[0][r] * y[0][r] + y[1][r] * y[1][r]; }
            q += __shfl_xor(q, 32);
            const float rstd = __builtin_amdgcn_rsqf(q * (1.0f / 64.0f) + 64e-5f);
            const size_t m = (size_t)b * SEQ + cc * 64 + 32 * cbt + l31; const float bon = BON[m * AH + h];
#pragma unroll
            for (int rbv = 0; rbv < 2; ++rbv)
#pragma unroll
                for (int g = 0; g < 4; ++g) { const int ch = h * 64 + 32 * rbv + 8 * g + 4 * hi;
                    const f32x4 g4 = *(const GAS f32x4*)(lng + ch), b4 = *(const GAS f32x4*)(lnb + ch); const v2u vv = *(const GAS v2u*)(VN + m * AW + ch), gg = *(const GAS v2u*)(GN + m * AW + ch);
                    const float o0 = (y[rbv][4 * g] * rstd * g4.x + b4.x + bon * bflo(vv.x)) * bflo(gg.x), o1 = (y[rbv][4 * g + 1] * rstd * g4.y + b4.y + bon * bfhi(vv.x)) * bfhi(gg.x);
                    const float o2 = (y[rbv][4 * g + 2] * rstd * g4.z + b4.z + bon * bflo(vv.y)) * bflo(gg.y), o3 = (y[rbv][4 * g + 3] * rstd * g4.w + b4.w + bon * bfhi(vv.y)) * bfhi(gg.y);
#ifdef RWKV_SANITIZE
                    { GAS float* oo[4] = {nullptr, nullptr, nullptr, nullptr}; (void)oo; }
#define SAN(x) ((x) == (x) && fabsf(x) < 1e30f ? (x) : 0.f)
                    *(GAS v2u*)(YC + m * D + ch) = (v2u){pk2(SAN(o0), SAN(o1)), pk2(SAN(o2), SAN(o3))}; }
#else
                    *(GAS v2u*)(YC + m * D + ch) = (v2u){pk2(o0, o1), pk2(o2, o3)}; }
#endif
        }
    }
}
__device__ __forceinline__ void phase_mla_prep(const Ctx& c, int l) {
    const GAS bf16* Z = (const GAS bf16*)(c.R + R_Z);
    GAS bf16* Q = (GAS bf16*)(c.R + R_Q); GAS bf16* K = (GAS bf16*)(c.R + R_K); GAS bf16* V = (GAS bf16*)(c.R + R_V);
    const GAS float* qng = c.in(I_QNG) + l * 256; const GAS float* wuq = c.in(I_WUQ) + (size_t)l * 256 * QP; const GAS float* kvng = c.in(I_KVNG) + l * 128; const GAS float* wukv = c.in(I_WUKV) + (size_t)l * 128 * 768;
    const GAS float* qhg = c.in(I_QHG) + l * QKD; const GAS float* khg = c.in(I_KHG) + l * QKD; const GAS int* pos = (const GAS int*)c.in(I_POS);
    LAS float* cqn = (LAS float*)c.lds;
    LAS float* ckn = cqn + 16 * 256;
    LAS float* krs = ckn + 16 * 128;
    LAS float* qb = krs + 16 * 32;
    LAS float* kvb = qb + 16 * QP;
    const float qscale = 1.4426950408889634f / sqrtf((float)QKD);
    for (int grp = c.bid; grp < M / 16; grp += c.nb) {
        const int m0 = grp * 16;
        __syncthreads();
#pragma unroll
        for (int q = 0; q < 2; ++q) { const int tk = 2 * c.wave + q; const GAS bf16* zr = Z + (size_t)(m0 + tk) * ZP;
            float x[4]; float ss = 0.f;
#pragma unroll
            for (int i = 0; i < 4; ++i) { x[i] = bf2f(zr[ZCQ + c.lane + 64 * i]); ss += x[i] * x[i]; }
            float rstd = __builtin_amdgcn_rsqf(wave_sum(ss) * (1.0f / 256.0f) + EPS);
#pragma unroll
            for (int i = 0; i < 4; ++i) cqn[tk * 256 + c.lane + 64 * i] = x[i] * rstd * qng[c.lane + 64 * i];
            float y[2]; ss = 0.f;
#pragma unroll
            for (int i = 0; i < 2; ++i) { y[i] = bf2f(zr[ZCKV + c.lane + 64 * i]); ss += y[i] * y[i]; }
            rstd = __builtin_amdgcn_rsqf(wave_sum(ss) * (1.0f / 128.0f) + EPS);
#pragma unroll
            for (int i = 0; i < 2; ++i) ckn[tk * 128 + c.lane + 64 * i] = y[i] * rstd * kvng[c.lane + 64 * i];
            if (c.lane < 32) krs[tk * 32 + c.lane] = bf2f(zr[ZKR + c.lane]);
        }
        __syncthreads();
        for (int col = c.tid; col < QP; col += NTHR) {
            float acc[16];
#pragma unroll
            for (int q = 0; q < 16; ++q) acc[q] = 0.f;
            for (int kx = 0; kx < 256; ++kx) { const float w = wuq[(size_t)kx * QP + col];
#pragma unroll
                for (int q = 0; q < 16; ++q) acc[q] += cqn[q * 256 + kx] * w; }
#pragma unroll
            for (int q = 0; q < 16; ++q) qb[q * QP + col] = acc[q];
        }
        for (int col = c.tid; col < 768; col += NTHR) {
            float acc[16];
#pragma unroll
            for (int q = 0; q < 16; ++q) acc[q] = 0.f;
            for (int kx = 0; kx < 128; ++kx) { const float w = wukv[(size_t)kx * 768 + col];
#pragma unroll
                for (int q = 0; q < 16; ++q) acc[q] += ckn[q * 128 + kx] * w; }
#pragma unroll
            for (int q = 0; q < 16; ++q) kvb[q * 768 + col] = acc[q];
        }
        __syncthreads();
        for (int pr = c.wave; pr < 16 * AH; pr += NWAVES) {
            const int tk = pr / AH, h = pr % AH, m = m0 + tk; const int ln = c.lane, l32 = ln & 31, fi = ln & 15;
            const float ang = (float)pos[m] * exp2f(-(float)(2 * fi) * (13.287712379549449f / 32.0f));
            const float cs = cosf(ang), sn = sinf(ang);
            { const float x0 = qb[tk * QP + h * QKD + ln], x1 = ln < 32 ? qb[tk * QP + h * QKD + 64 + l32] : 0.f;
              const float rstd = __builtin_amdgcn_rsqf(wave_sum(x0 * x0 + x1 * x1) * (1.0f / QKD) + EPS);
              const float n0 = x0 * rstd * qhg[ln], n1 = x1 * rstd * qhg[64 + l32];
              const float pn = __shfl_xor(n1, 16);
              const float ro = (ln & 16) ? (pn * sn + n1 * cs) : (n1 * cs - pn * sn);
              Q[(size_t)m * QP + h * QKD + ln] = (bf16)f2bf(n0 * qscale);
              if (ln < 32) Q[(size_t)m * QP + h * QKD + 64 + ln] = (bf16)f2bf(ro * qscale); }
            { const float x0 = kvb[tk * 768 + h * 128 + ln], x1 = ln < 32 ? krs[tk * 32 + l32] : 0.f;
              const float rstd = __builtin_amdgcn_rsqf(wave_sum(x0 * x0 + x1 * x1) * (1.0f / QKD) + EPS);
              const float n0 = x0 * rstd * khg[ln], n1 = x1 * rstd * khg[64 + l32];
              const float pn = __shfl_xor(n1, 16);
              const float ro = (ln & 16) ? (pn * sn + n1 * cs) : (n1 * cs - pn * sn);
              K[(size_t)m * QP + h * QKD + ln] = (bf16)f2bf(n0);
              if (ln < 32) K[(size_t)m * QP + h * QKD + 64 + ln] = (bf16)f2bf(ro); }
            { const int sq = m % SEQ, bb = m / SEQ; V[((size_t)((bb * AH + h) * 64 + ln)) * SEQ + (sq & ~15) + vt_pos(sq & 15)] = (bf16)f2bf(kvb[tk * 768 + h * 128 + 64 + ln]); }
        }
    }
    __syncthreads();
}


__device__ __forceinline__ void phase_mla_post1(const Ctx& c, int l) {
    const GAS bf16* Z = (const GAS bf16*)(c.R + R_Z); const GAS bf16* QR = (const GAS bf16*)(c.R + R_QR); const GAS bf16* KVR = (const GAS bf16*)(c.R + R_KVR);
    GAS bf16* Q = (GAS bf16*)(c.R + R_Q); GAS bf16* K = (GAS bf16*)(c.R + R_K); GAS bf16* Vt = (GAS bf16*)(c.R + R_V);
    const GAS float* qhg = c.in(I_QHG) + l * QKD; const GAS float* khg = c.in(I_KHG) + l * QKD; const GAS int* pos = (const GAS int*)c.in(I_POS);
    LAS unsigned short* vt = (LAS unsigned short*)c.lds;
    const float qscale = 1.4426950408889634f / sqrtf((float)QKD);
    const int ln = c.lane, l32 = ln & 31, fi = ln & 15;
    const float g0q = qhg[ln], g1q = qhg[64 + l32], g0k = khg[ln], g1k = khg[64 + l32];
    const float ifr = exp2f(-(float)(2 * fi) * (13.287712379549449f / 32.0f));
    for (int item = c.bid; item < M / 64; item += c.nb) {
        __syncthreads();
        float zq[4], zk2[2], xq0[AH], xq1[AH], xk0[AH], xv0[AH], krv; int pq;
#define P1_LOAD(tok) do { const GAS bf16* zr_ = Z + (size_t)(tok) * ZP; \
            _Pragma("unroll") for (int i = 0; i < 4; ++i) nzq[i] = bf2f(zr_[ZCQ + ln + 64 * i]); \
            _Pragma("unroll") for (int i = 0; i < 2; ++i) nzk[i] = bf2f(zr_[ZCKV + ln + 64 * i]); \
            nkr = ln < 32 ? bf2f(zr_[ZKR + l32]) : 0.f; npq = pos[tok]; \
            _Pragma("unroll") for (int h = 0; h < AH; ++h) { nq0[h] = bf2f(QR[(size_t)(tok) * 768 + h * 128 + ln]); nq1[h] = ln < 32 ? bf2f(QR[(size_t)(tok) * 768 + h * 128 + 64 + l32]) : 0.f; \
                nk0[h] = bf2f(KVR[(size_t)(tok) * 768 + h * 128 + ln]); nv0[h] = bf2f(KVR[(size_t)(tok) * 768 + h * 128 + 64 + ln]); } } while (0)
        float nzq[4], nzk[2], nq0[AH], nq1[AH], nk0[AH], nv0[AH], nkr; int npq;
        P1_LOAD(item * 64 + c.wave * 8);
        for (int q = 0; q < 8; ++q) {
            const int tl = c.wave * 8 + q, m = item * 64 + tl;
#pragma unroll
            for (int i = 0; i < 4; ++i) zq[i] = nzq[i];
            zk2[0] = nzk[0]; zk2[1] = nzk[1]; krv = nkr; pq = npq;
#pragma unroll
            for (int h = 0; h < AH; ++h) { xq0[h] = nq0[h]; xq1[h] = nq1[h]; xk0[h] = nk0[h]; xv0[h] = nv0[h]; }
            if (q + 1 < 8) P1_LOAD(m + 1);
            const float ang = (float)pq * ifr;
            const float rq = __builtin_amdgcn_rsqf(wave_sum((zq[0] * zq[0] + zq[1] * zq[1]) + (zq[2] * zq[2] + zq[3] * zq[3])) * (1.0f / 256.0f) + EPS);
            const float rkv = __builtin_amdgcn_rsqf(wave_sum(zk2[0] * zk2[0] + zk2[1] * zk2[1]) * (1.0f / 128.0f) + EPS);
            float rev = ang * 0.15915494309189535f; rev -= floorf(rev);
            const float cs = __builtin_amdgcn_cosf(rev), sn = __builtin_amdgcn_sinf(rev);
            const int tp = (tl & ~15) + vt_pos(tl & 15);
#pragma unroll
            for (int h = 0; h < AH; ++h) {
                { const float x0 = xq0[h] * rq, x1 = xq1[h] * rq;
                  const float rstd = __builtin_amdgcn_rsqf(wave_sum(x0 * x0 + x1 * x1) * (1.0f / QKD) + EPS);
                  const float n0 = x0 * rstd * g0q, n1 = x1 * rstd * g1q; const float pn = __shfl_xor(n1, 16);
                  const float ro = (ln & 16) ? (pn * sn + n1 * cs) : (n1 * cs - pn * sn);
                  Q[(size_t)m * QP + h * QKD + ln] = (bf16)f2bf(n0 * qscale); if (ln < 32) Q[(size_t)m * QP + h * QKD + 64 + ln] = (bf16)f2bf(ro * qscale); }
                { const float x0 = xk0[h] * rkv, x1 = krv;
                  const float rstd = __builtin_amdgcn_rsqf(wave_sum(x0 * x0 + x1 * x1) * (1.0f / QKD) + EPS);
                  const float n0 = x0 * rstd * g0k, n1 = x1 * rstd * g1k; const float pn = __shfl_xor(n1, 16);
                  const float ro = (ln & 16) ? (pn * sn + n1 * cs) : (n1 * cs - pn * sn);
                  K[(size_t)m * QP + h * QKD + ln] = (bf16)f2bf(n0); if (ln < 32) K[(size_t)m * QP + h * QKD + 64 + ln] = (bf16)f2bf(ro); }
                vt[(h * 64 + ln) * 72 + tp] = (unsigned short)f2bf(xv0[h] * rkv);
            }
        }
#undef P1_LOAD
        __syncthreads();
        const int b = (item * 64) / SEQ, s0 = (item * 64) % SEQ;
        for (int p = c.tid; p < AW * 8; p += NTHR) { const int row = p >> 3, pc = p & 7; const int h = row >> 6, d = row & 63;
            *(GAS v4u*)(Vt + ((size_t)((b * AH + h) * 64 + d)) * SEQ + s0 + 8 * pc) = *(const LAS v4u*)(vt + row * 72 + 8 * pc); }
    }
    __syncthreads();
}
__device__ __forceinline__ float oct_sum(float v) { v += dpp_mov<0xB1>(v); v += dpp_mov<0x4E>(v); v += dpp_mov<0x141>(v); return v; }
__device__ __forceinline__ float sq8(const v4u w) { const float a = bflo(w.x), b = bfhi(w.x), c_ = bflo(w.y), d = bfhi(w.y), e = bflo(w.z), f = bfhi(w.z), g = bflo(w.w), h = bfhi(w.w);
    return ((a * a + b * b) + (c_ * c_ + d * d)) + ((e * e + f * f) + (g * g + h * h)); }
__device__ __forceinline__ v4u p1_head(const v4u w, float sc, const float (&g)[8], const f32x4 c0, const f32x4 c1, const f32x4 s0, const f32x4 s1, bool act, bool rope, float sgn, float oscale) {
    float x[8]; x[0] = bflo(w.x) * sc; x[1] = bfhi(w.x) * sc; x[2] = bflo(w.y) * sc; x[3] = bfhi(w.y) * sc; x[4] = bflo(w.z) * sc; x[5] = bfhi(w.z) * sc; x[6] = bflo(w.w) * sc; x[7] = bfhi(w.w) * sc;
    float ss = ((x[0] * x[0] + x[1] * x[1]) + (x[2] * x[2] + x[3] * x[3])) + ((x[4] * x[4] + x[5] * x[5]) + (x[6] * x[6] + x[7] * x[7]));
    ss = row16_sum(act ? ss : 0.f);
    const float rstd = __builtin_amdgcn_rsqf(ss * (1.0f / QKD) + EPS);
    float o[8];
#pragma unroll
    for (int j = 0; j < 8; ++j) { const float n = x[j] * rstd * g[j]; const float pn = dpp_mov<0x4E>(n); const float cs = j < 4 ? c0[j & 3] : c1[j & 3], sn = j < 4 ? s0[j & 3] : s1[j & 3];
        const float ro = n * cs + sgn * (pn * sn); o[j] = (rope ? ro : n) * oscale; }
    return (v4u){pk2(o[0], o[1]), pk2(o[2], o[3]), pk2(o[4], o[5]), pk2(o[6], o[7])};
}
__device__ __forceinline__ void phase_mla_post1b(const Ctx& c, int l) {
    const GAS bf16* Z = (const GAS bf16*)(c.R + R_Z); const GAS bf16* QR = (const GAS bf16*)(c.R + R_QR); const GAS bf16* KVR = (const GAS bf16*)(c.R + R_KVR);
    GAS bf16* Q = (GAS bf16*)(c.R + R_Q); GAS bf16* K = (GAS bf16*)(c.R + R_K); GAS bf16* Vt = (GAS bf16*)(c.R + R_V);
    const GAS float* qhg = c.in(I_QHG) + l * QKD; const GAS float* khg = c.in(I_KHG) + l * QKD; const GAS int* pos = (const GAS int*)c.in(I_POS);
    constexpr int VTP = 68, TKP = 40;
    LAS unsigned short* vt = (LAS unsigned short*)c.lds;
    LAS float* tk = (LAS float*)(c.lds + 384 * VTP * 2);
    const float qscale = 1.4426950408889634f / sqrtf((float)QKD);
    const int ln = c.lane, i16 = ln & 15, g16 = ln >> 4, ic = i16 < 12 ? i16 : 11, s8 = ln & 7, t8 = ln >> 3;
    float gq[8], gk[8];
#pragma unroll
    for (int j = 0; j < 8; ++j) { gq[j] = qhg[8 * ic + j]; gk[j] = khg[8 * ic + j]; }
    const float ifa = exp2f(-(float)(2 * s8) * (13.287712379549449f / 32.0f)), ifb = exp2f(-(float)(2 * (s8 + 8)) * (13.287712379549449f / 32.0f));
    const bool act = i16 < 12, rope = i16 >= 8, nope = i16 < 8; const float sgn = (i16 & 2) ? 1.f : -1.f;
    for (int item = c.bid; item < M / 64; item += c.nb) {
        __syncthreads();
        {
            const int tok = item * 64 + c.wave * 8 + t8; const GAS bf16* zr = Z + (size_t)tok * ZP;
            v4u a[4], b2[2];
#pragma unroll
            for (int i = 0; i < 4; ++i) a[i] = *(const GAS v4u*)(zr + ZCQ + 32 * s8 + 8 * i);
#pragma unroll
            for (int i = 0; i < 2; ++i) b2[i] = *(const GAS v4u*)(zr + ZCKV + 16 * s8 + 8 * i);
            const int pq = pos[tok];
            const float ssq = oct_sum((sq8(a[0]) + sq8(a[1])) + (sq8(a[2]) + sq8(a[3]))), ssk = oct_sum(sq8(b2[0]) + sq8(b2[1]));
            const float rq = __builtin_amdgcn_rsqf(ssq * (1.0f / 256.0f) + EPS), rkv = __builtin_amdgcn_rsqf(ssk * (1.0f / 128.0f) + EPS);
            float ra = ((float)pq * ifa) * 0.15915494309189535f; ra -= floorf(ra); float rb = ((float)pq * ifb) * 0.15915494309189535f; rb -= floorf(rb);
            LAS float* tp_ = tk + (c.wave * 8 + t8) * TKP;
            tp_[4 + s8] = __builtin_amdgcn_cosf(ra); tp_[12 + s8] = __builtin_amdgcn_cosf(rb); tp_[20 + s8] = __builtin_amdgcn_sinf(ra); tp_[28 + s8] = __builtin_amdgcn_sinf(rb);
            if (s8 == 0) { tp_[0] = rq; tp_[1] = rkv; }
        }
        LDS_WAIT();
#pragma unroll 2
        for (int q = 0; q < 8; ++q) { const int tl = c.wave * 8 + q, m = item * 64 + tl; const float rkv = tk[tl * TKP + 1]; const int tp = (tl & ~15) + vt_pos(tl & 15);
            float xv[AH];
#pragma unroll
            for (int h = 0; h < AH; ++h) xv[h] = bf2f(KVR[(size_t)m * 768 + h * 128 + 64 + ln]);
#pragma unroll
            for (int h = 0; h < AH; ++h) vt[(h * 64 + ln) * VTP + tp] = (unsigned short)f2bf(xv[h] * rkv); }
        for (int pb = 0; pb < 12; pb += 4) {
            v4u wq[4], wk[4], wr[4];
#pragma unroll
            for (int u = 0; u < 4; ++u) { const int idx = (pb + u) * 4 + g16, t = idx & 7, h = idx >> 3; const size_t m = (size_t)(item * 64 + c.wave * 8 + t);
                wq[u] = *(const GAS v4u*)(QR + m * 768 + h * 128 + 8 * ic); wk[u] = *(const GAS v4u*)(KVR + m * 768 + h * 128 + 8 * (i16 & 7)); wr[u] = *(const GAS v4u*)(Z + m * ZP + ZKR + 8 * (ic & 3)); }
#pragma unroll
            for (int u = 0; u < 4; ++u) { const int idx = (pb + u) * 4 + g16, t = idx & 7, h = idx >> 3; const size_t m = (size_t)(item * 64 + c.wave * 8 + t);
                const LAS float* tp_ = tk + (c.wave * 8 + t) * TKP; const float rq = tp_[0], rkv = tp_[1];
                const LAS f32x4* cp = (const LAS f32x4*)(tp_ + 4 + 8 * (i16 & 1)); const LAS f32x4* sp = (const LAS f32x4*)(tp_ + 20 + 8 * (i16 & 1));
                const f32x4 c0 = cp[0], c1 = cp[1], s0 = sp[0], s1 = sp[1];
                const v4u oq = p1_head(wq[u], rq, gq, c0, c1, s0, s1, act, rope, sgn, qscale);
                v4u kw; kw.x = nope ? wk[u].x : wr[u].x; kw.y = nope ? wk[u].y : wr[u].y; kw.z = nope ? wk[u].z : wr[u].z; kw.w = nope ? wk[u].w : wr[u].w;
                const v4u ok = p1_head(kw, nope ? rkv : 1.0f, gk, c0, c1, s0, s1, act, rope, sgn, 1.0f);
                if (act) { *(GAS v4u*)(Q + m * QP + h * QKD + 8 * i16) = oq; *(GAS v4u*)(K + m * QP + h * QKD + 8 * i16) = ok; } }
        }
        __syncthreads();
        const int b = (item * 64) / SEQ, s0_ = (item * 64) % SEQ;
        for (int p = c.tid; p < AW * 8; p += NTHR) { const int row = p >> 3, pc = p & 7; const int h = row >> 6, d = row & 63;
            const LAS v2u* src = (const LAS v2u*)(vt + row * VTP + 8 * pc); const v2u lo = src[0], hi2 = src[1];
            *(GAS v4u*)(Vt + ((size_t)((b * AH + h) * 64 + d)) * SEQ + s0_ + 8 * pc) = (v4u){lo.x, lo.y, hi2.x, hi2.y}; }
    }
    __syncthreads();
}
__device__ __forceinline__ void phase_attn_naive(const Ctx& c) {
    const GAS bf16* Q = (const GAS bf16*)(c.R + R_Q); const GAS bf16* K = (const GAS bf16*)(c.R + R_K); const GAS bf16* V = (const GAS bf16*)(c.R + R_V); GAS float* O = (GAS float*)(c.R + R_OATT);
    LAS float* ks = (LAS float*)c.lds;
    LAS float* vs = ks + 64 * QKD;
    const int row = c.tid >> 1, hf = c.tid & 1;
    for (int item = c.bid; item < BATCH * AH * 32 * 2; item += c.nb) {
        const int qg = 31 - item / (BATCH * AH * 2), rem = item % (BATCH * AH * 2), vh = rem & 1, bh = rem >> 1, b = bh / AH, h = bh % AH;
        const size_t qrow = (size_t)b * SEQ + qg * 256 + row;
        float q[48];
#pragma unroll
        for (int i = 0; i < 24; ++i) { const unsigned w = *(const GAS unsigned*)(Q + qrow * QP + h * QKD + hf * 48 + 2 * i); q[2 * i] = bflo(w); q[2 * i + 1] = bfhi(w); }
        float acc[16];
#pragma unroll
        for (int i = 0; i < 16; ++i) acc[i] = 0.f;
        float mrun = -INFINITY, lrun = 0.f;
        const int myc = qg * 4 + (c.wave >> 1), ntile = qg * 4 + 4;
        for (int j = 0; j < ntile; ++j) {
            __syncthreads();
            const size_t kr0 = (size_t)b * SEQ + j * 64;
            for (int e = c.tid; e < 64 * QKD / 2; e += NTHR) { const int kr = e / (QKD / 2), dd = e % (QKD / 2); const unsigned w = *(const GAS unsigned*)(K + (kr0 + kr) * QP + h * QKD + 2 * dd); ks[kr * QKD + 2 * dd] = bflo(w); ks[kr * QKD + 2 * dd + 1] = bfhi(w); }
            for (int e = c.tid; e < 64 * 32; e += NTHR) { const int kr = e & 63, dd = e >> 6; vs[kr * 32 + dd] = bf2f(V[((size_t)(bh * 64 + vh * 32 + dd)) * SEQ + j * 64 + (kr & ~15) + vt_pos(kr & 15)]); }
            __syncthreads();
            if (j <= myc) {
#pragma unroll 1
                for (int k4 = 0; k4 < 64; k4 += 4) {
                    float s[4];
#pragma unroll
                    for (int u = 0; u < 4; ++u) { const LAS f32x4* kp = (const LAS f32x4*)(ks + (k4 + u) * QKD + hf * 48); float d0 = 0.f, d1 = 0.f;
#pragma unroll
                        for (int i = 0; i < 12; ++i) { const f32x4 kv = kp[i]; d0 += q[4 * i] * kv.x + q[4 * i + 2] * kv.z; d1 += q[4 * i + 1] * kv.y + q[4 * i + 3] * kv.w; }
                        s[u] = d0 + d1; }
#pragma unroll
                    for (int u = 0; u < 4; ++u) s[u] += __shfl_xor(s[u], 1);
                    const float mx = fmaxf(fmaxf(s[0], s[1]), fmaxf(s[2], s[3])), mnew = fmaxf(mrun, mx), corr = exp2f(mrun - mnew);
                    mrun = mnew; lrun *= corr;
#pragma unroll
                    for (int i = 0; i < 16; ++i) acc[i] *= corr;
#pragma unroll
                    for (int u = 0; u < 4; ++u) { const float p = exp2f(s[u] - mnew); lrun += p; const LAS f32x4* vp = (const LAS f32x4*)(vs + (k4 + u) * 32 + hf * 16);
#pragma unroll
                        for (int i = 0; i < 4; ++i) { const f32x4 vv = vp[i]; acc[4 * i] += p * vv.x; acc[4 * i + 1] += p * vv.y; acc[4 * i + 2] += p * vv.z; acc[4 * i + 3] += p * vv.w; } }
                }
            }
        }
        const float inv = 1.0f / lrun;
        GAS float* op = O + qrow * AW + h * 64 + vh * 32 + hf * 16;
#pragma unroll
        for (int i = 0; i < 4; ++i) *(GAS f32x4*)(op + 4 * i) = (f32x4){acc[4 * i] * inv, acc[4 * i + 1] * inv, acc[4 * i + 2] * inv, acc[4 * i + 3] * inv};
    }
    __syncthreads();
}
__device__ __forceinline__ void phase_attn_mfma(const Ctx& c) {
    const GAS bf16* Q = (const GAS bf16*)(c.R + R_Q); const GAS bf16* K = (const GAS bf16*)(c.R + R_K); const GAS bf16* Vt = (const GAS bf16*)(c.R + R_V); GAS float* O = (GAS float*)(c.R + R_OATT);
    constexpr int KP = 104, VP = 72, KBUF = 64 * KP * 2, VBUF = 64 * VP * 2, BUF = KBUF + VBUF;
    const int l31 = c.lane & 31, hi = c.lane >> 5, w = c.wave;
    const int nitem = BATCH * AH * 32;
    for (int rnd = 0;; ++rnd) {
        int item;
        const int na = c.nb >= 2 * SCAN_WGS ? c.nb - SCAN_WGS : c.nb;
        if (c.bid >= na) break;
        if (2 * na >= nitem) { if (rnd >= 2) break; item = rnd == 0 ? c.bid : 2 * na - 1 - c.bid; if (item >= nitem) continue; }
        else { item = c.bid + rnd * na; if (item >= nitem) break; }
        const int qb = 31 - item / (BATCH * AH), bh = item % (BATCH * AH), b = bh / AH, h = bh % AH;
        const size_t q0 = (size_t)b * SEQ + qb * 256 + 32 * w;
        bf16x8 qf[6];
#pragma unroll
        for (int ds = 0; ds < 6; ++ds) qf[ds] = *(const GAS bf16x8*)(Q + (q0 + l31) * QP + h * QKD + 16 * ds + 8 * hi);
        f32x16 o0, o1;
#pragma unroll
        for (int r = 0; r < 16; ++r) { o0[r] = 0.f; o1[r] = 0.f; }
        float mrun = -INFINITY, lrun = 0.f;
        const int NT = 4 * qb + 4, myc = 4 * qb + (w >> 1);
        const int kr0 = c.tid / 12, kc0 = c.tid % 12, kr1 = (c.tid + 512) / 12, kc1 = (c.tid + 512) % 12, vr = c.tid >> 3, vc = c.tid & 7;
        const GAS bf16* kg0 = K + ((size_t)b * SEQ + kr0) * QP + h * QKD + 8 * kc0; const GAS bf16* kg1 = K + ((size_t)b * SEQ + kr1) * QP + h * QKD + 8 * kc1;
        const GAS bf16* vg = Vt + ((size_t)(bh * 64 + vr)) * SEQ + 8 * vc;
        const int kl0 = (kr0 * KP + 8 * kc0) * 2, kl1 = (kr1 * KP + 8 * kc1) * 2, vl = KBUF + (vr * VP + 8 * vc) * 2;
        const bool two = c.tid < 256;
        v4u kx0 = *(const GAS v4u*)kg0, kx1 = two ? *(const GAS v4u*)kg1 : (v4u){0u, 0u, 0u, 0u}, vx = *(const GAS v4u*)vg;
        __syncthreads();
        *(LAS v4u*)(c.lds + kl0) = kx0; if (two) *(LAS v4u*)(c.lds + kl1) = kx1; *(LAS v4u*)(c.lds + vl) = vx;
        __syncthreads();
        for (int j = 0; j < NT; ++j) {
            const bool more = j + 1 < NT;
            if (more) { kx0 = *(const GAS v4u*)(kg0 + (size_t)(j + 1) * 64 * QP); if (two) kx1 = *(const GAS v4u*)(kg1 + (size_t)(j + 1) * 64 * QP); vx = *(const GAS v4u*)(vg + (j + 1) * 64); }
            if (j <= myc) {
                const LAS unsigned char* kb = c.lds + (j & 1) * BUF; const LAS unsigned char* vb = kb + KBUF;
                f32x16 p0, p1;
#pragma unroll
                for (int r = 0; r < 16; ++r) { p0[r] = 0.f; p1[r] = 0.f; }
#pragma unroll
                for (int ds = 0; ds < 6; ++ds) {
                    const bf16x8 kf0 = *(const LAS bf16x8*)(kb + (l31 * KP + 16 * ds + 8 * hi) * 2), kf1 = *(const LAS bf16x8*)(kb + ((l31 + 32) * KP + 16 * ds + 8 * hi) * 2);
                    p0 = __builtin_amdgcn_mfma_f32_32x32x16_bf16(kf0, qf[ds], p0, 0, 0, 0); p1 = __builtin_amdgcn_mfma_f32_32x32x16_bf16(kf1, qf[ds], p1, 0, 0, 0);
                }
                float mx = fmaxf(p0[0], p1[0]);
#pragma unroll
                for (int r = 1; r < 16; ++r) mx = fmaxf(mx, fmaxf(p0[r], p1[r]));
                mx = fmaxf(mx, __shfl_xor(mx, 32));
                const float mnew = fmaxf(mrun, mx), corr = __builtin_amdgcn_exp2f(mrun - mnew); mrun = mnew;
                float ls = 0.f;
#pragma unroll
                for (int r = 0; r < 16; ++r) { p0[r] = __builtin_amdgcn_exp2f(p0[r] - mnew); p1[r] = __builtin_amdgcn_exp2f(p1[r] - mnew); ls += p0[r] + p1[r]; }
                lrun = lrun * corr + ls;
#pragma unroll
                for (int r = 0; r < 16; ++r) { o0[r] *= corr; o1[r] *= corr; }
                bf16x8 pb[4];
                { v4u t;
                  t.x = cvtpk(p0[0], p0[1]); t.y = cvtpk(p0[2], p0[3]); t.z = cvtpk(p0[4], p0[5]); t.w = cvtpk(p0[6], p0[7]); pb[0] = __builtin_bit_cast(bf16x8, t);
                  t.x = cvtpk(p0[8], p0[9]); t.y = cvtpk(p0[10], p0[11]); t.z = cvtpk(p0[12], p0[13]); t.w = cvtpk(p0[14], p0[15]); pb[1] = __builtin_bit_cast(bf16x8, t);
                  t.x = cvtpk(p1[0], p1[1]); t.y = cvtpk(p1[2], p1[3]); t.z = cvtpk(p1[4], p1[5]); t.w = cvtpk(p1[6], p1[7]); pb[2] = __builtin_bit_cast(bf16x8, t);
                  t.x = cvtpk(p1[8], p1[9]); t.y = cvtpk(p1[10], p1[11]); t.z = cvtpk(p1[12], p1[13]); t.w = cvtpk(p1[14], p1[15]); pb[3] = __builtin_bit_cast(bf16x8, t); }
#pragma unroll
                for (int sx = 0; sx < 4; ++sx) {
                    const bf16x8 vf0 = *(const LAS bf16x8*)(vb + (l31 * VP + 16 * sx + 8 * hi) * 2), vf1 = *(const LAS bf16x8*)(vb + ((l31 + 32) * VP + 16 * sx + 8 * hi) * 2);
                    o0 = __builtin_amdgcn_mfma_f32_32x32x16_bf16(vf0, pb[sx], o0, 0, 0, 0); o1 = __builtin_amdgcn_mfma_f32_32x32x16_bf16(vf1, pb[sx], o1, 0, 0, 0);
                }
            }
            if (more) { LAS unsigned char* nb_ = c.lds + ((j + 1) & 1) * BUF; *(LAS v4u*)(nb_ + kl0) = kx0; if (two) *(LAS v4u*)(nb_ + kl1) = kx1; *(LAS v4u*)(nb_ + vl) = vx; }
            __syncthreads();
        }
        const float lt = lrun + __shfl_xor(lrun, 32), inv = 1.0f / lt;
        GAS float* op = O + (q0 + l31) * AW + h * 64 + 4 * hi;
#pragma unroll
        for (int g = 0; g < 4; ++g) {
            *(GAS f32x4*)(op + 8 * g) = (f32x4){o0[4 * g] * inv, o0[4 * g + 1] * inv, o0[4 * g + 2] * inv, o0[4 * g + 3] * inv};
            *(GAS f32x4*)(op + 32 + 8 * g) = (f32x4){o1[4 * g] * inv, o1[4 * g + 1] * inv, o1[4 * g + 2] * inv, o1[4 * g + 3] * inv};
        }
    }
    __syncthreads();
}
__device__ __forceinline__ void phase_attn_mfma2(const Ctx& c, int l) {
    const GAS bf16* Q = (const GAS bf16*)(c.R + R_Q); const GAS bf16* K = (const GAS bf16*)(c.R + R_K); const GAS bf16* Vt = (const GAS bf16*)(c.R + R_V); GAS float* O = (GAS float*)(c.R + R_OATT);
    constexpr int KP = 104, VP = 72, KBUF = 128 * KP * 2, VBUF = 64 * VP * 2, BUF = KBUF + 2 * VBUF;
    const int l31 = c.lane & 31, hi = c.lane >> 5, w = c.wave;
    const int nitem = BATCH * AH * 32;
    for (int rnd = 0;; ++rnd) {
        int item;
        const int na = c.nb >= 2 * SCAN_WGS ? c.nb - SCAN_WGS : c.nb;
        if (c.bid >= na) break;
        if (2 * na >= nitem) { if (rnd >= 2) break; item = rnd == 0 ? c.bid : 2 * na - 1 - c.bid; if (item >= nitem) continue; }
        else { item = c.bid + rnd * na; if (item >= nitem) break; }
        const int qb = 31 - item / (BATCH * AH), bh = item % (BATCH * AH), b = bh / AH, h = bh % AH;
        const size_t q0 = (size_t)b * SEQ + qb * 256 + 32 * w;
        bf16x8 qf[6];
#pragma unroll
        for (int ds = 0; ds < 6; ++ds) qf[ds] = *(const GAS bf16x8*)(Q + (q0 + l31) * QP + h * QKD + 16 * ds + 8 * hi);
        f32x16 o0 = zero16(), o1 = zero16();
        float mrun = -INFINITY, lrun = 0.f;
        const int NS = 2 * qb + 2, myc = 4 * qb + (w >> 1);
        int kl[3]; const GAS bf16* kg[3];
#pragma unroll
        for (int i = 0; i < 3; ++i) { const int p = c.tid + 512 * i, kr = p / 12, kc = p % 12; kl[i] = (kr * KP + 8 * kc) * 2; kg[i] = K + ((size_t)b * SEQ + kr) * QP + h * QKD + 8 * kc; }
        int vl[2]; const GAS bf16* vg[2];
#pragma unroll
        for (int i = 0; i < 2; ++i) { const int p = c.tid + 512 * i, half = p >> 9, vr = (p >> 3) & 63, vc = p & 7; vl[i] = KBUF + half * VBUF + (vr * VP + 8 * vc) * 2; vg[i] = Vt + ((size_t)(bh * 64 + vr)) * SEQ + 64 * half + 8 * vc; }
        v4u kx[3], vx[2];
#pragma unroll
        for (int i = 0; i < 3; ++i) kx[i] = *(const GAS v4u*)kg[i];
#pragma unroll
        for (int i = 0; i < 2; ++i) vx[i] = *(const GAS v4u*)vg[i];
        __syncthreads();
#pragma unroll
        for (int i = 0; i < 3; ++i) *(LAS v4u*)(c.lds + kl[i]) = kx[i];
#pragma unroll
        for (int i = 0; i < 2; ++i) *(LAS v4u*)(c.lds + vl[i]) = vx[i];
        __syncthreads();
        for (int j = 0; j < NS; ++j) {
            const bool more = j + 1 < NS;
            if (more) {
#pragma unroll
                for (int i = 0; i < 3; ++i) kx[i] = *(const GAS v4u*)(kg[i] + (size_t)(j + 1) * 128 * QP);
#pragma unroll
                for (int i = 0; i < 2; ++i) vx[i] = *(const GAS v4u*)(vg[i] + (j + 1) * 128); }
            const int nvis = myc - 2 * j + 1;
            if (nvis > 0) {
                const LAS unsigned char* kb = c.lds + (j & 1) * BUF; const LAS unsigned char* vb = kb + KBUF;
                const bool first = mrun == -INFINITY;
                const float cin = first ? 0.f : -mrun;
                f32x16 p0, p1, p2, p3;
#pragma unroll
                for (int r = 0; r < 16; ++r) { p0[r] = cin; p1[r] = cin; p2[r] = cin; p3[r] = cin; }
#define KFR(blk, ds) (*(const LAS bf16x8*)(kb + ((l31 + 32 * (blk)) * KP + 16 * (ds) + 8 * hi) * 2))
                bf16x8 ka[8], kc[8];
#pragma unroll
                for (int ds = 0; ds < 2; ++ds) { ka[4 * ds] = KFR(0, ds); ka[4 * ds + 1] = KFR(1, ds); ka[4 * ds + 2] = KFR(2, ds); ka[4 * ds + 3] = KFR(3, ds); }
#pragma unroll
                for (int ds = 0; ds < 2; ++ds) { kc[4 * ds] = KFR(0, ds + 2); kc[4 * ds + 1] = KFR(1, ds + 2); kc[4 * ds + 2] = KFR(2, ds + 2); kc[4 * ds + 3] = KFR(3, ds + 2); }
#pragma unroll
                for (int ds = 0; ds < 2; ++ds) { p0 = MFMA32(ka[4 * ds], qf[ds], p0); p1 = MFMA32(ka[4 * ds + 1], qf[ds], p1); p2 = MFMA32(ka[4 * ds + 2], qf[ds], p2); p3 = MFMA32(ka[4 * ds + 3], qf[ds], p3); }
#pragma unroll
                for (int ds = 0; ds < 2; ++ds) { ka[4 * ds] = KFR(0, ds + 4); ka[4 * ds + 1] = KFR(1, ds + 4); ka[4 * ds + 2] = KFR(2, ds + 4); ka[4 * ds + 3] = KFR(3, ds + 4); }
#pragma unroll
                for (int ds = 0; ds < 2; ++ds) { p0 = MFMA32(kc[4 * ds], qf[ds + 2], p0); p1 = MFMA32(kc[4 * ds + 1], qf[ds + 2], p1); p2 = MFMA32(kc[4 * ds + 2], qf[ds + 2], p2); p3 = MFMA32(kc[4 * ds + 3], qf[ds + 2], p3); }
#pragma unroll
                for (int ds = 0; ds < 2; ++ds) { p0 = MFMA32(ka[4 * ds], qf[ds + 4], p0); p1 = MFMA32(ka[4 * ds + 1], qf[ds + 4], p1); p2 = MFMA32(ka[4 * ds + 2], qf[ds + 4], p2); p3 = MFMA32(ka[4 * ds + 3], qf[ds + 4], p3); }
#undef KFR
                bf16x8 vfa[8];
#pragma unroll
                for (int sx = 0; sx < 8; ++sx) { const LAS unsigned char* vq = vb + (sx >> 2) * VBUF; vfa[sx] = *(const LAS bf16x8*)(vq + (l31 * VP + 16 * (sx & 3) + 8 * hi) * 2); }
                if (__builtin_amdgcn_readfirstlane(nvis) < 2) {
#pragma unroll
                    for (int r = 0; r < 16; ++r) { p2[r] = -INFINITY; p3[r] = -INFINITY; } }
                float mx = fmaxf(fmaxf(p0[0], p1[0]), fmaxf(p2[0], p3[0]));
#pragma unroll
                for (int r = 1; r < 16; ++r) mx = fmaxf(mx, fmaxf(fmaxf(p0[r], p1[r]), fmaxf(p2[r], p3[r])));
                mx = fmaxf(mx, __shfl_xor(mx, 32));
                const float dl = first ? mx : fmaxf(mx, 0.f);
                if (__any(first || dl != 0.f)) {
                    const float corr = first ? 0.f : __builtin_amdgcn_exp2f(-dl);
#pragma unroll
                    for (int r = 0; r < 16; ++r) { p0[r] -= dl; p1[r] -= dl; p2[r] -= dl; p3[r] -= dl; o0[r] *= corr; o1[r] *= corr; }
                    lrun *= corr; mrun = first ? mx : mrun + dl; }
                float ls = 0.f;
#pragma unroll
                for (int r = 0; r < 16; ++r) { p0[r] = __builtin_amdgcn_exp2f(p0[r]); p1[r] = __builtin_amdgcn_exp2f(p1[r]); p2[r] = __builtin_amdgcn_exp2f(p2[r]); p3[r] = __builtin_amdgcn_exp2f(p3[r]);
                    ls += (p0[r] + p1[r]) + (p2[r] + p3[r]); }
                lrun += ls;
#pragma unroll
                for (int sx = 0; sx < 8; ++sx) {
                    const bf16x8 pb = sx < 2 ? pack8(p0, 8 * (sx & 1)) : sx < 4 ? pack8(p1, 8 * (sx & 1)) : sx < 6 ? pack8(p2, 8 * (sx & 1)) : pack8(p3, 8 * (sx & 1));
                    const LAS unsigned char* vq = vb + (sx >> 2) * VBUF;
                    o0 = MFMA32(vfa[sx], pb, o0); o1 = MFMA32(*(const LAS bf16x8*)(vq + ((l31 + 32) * VP + 16 * (sx & 3) + 8 * hi) * 2), pb, o1);
                }
            }
            if (more) { LAS unsigned char* nb_ = c.lds + ((j + 1) & 1) * BUF;
#pragma unroll
                for (int i = 0; i < 3; ++i) *(LAS v4u*)(nb_ + kl[i]) = kx[i];
#pragma unroll
                for (int i = 0; i < 2; ++i) *(LAS v4u*)(nb_ + vl[i]) = vx[i]; }
            __syncthreads();
        }
        const float lt = lrun + __shfl_xor(lrun, 32), inv = 1.0f / lt;
        GAS float* op = O + (q0 + l31) * AW + h * 64 + 4 * hi;
#pragma unroll
        for (int g = 0; g < 4; ++g) {
            *(GAS f32x4*)(op + 8 * g) = (f32x4){o0[4 * g] * inv, o0[4 * g + 1] * inv, o0[4 * g + 2] * inv, o0[4 * g + 3] * inv};
            *(GAS f32x4*)(op + 32 + 8 * g) = (f32x4){o1[4 * g] * inv, o1[4 * g + 1] * inv, o1[4 * g + 2] * inv, o1[4 * g + 3] * inv};
        }
    }
    __syncthreads();
    if (l == 1) {
        const int na_ = c.nb >= 2 * SCAN_WGS ? c.nb - SCAN_WGS : c.nb;
        if (c.bid < na_) { GAS unsigned* cq = (GAS unsigned*)(c.ws + WS_CTL) + CW_CQ;
            if (c.tid == 0) (void)__hip_atomic_fetch_add(cq + 64, 1u, __ATOMIC_RELAXED, __HIP_MEMORY_SCOPE_AGENT);
            ExpertGUJobs JG{&c}; conv_pop(c, cq, ExpertGUJobs::TOTAL, JG, cq + 64, (unsigned)na_); }
    }
}
__device__ __forceinline__ void phase_mla_post(const Ctx& c, int l) {
    const GAS float* O = (const GAS float*)(c.R + R_OATT); GAS bf16* YC = (GAS bf16*)(c.ws + WS_XN); const GAS float* og = c.in(I_BOG) + l * AW;
    const int i16 = c.lane & 15, g16 = c.lane >> 4;
    f32x4 gv[6];
#pragma unroll
    for (int k = 0; k < 6; ++k) gv[k] = *(const GAS f32x4*)(og + 64 * k + 4 * i16);
    for (int m0 = c.gw * 4; m0 < M; m0 += c.ngw * 8) {
        const int mA = m0 + g16, mB = mA + c.ngw * 4; const bool hasB = m0 + c.ngw * 4 < M;
        f32x4 xa[6], xb[6];
#pragma unroll
        for (int k = 0; k < 6; ++k) xa[k] = *(const GAS f32x4*)(O + (size_t)mA * AW + 64 * k + 4 * i16);
        if (hasB) {
#pragma unroll
            for (int k = 0; k < 6; ++k) xb[k] = *(const GAS f32x4*)(O + (size_t)mB * AW + 64 * k + 4 * i16); }
        { float ss = 0.f;
#pragma unroll
          for (int k = 0; k < 6; ++k) ss += (xa[k].x * xa[k].x + xa[k].y * xa[k].y) + (xa[k].z * xa[k].z + xa[k].w * xa[k].w);
          const float rstd = __builtin_amdgcn_rsqf(row16_sum(ss) * (1.0f / AW) + EPS);
#pragma unroll
          for (int k = 0; k < 6; ++k) { const f32x4 v = xa[k] * rstd * gv[k]; *(GAS v2u*)(YC + (size_t)mA * D + AW + 64 * k + 4 * i16) = (v2u){pk2(v.x, v.y), pk2(v.z, v.w)}; } }
        if (hasB) { float ss = 0.f;
#pragma unroll
          for (int k = 0; k < 6; ++k) ss += (xb[k].x * xb[k].x + xb[k].y * xb[k].y) + (xb[k].z * xb[k].z + xb[k].w * xb[k].w);
          const float rstd = __builtin_amdgcn_rsqf(row16_sum(ss) * (1.0f / AW) + EPS);
#pragma unroll
          for (int k = 0; k < 6; ++k) { const f32x4 v = xb[k] * rstd * gv[k]; *(GAS v2u*)(YC + (size_t)mB * D + AW + 64 * k + 4 * i16) = (v2u){pk2(v.x, v.y), pk2(v.z, v.w)}; } }
    }
}

__device__ __forceinline__ void phase_gmlp(const Ctx& c, int l) {
    const GAS bf16* Z = (const GAS bf16*)(c.R + R_Z); GAS bf16* YC = (GAS bf16*)(c.ws + WS_XN);
    const GAS float* lng = c.in(I_CLNG) + l * 256; const GAS float* lnb = c.in(I_CLNB) + l * 256; const GAS float* ws = c.in(I_CWS) + (size_t)l * 4 * 128 * 128; const GAS float* bs = c.in(I_CBS) + l * 4 * 128; const GAS float* og = c.in(I_COG) + l * 256;
    LAS float* vln = (LAS float*)c.lds;
    LAS float* ssq2 = (LAS float*)(c.lds + MISC_OFF + 256);
    for (int item = c.bid; item < M / 128; item += c.nb) {
        const int m0 = item * 128;
        __syncthreads();
        for (int q = 0; q < 16; ++q) { const int t = c.wave * 16 + q; const GAS bf16* zr = Z + (size_t)(m0 + t) * ZP + ZCV;
            float x[4]; float s = 0.f;
#pragma unroll
            for (int i = 0; i < 4; ++i) { x[i] = gelu_erf(bf2f(zr[c.lane + 64 * i])); s += x[i]; }
            const float mean = wave_sum(s) * (1.0f / 256.0f); float s2 = 0.f;
#pragma unroll
            for (int i = 0; i < 4; ++i) { x[i] -= mean; s2 += x[i] * x[i]; }
            const float rstd = __builtin_amdgcn_rsqf(wave_sum(s2) * (1.0f / 256.0f) + EPS);
#pragma unroll
            for (int i = 0; i < 4; ++i) vln[t * 256 + c.lane + 64 * i] = x[i] * rstd * lng[c.lane + 64 * i] + lnb[c.lane + 64 * i];
        }
        __syncthreads();
        const int g = c.wave & 3, half = c.wave >> 2, ch = g * 64 + c.lane;
        for (int tt = 0; tt < 64; ++tt) { const int t = half * 64 + tt; const GAS float* wr = ws + ((size_t)g * 128 + t) * 128; float acc = 0.f;
            for (int s = 0; s <= t; ++s) acc += wr[s] * vln[s * 256 + ch];
            const float sv = acc + bs[g * 128 + t]; const float u = gelu_erf(bf2f(Z[(size_t)(m0 + t) * ZP + ZU + ch])); const float y = u * sv;
            const float p = wave_sum(y * y); if (c.lane == 0) ssq2[t * 4 + g] = p;
            YC[(size_t)(m0 + t) * D + 768 + ch] = (bf16)f2bf(y); }
        __syncthreads();
        for (int tt = 0; tt < 64; ++tt) { const int t = half * 64 + tt; const float tot = (ssq2[t * 4 + 0] + ssq2[t * 4 + 1]) + (ssq2[t * 4 + 2] + ssq2[t * 4 + 3]);
            const float rstd = __builtin_amdgcn_rsqf(tot * (1.0f / 256.0f) + EPS); GAS bf16* p = YC + (size_t)(m0 + t) * D + 768 + ch; *p = (bf16)f2bf(bf2f(*p) * rstd * og[ch]); }
    }
    __syncthreads();
}


__device__ __forceinline__ void phase_gmlp_mfma(const Ctx& c, int l) {
    const GAS bf16* Z = (const GAS bf16*)(c.R + R_Z); GAS bf16* YC = (GAS bf16*)(c.ws + WS_XN);
    const GAS float* lng = c.in(I_CLNG) + l * 256; const GAS float* lnb = c.in(I_CLNB) + l * 256; const GAS float* bs = c.in(I_CBS) + l * 4 * 128; const GAS float* og = c.in(I_COG) + l * 256;
    const GAS bf16* W = (const GAS bf16*)(c.ws + WS_WSM + WSM_GW) + (size_t)l * 4 * 128 * 128;
    constexpr int VP = 136;
    LAS unsigned short* vT = (LAS unsigned short*)c.lds;
    LAS float* sq = (LAS float*)(c.lds + 256 * VP * 2);
    const int lane = c.lane, l31 = lane & 31, hi = lane >> 5;
    float lg4[4], lb4[4];
#pragma unroll
    for (int i = 0; i < 4; ++i) { lg4[i] = lng[lane + 64 * i]; lb4[i] = lnb[lane + 64 * i]; }
    for (int it_ = c.bid; it_ < M / 64; it_ += c.nb) {
        const int item = c.nb == 256 ? (it_ < 64 ? 2 * it_ + 1 : it_ < 192 ? 2 * (it_ - 64) : 2 * (it_ - 128) + 1) : it_;
        const int th = item & 1, m0 = (item >> 1) * 128, nq = 8 * (th + 1);
        __syncthreads();
        for (int q0 = 0; q0 < nq; q0 += 4) {
            float zx[4][4];
#pragma unroll
            for (int u = 0; u < 4; ++u) { const GAS bf16* zr = Z + (size_t)(m0 + c.wave * nq + q0 + u) * ZP + ZCV;
#pragma unroll
                for (int i = 0; i < 4; ++i) zx[u][i] = bf2f(zr[lane + 64 * i]); }
            float x[4][4], s1[4], s2[4];
#pragma unroll
            for (int u = 0; u < 4; ++u) { s1[u] = 0.f; s2[u] = 0.f;
#pragma unroll
                for (int i = 0; i < 4; i += 2) { const pg8::f32x2 gv = pg8::gelu_pk((pg8::f32x2){zx[u][i], zx[u][i + 1]}); x[u][i] = gv.x; x[u][i + 1] = gv.y; s1[u] += gv.x + gv.y; s2[u] += gv.x * gv.x + gv.y * gv.y; } }
#pragma unroll
            for (int u = 0; u < 4; ++u) { s1[u] = wave_sum(s1[u]); s2[u] = wave_sum(s2[u]); }
            float mean[4], rstd[4];
#pragma unroll
            for (int u = 0; u < 4; ++u) { mean[u] = s1[u] * (1.0f / 256.0f); rstd[u] = __builtin_amdgcn_rsqf(fmaxf(s2[u] * (1.0f / 256.0f) - mean[u] * mean[u], 0.f) + EPS); }
            const int t0 = c.wave * nq + q0;
#pragma unroll
            for (int i = 0; i < 4; ++i) { float y[4];
#pragma unroll
                for (int u = 0; u < 4; ++u) y[u] = (x[u][i] - mean[u]) * rstd[u] * lg4[i] + lb4[i];
                *(LAS v2u*)(vT + (lane + 64 * i) * VP + t0) = (v2u){pk2(y[0], y[1]), pk2(y[2], y[3])}; }
        }
        __syncthreads();
        const int tb = 2 * th + (c.wave & 1), g = c.wave >> 1; const int t = 32 * tb + l31, tl = 32 * (c.wave & 1) + l31; const size_t m = (size_t)m0 + t;
        float ss = 0.f; const float bias = bs[g * 128 + t];
        const GAS bf16* wr = W + ((size_t)g * 128 + t) * 128 + 8 * hi;
#pragma unroll 1
        for (int i = 0; i < 2; ++i) { const int cblk = 2 * g + i; f32x16 a = zero16();
            for (int ks = 0; ks < 2 * tb + 2; ++ks) a = MFMA32(*(const LAS bf16x8*)(vT + (32 * cblk + l31) * VP + 16 * ks + 8 * hi), *(const GAS bf16x8*)(wr + 16 * ks), a);
#pragma unroll
            for (int gq = 0; gq < 4; ++gq) { const int ch = 32 * cblk + 8 * gq + 4 * hi; const v2u zu = *(const GAS v2u*)(Z + m * ZP + ZU + ch);
                const pg8::f32x2 u01 = pg8::gelu_pk((pg8::f32x2){bflo(zu.x), bfhi(zu.x)}), u23 = pg8::gelu_pk((pg8::f32x2){bflo(zu.y), bfhi(zu.y)});
                const float y0 = u01.x * (a[4 * gq] + bias), y1 = u01.y * (a[4 * gq + 1] + bias), y2 = u23.x * (a[4 * gq + 2] + bias), y3 = u23.y * (a[4 * gq + 3] + bias);
                ss += (y0 * y0 + y1 * y1) + (y2 * y2 + y3 * y3);
                *(GAS v2u*)(YC + m * D + 768 + ch) = (v2u){pk2(y0, y1), pk2(y2, y3)}; } }
        ss += __shfl_xor(ss, 32);
        if (hi == 0) sq[g * 64 + tl] = ss;
        __syncthreads();
        const float rstd = __builtin_amdgcn_rsqf(((sq[tl] + sq[64 + tl]) + (sq[128 + tl] + sq[192 + tl])) * (1.0f / 256.0f) + EPS);
#pragma unroll 1
        for (int i = 0; i < 2; ++i) { const int cblk = 2 * g + i;
#pragma unroll
            for (int gq = 0; gq < 4; ++gq) { const int ch = 32 * cblk + 8 * gq + 4 * hi; const f32x4 o4 = *(const GAS f32x4*)(og + ch); GAS v2u* p = (GAS v2u*)(YC + m * D + 768 + ch); const v2u w = *p;
                *p = (v2u){pk2(bflo(w.x) * rstd * o4.x, bfhi(w.x) * rstd * o4.y), pk2(bflo(w.y) * rstd * o4.z, bfhi(w.y) * rstd * o4.w)}; } }
    }
    __syncthreads();
}

__device__ __forceinline__ void phase_moe_count(const Ctx& c) {
    const GAS int* te = (const GAS int*)(c.ws + WS_TOK + TOK_E); GAS int* seg = (GAS int*)(c.ws + WS_TOK + TOK_SEG);
    for (int sgi = c.gw; sgi < NSEG; sgi += c.ngw) {
        const int m = sgi * SEGT + c.lane; const int e0 = te[2 * m], e1 = te[2 * m + 1];
#pragma unroll
        for (int e = 0; e < NE; ++e) { const unsigned long long b0 = __ballot(e0 == e), b1 = __ballot(e1 == e); if (c.lane == 0) seg[sgi * NE + e] = __popcll(b0) + __popcll(b1); }
    }
}
__device__ __forceinline__ void phase_moe_scatter(const Ctx& c) {
    const GAS int* te = (const GAS int*)(c.ws + WS_TOK + TOK_E); const GAS int* seg = (const GAS int*)(c.ws + WS_TOK + TOK_SEG); GAS int* tpos = (GAS int*)(c.ws + WS_TOK + TOK_POS); GAS int* tile = (GAS int*)(c.ws + WS_TOK + TOK_TILE);
    const GAS bf16* XN = (const GAS bf16*)(c.ws + WS_XN); GAS bf16* XNP = (GAS bf16*)(c.R + R_XNP);
    LAS int* pre = (LAS int*)c.lds;
    LAS int* tot = pre + NSEG * NE;
    LAS int* base = tot + NE;
    __syncthreads();
    if (c.tid < NE) { int s = 0; for (int sgi = 0; sgi < NSEG; ++sgi) { pre[sgi * NE + c.tid] = s; s += seg[sgi * NE + c.tid]; } tot[c.tid] = s; }
    __syncthreads();
    if (c.tid == 0) { int s = 0; for (int e = 0; e < NE; ++e) { base[e] = s; s += (tot[e] + 255) & ~255; }
        if (c.bid == 0) { int T = 0; for (int e = 0; e < NE; ++e) { const int n = ((tot[e] + 255) & ~255) / 256; tile[e] = base[e] / 256; tile[8 + e] = n; for (int i = 0; i < n; ++i) tile[32 + T + i] = e; T += n; } tile[16] = T; } }
    __syncthreads();
    for (int sgi = c.bid; sgi < NSEG; sgi += c.nb) {
        const int m = sgi * SEGT + c.lane; const int e0 = te[2 * m], e1 = te[2 * m + 1]; int p0 = 0, p1 = 0;
        const unsigned long long below = (1ull << c.lane) - 1ull;
#pragma unroll
        for (int e = 0; e < NE; ++e) { const unsigned long long b0 = __ballot(e0 == e), b1 = __ballot(e1 == e);
            const int r = __popcll(b0 & below) + __popcll(b1 & below); const int st = base[e] + pre[sgi * NE + e];
            if (e0 == e) p0 = st + r; if (e1 == e) p1 = st + r + ((e0 == e) ? 1 : 0); }
        if (c.wave == 0) { tpos[2 * m] = p0; tpos[2 * m + 1] = p1; }
        v4u x0[8], x1[8];
#pragma unroll
        for (int u = 0; u < 8; ++u) { const GAS v4u* src = (const GAS v4u*)(XN + (size_t)(sgi * SEGT + 8 * c.wave + u) * D) + c.lane; x0[u] = src[0]; x1[u] = src[64]; }
#pragma unroll
        for (int u = 0; u < 8; ++u) { const int d0 = __shfl(p0, 8 * c.wave + u), d1 = __shfl(p1, 8 * c.wave + u); GAS v4u* o0 = (GAS v4u*)(XNP + (size_t)d0 * D) + c.lane; GAS v4u* o1 = (GAS v4u*)(XNP + (size_t)d1 * D) + c.lane;
            o0[0] = x0[u]; o0[64] = x1[u]; o1[0] = x0[u]; o1[64] = x1[u]; }
    }
    for (int e = 0; e < NE; ++e) { const int r0 = base[e] + tot[e], r1 = base[e] + ((tot[e] + 255) & ~255);
        for (int r = r0 + c.gw; r < r1; r += c.ngw) { GAS v4u* o = (GAS v4u*)(XNP + (size_t)r * D) + c.lane; o[0] = (v4u){0u, 0u, 0u, 0u}; o[64] = (v4u){0u, 0u, 0u, 0u}; } }
    __syncthreads();
}
__device__ __forceinline__ void phase_moe_combine(const Ctx& c) {
    const GAS float* tg = (const GAS float*)(c.ws + WS_TOK + TOK_G); const GAS int* tpos = (const GAS int*)(c.ws + WS_TOK + TOK_POS); const GAS bf16* YP = (const GAS bf16*)(c.R + R_YP); GAS float* out = c.out();
    v2u a0n[4], a1n[4]; f32x4 xn_[4]; float g0n = 0.f, g1n = 0.f;
#define CB_LOAD(tok) do { g0n = tg[2 * (tok)]; g1n = tg[2 * (tok) + 1]; const int p0_ = tpos[2 * (tok)], p1_ = tpos[2 * (tok) + 1]; \
        const GAS v2u* y0_ = (const GAS v2u*)(YP + (size_t)p0_ * D) + c.lane; const GAS v2u* y1_ = (const GAS v2u*)(YP + (size_t)p1_ * D) + c.lane; \
        const GAS v2u* o_ = (const GAS v2u*)((tok) < M / 2 ? (const GAS bf16*)(c.ws + WS_XB2LO) + (size_t)(tok) * D : (const GAS bf16*)(c.R + R_XB2HI) + (size_t)((tok) - M / 2) * D) + c.lane; \
        _Pragma("unroll") for (int j = 0; j < 4; ++j) { a0n[j] = y0_[64 * j]; a1n[j] = y1_[64 * j]; const v2u w_ = o_[64 * j]; xn_[j] = (f32x4){bflo(w_.x), bfhi(w_.x), bflo(w_.y), bfhi(w_.y)}; } } while (0)
    if (c.gw < M) CB_LOAD(c.gw);
    for (int m = c.gw; m < M; m += c.ngw) {
        v2u a0[4], a1[4]; f32x4 x[4]; const float g0 = g0n, g1 = g1n;
#pragma unroll
        for (int j = 0; j < 4; ++j) { a0[j] = a0n[j]; a1[j] = a1n[j]; x[j] = xn_[j]; }
        if (m + c.ngw < M) CB_LOAD(m + c.ngw);
        GAS f32x4* o = (GAS f32x4*)(out + (size_t)m * D) + c.lane;
#pragma unroll
        for (int j = 0; j < 4; ++j) { f32x4 y = x[j];
            y.x += g0 * bflo(a0[j].x) + g1 * bflo(a1[j].x); y.y += g0 * bfhi(a0[j].x) + g1 * bfhi(a1[j].x); y.z += g0 * bflo(a0[j].y) + g1 * bflo(a1[j].y); y.w += g0 * bfhi(a0[j].y) + g1 * bfhi(a1[j].y); o[64 * j] = y; }
    }
#undef CB_LOAD
}

enum { PH_CONV = 0, PH_NORM1, PH_GEMM_IN, PH_RWKV_PREP, PH_MLA_PREP, PH_GMLP, PH_SCAN, PH_ATTN, PH_POST, PH_GEMM_OUT, PH_NORM2, PH_DGU, PH_DDOWN, PH_NORM2R, PH_COUNT, PH_SCATTER, PH_CONVE, PH_EGU, PH_EDOWN, PH_COMBINE, PH_CHUNK, PH_RWKV_OUT, PH_MLA_POST1, PH_MLA_PREP2, PH_EDOWNX, PH_GEMM_OUTN, PH_CONVB };
#ifndef PHASE_INLINE
#define PHASE_INLINE __forceinline__
#endif
template <int PH> __device__ PHASE_INLINE void do_phase(const Ctx& c, int l, int e) {
    bf16* XN = (bf16*)(c.ws + WS_XN); bf16* Zb = (bf16*)(c.R + R_Z); bf16* YC = (bf16*)(c.ws + WS_XN);
    GAS bf16* XNg = (GAS bf16*)(c.ws + WS_XN);
    if constexpr (PH == PH_CONV) phase_conv_static(c);
    if constexpr (PH == PH_CONVB) phase_conv_b(c);
    if constexpr (PH == PH_NORM1) phase_rmsnorm<false>(c, l == 0 ? c.in(I_X) : (const GAS float*)c.out(), c.in(I_MIXG) + l * D, XNg, nullptr);
    if constexpr (PH == PH_GEMM_IN) { pg8::Gemm g{XN, (const bf16*)(c.ws + WS_WIN) + (size_t)l * ZP * D, M, ZP, D, 0}; pg8::StaticOrder S; S.init(M, ZP, c.nb, c.bid); pg8::EpiBf16P E{Zb, ZP, ZP / 256, l == 1 ? (const float*)(c.R + R_SS1) : nullptr, 1.0f / D};
        pg8::gemm_phase<pg8::EpiBf16P, pg8::StaticOrder, true, true>(c.lds, g, S, E); }
#ifndef RWKV_NAIVE
#define RWKV_NAIVE 0
#endif
#ifndef RWKV_PREP_VALU
#define RWKV_PREP_VALU 0
#endif
#ifndef RWKV_PREP4
#define RWKV_PREP4 0
#endif
    if constexpr (PH == PH_RWKV_PREP) { if (RWKV_NAIVE) phase_rwkv_prep(c, l); else if (RWKV_PREP_VALU) phase_rwkv_prep2(c, l); else if (RWKV_PREP4) phase_rwkv_prep4(c, l); else phase_rwkv_prep3(c, l); }
    if constexpr (PH == PH_CHUNK) { if (!RWKV_NAIVE) phase_rwkv_chunk(c); }
    if constexpr (PH == PH_RWKV_OUT) { if (!RWKV_NAIVE) phase_rwkv_out(c, l); }
#ifndef MLA_NAIVE
#define MLA_NAIVE 0
#endif
    if constexpr (PH == PH_MLA_PREP) { if (MLA_NAIVE) phase_mla_prep(c, l); else {
        pg8::Gemm g{Zb + ZCQ, (const bf16*)(c.ws + WS_WSM + WSM_UQ) + (size_t)l * 768 * 256, M, 768, 256, ZP}; pg8::StaticOrder S; S.init(M, 768, c.nb, c.bid); pg8::EpiBf16P E{(bf16*)(c.R + R_QR), 768, 3, nullptr, 0.f};
        pg8::gemm_phase<pg8::EpiBf16P, pg8::StaticOrder, true, true>(c.lds, g, S, E); } }
    if constexpr (PH == PH_MLA_PREP2) { if (!MLA_NAIVE) {
        int k128 = 128; asm volatile("" : "+s"(k128));
        pg8::Gemm g{Zb + ZCKV, (const bf16*)(c.ws + WS_WSM + WSM_UKV) + (size_t)l * 768 * 128, M, 768, k128, ZP}; pg8::StaticOrder S; S.init(M, 768, c.nb, (c.bid + 192) % c.nb); pg8::EpiBf16P E{(bf16*)(c.R + R_KVR), 768, 3, nullptr, 0.f};
        pg8::gemm_phase<pg8::EpiBf16P, pg8::StaticOrder, true, true>(c.lds, g, S, E); } }
    #ifndef MLA_POST1_OLD
#define MLA_POST1_OLD 0
#endif
    if constexpr (PH == PH_MLA_POST1) { if (!MLA_NAIVE) { if (MLA_POST1_OLD) phase_mla_post1(c, l); else phase_mla_post1b(c, l); } }
#ifndef GMLP_NAIVE
#define GMLP_NAIVE 0
#endif
    if constexpr (PH == PH_GMLP) { if (GMLP_NAIVE) phase_gmlp(c, l); else phase_gmlp_mfma(c, l); }
    if constexpr (PH == PH_SCAN) { if (RWKV_NAIVE) phase_rwkv_scan_naive(c); else phase_rwkv_scan2(c); }
#ifndef ATTN_NAIVE
#define ATTN_NAIVE 0
#endif
#ifndef ATTN_ONE_TILE
#define ATTN_ONE_TILE 0
#endif
    if constexpr (PH == PH_ATTN) { if (ATTN_NAIVE) phase_attn_naive(c); else if (ATTN_ONE_TILE) phase_attn_mfma(c); else phase_attn_mfma2(c, l); }
    if constexpr (PH == PH_POST) { if (RWKV_NAIVE) phase_rwkv_post(c, l); phase_mla_post(c, l); }
    if constexpr (PH == PH_GEMM_OUT) { pg8::Gemm g{YC, (const bf16*)(c.ws + WS_WOUT) + (size_t)l * D * D, M, D, D, 0}; pg8::StaticOrder S; S.init(M, D, c.nb, c.bid);
        pg8::EpiResT<true, true> E{(const void*)(c.R + R_XB), (void*)(c.ws + WS_XB2LO), D, (long)((c.R + R_XB2HI) - (c.ws + WS_XB2LO)) - (long)(M / 2) * D * 2};
        pg8::gemm_phase<pg8::EpiResT<true, true>, pg8::StaticOrder, true, true>(c.lds, g, S, E); }
    if constexpr (PH == PH_NORM2) phase_rmsnorm<false>(c, c.out(), c.in(I_FFNG), XNg, nullptr);
    if constexpr (PH == PH_DGU) { pg8::Gemm g{(const bf16*)(c.R + R_XN2), (const bf16*)(c.ws + WS_WDGU), M, 2 * DFF, D, 0}; pg8::StaticOrder S; S.init(M, 2 * DFF, c.nb, c.bid); pg8::EpiSwiGLU E{(bf16*)(c.R + R_H), DFF, 2 * DFF / 256, (const float*)(c.R + R_SS0), 1.0f / D};
        pg8::gemm_phase<pg8::EpiSwiGLU, pg8::StaticOrder, true, true>(c.lds, g, S, E); }
    if constexpr (PH == PH_DDOWN) { pg8::Gemm g{(const bf16*)(c.R + R_H), (const bf16*)(c.ws + WS_WDD), M, D, DFF, 0}; pg8::StaticOrder S; S.init(M, D, c.nb, c.bid);
        pg8::EpiResNT<true, true> E{(const void*)(c.R + R_XB), (void*)(c.R + R_XB), D, XN, (const float*)(c.in(I_MIXG) + D), (float*)(c.R + R_SS1)};
        pg8::gemm_phase<pg8::EpiResNT<true, true>, pg8::StaticOrder, true, true>(c.lds, g, S, E); }
    if constexpr (PH == PH_GEMM_OUTN) { pg8::Gemm g{YC, (const bf16*)(c.ws + WS_WOUT), M, D, D, 0}; pg8::StaticOrder S; S.init(M, D, c.nb, c.bid);
        pg8::EpiResNT<false, true> E{(const void*)c.in(I_X), (void*)(c.R + R_XB), D, (bf16*)(c.R + R_XN2), (const float*)c.in(I_FFNG), (float*)(c.R + R_SS0)};
        pg8::gemm_phase<pg8::EpiResNT<false, true>, pg8::StaticOrder, true, true>(c.lds, g, S, E); }
    if constexpr (PH == PH_NORM2R) { phase_rmsnorm<true>(c, c.out(), c.in(I_FFNG) + D, XNg, c.in(I_ROUTER)); __syncthreads(); phase_conv_experts(c); }
    if constexpr (PH == PH_COUNT) phase_moe_count(c);
    if constexpr (PH == PH_SCATTER) phase_moe_scatter(c);
    if constexpr (PH == PH_EGU || PH == PH_EDOWN || PH == PH_EDOWNX) {
        const int* tile = (const int*)(c.ws + WS_TOK + TOK_TILE); LAS int* te = (LAS int*)(c.lds + RING_BYTES + 8192);
        const int T = __builtin_amdgcn_readfirstlane(tile[16]);
        __syncthreads();
        if (c.tid < 2 * M / 256 + NE) te[c.tid] = tile[32 + c.tid];
        __syncthreads();
        const int nx = T - 2 * HMAIN, ndx = nx * (D / 256) < c.nb / 2 ? nx * (D / 256) : 0;
        if constexpr (PH == PH_EGU) {
            const int t0 = e ? HMAIN : 0, n1 = e ? 0 : nx;
            pg8::Gemm g{(const bf16*)(c.R + R_XNP), (const bf16*)(c.R + R_WMGU), M2MAX, NE * 2 * DFE, D, 0};
            pg8::MoeOrder<true> S{te, t0, HMAIN, 0, 2 * HMAIN, n1, HMAIN, 2 * DFE / 256, c.nb, c.bid, e ? ndx : 0, 4};
            pg8::EpiSwiGLU E{(bf16*)(c.R + R_HME), DFE, 2 * DFE / 256, nullptr, 0.f};
            pg8::gemm_phase<pg8::EpiSwiGLU, pg8::MoeOrder<true>, true, true>(c.lds, g, S, E);
        } else {
            const bool xtra = PH == PH_EDOWNX;
            if (!xtra || ndx > 0) {
            pg8::Gemm g{(const bf16*)(c.R + R_HME), (const bf16*)(c.R + R_WMD), HCAP * 256, NE * D, DFE, 0};
            pg8::MoeOrder<false> S{te, xtra ? 2 * HMAIN : (e ? HMAIN : 0), xtra ? nx : HMAIN, xtra ? HMAIN : 0, 2 * HMAIN, (!xtra && !e && ndx == 0) ? nx : 0, HMAIN, D / 256, c.nb, c.bid, 0, 0};
            pg8::EpiBf16P E{(bf16*)(c.R + R_YP), D, D / 256, nullptr, 0.f};
            pg8::gemm_phase<pg8::EpiBf16P, pg8::MoeOrder<false>, true, true>(c.lds, g, S, E); }
        }
    }
    if constexpr (PH == PH_COMBINE) phase_moe_combine(c);
}


__device__ __forceinline__ void make_ctx(Ctx& c, LAS unsigned char* lds, int wave_s) {
    (void)wave_s; int tid = threadIdx.x; asm volatile("" : "+v"(tid));
    int bid = blockIdx.x, nb = gridDim.x; asm volatile("" : "+s"(bid)); asm volatile("" : "+s"(nb));
    c.lds = lds; c.tid = tid; c.lane = tid & 63; c.wave = __builtin_amdgcn_readfirstlane(tid >> 6); c.bid = bid; c.nb = nb;
    c.gw = c.bid * NWAVES + c.wave; c.ngw = c.nb * NWAVES; c.ws = (GAS unsigned char*)c.ptr_(40); c.R = c.ws + WS_R;
}
__device__ __forceinline__ void kernel_prologue(const Args& args, LAS unsigned char* lds) {
    for (int u = threadIdx.x; u < (LDS_BYTES - RING_BYTES) / 4; u += NTHR) ((LAS unsigned*)(lds + RING_BYTES))[u] = 0u;
    __syncthreads();
    if (threadIdx.x < 82) ((LAS unsigned*)(lds + ARGS_OFF))[threadIdx.x] = ((const unsigned*)&args)[threadIdx.x];
    __syncthreads();
}
template <int PH> __device__ __forceinline__ void run_phase(LAS unsigned char* lds, int l, int e, int wave_s) {
    asm volatile("" : "+s"(l)); asm volatile("" : "+s"(e)); asm volatile("" : "+s"(wave_s));
    Ctx c; make_ctx(c, lds, wave_s);
    do_phase<PH>(c, l, e);
}
#if !MK_ONE_LAUNCH
template <int PH> __global__ void __launch_bounds__(NTHR, 2) k_ph(Args args, int l, int e) {
    extern __shared__ __attribute__((aligned(16))) unsigned char lds_raw[];
    kernel_prologue(args, (LAS unsigned char*)lds_raw);
    run_phase<PH>((LAS unsigned char*)lds_raw, l, e, __builtin_amdgcn_readfirstlane(threadIdx.x >> 6));
}
#else
__global__ void __launch_bounds__(NTHR, 2) k_mega(Args args) {
    extern __shared__ __attribute__((aligned(16))) unsigned char lds_raw[];
    LAS unsigned char* lds = (LAS unsigned char*)lds_raw;
    kernel_prologue(args, lds);
    volatile LAS unsigned* MISC = (volatile LAS unsigned*)(lds + MISC_OFF);
    (void)xcd_barrier_post((unsigned*)(args.ws + WS_CTL) + CW_BAR, MISC + 8);
    int wave_s = __builtin_amdgcn_readfirstlane(threadIdx.x >> 6);
#define GRIDBAR() do { Ctx cb_; cb_.lds = lds; XcdBarrier b_; b_.bar = (unsigned*)((unsigned char*)cb_.ptr_(40) + WS_CTL) + CW_BAR; b_.x = xb_xcc_id(); b_.st = (volatile LAS unsigned*)(lds + MISC_OFF) + 8; xcd_barrier(b_); } while (0)
#define PHASE(PH, l, e) do { run_phase<PH>(lds, l, e, wave_s); GRIDBAR(); } while (0)
#define MIXER_CORE(l) do { run_phase<PH_GEMM_IN>(lds, l, 0, wave_s); if ((l) == 0) run_phase<PH_CONVB>(lds, 0, 0, wave_s); GRIDBAR(); \
        run_phase<PH_RWKV_PREP>(lds, l, 0, wave_s); run_phase<PH_MLA_PREP>(lds, l, 0, wave_s); run_phase<PH_MLA_PREP2>(lds, l, 0, wave_s); PHASE(PH_GMLP, l, 0); \
        run_phase<PH_MLA_POST1>(lds, l, 0, wave_s); PHASE(PH_CHUNK, l, 0); \
        run_phase<PH_SCAN>(lds, l, 0, wave_s); PHASE(PH_ATTN, l, 0); \
        run_phase<PH_RWKV_OUT>(lds, l, 0, wave_s); PHASE(PH_POST, l, 0); } while (0)
    run_phase<PH_CONV>(lds, 0, 0, wave_s); PHASE(PH_NORM1, 0, 0);
    MIXER_CORE(0);
    PHASE(PH_GEMM_OUTN, 0, 0);
    PHASE(PH_DGU, 0, 0); PHASE(PH_DDOWN, 0, 0);
    MIXER_CORE(1);
    PHASE(PH_GEMM_OUT, 1, 0);
    PHASE(PH_NORM2R, 1, 0); PHASE(PH_SCATTER, 1, 0);
    PHASE(PH_EGU, 1, 0); PHASE(PH_EDOWN, 1, 0); run_phase<PH_EDOWNX>(lds, 1, 0, wave_s); PHASE(PH_EGU, 1, 1); PHASE(PH_EDOWN, 1, 1);
    run_phase<PH_COMBINE>(lds, 1, 0, wave_s);
#undef MIXER_CORE
#undef PHASE
#undef GRIDBAR
}
#endif

#if !MK_ONE_LAUNCH
template <int PH> static void launch_ph(const Args& a, int l, int e, int grid, hipStream_t stream) {
    static bool attr = false;
    if (!attr) { (void)hipFuncSetAttribute((const void*)k_ph<PH>, hipFuncAttributeMaxDynamicSharedMemorySize, LDS_BYTES); attr = true; }
    hipLaunchKernelGGL(k_ph<PH>, dim3(grid), dim3(NTHR), LDS_BYTES, stream, a, l, e);
}
#endif
extern "C" void kernel_launch(void* const* d_in, const int* in_sizes, int n_in, void* d_out, int out_size, void* d_ws, size_t ws_size, hipStream_t stream) {
    static int grid = 0;
    if (grid == 0) {
        if (n_in != 39 || out_size != M * D || ws_size < WS_END) { fprintf(stderr, "kernel_launch: unexpected shapes (n_in %d, out %d, ws %zu < %zu)\n", n_in, out_size, ws_size, (size_t)WS_END); grid = -1; return; }
        int dev = 0, cus = 0;
        if (hipGetDevice(&dev) != hipSuccess || hipDeviceGetAttribute(&cus, hipDeviceAttributeMultiprocessorCount, dev) != hipSuccess) { grid = -1; return; }
        grid = cus;
    }
    if (grid < 0) return;
    Args a{};
    for (int i = 0; i < 39; ++i) a.in[i] = (const float*)d_in[i];
    a.out = (float*)d_out; a.ws = (unsigned char*)d_ws; a.ph_lo = 0; a.ph_hi = 0;
#if MK_ONE_LAUNCH
    {
        static bool attr = false;
        if (!attr) { (void)hipFuncSetAttribute((const void*)k_mega, hipFuncAttributeMaxDynamicSharedMemorySize, LDS_BYTES); attr = true; }
        (void)hipMemsetAsync((char*)d_ws + WS_CTL, 0, CTL_ZERO_BYTES, stream);
        hipLaunchKernelGGL(k_mega, dim3(grid), dim3(NTHR), LDS_BYTES, stream, a);
        return;
    }
#else
    (void)hipMemsetAsync((char*)d_ws + WS_CTL, 0, CTL_ZERO_BYTES, stream);
    launch_ph<PH_CONV>(a, 0, 0, grid, stream); launch_ph<PH_NORM1>(a, 0, 0, grid, stream);
    for (int l = 0; l < 2; ++l) {
        launch_ph<PH_GEMM_IN>(a, l, 0, grid, stream); if (l == 0) launch_ph<PH_CONVB>(a, 0, 0, grid, stream);
        launch_ph<PH_RWKV_PREP>(a, l, 0, grid, stream); launch_ph<PH_MLA_PREP>(a, l, 0, grid, stream); launch_ph<PH_MLA_PREP2>(a, l, 0, grid, stream); launch_ph<PH_GMLP>(a, l, 0, grid, stream);
        launch_ph<PH_MLA_POST1>(a, l, 0, grid, stream); launch_ph<PH_CHUNK>(a, l, 0, grid, stream);
        launch_ph<PH_SCAN>(a, l, 0, grid, stream); launch_ph<PH_ATTN>(a, l, 0, grid, stream);
        launch_ph<PH_RWKV_OUT>(a, l, 0, grid, stream); launch_ph<PH_POST>(a, l, 0, grid, stream);
        if (l == 0) { launch_ph<PH_GEMM_OUTN>(a, 0, 0, grid, stream); launch_ph<PH_DGU>(a, 0, 0, grid, stream); launch_ph<PH_DDOWN>(a, 0, 0, grid, stream); }
        else { launch_ph<PH_GEMM_OUT>(a, 1, 0, grid, stream);
            launch_ph<PH_NORM2R>(a, 1, 0, grid, stream); launch_ph<PH_SCATTER>(a, 1, 0, grid, stream);
            launch_ph<PH_EGU>(a, 1, 0, grid, stream); launch_ph<PH_EDOWN>(a, 1, 0, grid, stream); launch_ph<PH_EDOWNX>(a, 1, 0, grid, stream);
            launch_ph<PH_EGU>(a, 1, 1, grid, stream); launch_ph<PH_EDOWN>(a, 1, 1, grid, stream);
            launch_ph<PH_COMBINE>(a, 1, 0, grid, stream); }
    }
#endif
}
```
